# Optimizing an MI355X kernel written in HIP

```python
import jax
import jax.numpy as jnp
from jax import lax
import numpy as np


D_MODEL = 1024
BATCH = 4
SEQ = 4096
DEPTH = 1

N_HEADS = 8
N_KV_HEADS = 2
HEAD_DIM = 64
ATTN_WIDTH = N_HEADS * HEAD_DIM
KV_WIDTH = N_KV_HEADS * HEAD_DIM
WINDOW = 128
ATTN_BLOCK = 128
CONV_CH = 512
CONV_WIDTH = 31
Q_END = ATTN_WIDTH
K_END = Q_END + KV_WIDTH
V_END = K_END + KV_WIDTH
CONV_END = V_END + 2 * CONV_CH
IN_WIDTH = CONV_END + 2 * D_MODEL
N_EXPERTS = 32
TOP_K = 4
D_EXPERT = D_MODEL
SWIGLU_ALPHA = 1.702
SWIGLU_LIMIT = 7.0
MOE_BLOCK = 128
LN_EPS = 1e-5
DEEPNORM_ALPHA = (2 * DEPTH) ** 0.25
DEEPNORM_BETA = (8 * DEPTH) ** -0.25

kernel_name = "hybrid_swa_sink_conformer_moe_deepnorm"


def layer_norm(x, g, b):
    xf = x.astype(jnp.float32)
    mu = jnp.mean(xf, axis=-1, keepdims=True)
    var = jnp.mean(jnp.square(xf - mu), axis=-1, keepdims=True)
    y = (xf - mu) * lax.rsqrt(var + LN_EPS) * g.astype(jnp.float32) + b.astype(jnp.float32)
    return y.astype(x.dtype)


def band_mask(n_blocks):
    qi = np.arange(ATTN_BLOCK)[:, None]
    kj = np.arange(2 * ATTN_BLOCK)[None, :]
    delta = qi + ATTN_BLOCK - kj
    band = (delta >= 0) & (delta < WINDOW)
    blk = np.arange(n_blocks)[:, None, None]
    return band[None] & ((blk > 0) | (kj >= ATTN_BLOCK)[None])


def sliding_window_sink_attention(q, k, v, sinks):
    B, S, _ = q.shape
    nb = S // ATTN_BLOCK
    G = N_HEADS // N_KV_HEADS
    qb = q.reshape(B, nb, ATTN_BLOCK, N_KV_HEADS, G, HEAD_DIM)
    kb = k.reshape(B, nb, ATTN_BLOCK, N_KV_HEADS, HEAD_DIM)
    vb = v.reshape(B, nb, ATTN_BLOCK, N_KV_HEADS, HEAD_DIM)
    pad = ((0, 0), (1, 0), (0, 0), (0, 0), (0, 0))
    kk = jnp.concatenate([jnp.pad(kb[:, :-1], pad), kb], axis=2)
    vv = jnp.concatenate([jnp.pad(vb[:, :-1], pad), vb], axis=2)
    s = jnp.einsum('bnqhgd,bnkhd->bnhgqk', qb, kk,
                   preferred_element_type=jnp.float32) * (HEAD_DIM ** -0.5)
    mask = band_mask(nb)
    s = jnp.where(mask[None, :, None, None], s, -1e30)
    sink = sinks.astype(jnp.float32).reshape(N_KV_HEADS, G)[None, None, :, :, None, None]
    sink = jnp.broadcast_to(sink, s.shape[:-1] + (1,))
    p = jax.nn.softmax(jnp.concatenate([s, sink], axis=-1), axis=-1)[..., :-1]
    o = jnp.einsum('bnhgqk,bnkhd->bnqhgd', p.astype(v.dtype), vv)
    return o.reshape(B, S, ATTN_WIDTH)


def conformer_conv(c_in, conv_w, conv_b, ln_g, ln_b, w_br, b_br):
    a = c_in[..., :CONV_CH] * jax.nn.sigmoid(c_in[..., CONV_CH:])
    y = lax.conv_general_dilated(
        a, conv_w[:, None, :].astype(a.dtype), window_strides=(1,),
        padding=[(CONV_WIDTH - 1, 0)], dimension_numbers=('NWC', 'WIO', 'NWC'),
        feature_group_count=CONV_CH) + conv_b
    y = jax.nn.silu(layer_norm(y, ln_g, ln_b))
    return y @ w_br + b_br


def clamped_swiglu(up):
    x_glu = jnp.minimum(up[..., ::2], SWIGLU_LIMIT)
    x_lin = jnp.clip(up[..., 1::2], -SWIGLU_LIMIT, SWIGLU_LIMIT)
    return x_glu * jax.nn.sigmoid(SWIGLU_ALPHA * x_glu) * (x_lin + 1.0)


def moe_ffn(h, w_router, b_router, w_up, b_up, w_down, b_down):
    T, D = h.shape
    logits = (h @ w_router + b_router).astype(jnp.float32)
    top_val, top_idx = lax.top_k(logits, TOP_K)
    gates = jax.nn.softmax(top_val, axis=-1)
    A = T * TOP_K
    e_flat = top_idx.reshape(A)
    tok_flat = jnp.arange(A, dtype=jnp.int32) // TOP_K
    g_flat = gates.reshape(A)
    order = jnp.argsort(e_flat, stable=True)
    e_sorted = e_flat[order]
    counts = jnp.zeros((N_EXPERTS,), jnp.int32).at[e_flat].add(1)
    padded = (counts + MOE_BLOCK - 1) // MOE_BLOCK * MOE_BLOCK
    pad_end = jnp.cumsum(padded)
    pad_start = pad_end - padded
    start = jnp.cumsum(counts) - counts
    rank = jnp.arange(A, dtype=jnp.int32) - start[e_sorted]
    dest = pad_start[e_sorted] + rank
    P = A + N_EXPERTS * MOE_BLOCK
    n_blk = P // MOE_BLOCK
    slot_tok = jnp.zeros((P,), jnp.int32).at[dest].set(tok_flat[order])
    slot_gate = jnp.zeros((P,), jnp.float32).at[dest].set(g_flat[order])
    blk_expert = jnp.minimum(
        jnp.searchsorted(pad_end, jnp.arange(n_blk, dtype=jnp.int32) * MOE_BLOCK, side='right'),
        N_EXPERTS - 1)
    xs = h[slot_tok].reshape(n_blk, MOE_BLOCK, D)

    def expert_block(args):
        xb, e = args
        act = clamped_swiglu(xb @ w_up[e] + b_up[e])
        return act @ w_down[e] + b_down[e]

    ys = lax.map(expert_block, (xs, blk_expert)).reshape(P, D)
    return jnp.zeros_like(h).at[slot_tok].add(ys * slot_gate[:, None].astype(ys.dtype))


def setup_inputs(seed: int = 0) -> dict:
    key = jax.random.key(seed)
    ks = jax.random.split(key, 24)

    def nrm(k, shape, scale):
        return jax.random.normal(k, shape, jnp.float32) * scale

    x = nrm(ks[0], (BATCH, SEQ, D_MODEL), 1.0)
    col_scale = jnp.ones((IN_WIDTH,), jnp.float32).at[K_END:V_END].set(DEEPNORM_BETA)
    w_in = nrm(ks[1], (DEPTH, D_MODEL, IN_WIDTH), D_MODEL ** -0.5) * col_scale
    b_in = nrm(ks[2], (DEPTH, IN_WIDTH), 0.02)
    attn_sinks = nrm(ks[3], (DEPTH, N_HEADS), 0.5)
    w_attn_br = nrm(ks[4], (DEPTH, ATTN_WIDTH, D_MODEL), ATTN_WIDTH ** -0.5 * DEEPNORM_BETA)
    conv_w = nrm(ks[5], (DEPTH, CONV_WIDTH, CONV_CH), CONV_WIDTH ** -0.5)
    conv_b = nrm(ks[6], (DEPTH, CONV_CH), 0.02)
    conv_ln_g = 1.0 + nrm(ks[7], (DEPTH, CONV_CH), 0.02)
    conv_ln_b = nrm(ks[8], (DEPTH, CONV_CH), 0.02)
    w_conv_br = nrm(ks[9], (DEPTH, CONV_CH, D_MODEL), CONV_CH ** -0.5 * DEEPNORM_BETA)
    b_conv_br = nrm(ks[10], (DEPTH, D_MODEL), 0.02)
    w_o = nrm(ks[11], (DEPTH, D_MODEL, D_MODEL), D_MODEL ** -0.5 * DEEPNORM_BETA)
    ln1_g = 1.0 + nrm(ks[12], (DEPTH, D_MODEL), 0.02)
    ln1_b = nrm(ks[13], (DEPTH, D_MODEL), 0.02)
    w_router = nrm(ks[14], (DEPTH, D_MODEL, N_EXPERTS), D_MODEL ** -0.5)
    b_router = nrm(ks[15], (DEPTH, N_EXPERTS), 0.01)
    w_up = nrm(ks[16], (DEPTH, N_EXPERTS, D_MODEL, 2 * D_EXPERT), D_MODEL ** -0.5)
    b_up = nrm(ks[17], (DEPTH, N_EXPERTS, 2 * D_EXPERT), 0.02)
    w_down = nrm(ks[18], (DEPTH, N_EXPERTS, D_EXPERT, D_MODEL), D_EXPERT ** -0.5 * DEEPNORM_BETA)
    b_down = nrm(ks[19], (DEPTH, N_EXPERTS, D_MODEL), 0.02)
    ln2_g = 1.0 + nrm(ks[20], (DEPTH, D_MODEL), 0.02)
    ln2_b = nrm(ks[21], (DEPTH, D_MODEL), 0.02)
    return {"x": x, "w_in": w_in, "b_in": b_in, "attn_sinks": attn_sinks, "w_attn_br": w_attn_br,
            "conv_w": conv_w, "conv_b": conv_b, "conv_ln_g": conv_ln_g, "conv_ln_b": conv_ln_b,
            "w_conv_br": w_conv_br, "b_conv_br": b_conv_br, "w_o": w_o, "ln1_g": ln1_g, "ln1_b": ln1_b,
            "w_router": w_router, "b_router": b_router, "w_up": w_up, "b_up": b_up,
            "w_down": w_down, "b_down": b_down, "ln2_g": ln2_g, "ln2_b": ln2_b}


def reference(x, w_in, b_in, attn_sinks, w_attn_br, conv_w, conv_b, conv_ln_g, conv_ln_b,
              w_conv_br, b_conv_br, w_o, ln1_g, ln1_b, w_router, b_router, w_up, b_up,
              w_down, b_down, ln2_g, ln2_b):
    B, S, D = x.shape
    for l in range(DEPTH):
        u = x @ w_in[l] + b_in[l]
        q = u[..., :Q_END]
        k = u[..., Q_END:K_END]
        v = u[..., K_END:V_END]
        c_in = u[..., V_END:CONV_END]
        gate = jax.nn.sigmoid(u[..., CONV_END:])
        y_attn = sliding_window_sink_attention(q, k, v, attn_sinks[l]) @ w_attn_br[l]
        y_conv = conformer_conv(c_in, conv_w[l], conv_b[l], conv_ln_g[l], conv_ln_b[l],
                                w_conv_br[l], b_conv_br[l])
        merged = gate[..., :D] * y_attn + gate[..., D:] * y_conv
        x = layer_norm(DEEPNORM_ALPHA * x + merged @ w_o[l], ln1_g[l], ln1_b[l])
        h = x.reshape(B * S, D)
        y_moe = moe_ffn(h, w_router[l], b_router[l], w_up[l], b_up[l], w_down[l], b_down[l])
        x = layer_norm(DEEPNORM_ALPHA * x + y_moe.reshape(B, S, D), ln2_g[l], ln2_b[l])
    return x
```

```cpp
#include <hip/hip_runtime.h>
#include <cstdio>
#include <cstdint>

#define GAS __attribute__((address_space(1)))
#define LAS __attribute__((address_space(3)))
typedef unsigned short bf16;
typedef short bf16x8 __attribute__((ext_vector_type(8)));
typedef float f32x4 __attribute__((ext_vector_type(4)));
typedef float f32x2 __attribute__((ext_vector_type(2)));
typedef float f32x16 __attribute__((ext_vector_type(16)));
typedef unsigned u32x4 __attribute__((ext_vector_type(4)));
typedef unsigned u32x2 __attribute__((ext_vector_type(2)));

constexpr int T = 16384, D = 1024, SEQ = 4096, NBATCH = 4;
constexpr int NH = 8, NKV = 2, HD = 64, AW = 512, KVW = 128, CCH = 512, CW = 31;
constexpr int INW = 3840, NE = 32, TOPK = 4, DE = 1024;
constexpr float LN_EPS = 1e-5f;
constexpr float DN_ALPHA = 1.189207115002721f;
constexpr int SLOT_CAP = 16384;
constexpr int MAX_MT = (T * TOPK) / 256 + NE;

constexpr size_t MiB = 1u << 20;
constexpr size_t WS_CTL = 0, CTL_BYTES = 65536;
constexpr int CW_BAR = 4096;
constexpr size_t WS_WIN = 1 * MiB;
constexpr size_t WS_WAB = 9 * MiB;
constexpr size_t WS_WO = 11 * MiB;
constexpr size_t WS_BPERM = 13 * MiB;
constexpr size_t WS_SLOT = 14 * MiB;
constexpr size_t WS_GATE = 16 * MiB;
constexpr size_t WS_LN1S = 17 * MiB;
constexpr size_t WS_WUP = 32 * MiB;
constexpr size_t WS_WDN = 160 * MiB;
constexpr size_t WS_XB = 224 * MiB;
constexpr size_t WS_QB = 256 * MiB;
constexpr size_t WS_KB = 272 * MiB;
constexpr size_t WS_VT = 276 * MiB;
constexpr size_t WS_AB = 792 * MiB;
constexpr size_t WS_GATES = 296 * MiB;
constexpr size_t WS_AY = 360 * MiB;
constexpr size_t WS_MERGED = 392 * MiB;
constexpr size_t WS_HF = 424 * MiB;
constexpr size_t WS_HB = 488 * MiB;
constexpr size_t WS_ACT = 520 * MiB;
constexpr size_t WS_YS = 664 * MiB;
constexpr size_t WS_END = 810 * MiB;
constexpr int AB_PAD = 32, AB_SEQ = SEQ + AB_PAD;

constexpr int LDS_SCR = 135168;
constexpr int MISC_OFF = 135168;
constexpr int MO_LG = 0, MO_SELE = 4224, MO_SELG = 4736, MO_LCNT = 5248, MO_LBASE = 5376, MO_TAB = 5504, MO_BAR = 6016;
constexpr int OFFN_OFF = 147456;
constexpr int LDS_BYTES = 155648;

#define LDS_WAIT() asm volatile("s_waitcnt lgkmcnt(0)" ::: "memory")
#define VM_WAIT() asm volatile("s_waitcnt vmcnt(0)" ::: "memory")

__device__ __forceinline__ unsigned f2bf(float f) { unsigned u = __builtin_bit_cast(unsigned, f); return (u + 0x7fffu + ((u >> 16) & 1u)) >> 16; }
__device__ __forceinline__ unsigned pk2(float lo, float hi) { return f2bf(lo) | (f2bf(hi) << 16); }
__device__ __forceinline__ float bf2f(unsigned b) { return __builtin_bit_cast(float, b << 16); }
__device__ __forceinline__ float bflo(unsigned w) { return __builtin_bit_cast(float, w << 16); }
__device__ __forceinline__ float bfhi(unsigned w) { return __builtin_bit_cast(float, w & 0xffff0000u); }
typedef __bf16 bf16x2_t __attribute__((ext_vector_type(2)));
__device__ __forceinline__ unsigned cvt_pk_bf16(float lo, float hi) { const f32x2 v = {lo, hi}; return __builtin_bit_cast(unsigned, __builtin_convertvector(v, bf16x2_t)); }
__device__ __forceinline__ float sigmoidf_(float x) { return __builtin_amdgcn_rcpf(1.0f + __expf(-x)); }
#define DPP_ADD(v, ctrl) ((v) + __builtin_bit_cast(float, __builtin_amdgcn_update_dpp(0, __builtin_bit_cast(int, (v)), (ctrl), 0xf, 0xf, true)))
__device__ __forceinline__ float wave_sum(float v) {
    v = DPP_ADD(v, 0xB1);
    v = DPP_ADD(v, 0x4E);
    v = DPP_ADD(v, 0x141);
    v = DPP_ADD(v, 0x140);
    const int vi = __builtin_bit_cast(int, v);
    const float r0 = __builtin_bit_cast(float, __builtin_amdgcn_readlane(vi, 0)), r1 = __builtin_bit_cast(float, __builtin_amdgcn_readlane(vi, 16));
    const float r2 = __builtin_bit_cast(float, __builtin_amdgcn_readlane(vi, 32)), r3 = __builtin_bit_cast(float, __builtin_amdgcn_readlane(vi, 48));
    return (r0 + r1) + (r2 + r3);
}
template <class V> __device__ __forceinline__ V ldgo(const void* base, unsigned off) { return *(const V*)((const char*)base + off); }
#define PIN10(a) asm volatile("" : "+v"((a)[0]), "+v"((a)[1]), "+v"((a)[2]), "+v"((a)[3]), "+v"((a)[4]), "+v"((a)[5]), "+v"((a)[6]), "+v"((a)[7]), "+v"((a)[8]), "+v"((a)[9]))

struct Args { const float* in[22]; float* out; unsigned char* ws; int ph_lo, ph_hi; };
enum { I_X = 0, I_WIN, I_BIN, I_SINK, I_WATT, I_CONVW, I_CONVB, I_CLNG, I_CLNB, I_WCONV, I_BCONV, I_WO, I_LN1G, I_LN1B, I_WR, I_BR, I_WUP, I_BUP, I_WDN, I_BDN, I_LN2G, I_LN2B };
constexpr int CVI_UP = NE * 64, CVI_DN = NE * 32, CVI_ITEMS = CVI_UP + CVI_DN;
__device__ __forceinline__ void cvi_decode(const Args& a, int it, const float*& src, unsigned char*& dst, int& nw) {
    if (it < CVI_UP) { const int e = it >> 6, kg = it & 63; nw = 2048; src = a.in[I_WUP] + ((size_t)e * 1024 + 16 * kg) * 2048; dst = a.ws + WS_WUP + (size_t)e * 2048 * 1024 + (size_t)kg * 2048 * 16; }
    else { const int r = it - CVI_UP, e = r >> 5, kg2 = r & 31; nw = 1024; src = a.in[I_WDN] + ((size_t)e * 1024 + 32 * kg2) * 1024; dst = a.ws + WS_WDN + (size_t)e * 1024 * 1024 + (size_t)kg2 * 2 * 1024 * 16; }
}
__device__ __forceinline__ void cvi_slice_ptrs(const Args& a, int it, int wave, int lane, const float*& sp, unsigned& pitch, unsigned char*& dp) {
    const float* src; unsigned char* dst; int nw; cvi_decode(a, it, src, dst, nw);
    const int g = nw == 2048 ? 0 : (wave >> 2), cw = nw == 2048 ? wave : (wave & 3);
    sp = src + (size_t)(16 * g) * nw + 256 * cw + 4 * lane; pitch = (unsigned)nw;
    dp = dst + ((size_t)g * nw + 256 * cw + 4 * lane) * 16;
}
__device__ __forceinline__ void cvi_slice_load(const float* sp, unsigned pitch, f32x4 (&r)[16]) {
#pragma unroll
    for (int kk = 0; kk < 16; ++kk) r[kk] = __builtin_nontemporal_load((const f32x4*)(sp + (size_t)kk * pitch));
}
__device__ __forceinline__ void cvi_slice_out(unsigned char* dp, f32x4 (&r)[16]) {
    asm volatile("" : "+v"(r[0]), "+v"(r[1]), "+v"(r[2]), "+v"(r[3]), "+v"(r[4]), "+v"(r[5]), "+v"(r[6]), "+v"(r[7]), "+v"(r[8]), "+v"(r[9]), "+v"(r[10]), "+v"(r[11]), "+v"(r[12]), "+v"(r[13]), "+v"(r[14]), "+v"(r[15]));
#pragma unroll
    for (int j = 0; j < 4; ++j) { unsigned w[4];
#pragma unroll
        for (int c = 0; c < 4; ++c) { unsigned x = 0u; x = __builtin_amdgcn_cvt_pk_fp8_f32(r[4 * c][j] * 64.0f, r[4 * c + 1][j] * 64.0f, x, false);
            x = __builtin_amdgcn_cvt_pk_fp8_f32(r[4 * c + 2][j] * 64.0f, r[4 * c + 3][j] * 64.0f, x, true); w[c] = x; }
        *(u32x4*)(dp + 16 * j) = (u32x4){w[0], w[1], w[2], w[3]}; }
}
__device__ __forceinline__ void side_convert(const Args& a, int bx, int G, int wave, int lane) {
    int base, nit;
    if (G == 256) { base = bx < 192 ? 11 * bx : 2112 + 15 * (bx - 192); nit = bx < 192 ? 11 : 15; }
    else { const int per = (CVI_ITEMS + G - 1) / G; base = bx * per; nit = base >= CVI_ITEMS ? 0 : (CVI_ITEMS - base < per ? CVI_ITEMS - base : per); }
    const int end = base + nit;
    f32x4 r0[16], r1[16];
    const float* sp0; const float* sp1; unsigned p0 = 0, p1 = 0; unsigned char* d0; unsigned char* d1;
    if (nit > 0) { cvi_slice_ptrs(a, base, wave, lane, sp0, p0, d0); cvi_slice_load(sp0, p0, r0); }
    if (nit > 1) { cvi_slice_ptrs(a, base + 1, wave, lane, sp1, p1, d1); cvi_slice_load(sp1, p1, r1); }
#pragma unroll 1
    for (int it0 = base; it0 < end; it0 += 2) {
        const int it1 = it0 + 1;
        { unsigned char* dcur = d0; cvi_slice_out(dcur, r0); if (it0 + 2 < end) { cvi_slice_ptrs(a, it0 + 2, wave, lane, sp0, p0, d0); cvi_slice_load(sp0, p0, r0); } }
        if (it1 >= end) break;
        { unsigned char* dcur = d1; cvi_slice_out(dcur, r1); if (it1 + 2 < end) { cvi_slice_ptrs(a, it1 + 2, wave, lane, sp1, p1, d1); cvi_slice_load(sp1, p1, r1); } }
    }
}

namespace pg8 {
constexpr int BM = 256, BK = 64, HALF = 128, HTB = HALF * BK * 2, STAGE_BYTES = 8 * HTB, NXCD = 8, WGM = 8;
constexpr int KD = 1024, NT_K = KD / BK;
__host__ __device__ __forceinline__ int lds_byte(int r, int c) { const int st = (r >> 4) * 2 + (c >> 5), rr = r & 15, cc = c & 31, ob = rr * 64 + cc * 2; return st * 1024 + (ob ^ (((ob >> 9) & 1) << 5)); }
__host__ __device__ __forceinline__ void stage_rc(int b, int& R, int& C) { const int st = b / 1024, sb = b % 1024, swz = sb ^ (((sb >> 9) & 1) << 5); R = (st >> 1) * 16 + swz / 64; C = (st & 1) * 32 + (swz % 64) / 2; }
__host__ __device__ __forceinline__ int perm32(int rho) { const int n = rho >> 4, i = rho & 15; return 8 * (i >> 2) + 4 * n + (i & 3); }

struct Unit { const char* A; const char* B; int pm, pn, e, mt, cnt, type; };

struct DenseOrder {
    const char* Ab; const char* Bb; int nM, nN, nwg, G, c, i0 = 0, i1 = 1 << 20; static constexpr int rowb = KD * 2; static constexpr bool PARK = false, FUSED = false;
    __device__ __forceinline__ unsigned boff(int Rb, int C) const { return (unsigned)(Rb * rowb + C * 2); }
    __device__ __forceinline__ size_t bstep_k() const { return 128; }
    __device__ __forceinline__ size_t bstep_h() const { return (size_t)HALF * rowb; }
    __device__ void init(const void* A, const void* B, int M, int N, int G_, int c_) { Ab = (const char*)A; Bb = (const char*)B; nM = M / BM; nN = N / BM; nwg = nM * nN; G = G_; c = c_; }
    __device__ __forceinline__ bool next(int i, Unit& u) const {
        if (i + i0 >= i1) return false;
        const long L = (long)(i + i0) * G + c; if (L >= nwg) return false;
        int wgid = (int)L; { const int q = nwg / NXCD, r = nwg % NXCD, xcd = wgid % NXCD, off = wgid / NXCD; wgid = (xcd < r ? xcd * (q + 1) : r * (q + 1) + (xcd - r) * q) + off; }
        const int nig = WGM * nN, gid = wgid / nig, fm = gid * WGM, gsz = (nM - fm) < WGM ? (nM - fm) : WGM;
        u.pm = fm + ((wgid % nig) % gsz); u.pn = (wgid % nig) / gsz; u.e = 0; u.mt = 0; u.cnt = 0; u.type = 0;
        u.A = Ab + (size_t)u.pm * (BM * KD * 2); u.B = Bb + (size_t)u.pn * (BM * KD * 2); return true;
    }
    __device__ __forceinline__ void offsets(const Unit&, const int (&R)[2], const int (&C)[2], unsigned (&off)[2][2]) const {
#pragma unroll
        for (int h = 0; h < 2; ++h)
#pragma unroll
            for (int i = 0; i < 2; ++i) off[h][i] = (unsigned)(((h * HALF + R[i]) * KD + C[i]) * 2);
    }
};
struct MoeOrder {
    const LAS int* tab; int NTN, G, c, total; const char* Ab; const char* Bb; size_t bexp; const int* slot; bool gather; int rowb;
    static constexpr bool PARK = true, FUSED = false;
    int bn16;
    __device__ __forceinline__ unsigned boff(int Rb, int C) const { return (unsigned)((C >> 3) * bn16 + Rb * 16); }
    __device__ __forceinline__ size_t bstep_k() const { return (size_t)8 * bn16; }
    __device__ __forceinline__ size_t bstep_h() const { return (size_t)HALF * 16; }
    __device__ __forceinline__ bool next(int i, Unit& u) const {
        const int L = i * G + c; if (L >= total) return false;
        int e = 0;
        for (int j = 1; j < NE; ++j) e += (L >= NTN * tab[64 + j]) ? 1 : 0;
        e = __builtin_amdgcn_readfirstlane(e);
        const int ms = __builtin_amdgcn_readfirstlane(tab[64 + e]), ml = __builtin_amdgcn_readfirstlane(tab[32 + e]);
        const int r = L - NTN * ms; const int nt = r / ml, mt = r - nt * ml;
        u.e = e; u.mt = mt; u.cnt = __builtin_amdgcn_readfirstlane(tab[e]); u.pm = ms + mt; u.pn = nt; u.type = 0;
        u.A = gather ? Ab : Ab + (size_t)u.pm * (size_t)(BM * rowb);
        u.B = Bb + (size_t)e * bexp + (size_t)nt * (size_t)(BM * 16); return true;
    }
    __device__ __forceinline__ void offsets(const Unit& u, const int (&R)[2], const int (&C)[2], unsigned (&off)[2][2]) const {
#pragma unroll
        for (int h = 0; h < 2; ++h)
#pragma unroll
            for (int i = 0; i < 2; ++i) {
                if (gather) { const int idx = u.mt * BM + h * HALF + R[i]; const int idc = idx < u.cnt ? idx : u.cnt - 1; int tok = slot[u.e * SLOT_CAP + idc] >> 2; tok = idx < u.cnt ? tok : 0; off[h][i] = (unsigned)(tok * rowb + C[i] * 2); }
                else off[h][i] = (unsigned)((h * HALF + R[i]) * rowb + C[i] * 2);
            }
    }
};


#define GAS_U32 __attribute__((address_space(1))) unsigned
struct MoeFusedOrder {
    const LAS int* tab; int G, c, total6, total7; const char* hb; const char* act; const char* wup; const char* wdn; const int* slot; unsigned* cnt; unsigned* tmo;
    static constexpr bool PARK = true, FUSED = true; static constexpr int rowb = 1024;
    __device__ __forceinline__ unsigned boff_t(int type, int R, int C) const {
        const int rs = 64 * (R >> 5) + 32 * ((R >> 2) & 1) + 16 * ((R >> 3) & 1) + 4 * ((R >> 4) & 1) + (R & 3), rb = (R & ~31) + perm32(R & 31);
        return type ? (unsigned)((C >> 3) * (1024 * 16) + rb * 16) : (unsigned)((C >> 3) * (2048 * 16) + rs * 16); }
    __device__ __forceinline__ unsigned boff(int R, int C) const { return boff_t(0, R, C); }
    __device__ __forceinline__ size_t bstep_kt(int type) const { return (size_t)8 * (type ? 1024 * 16 : 2048 * 16); }
    __device__ __forceinline__ size_t bstep_ht(int type) const { return type ? (size_t)HALF * 16 : (size_t)8 * 16; }
    __device__ __forceinline__ size_t bstep_k() const { return bstep_kt(0); }
    __device__ __forceinline__ size_t bstep_h() const { return bstep_ht(0); }
    __device__ __forceinline__ bool next(int i, Unit& u) const {
        int L = i * G + c; if (L >= total6 + total7) return false;
        const int type = L >= total6 ? 1 : 0; L -= type ? total6 : 0; const int NTN = type ? 4 : 8;
        int e = 0;
        for (int j = 1; j < NE; ++j) e += (L >= NTN * tab[64 + j]) ? 1 : 0;
        e = __builtin_amdgcn_readfirstlane(e);
        const int ms = __builtin_amdgcn_readfirstlane(tab[64 + e]), ml = __builtin_amdgcn_readfirstlane(tab[32 + e]);
        const int r = L - NTN * ms; const int nt = r / ml, mt = r - nt * ml;
        u.e = e; u.mt = mt; u.cnt = __builtin_amdgcn_readfirstlane(tab[e]); u.pm = ms + mt; u.pn = nt; u.type = type;
        u.A = type ? act + (size_t)u.pm * (size_t)(BM * rowb) : hb;
        u.B = (type ? wdn + (size_t)e * 1024 * 1024 : wup + (size_t)e * 2048 * 1024) + (size_t)nt * (size_t)(BM * 16); return true;
    }
    __device__ __forceinline__ void offsets(const Unit& u, const int (&R)[2], const int (&C)[2], unsigned (&off)[2][2]) const {
        if (u.type == 0) { int tok[2][2];
#pragma unroll
            for (int h = 0; h < 2; ++h)
#pragma unroll
                for (int i = 0; i < 2; ++i) { const int idx = u.mt * BM + h * HALF + R[i]; tok[h][i] = slot[u.e * SLOT_CAP + (idx < u.cnt ? idx : u.cnt - 1)]; }
#pragma unroll
            for (int h = 0; h < 2; ++h)
#pragma unroll
                for (int i = 0; i < 2; ++i) { const int idx = u.mt * BM + h * HALF + R[i]; const int t = idx < u.cnt ? (tok[h][i] >> 2) : 0; off[h][i] = (unsigned)(t * rowb + C[i] * 2); }
        } else {
#pragma unroll
            for (int h = 0; h < 2; ++h)
#pragma unroll
                for (int i = 0; i < 2; ++i) off[h][i] = (unsigned)((h * HALF + R[i]) * rowb + C[i] * 2);
        }
    }
    __device__ __forceinline__ void a_ready(const Unit& u) const {
        if (u.type) {
            if (threadIdx.x < 64) { const unsigned* p = cnt + 16 * u.pm; unsigned v, spins = 0u;
                for (;;) { asm volatile("global_load_dword %0, %1, off sc1\n\ts_waitcnt vmcnt(0)" : "=&v"(v) : "v"(p) : "memory");
                    if ((unsigned)__builtin_amdgcn_readfirstlane(v) >= 64u) break;
                    __builtin_amdgcn_s_sleep(2);
                    if (++spins > (1u << 20)) { if (threadIdx.x == 0) __hip_atomic_store(tmo, 1u, __ATOMIC_RELAXED, __HIP_MEMORY_SCOPE_AGENT); break; } }
                }
            asm volatile("" ::: "memory"); __builtin_amdgcn_s_barrier(); asm volatile("" ::: "memory");
        }
    }
    __device__ __forceinline__ void done(const Unit& u) const {
        if (u.type == 0) { asm volatile("s_waitcnt vmcnt(0)" ::: "memory");
            if ((threadIdx.x & 63) == 0) __hip_atomic_fetch_add(cnt + 16 * u.pm, 1u, __ATOMIC_RELAXED, __HIP_MEMORY_SCOPE_AGENT); }
    }
};

typedef f32x4 Acc[2][2][4][2];

typedef int i32x8 __attribute__((ext_vector_type(8)));
struct u32x4x2 { u32x4 a, b; };
template <class Epi, class Sched, bool FP8 = false>
__device__ __forceinline__ void gemm_phase(LAS unsigned char* lds, const Sched& S, const Epi& E) {
    const int tid = threadIdx.x, wid = __builtin_amdgcn_readfirstlane(tid >> 6), lane = tid & 63, wr = wid >> 2, wc = wid & 3, fr = lane & 15, fq = lane >> 4;
    constexpr int ROWB = FP8 ? KD : KD * 2, nt = FP8 ? KD / 128 : NT_K;
    int sR[2], sC[2], sRb[2]; unsigned voffB[2];
#pragma unroll
    for (int i = 0; i < 2; ++i) { int R, C; stage_rc(tid * 16 + i * 8192, R, C); sR[i] = R; sC[i] = C; const int Rb = Epi::PERM ? ((R & ~31) + perm32(R & 31)) : R; sRb[i] = Rb; voffB[i] = S.boff(Rb, C); }
    constexpr size_t kstep = (size_t)(BK * 2);
    size_t kstepB = S.bstep_k(), kstepBn = kstepB, hstepB = S.bstep_h(), hstepBn = hstepB;
    const unsigned ldsw = (unsigned)wid * 1024u;
    const int aoff = lds_byte(wr * 64 + fr, fq * 8), boff = lds_byte(wc * 32 + fr, fq * 8);
    constexpr int KST = 1024;
#define PG8_SA(b, h) (((b) * 2 + (h)) * HTB)
#define PG8_SB(b, h) ((4 + (b) * 2 + (h)) * HTB)
#define PG8_STAGE(bufoff, gbase, voff) do { const char* _gb = (const char*)(gbase); asm volatile("" : "+s"(_gb));     \
        _Pragma("unroll") for (int _i = 0; _i < 2; ++_i) \
        __builtin_amdgcn_global_load_lds((const unsigned*)(_gb + (voff)[_i]), (LAS unsigned*)(lds + (bufoff) + ldsw + _i * 8192), 16, 0, 0); } while (0)
#define PG8_STAGE_A(bufoff, gbase, voff) do { const char* _gb = (const char*)(gbase); asm volatile("" : "+s"(_gb)); \
        _Pragma("unroll") for (int _i = 0; _i < 2; ++_i) \
        __builtin_amdgcn_global_load_lds((const unsigned*)(_gb + (voff)[_i]), (LAS unsigned*)(lds + (bufoff) + ldsw + _i * 8192), 16, 0, 0); } while (0)
#define PG8_LDA(dst, b, h) do { _Pragma("unroll") for (int m = 0; m < 4; ++m) _Pragma("unroll") for (int k = 0; k < 2; ++k) dst[m][k] = *(const LAS bf16x8*)(lds + PG8_SA(b, h) + aoff + m * 2048 + k * KST); } while (0)
#define PG8_LDB(dst, b, h) do { _Pragma("unroll") for (int n = 0; n < 2; ++n) _Pragma("unroll") for (int k = 0; k < 2; ++k) dst[n][k] = *(const LAS bf16x8*)(lds + PG8_SB(b, h) + boff + n * 2048 + k * KST); } while (0)
#define PG8_CAT(x) __builtin_bit_cast(i32x8, (u32x4x2){__builtin_bit_cast(u32x4, (x)[0]), __builtin_bit_cast(u32x4, (x)[1])})
#define PG8_MMA(ai, bj, At, Bt) do { __builtin_amdgcn_s_setprio(1); \
        if constexpr (FP8) { _Pragma("unroll") for (int m = 0; m < 4; ++m) _Pragma("unroll") for (int n = 0; n < 2; ++n) \
            acc[ai][bj][m][n] = __builtin_amdgcn_mfma_scale_f32_16x16x128_f8f6f4(PG8_CAT(Bt[n]), PG8_CAT(At[m]), acc[ai][bj][m][n], 0, 0, 0, Epi::SCALE_B, 0, Epi::SCALE_A); } \
        else { _Pragma("unroll") for (int m = 0; m < 4; ++m) _Pragma("unroll") for (int n = 0; n < 2; ++n) _Pragma("unroll") for (int k = 0; k < 2; ++k) \
            acc[ai][bj][m][n] = __builtin_amdgcn_mfma_f32_16x16x32_bf16(Bt[n][k], At[m][k], acc[ai][bj][m][n], 0, 0, 0); } \
        __builtin_amdgcn_s_setprio(0); } while (0)
#define PG8_WAIT_V(n) asm volatile("s_waitcnt vmcnt(" #n ")" ::: "memory")
#define PG8_WAIT_L(n) asm volatile("s_waitcnt lgkmcnt(" #n ")" ::: "memory")
#define PG8_BAR __builtin_amdgcn_s_barrier()
#define PG8_SCHED __builtin_amdgcn_sched_barrier(0)
    Unit cur, nxt; int ui = 0;
    if (!S.next(0, cur)) return;
    Acc acc;
    bf16x8 At[4][2], B0[2][2], B1[2][2];
    unsigned offA[2][2], offN[2][2];
    S.offsets(cur, sR, sC, offA);
    if constexpr (Sched::FUSED) { kstepB = S.bstep_kt(cur.type); hstepB = S.bstep_ht(cur.type);
#pragma unroll
        for (int i = 0; i < 2; ++i) voffB[i] = S.boff_t(cur.type, sR[i], sC[i]); }
    const char* cA = cur.A; const char* cB = cur.B;
    PG8_STAGE(PG8_SB(0, 0), cB, voffB); PG8_STAGE(PG8_SB(0, 1), cB + hstepB, voffB); PG8_STAGE_A(PG8_SA(0, 0), cA, offA[0]); PG8_STAGE_A(PG8_SA(0, 1), cA, offA[1]);
    if (wr == 1) PG8_BAR;
    PG8_WAIT_V(2); PG8_BAR;
    PG8_STAGE(PG8_SB(1, 0), cB + kstepB, voffB); PG8_STAGE_A(PG8_SA(1, 0), cA + kstep, offA[0]); PG8_STAGE(PG8_SB(1, 1), cB + hstepB + kstepB, voffB);
    PG8_WAIT_V(6); PG8_BAR;
    for (;;) {
#pragma unroll
        for (int a = 0; a < 2; ++a)
#pragma unroll
            for (int b = 0; b < 2; ++b)
#pragma unroll
                for (int m = 0; m < 4; ++m)
#pragma unroll
                    for (int n = 0; n < 2; ++n) acc[a][b][m][n] = (f32x4){0.f, 0.f, 0.f, 0.f};
        const bool has_next = S.next(ui + 1, nxt);
        const char* nA = has_next ? nxt.A : cA; const char* nB = has_next ? nxt.B : cB;
        if constexpr (Sched::FUSED) { kstepBn = has_next ? S.bstep_kt(nxt.type) : kstepB; hstepBn = has_next ? S.bstep_ht(nxt.type) : hstepB; }
        if (has_next) S.offsets(nxt, sR, sC, offN);
        else {
#pragma unroll
            for (int h = 0; h < 2; ++h)
#pragma unroll
                for (int i = 0; i < 2; ++i) offN[h][i] = offA[h][i];
        }
        if constexpr (Sched::PARK) *(LAS u32x4*)(lds + OFFN_OFF + tid * 16) = (u32x4){offN[0][0], offN[0][1], offN[1][0], offN[1][1]};
#pragma unroll 1
        for (int t = 0; t < nt; t += 2) {
            const bool last = (t == nt - 2);
            const char* a1 = cA + (size_t)(t + 1) * kstep;
            const char* a2 = last ? nA : cA + (size_t)(t + 2) * kstep; const char* b2 = last ? nB : cB + (size_t)(t + 2) * kstepB;
            const char* a3 = a2 + kstep; const char* b3 = b2 + (last ? kstepBn : kstepB); const size_t hB = last ? hstepBn : hstepB;
            if constexpr (Sched::FUSED) { if (last && has_next) S.a_ready(nxt); }
            if constexpr (Epi::MID_T > 0) { if (t == Epi::MID_T) E.mid(acc, cur, wr, wc, fr, fq); }
            PG8_LDB(B0, 0, 0); PG8_LDB(B1, 0, 1); PG8_SCHED; PG8_LDA(At, 0, 0); PG8_STAGE_A(PG8_SA(1, 1), a1, offA[1]);
            PG8_WAIT_V(8); PG8_WAIT_L(0); PG8_BAR; PG8_MMA(0, 0, At, B0); PG8_MMA(0, 1, At, B1);
            asm volatile("" : "+v"(acc[0][0][0][0]), "+v"(acc[0][0][0][1]), "+v"(acc[0][0][1][0]), "+v"(acc[0][0][1][1]), "+v"(acc[0][0][2][0]), "+v"(acc[0][0][2][1]), "+v"(acc[0][0][3][0]), "+v"(acc[0][0][3][1]));
            asm volatile("" : "+v"(acc[0][1][0][0]), "+v"(acc[0][1][0][1]), "+v"(acc[0][1][1][0]), "+v"(acc[0][1][1][1]), "+v"(acc[0][1][2][0]), "+v"(acc[0][1][2][1]), "+v"(acc[0][1][3][0]), "+v"(acc[0][1][3][1]));
            PG8_BAR; PG8_SCHED;
            if (last) {
                if constexpr (Sched::FUSED) { if (has_next) {
#pragma unroll
                    for (int i = 0; i < 2; ++i) voffB[i] = S.boff_t(nxt.type, sR[i], sC[i]); } }
                if constexpr (Sched::PARK) { const u32x4 pk = *(const LAS u32x4*)(lds + OFFN_OFF + tid * 16); offA[0][0] = pk.x; offA[0][1] = pk.y; offA[1][0] = pk.z; offA[1][1] = pk.w; }
                else {
#pragma unroll
                    for (int h = 0; h < 2; ++h)
#pragma unroll
                        for (int i = 0; i < 2; ++i) offA[h][i] = offN[h][i];
                }
            }
            PG8_LDA(At, 0, 1); PG8_STAGE(PG8_SB(0, 0), b2, voffB); PG8_STAGE(PG8_SB(0, 1), b2 + hB, voffB); PG8_STAGE_A(PG8_SA(0, 0), a2, offA[0]);
            PG8_WAIT_V(8); PG8_WAIT_L(0); PG8_BAR; PG8_MMA(1, 0, At, B0); PG8_MMA(1, 1, At, B1); PG8_BAR; PG8_SCHED;
            PG8_LDB(B0, 1, 0); PG8_LDB(B1, 1, 1); PG8_SCHED; PG8_LDA(At, 1, 0); PG8_STAGE_A(PG8_SA(0, 1), a2, offA[1]);
            PG8_WAIT_V(8); PG8_WAIT_L(0); PG8_BAR; PG8_MMA(0, 0, At, B0); PG8_MMA(0, 1, At, B1); PG8_BAR; PG8_SCHED;
            PG8_LDA(At, 1, 1); PG8_STAGE(PG8_SB(1, 0), b3, voffB); PG8_STAGE(PG8_SB(1, 1), b3 + hB, voffB); PG8_STAGE_A(PG8_SA(1, 0), a3, offA[0]);
            PG8_WAIT_V(8); PG8_WAIT_L(0); PG8_BAR; PG8_MMA(1, 0, At, B0); PG8_MMA(1, 1, At, B1); PG8_BAR; PG8_SCHED;
        }
        if (wr == 0) PG8_BAR;
        E(acc, cur, wr, wc, fr, fq);
        if constexpr (Sched::FUSED) S.done(cur);
        __builtin_amdgcn_s_waitcnt(0x0F70);
        if (!has_next) break;
        cur = nxt; cA = nA; cB = nB; kstepB = kstepBn; hstepB = hstepBn; ++ui;
        if (wr == 1) PG8_BAR;
    }
    PG8_WAIT_V(0);
    PG8_BAR;
#undef PG8_SA
#undef PG8_SB
#undef PG8_STAGE
#undef PG8_STAGE_A
#undef PG8_LDA
#undef PG8_LDB
#undef PG8_MMA
#undef PG8_WAIT_V
#undef PG8_WAIT_L
#undef PG8_BAR
#undef PG8_SCHED
}

#define EPI_SEED(r, c) asm volatile("" : "+v"(r), "+v"(c))
template <class V> __device__ __forceinline__ V ldg(const void* base, unsigned off) { return *(const V*)((const char*)base + off); }
template <class V> __device__ __forceinline__ void stg(void* base, unsigned off, V v) { *(V*)((char*)base + off) = v; }
__device__ __forceinline__ u32x4 pack8(const f32x4 v0, const f32x4 v1) { u32x4 w; w.x = cvt_pk_bf16(v0[0], v0[1]); w.y = cvt_pk_bf16(v0[2], v0[3]); w.z = cvt_pk_bf16(v1[0], v1[1]); w.w = cvt_pk_bf16(v1[2], v1[3]); return w; }

struct EpiU {
    static constexpr int SCALE_B = 0, SCALE_A = 0;
    static constexpr bool PERM = true; static constexpr int MID_T = 0;
    bf16 *q, *k, *vT, *ab, *gates; const float* bias;
    __device__ __forceinline__ void mid(Acc&, const Unit&, int, int, int, int) const {}
    __device__ __forceinline__ void operator()(const Acc& acc, const Unit& u, int wr, int wc, int fr, int fq) const {
        int rl = wr * 64 + fr, cl = wc * 32 + 8 * fq; EPI_SEED(rl, cl);
        const int row0 = u.pm * BM + rl, pn = u.pn;
        f32x4 bv[2][2];
#pragma unroll
        for (int bj = 0; bj < 2; ++bj)
#pragma unroll
            for (int n = 0; n < 2; ++n) bv[bj][n] = ldg<f32x4>(bias, (unsigned)(pn * BM + bj * HALF + cl + 4 * n) * 4u);
        if (pn < 2) {
            const unsigned o0 = ((unsigned)row0 * AW + pn * BM + cl) * 2u;
#pragma unroll
            for (int ai = 0; ai < 2; ++ai)
#pragma unroll
                for (int m = 0; m < 4; ++m)
#pragma unroll
                    for (int bj = 0; bj < 2; ++bj)
                        stg<u32x4>(q, o0 + (unsigned)((ai * HALF + m * 16) * AW + bj * HALF) * 2u, pack8((acc[ai][bj][m][0] + bv[bj][0]) * 0.125f, (acc[ai][bj][m][1] + bv[bj][1]) * 0.125f));
        } else if (pn == 2) {
            const unsigned o0 = ((unsigned)row0 * KVW + cl) * 2u;
            const int b = row0 >> 12, s0 = row0 & (SEQ - 1);
#pragma unroll
            for (int ai = 0; ai < 2; ++ai)
#pragma unroll
                for (int m = 0; m < 4; ++m) {
                    stg<u32x4>(k, o0 + (unsigned)((ai * HALF + m * 16) * KVW) * 2u, pack8(acc[ai][0][m][0] + bv[0][0], acc[ai][0][m][1] + bv[0][1]));
#pragma unroll
                    for (int n = 0; n < 2; ++n) { const f32x4 v = acc[ai][1][m][n] + bv[1][n];
#pragma unroll
                        for (int j = 0; j < 4; ++j) { const int col = cl + 4 * n + j, kvh = col >> 6, dim = col & 63;
                            stg<bf16>(vT, (unsigned)(((b * NKV + kvh) * HD + dim) * SEQ + s0 + ai * HALF + m * 16) * 2u, (bf16)f2bf(v[j])); } } }
        } else if (pn < 7) {
            const unsigned o0 = ((unsigned)(row0 + AB_PAD * ((row0 >> 12) + 1)) * CCH + (pn - 3) * HALF + cl) * 2u;
#pragma unroll
            for (int ai = 0; ai < 2; ++ai)
#pragma unroll
                for (int m = 0; m < 4; ++m) { f32x4 o[2];
#pragma unroll
                    for (int n = 0; n < 2; ++n) { const f32x4 a = acc[ai][0][m][n] + bv[0][n], g = acc[ai][1][m][n] + bv[1][n];
#pragma unroll
                        for (int j = 0; j < 4; ++j) o[n][j] = a[j] * sigmoidf_(g[j]); }
                    stg<u32x4>(ab, o0 + (unsigned)((ai * HALF + m * 16) * CCH) * 2u, pack8(o[0], o[1])); }
        } else {
            const unsigned o0 = ((unsigned)row0 * 2048 + (pn - 7) * HALF + cl) * 2u;
#pragma unroll
            for (int ai = 0; ai < 2; ++ai)
#pragma unroll
                for (int m = 0; m < 4; ++m) { f32x4 ra[2], gb[2];
#pragma unroll
                    for (int n = 0; n < 2; ++n) { const f32x4 va = acc[ai][0][m][n] + bv[0][n], vb = acc[ai][1][m][n] + bv[1][n];
#pragma unroll
                        for (int j = 0; j < 4; ++j) { const float sb = sigmoidf_(vb[j]); gb[n][j] = sb; ra[n][j] = sigmoidf_(va[j]) * __builtin_amdgcn_rcpf(sb); } }
                    stg<u32x4>(gates, o0 + (unsigned)((ai * HALF + m * 16) * 2048) * 2u, pack8(ra[0], ra[1]));
                    stg<u32x4>(gates, o0 + (unsigned)((ai * HALF + m * 16) * 2048 + 1024) * 2u, pack8(gb[0], gb[1])); }
        }
    }
};
struct EpiMerged {
    static constexpr int SCALE_B = 0, SCALE_A = 0;
    static constexpr bool PERM = true; static constexpr int MID_T = 8;
    const bf16* gates; const float* bc; bf16* merged;
    __device__ __forceinline__ void mid(Acc& acc, const Unit& u, int wr, int wc, int fr, int fq) const {
        int rl = wr * 64 + fr, cl = wc * 32 + 8 * fq; EPI_SEED(rl, cl);
        const unsigned g0 = ((unsigned)(u.pm * BM + rl) * 2048 + u.pn * BM + cl) * 2u;
#pragma unroll
        for (int ai = 0; ai < 2; ++ai) { u32x4 rt[4][2];
#pragma unroll
            for (int m = 0; m < 4; ++m)
#pragma unroll
                for (int bj = 0; bj < 2; ++bj) rt[m][bj] = ldg<u32x4>(gates, g0 + (unsigned)((ai * HALF + m * 16) * 2048 + bj * HALF) * 2u);
            __builtin_amdgcn_sched_barrier(0);
#pragma unroll
            for (int m = 0; m < 4; ++m)
#pragma unroll
                for (int bj = 0; bj < 2; ++bj)
#pragma unroll
                    for (int n = 0; n < 2; ++n) { acc[ai][bj][m][n][0] *= bflo(rt[m][bj][2 * n]); acc[ai][bj][m][n][1] *= bfhi(rt[m][bj][2 * n]); acc[ai][bj][m][n][2] *= bflo(rt[m][bj][2 * n + 1]); acc[ai][bj][m][n][3] *= bfhi(rt[m][bj][2 * n + 1]); }
            __builtin_amdgcn_sched_barrier(0); }
    }
    __device__ __forceinline__ void operator()(const Acc& acc, const Unit& u, int wr, int wc, int fr, int fq) const {
        int rl = wr * 64 + fr, cl = wc * 32 + 8 * fq; EPI_SEED(rl, cl);
        const int row0 = u.pm * BM + rl, col0 = u.pn * BM + cl;
        const unsigned g0 = ((unsigned)row0 * 2048 + 1024 + col0) * 2u, m0 = ((unsigned)row0 * D + col0) * 2u;
        f32x4 bv[2][2];
#pragma unroll
        for (int bj = 0; bj < 2; ++bj)
#pragma unroll
            for (int n = 0; n < 2; ++n) bv[bj][n] = ldg<f32x4>(bc, (unsigned)(col0 + bj * HALF + 4 * n) * 4u);
#pragma unroll
        for (int ai = 0; ai < 2; ++ai)
#pragma unroll
            for (int m = 0; m < 4; ++m) {
#pragma unroll
                for (int bj = 0; bj < 2; ++bj) { const u32x4 gb = ldg<u32x4>(gates, g0 + (unsigned)((ai * HALF + m * 16) * 2048 + bj * HALF) * 2u); f32x4 o[2];
#pragma unroll
                    for (int n = 0; n < 2; ++n) { const f32x4 v = acc[ai][bj][m][n] + bv[bj][n];
                        o[n][0] = v[0] * bflo(gb[2 * n]); o[n][1] = v[1] * bfhi(gb[2 * n]); o[n][2] = v[2] * bflo(gb[2 * n + 1]); o[n][3] = v[3] * bfhi(gb[2 * n + 1]); }
                    stg<u32x4>(merged, m0 + (unsigned)((ai * HALF + m * 16) * D + bj * HALF) * 2u, pack8(o[0], o[1])); }
                if (m & 1) asm volatile("" ::: "memory"); }
    }
};
struct EpiPre1 {
    static constexpr int SCALE_B = 0, SCALE_A = 0;
    static constexpr bool PERM = false; static constexpr int MID_T = 0;
    const bf16* xb; bf16* out;
    __device__ __forceinline__ void mid(Acc&, const Unit&, int, int, int, int) const {}
    __device__ __forceinline__ void operator()(const Acc& acc, const Unit& u, int wr, int wc, int fr, int fq) const {
        int rl = wr * 64 + fr, cl = wc * 32 + 4 * fq; EPI_SEED(rl, cl);
        const unsigned o0 = ((unsigned)(u.pm * BM + rl) * D + u.pn * BM + cl);
#pragma unroll
        for (int ai = 0; ai < 2; ++ai) { u32x2 xv[4][2][2];
#pragma unroll
            for (int m = 0; m < 4; ++m)
#pragma unroll
                for (int bj = 0; bj < 2; ++bj)
#pragma unroll
                    for (int n = 0; n < 2; ++n) xv[m][bj][n] = ldg<u32x2>(xb, (o0 + (unsigned)((ai * HALF + m * 16) * D + bj * HALF + n * 16)) * 2u);
            __builtin_amdgcn_sched_barrier(0);
#pragma unroll
            for (int m = 0; m < 4; ++m)
#pragma unroll
                for (int bj = 0; bj < 2; ++bj)
#pragma unroll
                    for (int n = 0; n < 2; ++n) { const u32x2 w = xv[m][bj][n]; const f32x4 r = (f32x4){bflo(w.x), bfhi(w.x), bflo(w.y), bfhi(w.y)} * DN_ALPHA + acc[ai][bj][m][n];
                        stg<u32x2>(out, (o0 + (unsigned)((ai * HALF + m * 16) * D + bj * HALF + n * 16)) * 2u, (u32x2){cvt_pk_bf16(r[0], r[1]), cvt_pk_bf16(r[2], r[3])}); }
            __builtin_amdgcn_sched_barrier(0); }
    }
};
struct EpiUp {
    static constexpr bool PERM = true; static constexpr int MID_T = 0;
    static constexpr int SCALE_B = 0x79797979, SCALE_A = 0x7C7C7C7C;
    const float* b_up; unsigned char* act;
    __device__ __forceinline__ void mid(Acc&, const Unit&, int, int, int, int) const {}
    __device__ __forceinline__ void operator()(const Acc& acc, const Unit& u, int wr, int wc, int fr, int fq) const {
        int rl = wr * 64 + fr, cl = wc * 32 + 8 * fq; EPI_SEED(rl, cl);
        const unsigned o0 = (unsigned)(u.pm * BM + rl) * DE + u.pn * HALF + (cl >> 1);
        f32x4 bv[2][2];
#pragma unroll
        for (int bj = 0; bj < 2; ++bj)
#pragma unroll
            for (int n = 0; n < 2; ++n) bv[bj][n] = ldg<f32x4>(b_up, (unsigned)(u.e * 2048 + u.pn * BM + cl + bj * HALF + 4 * n) * 4u);
#pragma unroll
        for (int ai = 0; ai < 2; ++ai)
#pragma unroll
            for (int m = 0; m < 4; ++m)
#pragma unroll
                for (int bj = 0; bj < 2; ++bj) { float o[4];
#pragma unroll
                    for (int n = 0; n < 2; ++n) { const f32x4 v = acc[ai][bj][m][n] + bv[bj][n];
#pragma unroll
                        for (int p = 0; p < 2; ++p) { const float xg = fminf(v[2 * p], 7.0f), xl = fminf(fmaxf(v[2 * p + 1], -7.0f), 7.0f);
                            o[2 * n + p] = xg * sigmoidf_(1.702f * xg) * (xl + 1.0f); } }
                    unsigned w = 0u; w = __builtin_amdgcn_cvt_pk_fp8_f32(o[0] * 8.0f, o[1] * 8.0f, w, false); w = __builtin_amdgcn_cvt_pk_fp8_f32(o[2] * 8.0f, o[3] * 8.0f, w, true);
                    __hip_atomic_store((unsigned*)(act + (o0 + (unsigned)((ai * HALF + m * 16) * DE + bj * 64))), w, __ATOMIC_RELAXED, __HIP_MEMORY_SCOPE_AGENT); }
    }
};
struct EpiDown {
    static constexpr bool PERM = true; static constexpr int MID_T = 0;
    static constexpr int SCALE_B = 0x79797979, SCALE_A = 0x7C7C7C7C;
    const float* b_dn; const int* slot; unsigned char* ys;
    __device__ __forceinline__ void mid(Acc&, const Unit&, int, int, int, int) const {}
    __device__ __forceinline__ void operator()(const Acc& acc, const Unit& u, int wr, int wc, int fr, int fq) const {
        int rl = wr * 64 + fr, cl = wc * 32 + 8 * fq; EPI_SEED(rl, cl);
        const int col0 = u.pn * BM + cl, idx0 = u.mt * BM + rl;
        f32x4 bv[2][2];
#pragma unroll
        for (int bj = 0; bj < 2; ++bj)
#pragma unroll
            for (int n = 0; n < 2; ++n) bv[bj][n] = ldg<f32x4>(b_dn, (unsigned)(u.e * D + col0 + bj * HALF + 4 * n) * 4u);
        int asg[2][4];
#pragma unroll
        for (int ai = 0; ai < 2; ++ai)
#pragma unroll
            for (int m = 0; m < 4; ++m) { const int idx = idx0 + ai * HALF + m * 16; asg[ai][m] = ldg<int>(slot, (unsigned)(u.e * SLOT_CAP + (idx < u.cnt ? idx : u.cnt - 1)) * 4u); }
#pragma unroll
        for (int ai = 0; ai < 2; ++ai)
#pragma unroll
            for (int m = 0; m < 4; ++m) { const int idx = idx0 + ai * HALF + m * 16;
                if (idx < u.cnt) { const unsigned o0 = (unsigned)asg[ai][m] * D + col0;
#pragma unroll
                    for (int bj = 0; bj < 2; ++bj) { const f32x4 v0 = (acc[ai][bj][m][0] + bv[bj][0]) * 16.0f, v1 = (acc[ai][bj][m][1] + bv[bj][1]) * 16.0f;
                        u32x2 w; w.x = __builtin_amdgcn_cvt_pk_fp8_f32(v0[0], v0[1], 0u, false); w.x = __builtin_amdgcn_cvt_pk_fp8_f32(v0[2], v0[3], w.x, true);
                        w.y = __builtin_amdgcn_cvt_pk_fp8_f32(v1[0], v1[1], 0u, false); w.y = __builtin_amdgcn_cvt_pk_fp8_f32(v1[2], v1[3], w.y, true);
                        stg<u32x2>(ys, o0 + (unsigned)(bj * HALF), w); } } }
    }
};
struct EpiUpX {
    const float* b_up; unsigned char* act;
    __device__ __forceinline__ void operator()(const Acc& acc, const Unit& u, int wr, int wc, int fr, int fq) const {
        int rl = wr * 64 + fr, cb = 64 * wc + 32 * (fq & 1) + 16 * (fq >> 1); EPI_SEED(rl, cb);
        f32x4 bv[2][2];
#pragma unroll
        for (int bj = 0; bj < 2; ++bj)
#pragma unroll
            for (int n = 0; n < 2; ++n) bv[bj][n] = ldg<f32x4>(b_up, (unsigned)(u.e * 2048 + u.pn * BM + cb + 8 * bj + 4 * n) * 4u);
        const __amdgpu_buffer_rsrc_t rs = __builtin_amdgcn_make_buffer_rsrc(act, 0, (MAX_MT * 256) * 1024, 0x00020000);
        const unsigned o0 = (unsigned)(u.pm * BM + rl + 16 * (fq >> 1)) * DE + u.pn * HALF + 32 * wc + 16 * (fq & 1);
#pragma unroll
        for (int ai = 0; ai < 2; ++ai)
#pragma unroll
            for (int j = 0; j < 2; ++j) { unsigned d[2][2];
#pragma unroll
                for (int mm = 0; mm < 2; ++mm)
#pragma unroll
                    for (int bj = 0; bj < 2; ++bj) { float o[4];
#pragma unroll
                        for (int n = 0; n < 2; ++n) { const f32x4 v = acc[ai][bj][2 * j + mm][n] + bv[bj][n];
#pragma unroll
                            for (int p = 0; p < 2; ++p) { const float xg = fminf(v[2 * p], 7.0f), xl = fminf(fmaxf(v[2 * p + 1], -7.0f), 7.0f);
                                o[2 * n + p] = (xg * __builtin_amdgcn_rcpf(1.0f + __builtin_amdgcn_exp2f(xg * (-1.702f * 1.44269504f)))) * __builtin_fmaf(xl, 8.0f, 8.0f); } }
                        unsigned w = 0u; w = __builtin_amdgcn_cvt_pk_fp8_f32(o[0], o[1], w, false); w = __builtin_amdgcn_cvt_pk_fp8_f32(o[2], o[3], w, true); d[mm][bj] = w; }
                const u32x2 s0 = __builtin_amdgcn_permlane32_swap(d[0][0], d[1][0], false, false), s1 = __builtin_amdgcn_permlane32_swap(d[0][1], d[1][1], false, false);
                const u32x4 w4 = (u32x4){s0.x, s1.x, s0.y, s1.y};
                __builtin_amdgcn_raw_buffer_store_b128(w4, rs, o0 + (unsigned)((ai * HALF + 32 * j) * DE), 0, 16); }
    }
};
struct EpiMoe {
    static constexpr bool PERM = true; static constexpr int MID_T = 0;
    static constexpr int SCALE_B = 0x79797979, SCALE_A = 0x7C7C7C7C;
    EpiUpX up; EpiDown dn;
    __device__ __forceinline__ void mid(Acc&, const Unit&, int, int, int, int) const {}
    __device__ __forceinline__ void operator()(const Acc& acc, const Unit& u, int wr, int wc, int fr, int fq) const { if (u.type == 0) up(acc, u, wr, wc, fr, fq); else dn(acc, u, wr, wc, fr, fq); }
};
}

#define XB_TMO      128
#define XB_XCNT(j)  (256  + 64 * (j))
#define XB_XSUB(j)  (1280 + 64 * (j))
#define XB_XGEN(j)  (2304 + 64 * (j))
#define XB_TOP      3328
#define XB_TOPGEN   3392
#define XCD_BAR_WORDS 3456
#define XB_SPIN_CAP (1u << 18)
__device__ __forceinline__ unsigned xb_ld(unsigned* p)              { return __hip_atomic_load(p, __ATOMIC_RELAXED, __HIP_MEMORY_SCOPE_AGENT); }
__device__ __forceinline__ unsigned xb_add(unsigned* p, unsigned v) { return __hip_atomic_fetch_add(p, v, __ATOMIC_RELAXED, __HIP_MEMORY_SCOPE_AGENT); }
__device__ __forceinline__ unsigned xb_xcc_id() { return (unsigned)__builtin_amdgcn_s_getreg((3 << 11) | 20) & 0xFu; }
#define XB_SPIN(cond, bar) do { unsigned _sp = 0; while (cond) { __builtin_amdgcn_s_sleep(1); \
    if ((++_sp & 255u) == 0u) { if (xb_ld(&(bar)[XB_TMO])) break; if (_sp > XB_SPIN_CAP) { atomicAdd(&(bar)[XB_TMO], 1u); break; } } } } while (0)
struct XcdBarrier { unsigned* bar; unsigned x; volatile LAS unsigned* st; };
__device__ __forceinline__ XcdBarrier xcd_barrier_post(unsigned* bar, volatile LAS unsigned* st) {
    XcdBarrier b; b.bar = bar; b.x = xb_xcc_id(); b.st = st;
    if (threadIdx.x == 0) (void)xb_add(&bar[XB_XCNT(b.x)], 1u);
    return b;
}
__device__ __forceinline__ void xcd_barrier_complete(unsigned* bar, unsigned x, unsigned& nloc, unsigned& nx) {
    const unsigned G = gridDim.x * gridDim.y * gridDim.z;
    unsigned sum, cnt, mine, sp = 0u;
    for (;;) {
        sum = 0u; cnt = 0u; mine = 0u;
#pragma unroll
        for (unsigned j = 0; j < 16; ++j) { const unsigned c = xb_ld(&bar[XB_XCNT(j)]); sum += c; cnt += (c > 0u) ? 1u : 0u; mine = (j == x) ? c : mine; }
        if (sum == G) break;
        __builtin_amdgcn_s_sleep(1);
        if ((++sp & 255u) == 0u) { if (xb_ld(&bar[XB_TMO])) break; if (sp > XB_SPIN_CAP) { atomicAdd(&bar[XB_TMO], 1u); break; } }
    }
    nloc = mine > 0u ? mine : 1u; nx = cnt > 0u ? cnt : 1u;
}
__device__ __forceinline__ void xcd_barrier(const XcdBarrier& b) {
    asm volatile("s_waitcnt vmcnt(0)" ::: "memory");
    __syncthreads();
    if (threadIdx.x == 0) {
        unsigned* bar = b.bar;
        __builtin_amdgcn_s_waitcnt(0);
        unsigned nloc = b.st[0], nx = b.st[1];
        if (nloc == 0u) { xcd_barrier_complete(bar, b.x, nloc, nx); b.st[0] = nloc; b.st[1] = nx; }
        const unsigned old = xb_add(&bar[XB_XSUB(b.x)], 1u);
        const unsigned gen = old / nloc;
        if (old + 1u == (gen + 1u) * nloc) {
            __builtin_amdgcn_fence(__ATOMIC_RELEASE, "agent");
            asm volatile("s_waitcnt vmcnt(0)" ::: "memory");
            const unsigned og = xb_add(&bar[XB_TOP], 1u);
            const unsigned tg = og / nx;
            if (og + 1u == (tg + 1u) * nx) xb_add(&bar[XB_TOPGEN], 1u);
            else XB_SPIN(xb_ld(&bar[XB_TOPGEN]) == tg, bar);
            __builtin_amdgcn_fence(__ATOMIC_ACQUIRE, "agent");
            xb_add(&bar[XB_XGEN(b.x)], 1u);
            asm volatile("s_waitcnt vmcnt(0)" ::: "memory");
        } else {
            XB_SPIN(xb_ld(&bar[XB_XGEN(b.x)]) == gen, bar);
            __builtin_amdgcn_fence(__ATOMIC_ACQUIRE, "agent");
            asm volatile("s_waitcnt vmcnt(0)" ::: "memory");
        }
    }
    __syncthreads();
}


__device__ __forceinline__ void tr_item(const float* W, int ldw, int scol0, int srow0, bf16* WT, int Kd, int drow0, int dk0, LAS float* scr, int lane) {
#pragma unroll 8
    for (int i = 0; i < 32; ++i) { const int kk = 2 * i + (lane >> 5); scr[kk * 33 + (lane & 31)] = __builtin_nontemporal_load(W + (size_t)(srow0 + kk) * ldw + scol0 + (lane & 31)); }
    LDS_WAIT(); asm volatile("" ::: "memory");
    const int c = lane & 7;
#pragma unroll
    for (int j = 0; j < 4; ++j) { const int n = (lane >> 3) + 8 * j; const LAS float* s = scr + (8 * c) * 33 + n;
        u32x4 o; o.x = pk2(s[0 * 33], s[1 * 33]); o.y = pk2(s[2 * 33], s[3 * 33]); o.z = pk2(s[4 * 33], s[5 * 33]); o.w = pk2(s[6 * 33], s[7 * 33]);
        *(u32x4*)(WT + (size_t)(drow0 + n) * Kd + dk0 + 8 * c) = o; }
    LDS_WAIT(); asm volatile("" ::: "memory");
}
__device__ __forceinline__ int src_col_u(int np) {
    if (np < 768) return np;
    if (np >= 1792) { const int tt = (np - 1792) >> 8, w = (np - 1792) & 255; return w < 128 ? 1792 + 128 * tt + w : 2816 + 128 * tt + (w - 128); }
    const int tt = (np - 768) >> 8, w = (np - 768) & 255;
    return w < 128 ? 768 + 128 * tt + w : 1280 + 128 * tt + (w - 128);
}

__device__ __forceinline__ void p0_prologue(const Args& a, LAS unsigned char* lds, int gw, int NGW, int lane, int wave) {
    unsigned char* ws = a.ws;
    LAS float* scr = (LAS float*)(lds + wave * 16384);
    constexpr int J1 = 16 * 120, J2 = 8 * 32, J3 = 8 * 32, J4 = 16 * 32;
    constexpr int NITEMS = J1 + J2 + J3 + J4;
    for (int it = gw; it < NITEMS; it += NGW) {
        int r = it;
        if (r < J1) { const int kb = r / 120, nb = r % 120; tr_item(a.in[I_WIN], INW, src_col_u(32 * nb), 64 * kb, (bf16*)(ws + WS_WIN), 1024, 32 * nb, 64 * kb, scr, lane); continue; } r -= J1;
        if (r < J2) { const int kb = r / 32, nb = r % 32; tr_item(a.in[I_WATT], D, 32 * nb, 64 * kb, (bf16*)(ws + WS_WAB), 1024, 32 * nb, 64 * kb, scr, lane); continue; } r -= J2;
        if (r < J3) { const int kb = r / 32, nb = r % 32; tr_item(a.in[I_WCONV], D, 32 * nb, 64 * kb, (bf16*)(ws + WS_WAB), 1024, 32 * nb, 512 + 64 * kb, scr, lane); continue; } r -= J3;
        { const int kb = r / 32, nb = r % 32; tr_item(a.in[I_WO], D, 32 * nb, 64 * kb, (bf16*)(ws + WS_WO), 1024, 32 * nb, 64 * kb, scr, lane); }
    }
    const float* x = a.in[I_X]; bf16* xb = (bf16*)(ws + WS_XB);
    for (int m = gw; m < T; m += NGW) {
        const f32x4* xr = (const f32x4*)(x + (size_t)m * D) + lane; u32x2* o = (u32x2*)(xb + (size_t)m * D) + lane;
#pragma unroll
        for (int j = 0; j < 4; ++j) { const f32x4 v = __builtin_nontemporal_load(xr + 64 * j); u32x2 w; w.x = pk2(v[0], v[1]); w.y = pk2(v[2], v[3]); o[64 * j] = w; }
    }
    { u32x4* abz = (u32x4*)(ws + WS_AB); const u32x4 z4 = (u32x4){0u, 0u, 0u, 0u};
      for (int i = gw * 64 + lane; i < NBATCH * AB_PAD * CCH * 2 / 16; i += NGW * 64) { const int bb = i / (AB_PAD * CCH * 2 / 16), q = i % (AB_PAD * CCH * 2 / 16); abz[(size_t)bb * (AB_SEQ * CCH * 2 / 16) + q] = z4; } }
    float* bperm = (float*)(ws + WS_BPERM);
    for (int i = gw * 64 + lane; i < INW; i += NGW * 64) bperm[i] = a.in[I_BIN][src_col_u(i)];
}

constexpr int KLS = 144, VLS = 528, ATT_V_OFF = 256 * KLS, CONV_W_OFF = 70656;
__device__ __forceinline__ void attn_unit(const Args& a, int unit, LAS unsigned char* lds, int tid, int wave, int lane) {
    const bf16* qb = (const bf16*)(a.ws + WS_QB); const bf16* kb = (const bf16*)(a.ws + WS_KB); const bf16* vT = (const bf16*)(a.ws + WS_VT); bf16* ay = (bf16*)(a.ws + WS_AY);
    const int kvh = unit & 1, blk = (unit >> 1) & 31, b = unit >> 6;
    const int r = lane & 15, qd = lane >> 4, w = wave;
    const int t0 = b * SEQ + blk * 128, seq0 = b * SEQ, lo = w & ~1;
    { u32x4 kreg[4], vreg[4];
#pragma unroll
      for (int i = 0; i < 4; ++i) { const int c = tid + 512 * i;
          int tok = t0 - 128 + (c >> 3); tok = tok < seq0 ? seq0 : tok;
          kreg[i] = ldgo<u32x4>(kb, (unsigned)(tok * KVW + kvh * HD + (c & 7) * 8) * 2u);
          int sk = blk * 128 - 128 + 8 * (c & 31); sk = sk < 0 ? 0 : sk;
          vreg[i] = ldgo<u32x4>(vT, (unsigned)(((b * NKV + kvh) * HD + (c >> 5)) * SEQ + sk) * 2u); }
      __builtin_amdgcn_sched_barrier(0);
      asm volatile("" : "+v"(kreg[0]), "+v"(kreg[1]), "+v"(kreg[2]), "+v"(kreg[3]), "+v"(vreg[0]), "+v"(vreg[1]), "+v"(vreg[2]), "+v"(vreg[3]));
#pragma unroll
      for (int i = 0; i < 4; ++i) { const int c = tid + 512 * i;
          *(LAS u32x4*)(lds + (c >> 3) * KLS + (c & 7) * 16) = kreg[i];
          *(LAS u32x4*)(lds + ATT_V_OFF + (c >> 5) * VLS + (c & 31) * 16) = vreg[i]; } }
    __syncthreads();
    const int qi = 16 * w + r;
#pragma unroll 1
    for (int hh = 0; hh < 4; ++hh) {
        const int head = kvh * 4 + hh;
        u32x4 qf[2];
        { const unsigned qo = (unsigned)((t0 + qi) * AW + head * HD + 8 * qd) * 2u; qf[0] = ldgo<u32x4>(qb, qo); qf[1] = ldgo<u32x4>(qb, qo + 64u); }
        const float sinkv = a.in[I_SINK][head];
        int qiv = qi; asm volatile("" : "+v"(qiv));
        const int klo = max(qiv + 1, blk > 0 ? 0 : 128); const int kjb = lo * 16 + 4 * qd - klo; const unsigned span = (unsigned)(qiv + 128 - klo);
        f32x4 s[10];
#pragma unroll
        for (int i = 0; i < 10; ++i) {
            const LAS unsigned char* kp = lds + ((lo + i) * 16 + r) * KLS + qd * 16;
            const u32x4 k0 = *(const LAS u32x4*)kp, k1 = *(const LAS u32x4*)(kp + 64);
            f32x4 z = (f32x4){0.f, 0.f, 0.f, 0.f};
            z = __builtin_amdgcn_mfma_f32_16x16x32_bf16(__builtin_bit_cast(bf16x8, k0), __builtin_bit_cast(bf16x8, qf[0]), z, 0, 0, 0);
            s[i] = __builtin_amdgcn_mfma_f32_16x16x32_bf16(__builtin_bit_cast(bf16x8, k1), __builtin_bit_cast(bf16x8, qf[1]), z, 0, 0, 0);
        }
        float mx = sinkv;
#pragma unroll
        for (int i = 0; i < 10; ++i)
#pragma unroll
            for (int g = 0; g < 4; ++g) { const bool valid = (unsigned)(kjb + (16 * i + g)) <= span; s[i][g] = valid ? s[i][g] : -1e30f; mx = fmaxf(mx, s[i][g]); }
        mx = fmaxf(mx, __shfl_xor(mx, 16)); mx = fmaxf(mx, __shfl_xor(mx, 32));
        float sum = 0.f;
#pragma unroll
        for (int i = 0; i < 10; ++i)
#pragma unroll
            for (int g = 0; g < 4; ++g) { const float p = (s[i][g] > -1e29f) ? __expf(s[i][g] - mx) : 0.f; s[i][g] = p; sum += p; }
        sum += __shfl_xor(sum, 16); sum += __shfl_xor(sum, 32);
        const float inv = 1.0f / (sum + __expf(sinkv - mx));
        f32x4 o[4];
#pragma unroll
        for (int mt = 0; mt < 4; ++mt) o[mt] = (f32x4){0.f, 0.f, 0.f, 0.f};
#pragma unroll
        for (int ip = 0; ip < 5; ++ip) {
            u32x4 pw; pw.x = cvt_pk_bf16(s[2 * ip][0], s[2 * ip][1]); pw.y = cvt_pk_bf16(s[2 * ip][2], s[2 * ip][3]); pw.z = cvt_pk_bf16(s[2 * ip + 1][0], s[2 * ip + 1][1]); pw.w = cvt_pk_bf16(s[2 * ip + 1][2], s[2 * ip + 1][3]);
            const bf16x8 pb = __builtin_bit_cast(bf16x8, pw);
#pragma unroll
            for (int mt = 0; mt < 4; ++mt) { const LAS unsigned char* vp = lds + ATT_V_OFF + (16 * mt + r) * VLS + ((lo + 2 * ip) * 16 + 4 * qd) * 2;
                const u32x2 va = *(const LAS u32x2*)vp, vb = *(const LAS u32x2*)(vp + 32);
                u32x4 vw; vw.x = va.x; vw.y = va.y; vw.z = vb.x; vw.w = vb.y;
                o[mt] = __builtin_amdgcn_mfma_f32_16x16x32_bf16(__builtin_bit_cast(bf16x8, vw), pb, o[mt], 0, 0, 0); }
        }
        const unsigned oo = (unsigned)((t0 + qi) * D + head * HD + 4 * qd) * 2u;
#pragma unroll
        for (int mt = 0; mt < 4; ++mt) { u32x2 wv; wv.x = cvt_pk_bf16(o[mt][0] * inv, o[mt][1] * inv); wv.y = cvt_pk_bf16(o[mt][2] * inv, o[mt][3] * inv); *(u32x2*)((char*)ay + oo + 32u * mt) = wv; }
    }
    __syncthreads();
}

constexpr int CBS = 516;
__device__ __forceinline__ void conv_unit(const Args& a, int unit, LAS unsigned char* lds, int tid, int wave, int lane) {
    const bf16* ab = (const bf16*)(a.ws + WS_AB); bf16* ay = (bf16*)(a.ws + WS_AY);
    LAS float* cb = (LAS float*)lds;
    const int t0 = unit * 32, prow0 = t0 + AB_PAD * ((t0 >> 12) + 1);
    int cp = tid & 255; asm volatile("" : "+v"(cp));
    const int half = wave >> 2;
    const LAS float* wl = (const LAS float*)(lds + CONV_W_OFF) + 2 * cp;
    const f32x2 cbias = *(const f32x2*)(a.in[I_CONVB] + 2 * cp);
#pragma unroll 1
    for (int it = 0; it < 2; ++it) {
        const int tl0 = 16 * half + 8 * it;
        const unsigned o0 = (unsigned)((prow0 + tl0 - 30) * CCH + 2 * cp) * 2u;
        unsigned raw[38];
#pragma unroll
        for (int rr = 0; rr < 38; ++rr) raw[rr] = ldgo<unsigned>(ab, o0 + (unsigned)(rr * CCH * 2));
        __builtin_amdgcn_sched_barrier(0);
        asm volatile("" : "+v"(raw[0]), "+v"(raw[1]), "+v"(raw[2]), "+v"(raw[3]), "+v"(raw[4]), "+v"(raw[5]), "+v"(raw[6]), "+v"(raw[7]), "+v"(raw[8]), "+v"(raw[9]),
                          "+v"(raw[10]), "+v"(raw[11]), "+v"(raw[12]), "+v"(raw[13]), "+v"(raw[14]), "+v"(raw[15]), "+v"(raw[16]), "+v"(raw[17]), "+v"(raw[18]));
        asm volatile("" : "+v"(raw[19]), "+v"(raw[20]), "+v"(raw[21]), "+v"(raw[22]), "+v"(raw[23]), "+v"(raw[24]), "+v"(raw[25]), "+v"(raw[26]), "+v"(raw[27]), "+v"(raw[28]),
                          "+v"(raw[29]), "+v"(raw[30]), "+v"(raw[31]), "+v"(raw[32]), "+v"(raw[33]), "+v"(raw[34]), "+v"(raw[35]), "+v"(raw[36]), "+v"(raw[37]));
        float i0[38], i1[38];
#pragma unroll
        for (int rr = 0; rr < 38; ++rr) { i0[rr] = bflo(raw[rr]); i1[rr] = bfhi(raw[rr]); }
        float a0[8], a1[8];
#pragma unroll
        for (int o = 0; o < 8; ++o) { a0[o] = cbias.x; a1[o] = cbias.y; }
#pragma unroll
        for (int j = 0; j < CW; ++j) { const f32x2 wv = *(const LAS f32x2*)(wl + j * CCH);
#pragma unroll
            for (int o = 0; o < 8; ++o) { a0[o] = fmaf(i0[o + j], wv.x, a0[o]); a1[o] = fmaf(i1[o + j], wv.y, a1[o]); } }
#pragma unroll
        for (int o = 0; o < 8; ++o) *(LAS f32x2*)(cb + (tl0 + o) * CBS + 2 * cp) = (f32x2){a0[o], a1[o]};
    }
    __syncthreads();
    const f32x4 g0 = *(const f32x4*)(a.in[I_CLNG] + 8 * lane), g1 = *(const f32x4*)(a.in[I_CLNG] + 8 * lane + 4), b0 = *(const f32x4*)(a.in[I_CLNB] + 8 * lane), b1 = *(const f32x4*)(a.in[I_CLNB] + 8 * lane + 4);
#pragma unroll
    for (int tt = 0; tt < 4; ++tt) { const int tok = 4 * wave + tt;
        f32x4 v0 = *(const LAS f32x4*)(cb + tok * CBS + 8 * lane), v1 = *(const LAS f32x4*)(cb + tok * CBS + 8 * lane + 4);
        const float mean = wave_sum((v0[0] + v0[1]) + (v0[2] + v0[3]) + (v1[0] + v1[1]) + (v1[2] + v1[3])) * (1.0f / CCH);
        v0 = v0 - mean; v1 = v1 - mean;
        const float var = wave_sum((v0[0] * v0[0] + v0[1] * v0[1]) + (v0[2] * v0[2] + v0[3] * v0[3]) + (v1[0] * v1[0] + v1[1] * v1[1]) + (v1[2] * v1[2] + v1[3] * v1[3])) * (1.0f / CCH);
        const float rstd = 1.0f / sqrtf(var + LN_EPS);
        float y[8];
#pragma unroll
        for (int j = 0; j < 4; ++j) { const float y0 = v0[j] * rstd * g0[j] + b0[j], y1 = v1[j] * rstd * g1[j] + b1[j]; y[j] = y0 * sigmoidf_(y0); y[4 + j] = y1 * sigmoidf_(y1); }
        u32x4 wv; wv.x = cvt_pk_bf16(y[0], y[1]); wv.y = cvt_pk_bf16(y[2], y[3]); wv.z = cvt_pk_bf16(y[4], y[5]); wv.w = cvt_pk_bf16(y[6], y[7]);
        *(u32x4*)(ay + (size_t)(t0 + tok) * D + 512 + 8 * lane) = wv; }
    __syncthreads();
}

constexpr int HLS = 1025;
__device__ __forceinline__ void route_chunk(const Args& a, int chunk, LAS unsigned char* lds, int tid, int wave, int lane, const float (&bw)[64], const f32x4 (&g)[4], const f32x4 (&bb)[4]) {
    const bf16* hf = (const bf16*)(a.ws + WS_HF); unsigned char* hb = a.ws + WS_HB;
    int* slot = (int*)(a.ws + WS_SLOT); float* gatev = (float*)(a.ws + WS_GATE); unsigned* cursor = (unsigned*)(a.ws + WS_CTL);
    LAS float* hl = (LAS float*)lds;
    LAS float* lg = (LAS float*)(lds + MISC_OFF + MO_LG); LAS int* sel_e = (LAS int*)(lds + MISC_OFF + MO_SELE); LAS float* sel_g = (LAS float*)(lds + MISC_OFF + MO_SELG);
    LAS int* lcnt = (LAS int*)(lds + MISC_OFF + MO_LCNT); LAS int* lbase = (LAS int*)(lds + MISC_OFF + MO_LBASE);
    const int t0 = chunk * 32;
    f32x4 v[4][4];
    { u32x2 rw[4][4];
#pragma unroll
      for (int tt = 0; tt < 4; ++tt)
#pragma unroll
        for (int j = 0; j < 4; ++j) rw[tt][j] = *((const u32x2*)(hf + (size_t)(t0 + 4 * wave + tt) * D) + lane + 64 * j);
      __builtin_amdgcn_sched_barrier(0);
      asm volatile("" : "+v"(rw[0][0]), "+v"(rw[0][1]), "+v"(rw[0][2]), "+v"(rw[0][3]), "+v"(rw[1][0]), "+v"(rw[1][1]), "+v"(rw[1][2]), "+v"(rw[1][3]),
                        "+v"(rw[2][0]), "+v"(rw[2][1]), "+v"(rw[2][2]), "+v"(rw[2][3]), "+v"(rw[3][0]), "+v"(rw[3][1]), "+v"(rw[3][2]), "+v"(rw[3][3]));
#pragma unroll
      for (int tt = 0; tt < 4; ++tt)
#pragma unroll
        for (int j = 0; j < 4; ++j) v[tt][j] = (f32x4){bflo(rw[tt][j].x), bfhi(rw[tt][j].x), bflo(rw[tt][j].y), bfhi(rw[tt][j].y)}; }
#pragma unroll
    for (int tt = 0; tt < 4; ++tt) { const int tl = 4 * wave + tt;
        float sm = 0.f;
#pragma unroll
        for (int j = 0; j < 4; ++j) sm += (v[tt][j][0] + v[tt][j][1]) + (v[tt][j][2] + v[tt][j][3]);
        const float mean = wave_sum(sm) * (1.0f / D); float s2 = 0.f;
#pragma unroll
        for (int j = 0; j < 4; ++j) { v[tt][j] = v[tt][j] - mean; s2 += (v[tt][j][0] * v[tt][j][0] + v[tt][j][1] * v[tt][j][1]) + (v[tt][j][2] * v[tt][j][2] + v[tt][j][3] * v[tt][j][3]); }
        const float rstd = 1.0f / sqrtf(wave_sum(s2) * (1.0f / D) + LN_EPS);
        if (lane == 0) *(f32x2*)((float*)(a.ws + WS_LN1S) + 2 * (size_t)(t0 + tl)) = (f32x2){mean, rstd};
#pragma unroll
        for (int j = 0; j < 4; ++j) { const f32x4 h = v[tt][j] * rstd * g[j] + bb[j];
            unsigned wv = 0u; wv = __builtin_amdgcn_cvt_pk_fp8_f32(h[0] * 8.0f, h[1] * 8.0f, wv, false); wv = __builtin_amdgcn_cvt_pk_fp8_f32(h[2] * 8.0f, h[3] * 8.0f, wv, true); *((unsigned*)(hb + (size_t)(t0 + tl) * D) + lane + 64 * j) = wv;
            LAS float* hp = hl + tl * HLS + 4 * lane + 256 * j; hp[0] = h[0]; hp[1] = h[1]; hp[2] = h[2]; hp[3] = h[3]; }
    }
    if (tid < 32) lcnt[tid] = 0;
    __syncthreads();
    f32x16 acc;
#pragma unroll
    for (int i = 0; i < 16; ++i) acc[i] = 0.f;
    { const int tok = lane & 31, kp = lane >> 5; const LAS float* hp = hl + tok * HLS + 128 * wave + kp;
#pragma unroll
      for (int s = 0; s < 64; ++s) acc = __builtin_amdgcn_mfma_f32_32x32x2f32(hp[2 * s], bw[s], acc, 0, 0, 0); }
    __syncthreads();
    { LAS float* part = hl + wave * 1024;
#pragma unroll
      for (int i = 0; i < 16; ++i) { const int rowi = (i & 3) + 8 * (i >> 2) + 4 * (lane >> 5); part[rowi * 32 + (lane & 31)] = acc[i]; } }
    __syncthreads();
    for (int o = tid; o < 1024; o += 512) { float sm = a.in[I_BR][o & 31];
#pragma unroll
        for (int w = 0; w < 8; ++w) sm += hl[w * 1024 + o];
        lg[(o >> 5) * 33 + (o & 31)] = sm; }
    __syncthreads();
    if (tid < 32) { float v[NE];
#pragma unroll
        for (int e = 0; e < NE; ++e) v[e] = lg[tid * 33 + e];
        float tv[4]; int ti[4];
#pragma unroll
        for (int k = 0; k < 4; ++k) { float best = -3.0e38f; int bi = 0;
#pragma unroll
            for (int e = 0; e < NE; ++e) { const bool take = v[e] > best; best = take ? v[e] : best; bi = take ? e : bi; }
            tv[k] = best; ti[k] = bi;
#pragma unroll
            for (int e = 0; e < NE; ++e) v[e] = (e == bi) ? -3.0e38f : v[e]; }
        const float e1 = __expf(tv[1] - tv[0]), e2 = __expf(tv[2] - tv[0]), e3 = __expf(tv[3] - tv[0]); const float inv = 1.0f / (1.0f + e1 + e2 + e3);
        sel_e[4 * tid + 0] = ti[0]; sel_e[4 * tid + 1] = ti[1]; sel_e[4 * tid + 2] = ti[2]; sel_e[4 * tid + 3] = ti[3];
        sel_g[4 * tid + 0] = inv; sel_g[4 * tid + 1] = e1 * inv; sel_g[4 * tid + 2] = e2 * inv; sel_g[4 * tid + 3] = e3 * inv; }
    __syncthreads();
    int my_e = 0, my_rank = 0;
    if (tid < 128) { my_e = sel_e[tid]; my_rank = atomicAdd((int*)&lcnt[my_e], 1); }
    __syncthreads();
    if (tid < 32) { const int c = lcnt[tid]; lbase[tid] = c > 0 ? (int)atomicAdd(cursor + tid, (unsigned)c) : 0; }
    __syncthreads();
    if (tid < 128) { const int asg = (t0 + (tid >> 2)) * 4 + (tid & 3); slot[my_e * SLOT_CAP + lbase[my_e] + my_rank] = asg; gatev[asg] = sel_g[tid]; }
    __syncthreads();
}

__device__ __forceinline__ void combine_row(const Args& a, int m, int lane) {
    const bf16* hf = (const bf16*)(a.ws + WS_HF); const unsigned char* ys = a.ws + WS_YS; const float* gatev = (const float*)(a.ws + WS_GATE);
    f32x4 gt = *(const f32x4*)(gatev + 4 * (size_t)m); gt = gt * (1.0f / 16.0f);
    const f32x2 st = *(const f32x2*)((const float*)(a.ws + WS_LN1S) + 2 * (size_t)m);
    f32x4 v[4]; float sm = 0.f;
#pragma unroll
    for (int j = 0; j < 4; ++j) { const f32x4 g1 = *((const f32x4*)a.in[I_LN1G] + lane + 64 * j), b1 = *((const f32x4*)a.in[I_LN1B] + lane + 64 * j);
        const u32x2 pw = *((const u32x2*)(hf + (size_t)m * D) + lane + 64 * j); f32x4 p = (f32x4){bflo(pw.x), bfhi(pw.x), bflo(pw.y), bfhi(pw.y)}; p = p - st.x; const f32x4 h = p * st.y * g1 + b1;
        v[j] = h * DN_ALPHA;
#pragma unroll
        for (int k = 0; k < 4; ++k) { const unsigned y = *((const unsigned*)(ys + ((size_t)m * 4 + k) * D) + lane + 64 * j); const float gk = gt[k];
            const f32x2 lo = __builtin_amdgcn_cvt_pk_f32_fp8(y, false), hi = __builtin_amdgcn_cvt_pk_f32_fp8(y, true);
            v[j][0] += gk * lo.x; v[j][1] += gk * lo.y; v[j][2] += gk * hi.x; v[j][3] += gk * hi.y; }
        sm += (v[j][0] + v[j][1]) + (v[j][2] + v[j][3]); }
    const float mean = wave_sum(sm) * (1.0f / D); float s2 = 0.f;
#pragma unroll
    for (int j = 0; j < 4; ++j) { v[j] = v[j] - mean; s2 += (v[j][0] * v[j][0] + v[j][1] * v[j][1]) + (v[j][2] * v[j][2] + v[j][3] * v[j][3]); }
    const float rstd = 1.0f / sqrtf(wave_sum(s2) * (1.0f / D) + LN_EPS);
#pragma unroll
    for (int j = 0; j < 4; ++j) { const f32x4 g = *((const f32x4*)a.in[I_LN2G] + lane + 64 * j), bb = *((const f32x4*)a.in[I_LN2B] + lane + 64 * j);
        *((f32x4*)(a.out + (size_t)m * D) + lane + 64 * j) = v[j] * rstd * g + bb; }
}

__global__ void __launch_bounds__(512, 2) fwd_megakernel(Args args) {
    extern __shared__ __attribute__((aligned(16))) unsigned char lds_raw[];
    LAS unsigned char* lds = (LAS unsigned char*)lds_raw;
    const int tid = threadIdx.x, wave = __builtin_amdgcn_readfirstlane(tid >> 6);
#define FRESH_LANE int lane; { int t_ = tid; asm volatile("" : "+v"(t_)); lane = t_ & 63; }
    const int G = gridDim.x, bx = blockIdx.x;
    const int vcu = (G % 8 == 0) ? (bx % 8) * (G / 8) + bx / 8 : bx;
    const int gw = vcu * 8 + wave, NGW = G * 8;
    const int lo = args.ph_lo, hi = args.ph_hi;
    unsigned char* ws = args.ws;
    volatile LAS unsigned* bst = (volatile LAS unsigned*)(lds + MISC_OFF + MO_BAR);
    if (tid < 2) bst[tid] = 0u;
    __syncthreads();
    XcdBarrier xbar = xcd_barrier_post((unsigned*)(ws + WS_CTL) + CW_BAR, bst);
#ifndef PMASK
#define PMASK 0x1ff
#endif
#define IN(k) (((PMASK >> (k)) & 1) && lo <= (k) && (k) < hi)
#define SEAM(k) do { if (lo <= (k) && (k) + 1 < hi) xcd_barrier(xbar); } while (0)

    if (IN(0)) { FRESH_LANE; p0_prologue(args, lds, gw, NGW, lane, wave); }
    SEAM(0);
    if (IN(1)) {
        pg8::DenseOrder S; S.init(ws + WS_XB, ws + WS_WIN, T, INW, G, bx);
        pg8::EpiU E{(bf16*)(ws + WS_QB), (bf16*)(ws + WS_KB), (bf16*)(ws + WS_VT), (bf16*)(ws + WS_AB), (bf16*)(ws + WS_GATES), (const float*)(ws + WS_BPERM)};
        const int slot = vcu & 3;
        S.i0 = 0; S.i1 = slot;
        pg8::gemm_phase<pg8::EpiU, pg8::DenseOrder>(lds, S, E);
        { FRESH_LANE; side_convert(args, bx, G, wave, lane); }
        S.i0 = slot; S.i1 = 1 << 20;
        pg8::gemm_phase<pg8::EpiU, pg8::DenseOrder>(lds, S, E);
    }
    SEAM(1);
    if (IN(2)) {
        FRESH_LANE;
        __syncthreads();
        for (int i = tid; i < CW * CCH / 4; i += 512) ((LAS f32x4*)(lds + CONV_W_OFF))[i] = ((const f32x4*)args.in[I_CONVW])[i];
        __syncthreads();
        for (int u = vcu; u < 256 + 512; u += G) {
            if (u < 256) attn_unit(args, u, lds, tid, wave, lane);
            else conv_unit(args, u - 256, lds, tid, wave, lane);
        }
    }
    SEAM(2);
    if (IN(3)) {
        pg8::DenseOrder S; S.init(ws + WS_AY, ws + WS_WAB, T, D, G, bx);
        pg8::EpiMerged E{(const bf16*)(ws + WS_GATES), args.in[I_BCONV], (bf16*)(ws + WS_MERGED)};
        pg8::gemm_phase<pg8::EpiMerged, pg8::DenseOrder>(lds, S, E);
    }
    SEAM(3);
    if (IN(4)) {
        pg8::DenseOrder S; S.init(ws + WS_MERGED, ws + WS_WO, T, D, G, bx);
        pg8::EpiPre1 E{(const bf16*)(ws + WS_XB), (bf16*)(ws + WS_HF)};
        pg8::gemm_phase<pg8::EpiPre1, pg8::DenseOrder>(lds, S, E);
    }
    SEAM(4);
    if (IN(5)) {
        FRESH_LANE;
        __syncthreads();
        float bw[64]; f32x4 g1[4], b1[4];
#pragma unroll
        for (int s_ = 0; s_ < 64; ++s_) bw[s_] = args.in[I_WR][(size_t)(128 * wave + 2 * s_ + (lane >> 5)) * NE + (lane & 31)];
#pragma unroll
        for (int j = 0; j < 4; ++j) { g1[j] = *((const f32x4*)args.in[I_LN1G] + lane + 64 * j); b1[j] = *((const f32x4*)args.in[I_LN1B] + lane + 64 * j); }
        for (int c = vcu; c < T / 32; c += G) route_chunk(args, c, lds, tid, wave, lane, bw, g1, b1);
    }
    SEAM(5);
    if (IN(6) || IN(7)) {
        LAS int* tab = (LAS int*)(lds + MISC_OFF + MO_TAB);
        __syncthreads();
        if (tid == 0) { const unsigned* cursor = (const unsigned*)(ws + WS_CTL); int acc = 0;
            for (int e = 0; e < NE; ++e) { const int c = (int)__hip_atomic_load(cursor + e, __ATOMIC_RELAXED, __HIP_MEMORY_SCOPE_AGENT); tab[e] = c; const int ml = (c + 255) >> 8; tab[32 + e] = ml; tab[64 + e] = acc; acc += ml; }
            tab[64 + NE] = acc; }
        __syncthreads();
        const int total_mt = tab[64 + NE];
        if (IN(6)) {
            unsigned* ctl = (unsigned*)(ws + WS_CTL);
            pg8::MoeFusedOrder S{tab, G, vcu, total_mt * 8, total_mt * 4, (const char*)(ws + WS_HB), (const char*)(ws + WS_ACT), (const char*)(ws + WS_WUP), (const char*)(ws + WS_WDN), (const int*)(ws + WS_SLOT), ctl + 8192, ctl + 64};
            pg8::EpiMoe E{pg8::EpiUpX{args.in[I_BUP], ws + WS_ACT}, pg8::EpiDown{args.in[I_BDN], (const int*)(ws + WS_SLOT), ws + WS_YS}};
            pg8::gemm_phase<pg8::EpiMoe, pg8::MoeFusedOrder, true>(lds, S, E);
        }
    }
    SEAM(7);
    if (IN(8)) { FRESH_LANE; for (int m = gw; m < T; m += NGW) combine_row(args, m, lane); }

#undef IN
#undef SEAM
#undef FRESH_LANE
}

extern "C" void kernel_launch(void* const* d_in, const int* in_sizes, int n_in, void* d_out, int out_size, void* d_ws, size_t ws_size, hipStream_t stream) {
    static int grid = 0;
    if (grid == 0) {
        if (n_in != 22 || out_size != T * D || ws_size < WS_END) { fprintf(stderr, "kernel_launch: unexpected problem (n_in %d, out %d, ws %zu)\n", n_in, out_size, ws_size); grid = -1; return; }
        int dev = 0, cus = 0, per_cu = 0;
        hipGetDevice(&dev); hipDeviceGetAttribute(&cus, hipDeviceAttributeMultiprocessorCount, dev);
        hipFuncSetAttribute((const void*)fwd_megakernel, hipFuncAttributeMaxDynamicSharedMemorySize, LDS_BYTES);
        hipOccupancyMaxActiveBlocksPerMultiprocessor(&per_cu, (const void*)fwd_megakernel, 512, LDS_BYTES);
        if (per_cu < 1) { fprintf(stderr, "kernel_launch: occupancy query says %d blocks per CU\n", per_cu); per_cu = 1; }
        (void)hipGetLastError();
        grid = cus * 1;
        fprintf(stderr, "kernel_launch: grid %d (cus %d, occupancy %d)\n", grid, cus, per_cu);
    }
    if (grid < 0) return;
    hipMemsetAsync((char*)d_ws + WS_CTL, 0, 65536, stream);
    Args a{};
    for (int i = 0; i < 22; ++i) a.in[i] = (const float*)d_in[i];
    a.out = (float*)d_out; a.ws = (unsigned char*)d_ws; a.ph_lo = 0; a.ph_hi = 9;
    void* kargs[] = {&a};
    hipError_t e = hipLaunchCooperativeKernel((const void*)fwd_megakernel, dim3(grid), dim3(512), kargs, LDS_BYTES, stream);
    if (e != hipSuccess) fprintf(stderr, "cooperative launch failed: %s (grid %d)\n", hipGetErrorString(e), grid);
}
```

```cpp
#include <hip/hip_runtime.h>
#include <cstdio>
#include <cstdint>

#define GAS __attribute__((address_space(1)))
#define LAS __attribute__((address_space(3)))
typedef unsigned short bf16;
typedef short bf16x8 __attribute__((ext_vector_type(8)));
typedef float f32x4 __attribute__((ext_vector_type(4)));
typedef float f32x2 __attribute__((ext_vector_type(2)));
typedef float f32x16 __attribute__((ext_vector_type(16)));
typedef unsigned u32x4 __attribute__((ext_vector_type(4)));
typedef unsigned u32x2 __attribute__((ext_vector_type(2)));

constexpr int T = 16384, D = 1024, SEQ = 4096, NBATCH = 4;
constexpr int NH = 8, NKV = 2, HD = 64, AW = 512, KVW = 128, CCH = 512, CW = 31;
constexpr int INW = 3840, NE = 32, TOPK = 4, DE = 1024;
constexpr float LN_EPS = 1e-5f;
constexpr float DN_ALPHA = 1.189207115002721f;
constexpr int SLOT_CAP = 16384;
constexpr int MAX_MT = (T * TOPK) / 256 + NE;

constexpr size_t MiB = 1u << 20;
constexpr size_t WS_CTL = 0, CTL_BYTES = 65536;
constexpr int CW_BAR = 4096;
constexpr size_t WS_WIN = 1 * MiB;
constexpr size_t WS_WAB = 9 * MiB;
constexpr size_t WS_WO = 11 * MiB;
constexpr size_t WS_BPERM = 13 * MiB;
constexpr size_t WS_SLOT = 14 * MiB;
constexpr size_t WS_GATE = 16 * MiB;
constexpr size_t WS_LN1S = 17 * MiB;
constexpr size_t WS_WUP = 32 * MiB;
constexpr size_t WS_WDN = 160 * MiB;
constexpr size_t WS_XB = 224 * MiB;
constexpr size_t WS_QB = 256 * MiB;
constexpr size_t WS_KB = 272 * MiB;
constexpr size_t WS_VT = 276 * MiB;
constexpr size_t WS_AB = 792 * MiB;
constexpr size_t WS_GATES = 296 * MiB;
constexpr size_t WS_AY = 360 * MiB;
constexpr size_t WS_MERGED = 392 * MiB;
constexpr size_t WS_HF = 424 * MiB;
constexpr size_t WS_HB = 488 * MiB;
constexpr size_t WS_ACT = 520 * MiB;
constexpr size_t WS_YS = 664 * MiB;
constexpr size_t WS_END = 810 * MiB;
constexpr int AB_PAD = 32, AB_SEQ = SEQ + AB_PAD;

constexpr int LDS_SCR = 135168;
constexpr int MISC_OFF = 135168;
constexpr int MO_LG = 0, MO_SELE = 4224, MO_SELG = 4736, MO_LCNT = 5248, MO_LBASE = 5376, MO_TAB = 5504, MO_BAR = 6016;
constexpr int OFFN_OFF = 147456;
constexpr int LDS_BYTES = 155648;

#define LDS_WAIT() asm volatile("s_waitcnt lgkmcnt(0)" ::: "memory")
#define VM_WAIT() asm volatile("s_waitcnt vmcnt(0)" ::: "memory")

__device__ __forceinline__ unsigned f2bf(float f) { unsigned u = __builtin_bit_cast(unsigned, f); return (u + 0x7fffu + ((u >> 16) & 1u)) >> 16; }
__device__ __forceinline__ unsigned pk2(float lo, float hi) { return f2bf(lo) | (f2bf(hi) << 16); }
__device__ __forceinline__ float bf2f(unsigned b) { return __builtin_bit_cast(float, b << 16); }
__device__ __forceinline__ float bflo(unsigned w) { return __builtin_bit_cast(float, w << 16); }
__device__ __forceinline__ float bfhi(unsigned w) { return __builtin_bit_cast(float, w & 0xffff0000u); }
typedef __bf16 bf16x2_t __attribute__((ext_vector_type(2)));
__device__ __forceinline__ unsigned cvt_pk_bf16(float lo, float hi) { const f32x2 v = {lo, hi}; return __builtin_bit_cast(unsigned, __builtin_convertvector(v, bf16x2_t)); }
__device__ __forceinline__ float sigmoidf_(float x) { return __builtin_amdgcn_rcpf(1.0f + __expf(-x)); }
#define DPP_ADD(v, ctrl) ((v) + __builtin_bit_cast(float, __builtin_amdgcn_update_dpp(0, __builtin_bit_cast(int, (v)), (ctrl), 0xf, 0xf, true)))
__device__ __forceinline__ float wave_sum(float v) {
    v = DPP_ADD(v, 0xB1);
    v = DPP_ADD(v, 0x4E);
    v = DPP_ADD(v, 0x141);
    v = DPP_ADD(v, 0x140);
    const int vi = __builtin_bit_cast(int, v);
    const float r0 = __builtin_bit_cast(float, __builtin_amdgcn_readlane(vi, 0)), r1 = __builtin_bit_cast(float, __builtin_amdgcn_readlane(vi, 16));
    const float r2 = __builtin_bit_cast(float, __builtin_amdgcn_readlane(vi, 32)), r3 = __builtin_bit_cast(float, __builtin_amdgcn_readlane(vi, 48));
    return (r0 + r1) + (r2 + r3);
}
template <class V> __device__ __forceinline__ V ldgo(const void* base, unsigned off) { return *(const V*)((const char*)base + off); }
#define PIN10(a) asm volatile("" : "+v"((a)[0]), "+v"((a)[1]), "+v"((a)[2]), "+v"((a)[3]), "+v"((a)[4]), "+v"((a)[5]), "+v"((a)[6]), "+v"((a)[7]), "+v"((a)[8]), "+v"((a)[9]))

struct Args { const float* in[22]; float* out; unsigned char* ws; int ph_lo, ph_hi; };
enum { I_X = 0, I_WIN, I_BIN, I_SINK, I_WATT, I_CONVW, I_CONVB, I_CLNG, I_CLNB, I_WCONV, I_BCONV, I_WO, I_LN1G, I_LN1B, I_WR, I_BR, I_WUP, I_BUP, I_WDN, I_BDN, I_LN2G, I_LN2B };
constexpr int CVI_UP = NE * 64, CVI_DN = NE * 32, CVI_ITEMS = CVI_UP + CVI_DN;
__device__ __forceinline__ void cvi_decode(const Args& a, int it, const float*& src, unsigned char*& dst, int& nw) {
    if (it < CVI_UP) { const int e = it >> 6, kg = it & 63; nw = 2048; src = a.in[I_WUP] + ((size_t)e * 1024 + 16 * kg) * 2048; dst = a.ws + WS_WUP + (size_t)e * 2048 * 1024 + (size_t)kg * 2048 * 16; }
    else { const int r = it - CVI_UP, e = r >> 5, kg2 = r & 31; nw = 1024; src = a.in[I_WDN] + ((size_t)e * 1024 + 32 * kg2) * 1024; dst = a.ws + WS_WDN + (size_t)e * 1024 * 1024 + (size_t)kg2 * 2 * 1024 * 16; }
}
__device__ __forceinline__ void cvi_slice_ptrs(const Args& a, int it, int wave, int lane, const float*& sp, unsigned& pitch, unsigned char*& dp) {
    const float* src; unsigned char* dst; int nw; cvi_decode(a, it, src, dst, nw);
    const int g = nw == 2048 ? 0 : (wave >> 2), cw = nw == 2048 ? wave : (wave & 3);
    sp = src + (size_t)(16 * g) * nw + 256 * cw + 4 * lane; pitch = (unsigned)nw;
    dp = dst + ((size_t)g * nw + 256 * cw + 4 * lane) * 16;
}
__device__ __forceinline__ void cvi_slice_load(const float* sp, unsigned pitch, f32x4 (&r)[16]) {
#pragma unroll
    for (int kk = 0; kk < 16; ++kk) r[kk] = __builtin_nontemporal_load((const f32x4*)(sp + (size_t)kk * pitch));
}
__device__ __forceinline__ void cvi_slice_out(unsigned char* dp, f32x4 (&r)[16]) {
    asm volatile("" : "+v"(r[0]), "+v"(r[1]), "+v"(r[2]), "+v"(r[3]), "+v"(r[4]), "+v"(r[5]), "+v"(r[6]), "+v"(r[7]), "+v"(r[8]), "+v"(r[9]), "+v"(r[10]), "+v"(r[11]), "+v"(r[12]), "+v"(r[13]), "+v"(r[14]), "+v"(r[15]));
#pragma unroll
    for (int j = 0; j < 4; ++j) { unsigned w[4];
#pragma unroll
        for (int c = 0; c < 4; ++c) { unsigned x = 0u; x = __builtin_amdgcn_cvt_pk_fp8_f32(r[4 * c][j] * 64.0f, r[4 * c + 1][j] * 64.0f, x, false);
            x = __builtin_amdgcn_cvt_pk_fp8_f32(r[4 * c + 2][j] * 64.0f, r[4 * c + 3][j] * 64.0f, x, true); w[c] = x; }
        *(u32x4*)(dp + 16 * j) = (u32x4){w[0], w[1], w[2], w[3]}; }
}
__device__ __forceinline__ void side_convert(const Args& a, int bx, int G, int wave, int lane) {
    int base, nit;
    if (G == 256) { base = bx < 192 ? 11 * bx : 2112 + 15 * (bx - 192); nit = bx < 192 ? 11 : 15; }
    else { const int per = (CVI_ITEMS + G - 1) / G; base = bx * per; nit = base >= CVI_ITEMS ? 0 : (CVI_ITEMS - base < per ? CVI_ITEMS - base : per); }
    const int end = base + nit;
    f32x4 r0[16], r1[16];
    const float* sp0; const float* sp1; unsigned p0 = 0, p1 = 0; unsigned char* d0; unsigned char* d1;
    if (nit > 0) { cvi_slice_ptrs(a, base, wave, lane, sp0, p0, d0); cvi_slice_load(sp0, p0, r0); }
    if (nit > 1) { cvi_slice_ptrs(a, base + 1, wave, lane, sp1, p1, d1); cvi_slice_load(sp1, p1, r1); }
#pragma unroll 1
    for (int it0 = base; it0 < end; it0 += 2) {
        const int it1 = it0 + 1;
        { unsigned char* dcur = d0; cvi_slice_out(dcur, r0); if (it0 + 2 < end) { cvi_slice_ptrs(a, it0 + 2, wave, lane, sp0, p0, d0); cvi_slice_load(sp0, p0, r0); } }
        if (it1 >= end) break;
        { unsigned char* dcur = d1; cvi_slice_out(dcur, r1); if (it1 + 2 < end) { cvi_slice_ptrs(a, it1 + 2, wave, lane, sp1, p1, d1); cvi_slice_load(sp1, p1, r1); } }
    }
}

namespace pg8 {
constexpr int BM = 256, BK = 64, HALF = 128, HTB = HALF * BK * 2, STAGE_BYTES = 8 * HTB, NXCD = 8, WGM = 8;
constexpr int KD = 1024, NT_K = KD / BK;
__host__ __device__ __forceinline__ int lds_byte(int r, int c) { const int st = (r >> 4) * 2 + (c >> 5), rr = r & 15, cc = c & 31, ob = rr * 64 + cc * 2; return st * 1024 + (ob ^ (((ob >> 9) & 1) << 5)); }
__host__ __device__ __forceinline__ void stage_rc(int b, int& R, int& C) { const int st = b / 1024, sb = b % 1024, swz = sb ^ (((sb >> 9) & 1) << 5); R = (st >> 1) * 16 + swz / 64; C = (st & 1) * 32 + (swz % 64) / 2; }
__host__ __device__ __forceinline__ int perm32(int rho) { const int n = rho >> 4, i = rho & 15; return 8 * (i >> 2) + 4 * n + (i & 3); }

struct Unit { const char* A; const char* B; int pm, pn, e, mt, cnt, type; };

struct DenseOrder {
    const char* Ab; const char* Bb; int nM, nN, nwg, G, c, i0 = 0, i1 = 1 << 20; static constexpr int rowb = KD * 2; static constexpr bool PARK = false, FUSED = false;
    __device__ __forceinline__ unsigned boff(int Rb, int C) const { return (unsigned)(Rb * rowb + C * 2); }
    __device__ __forceinline__ size_t bstep_k() const { return 128; }
    __device__ __forceinline__ size_t bstep_h() const { return (size_t)HALF * rowb; }
    __device__ void init(const void* A, const void* B, int M, int N, int G_, int c_) { Ab = (const char*)A; Bb = (const char*)B; nM = M / BM; nN = N / BM; nwg = nM * nN; G = G_; c = c_; }
    __device__ __forceinline__ bool next(int i, Unit& u) const {
        if (i + i0 >= i1) return false;
        const long L = (long)(i + i0) * G + c; if (L >= nwg) return false;
        int wgid = (int)L; { const int q = nwg / NXCD, r = nwg % NXCD, xcd = wgid % NXCD, off = wgid / NXCD; wgid = (xcd < r ? xcd * (q + 1) : r * (q + 1) + (xcd - r) * q) + off; }
        const int nig = WGM * nN, gid = wgid / nig, fm = gid * WGM, gsz = (nM - fm) < WGM ? (nM - fm) : WGM;
        u.pm = fm + ((wgid % nig) % gsz); u.pn = (wgid % nig) / gsz; u.e = 0; u.mt = 0; u.cnt = 0; u.type = 0;
        u.A = Ab + (size_t)u.pm * (BM * KD * 2); u.B = Bb + (size_t)u.pn * (BM * KD * 2); return true;
    }
    __device__ __forceinline__ void offsets(const Unit&, const int (&R)[2], const int (&C)[2], unsigned (&off)[2][2]) const {
#pragma unroll
        for (int h = 0; h < 2; ++h)
#pragma unroll
            for (int i = 0; i < 2; ++i) off[h][i] = (unsigned)(((h * HALF + R[i]) * KD + C[i]) * 2);
    }
};
struct MoeOrder {
    const LAS int* tab; int NTN, G, c, total; const char* Ab; const char* Bb; size_t bexp; const int* slot; bool gather; int rowb;
    static constexpr bool PARK = true, FUSED = false;
    int bn16;
    __device__ __forceinline__ unsigned boff(int Rb, int C) const { return (unsigned)((C >> 3) * bn16 + Rb * 16); }
    __device__ __forceinline__ size_t bstep_k() const { return (size_t)8 * bn16; }
    __device__ __forceinline__ size_t bstep_h() const { return (size_t)HALF * 16; }
    __device__ __forceinline__ bool next(int i, Unit& u) const {
        const int L = i * G + c; if (L >= total) return false;
        int e = 0;
        for (int j = 1; j < NE; ++j) e += (L >= NTN * tab[64 + j]) ? 1 : 0;
        e = __builtin_amdgcn_readfirstlane(e);
        const int ms = __builtin_amdgcn_readfirstlane(tab[64 + e]), ml = __builtin_amdgcn_readfirstlane(tab[32 + e]);
        const int r = L - NTN * ms; const int nt = r / ml, mt = r - nt * ml;
        u.e = e; u.mt = mt; u.cnt = __builtin_amdgcn_readfirstlane(tab[e]); u.pm = ms + mt; u.pn = nt; u.type = 0;
        u.A = gather ? Ab : Ab + (size_t)u.pm * (size_t)(BM * rowb);
        u.B = Bb + (size_t)e * bexp + (size_t)nt * (size_t)(BM * 16); return true;
    }
    __device__ __forceinline__ void offsets(const Unit& u, const int (&R)[2], const int (&C)[2], unsigned (&off)[2][2]) const {
#pragma unroll
        for (int h = 0; h < 2; ++h)
#pragma unroll
            for (int i = 0; i < 2; ++i) {
                if (gather) { const int idx = u.mt * BM + h * HALF + R[i]; const int idc = idx < u.cnt ? idx : u.cnt - 1; int tok = slot[u.e * SLOT_CAP + idc] >> 2; tok = idx < u.cnt ? tok : 0; off[h][i] = (unsigned)(tok * rowb + C[i] * 2); }
                else off[h][i] = (unsigned)((h * HALF + R[i]) * rowb + C[i] * 2);
            }
    }
};


#define GAS_U32 __attribute__((address_space(1))) unsigned
struct MoeFusedOrder {
    const LAS int* tab; int G, c, total6, total7; const char* hb; const char* act; const char* wup; const char* wdn; const int* slot; unsigned* cnt; unsigned* tmo;
    static constexpr bool PARK = true, FUSED = true; static constexpr int rowb = 1024;
    __device__ __forceinline__ unsigned boff_t(int type, int R, int C) const {
        const int rs = 64 * (R >> 5) + 32 * ((R >> 2) & 1) + 16 * ((R >> 3) & 1) + 4 * ((R >> 4) & 1) + (R & 3), rb = (R & ~31) + perm32(R & 31);
        return type ? (unsigned)((C >> 3) * (1024 * 16) + rb * 16) : (unsigned)((C >> 3) * (2048 * 16) + rs * 16); }
    __device__ __forceinline__ unsigned boff(int R, int C) const { return boff_t(0, R, C); }
    __device__ __forceinline__ size_t bstep_kt(int type) const { return (size_t)8 * (type ? 1024 * 16 : 2048 * 16); }
    __device__ __forceinline__ size_t bstep_ht(int type) const { return type ? (size_t)HALF * 16 : (size_t)8 * 16; }
    __device__ __forceinline__ size_t bstep_k() const { return bstep_kt(0); }
    __device__ __forceinline__ size_t bstep_h() const { return bstep_ht(0); }
    __device__ __forceinline__ bool next(int i, Unit& u) const {
        int L = i * G + c; if (L >= total6 + total7) return false;
        const int type = L >= total6 ? 1 : 0; L -= type ? total6 : 0; const int NTN = type ? 4 : 8;
        int e = 0;
        for (int j = 1; j < NE; ++j) e += (L >= NTN * tab[64 + j]) ? 1 : 0;
        e = __builtin_amdgcn_readfirstlane(e);
        const int ms = __builtin_amdgcn_readfirstlane(tab[64 + e]), ml = __builtin_amdgcn_readfirstlane(tab[32 + e]);
        const int r = L - NTN * ms; const int nt = r / ml, mt = r - nt * ml;
        u.e = e; u.mt = mt; u.cnt = __builtin_amdgcn_readfirstlane(tab[e]); u.pm = ms + mt; u.pn = nt; u.type = type;
        u.A = type ? act + (size_t)u.pm * (size_t)(BM * rowb) : hb;
        u.B = (type ? wdn + (size_t)e * 1024 * 1024 : wup + (size_t)e * 2048 * 1024) + (size_t)nt * (size_t)(BM * 16); return true;
    }
    __device__ __forceinline__ void offsets(const Unit& u, const int (&R)[2], const int (&C)[2], unsigned (&off)[2][2]) const {
        if (u.type == 0) { int tok[2][2];
#pragma unroll
            for (int h = 0; h < 2; ++h)
#pragma unroll
                for (int i = 0; i < 2; ++i) { const int idx = u.mt * BM + h * HALF + R[i]; tok[h][i] = slot[u.e * SLOT_CAP + (idx < u.cnt ? idx : u.cnt - 1)]; }
#pragma unroll
            for (int h = 0; h < 2; ++h)
#pragma unroll
                for (int i = 0; i < 2; ++i) { const int idx = u.mt * BM + h * HALF + R[i]; const int t = idx < u.cnt ? (tok[h][i] >> 2) : 0; off[h][i] = (unsigned)(t * rowb + C[i] * 2); }
        } else {
#pragma unroll
            for (int h = 0; h < 2; ++h)
#pragma unroll
                for (int i = 0; i < 2; ++i) off[h][i] = (unsigned)((h * HALF + R[i]) * rowb + C[i] * 2);
        }
    }
    __device__ __forceinline__ void a_ready(const Unit& u) const {
        if (u.type) {
            if (threadIdx.x < 64) { const unsigned* p = cnt + 16 * u.pm; unsigned v, spins = 0u;
                for (;;) { asm volatile("global_load_dword %0, %1, off sc1\n\ts_waitcnt vmcnt(0)" : "=&v"(v) : "v"(p) : "memory");
                    if ((unsigned)__builtin_amdgcn_readfirstlane(v) >= 64u) break;
                    __builtin_amdgcn_s_sleep(2);
                    if (++spins > (1u << 20)) { if (threadIdx.x == 0) __hip_atomic_store(tmo, 1u, __ATOMIC_RELAXED, __HIP_MEMORY_SCOPE_AGENT); break; } }
                }
            asm volatile("" ::: "memory"); __builtin_amdgcn_s_barrier(); asm volatile("" ::: "memory");
        }
    }
    __device__ __forceinline__ void done(const Unit& u) const {
        if (u.type == 0) { asm volatile("s_waitcnt vmcnt(0)" ::: "memory");
            if ((threadIdx.x & 63) == 0) __hip_atomic_fetch_add(cnt + 16 * u.pm, 1u, __ATOMIC_RELAXED, __HIP_MEMORY_SCOPE_AGENT); }
    }
};

typedef f32x4 Acc[2][2][4][2];

typedef int i32x8 __attribute__((ext_vector_type(8)));
struct u32x4x2 { u32x4 a, b; };
template <class Epi, class Sched, bool FP8 = false>
__device__ __forceinline__ void gemm_phase(LAS unsigned char* lds, const Sched& S, const Epi& E) {
    const int tid = threadIdx.x, wid = __builtin_amdgcn_readfirstlane(tid >> 6), lane = tid & 63, wr = wid >> 2, wc = wid & 3, fr = lane & 15, fq = lane >> 4;
    constexpr int ROWB = FP8 ? KD : KD * 2, nt = FP8 ? KD / 128 : NT_K;
    int sR[2], sC[2], sRb[2]; unsigned voffB[2];
#pragma unroll
    for (int i = 0; i < 2; ++i) { int R, C; stage_rc(tid * 16 + i * 8192, R, C); sR[i] = R; sC[i] = C; const int Rb = Epi::PERM ? ((R & ~31) + perm32(R & 31)) : R; sRb[i] = Rb; voffB[i] = S.boff(Rb, C); }
    constexpr size_t kstep = (size_t)(BK * 2);
    size_t kstepB = S.bstep_k(), kstepBn = kstepB, hstepB = S.bstep_h(), hstepBn = hstepB;
    const unsigned ldsw = (unsigned)wid * 1024u;
    const int aoff = lds_byte(wr * 64 + fr, fq * 8), boff = lds_byte(wc * 32 + fr, fq * 8);
    constexpr int KST = 1024;
#define PG8_SA(b, h) (((b) * 2 + (h)) * HTB)
#define PG8_SB(b, h) ((4 + (b) * 2 + (h)) * HTB)
#define PG8_STAGE(bufoff, gbase, voff) do { const char* _gb = (const char*)(gbase); asm volatile("" : "+s"(_gb));     \
        _Pragma("unroll") for (int _i = 0; _i < 2; ++_i) \
        __builtin_amdgcn_global_load_lds((const unsigned*)(_gb + (voff)[_i]), (LAS unsigned*)(lds + (bufoff) + ldsw + _i * 8192), 16, 0, 0); } while (0)
#define PG8_STAGE_A(bufoff, gbase, voff) do { const char* _gb = (const char*)(gbase); asm volatile("" : "+s"(_gb)); \
        _Pragma("unroll") for (int _i = 0; _i < 2; ++_i) \
        __builtin_amdgcn_global_load_lds((const unsigned*)(_gb + (voff)[_i]), (LAS unsigned*)(lds + (bufoff) + ldsw + _i * 8192), 16, 0, 0); } while (0)
#define PG8_LDA(dst, b, h) do { _Pragma("unroll") for (int m = 0; m < 4; ++m) _Pragma("unroll") for (int k = 0; k < 2; ++k) dst[m][k] = *(const LAS bf16x8*)(lds + PG8_SA(b, h) + aoff + m * 2048 + k * KST); } while (0)
#define PG8_LDB(dst, b, h) do { _Pragma("unroll") for (int n = 0; n < 2; ++n) _Pragma("unroll") for (int k = 0; k < 2; ++k) dst[n][k] = *(const LAS bf16x8*)(lds + PG8_SB(b, h) + boff + n * 2048 + k * KST); } while (0)
#define PG8_CAT(x) __builtin_bit_cast(i32x8, (u32x4x2){__builtin_bit_cast(u32x4, (x)[0]), __builtin_bit_cast(u32x4, (x)[1])})
#define PG8_MMA(ai, bj, At, Bt) do { __builtin_amdgcn_s_setprio(1); \
        if constexpr (FP8) { _Pragma("unroll") for (int m = 0; m < 4; ++m) _Pragma("unroll") for (int n = 0; n < 2; ++n) \
            acc[ai][bj][m][n] = __builtin_amdgcn_mfma_scale_f32_16x16x128_f8f6f4(PG8_CAT(Bt[n]), PG8_CAT(At[m]), acc[ai][bj][m][n], 0, 0, 0, Epi::SCALE_B, 0, Epi::SCALE_A); } \
        else { _Pragma("unroll") for (int m = 0; m < 4; ++m) _Pragma("unroll") for (int n = 0; n < 2; ++n) _Pragma("unroll") for (int k = 0; k < 2; ++k) \
            acc[ai][bj][m][n] = __builtin_amdgcn_mfma_f32_16x16x32_bf16(Bt[n][k], At[m][k], acc[ai][bj][m][n], 0, 0, 0); } \
        __builtin_amdgcn_s_setprio(0); } while (0)
#define PG8_WAIT_V(n) asm volatile("s_waitcnt vmcnt(" #n ")" ::: "memory")
#define PG8_WAIT_L(n) asm volatile("s_waitcnt lgkmcnt(" #n ")" ::: "memory")
#define PG8_BAR __builtin_amdgcn_s_barrier()
#define PG8_SCHED __builtin_amdgcn_sched_barrier(0)
    Unit cur, nxt; int ui = 0;
    if (!S.next(0, cur)) return;
    Acc acc;
    bf16x8 At[4][2], B0[2][2], B1[2][2];
    unsigned offA[2][2], offN[2][2];
    S.offsets(cur, sR, sC, offA);
    if constexpr (Sched::FUSED) { kstepB = S.bstep_kt(cur.type); hstepB = S.bstep_ht(cur.type);
#pragma unroll
        for (int i = 0; i < 2; ++i) voffB[i] = S.boff_t(cur.type, sR[i], sC[i]); }
    const char* cA = cur.A; const char* cB = cur.B;
    PG8_STAGE(PG8_SB(0, 0), cB, voffB); PG8_STAGE(PG8_SB(0, 1), cB + hstepB, voffB); PG8_STAGE_A(PG8_SA(0, 0), cA, offA[0]); PG8_STAGE_A(PG8_SA(0, 1), cA, offA[1]);
    if (wr == 1) PG8_BAR;
    PG8_WAIT_V(2); PG8_BAR;
    PG8_STAGE(PG8_SB(1, 0), cB + kstepB, voffB); PG8_STAGE_A(PG8_SA(1, 0), cA + kstep, offA[0]); PG8_STAGE(PG8_SB(1, 1), cB + hstepB + kstepB, voffB);
    PG8_WAIT_V(6); PG8_BAR;
    for (;;) {
#pragma unroll
        for (int a = 0; a < 2; ++a)
#pragma unroll
            for (int b = 0; b < 2; ++b)
#pragma unroll
                for (int m = 0; m < 4; ++m)
#pragma unroll
                    for (int n = 0; n < 2; ++n) acc[a][b][m][n] = (f32x4){0.f, 0.f, 0.f, 0.f};
        const bool has_next = S.next(ui + 1, nxt);
        const char* nA = has_next ? nxt.A : cA; const char* nB = has_next ? nxt.B : cB;
        if constexpr (Sched::FUSED) { kstepBn = has_next ? S.bstep_kt(nxt.type) : kstepB; hstepBn = has_next ? S.bstep_ht(nxt.type) : hstepB; }
        if (has_next) S.offsets(nxt, sR, sC, offN);
        else {
#pragma unroll
            for (int h = 0; h < 2; ++h)
#pragma unroll
                for (int i = 0; i < 2; ++i) offN[h][i] = offA[h][i];
        }
        if constexpr (Sched::PARK) *(LAS u32x4*)(lds + OFFN_OFF + tid * 16) = (u32x4){offN[0][0], offN[0][1], offN[1][0], offN[1][1]};
#pragma unroll 1
        for (int t = 0; t < nt; t += 2) {
            const bool last = (t == nt - 2);
            const char* a1 = cA + (size_t)(t + 1) * kstep;
            const char* a2 = last ? nA : cA + (size_t)(t + 2) * kstep; const char* b2 = last ? nB : cB + (size_t)(t + 2) * kstepB;
            const char* a3 = a2 + kstep; const char* b3 = b2 + (last ? kstepBn : kstepB); const size_t hB = last ? hstepBn : hstepB;
            if constexpr (Sched::FUSED) { if (last && has_next) S.a_ready(nxt); }
            if constexpr (Epi::MID_T > 0) { if (t == Epi::MID_T) E.mid(acc, cur, wr, wc, fr, fq); }
            PG8_LDB(B0, 0, 0); PG8_LDB(B1, 0, 1); PG8_SCHED; PG8_LDA(At, 0, 0); PG8_STAGE_A(PG8_SA(1, 1), a1, offA[1]);
            PG8_WAIT_V(8); PG8_WAIT_L(0); PG8_BAR; PG8_MMA(0, 0, At, B0); PG8_MMA(0, 1, At, B1);
            asm volatile("" : "+v"(acc[0][0][0][0]), "+v"(acc[0][0][0][1]), "+v"(acc[0][0][1][0]), "+v"(acc[0][0][1][1]), "+v"(acc[0][0][2][0]), "+v"(acc[0][0][2][1]), "+v"(acc[0][0][3][0]), "+v"(acc[0][0][3][1]));
            asm volatile("" : "+v"(acc[0][1][0][0]), "+v"(acc[0][1][0][1]), "+v"(acc[0][1][1][0]), "+v"(acc[0][1][1][1]), "+v"(acc[0][1][2][0]), "+v"(acc[0][1][2][1]), "+v"(acc[0][1][3][0]), "+v"(acc[0][1][3][1]));
            PG8_BAR; PG8_SCHED;
            if (last) {
                if constexpr (Sched::FUSED) { if (has_next) {
#pragma unroll
                    for (int i = 0; i < 2; ++i) voffB[i] = S.boff_t(nxt.type, sR[i], sC[i]); } }
                if constexpr (Sched::PARK) { const u32x4 pk = *(const LAS u32x4*)(lds + OFFN_OFF + tid * 16); offA[0][0] = pk.x; offA[0][1] = pk.y; offA[1][0] = pk.z; offA[1][1] = pk.w; }
                else {
#pragma unroll
                    for (int h = 0; h < 2; ++h)
#pragma unroll
                        for (int i = 0; i < 2; ++i) offA[h][i] = offN[h][i];
                }
            }
            PG8_LDA(At, 0, 1); PG8_STAGE(PG8_SB(0, 0), b2, voffB); PG8_STAGE(PG8_SB(0, 1), b2 + hB, voffB); PG8_STAGE_A(PG8_SA(0, 0), a2, offA[0]);
            PG8_WAIT_V(8); PG8_WAIT_L(0); PG8_BAR; PG8_MMA(1, 0, At, B0); PG8_MMA(1, 1, At, B1); PG8_BAR; PG8_SCHED;
            PG8_LDB(B0, 1, 0); PG8_LDB(B1, 1, 1); PG8_SCHED; PG8_LDA(At, 1, 0); PG8_STAGE_A(PG8_SA(0, 1), a2, offA[1]);
            PG8_WAIT_V(8); PG8_WAIT_L(0); PG8_BAR; PG8_MMA(0, 0, At, B0); PG8_MMA(0, 1, At, B1); PG8_BAR; PG8_SCHED;
            PG8_LDA(At, 1, 1); PG8_STAGE(PG8_SB(1, 0), b3, voffB); PG8_STAGE(PG8_SB(1, 1), b3 + hB, voffB); PG8_STAGE_A(PG8_SA(1, 0), a3, offA[0]);
            PG8_WAIT_V(8); PG8_WAIT_L(0); PG8_BAR; PG8_MMA(1, 0, At, B0); PG8_MMA(1, 1, At, B1); PG8_BAR; PG8_SCHED;
        }
        if (wr == 0) PG8_BAR;
        E(acc, cur, wr, wc, fr, fq);
        if constexpr (Sched::FUSED) S.done(cur);
        __builtin_amdgcn_s_waitcnt(0x0F70);
        if (!has_next) break;
        cur = nxt; cA = nA; cB = nB; kstepB = kstepBn; hstepB = hstepBn; ++ui;
        if (wr == 1) PG8_BAR;
    }
    PG8_WAIT_V(0);
    PG8_BAR;
#undef PG8_SA
#undef PG8_SB
#undef PG8_STAGE
#undef PG8_STAGE_A
#undef PG8_LDA
#undef PG8_LDB
#undef PG8_MMA
#undef PG8_WAIT_V
#undef PG8_WAIT_L
#undef PG8_BAR
#undef PG8_SCHED
}

#define EPI_SEED(r, c) asm volatile("" : "+v"(r), "+v"(c))
template <class V> __device__ __forceinline__ V ldg(const void* base, unsigned off) { return *(const V*)((const char*)base + off); }
template <class V> __device__ __forceinline__ void stg(void* base, unsigned off, V v) { *(V*)((char*)base + off) = v; }
__device__ __forceinline__ u32x4 pack8(const f32x4 v0, const f32x4 v1) { u32x4 w; w.x = cvt_pk_bf16(v0[0], v0[1]); w.y = cvt_pk_bf16(v0[2], v0[3]); w.z = cvt_pk_bf16(v1[0], v1[1]); w.w = cvt_pk_bf16(v1[2], v1[3]); return w; }

struct EpiU {
    static constexpr int SCALE_B = 0, SCALE_A = 0;
    static constexpr bool PERM = true; static constexpr int MID_T = 0;
    bf16 *q, *k, *vT, *ab, *gates; const float* bias;
    __device__ __forceinline__ void mid(Acc&, const Unit&, int, int, int, int) const {}
    __device__ __forceinline__ void operator()(const Acc& acc, const Unit& u, int wr, int wc, int fr, int fq) const {
        int rl = wr * 64 + fr, cl = wc * 32 + 8 * fq; EPI_SEED(rl, cl);
        const int row0 = u.pm * BM + rl, pn = u.pn;
        f32x4 bv[2][2];
#pragma unroll
        for (int bj = 0; bj < 2; ++bj)
#pragma unroll
            for (int n = 0; n < 2; ++n) bv[bj][n] = ldg<f32x4>(bias, (unsigned)(pn * BM + bj * HALF + cl + 4 * n) * 4u);
        if (pn < 2) {
            const unsigned o0 = ((unsigned)row0 * AW + pn * BM + cl) * 2u;
#pragma unroll
            for (int ai = 0; ai < 2; ++ai)
#pragma unroll
                for (int m = 0; m < 4; ++m)
#pragma unroll
                    for (int bj = 0; bj < 2; ++bj)
                        stg<u32x4>(q, o0 + (unsigned)((ai * HALF + m * 16) * AW + bj * HALF) * 2u, pack8((acc[ai][bj][m][0] + bv[bj][0]) * 0.125f, (acc[ai][bj][m][1] + bv[bj][1]) * 0.125f));
        } else if (pn == 2) {
            const unsigned o0 = ((unsigned)row0 * KVW + cl) * 2u;
            const int b = row0 >> 12, s0 = row0 & (SEQ - 1);
#pragma unroll
            for (int ai = 0; ai < 2; ++ai)
#pragma unroll
                for (int m = 0; m < 4; ++m) {
                    stg<u32x4>(k, o0 + (unsigned)((ai * HALF + m * 16) * KVW) * 2u, pack8(acc[ai][0][m][0] + bv[0][0], acc[ai][0][m][1] + bv[0][1]));
#pragma unroll
                    for (int n = 0; n < 2; ++n) { const f32x4 v = acc[ai][1][m][n] + bv[1][n];
#pragma unroll
                        for (int j = 0; j < 4; ++j) { const int col = cl + 4 * n + j, kvh = col >> 6, dim = col & 63;
                            stg<bf16>(vT, (unsigned)(((b * NKV + kvh) * HD + dim) * SEQ + s0 + ai * HALF + m * 16) * 2u, (bf16)f2bf(v[j])); } } }
        } else if (pn < 7) {
            const unsigned o0 = ((unsigned)(row0 + AB_PAD * ((row0 >> 12) + 1)) * CCH + (pn - 3) * HALF + cl) * 2u;
#pragma unroll
            for (int ai = 0; ai < 2; ++ai)
#pragma unroll
                for (int m = 0; m < 4; ++m) { f32x4 o[2];
#pragma unroll
                    for (int n = 0; n < 2; ++n) { const f32x4 a = acc[ai][0][m][n] + bv[0][n], g = acc[ai][1][m][n] + bv[1][n];
#pragma unroll
                        for (int j = 0; j < 4; ++j) o[n][j] = a[j] * sigmoidf_(g[j]); }
                    stg<u32x4>(ab, o0 + (unsigned)((ai * HALF + m * 16) * CCH) * 2u, pack8(o[0], o[1])); }
        } else {
            const unsigned o0 = ((unsigned)row0 * 2048 + (pn - 7) * HALF + cl) * 2u;
#pragma unroll
            for (int ai = 0; ai < 2; ++ai)
#pragma unroll
                for (int m = 0; m < 4; ++m) { f32x4 ra[2], gb[2];
#pragma unroll
                    for (int n = 0; n < 2; ++n) { const f32x4 va = acc[ai][0][m][n] + bv[0][n], vb = acc[ai][1][m][n] + bv[1][n];
#pragma unroll
                        for (int j = 0; j < 4; ++j) { const float sb = sigmoidf_(vb[j]); gb[n][j] = sb; ra[n][j] = sigmoidf_(va[j]) * __builtin_amdgcn_rcpf(sb); } }
                    stg<u32x4>(gates, o0 + (unsigned)((ai * HALF + m * 16) * 2048) * 2u, pack8(ra[0], ra[1]));
                    stg<u32x4>(gates, o0 + (unsigned)((ai * HALF + m * 16) * 2048 + 1024) * 2u, pack8(gb[0], gb[1])); }
        }
    }
};
struct EpiMerged {
    static constexpr int SCALE_B = 0, SCALE_A = 0;
    static constexpr bool PERM = true; static constexpr int MID_T = 8;
    const bf16* gates; const float* bc; bf16* merged;
    __device__ __forceinline__ void mid(Acc& acc, const Unit& u, int wr, int wc, int fr, int fq) const {
        int rl = wr * 64 + fr, cl = wc * 32 + 8 * fq; EPI_SEED(rl, cl);
        const unsigned g0 = ((unsigned)(u.pm * BM + rl) * 2048 + u.pn * BM + cl) * 2u;
#pragma unroll
        for (int ai = 0; ai < 2; ++ai) { u32x4 rt[4][2];
#pragma unroll
            for (int m = 0; m < 4; ++m)
#pragma unroll
                for (int bj = 0; bj < 2; ++bj) rt[m][bj] = ldg<u32x4>(gates, g0 + (unsigned)((ai * HALF + m * 16) * 2048 + bj * HALF) * 2u);
            __builtin_amdgcn_sched_barrier(0);
#pragma unroll
            for (int m = 0; m < 4; ++m)
#pragma unroll
                for (int bj = 0; bj < 2; ++bj)
#pragma unroll
                    for (int n = 0; n < 2; ++n) { acc[ai][bj][m][n][0] *= bflo(rt[m][bj][2 * n]); acc[ai][bj][m][n][1] *= bfhi(rt[m][bj][2 * n]); acc[ai][bj][m][n][2] *= bflo(rt[m][bj][2 * n + 1]); acc[ai][bj][m][n][3] *= bfhi(rt[m][bj][2 * n + 1]); }
            __builtin_amdgcn_sched_barrier(0); }
    }
    __device__ __forceinline__ void operator()(const Acc& acc, const Unit& u, int wr, int wc, int fr, int fq) const {
        int rl = wr * 64 + fr, cl = wc * 32 + 8 * fq; EPI_SEED(rl, cl);
        const int row0 = u.pm * BM + rl, col0 = u.pn * BM + cl;
        const unsigned g0 = ((unsigned)row0 * 2048 + 1024 + col0) * 2u, m0 = ((unsigned)row0 * D + col0) * 2u;
        f32x4 bv[2][2];
#pragma unroll
        for (int bj = 0; bj < 2; ++bj)
#pragma unroll
            for (int n = 0; n < 2; ++n) bv[bj][n] = ldg<f32x4>(bc, (unsigned)(col0 + bj * HALF + 4 * n) * 4u);
#pragma unroll
        for (int ai = 0; ai < 2; ++ai)
#pragma unroll
            for (int m = 0; m < 4; ++m) {
#pragma unroll
                for (int bj = 0; bj < 2; ++bj) { const u32x4 gb = ldg<u32x4>(gates, g0 + (unsigned)((ai * HALF + m * 16) * 2048 + bj * HALF) * 2u); f32x4 o[2];
#pragma unroll
                    for (int n = 0; n < 2; ++n) { const f32x4 v = acc[ai][bj][m][n] + bv[bj][n];
                        o[n][0] = v[0] * bflo(gb[2 * n]); o[n][1] = v[1] * bfhi(gb[2 * n]); o[n][2] = v[2] * bflo(gb[2 * n + 1]); o[n][3] = v[3] * bfhi(gb[2 * n + 1]); }
                    stg<u32x4>(merged, m0 + (unsigned)((ai * HALF + m * 16) * D + bj * HALF) * 2u, pack8(o[0], o[1])); }
                if (m & 1) asm volatile("" ::: "memory"); }
    }
};
struct EpiPre1 {
    static constexpr int SCALE_B = 0, SCALE_A = 0;
    static constexpr bool PERM = false; static constexpr int MID_T = 0;
    const bf16* xb; bf16* out;
    __device__ __forceinline__ void mid(Acc&, const Unit&, int, int, int, int) const {}
    __device__ __forceinline__ void operator()(const Acc& acc, const Unit& u, int wr, int wc, int fr, int fq) const {
        int rl = wr * 64 + fr, cl = wc * 32 + 4 * fq; EPI_SEED(rl, cl);
        const unsigned o0 = ((unsigned)(u.pm * BM + rl) * D + u.pn * BM + cl);
#pragma unroll
        for (int ai = 0; ai < 2; ++ai) { u32x2 xv[4][2][2];
#pragma unroll
            for (int m = 0; m < 4; ++m)
#pragma unroll
                for (int bj = 0; bj < 2; ++bj)
#pragma unroll
                    for (int n = 0; n < 2; ++n) xv[m][bj][n] = ldg<u32x2>(xb, (o0 + (unsigned)((ai * HALF + m * 16) * D + bj * HALF + n * 16)) * 2u);
            __builtin_amdgcn_sched_barrier(0);
#pragma unroll
            for (int m = 0; m < 4; ++m)
#pragma unroll
                for (int bj = 0; bj < 2; ++bj)
#pragma unroll
                    for (int n = 0; n < 2; ++n) { const u32x2 w = xv[m][bj][n]; const f32x4 r = (f32x4){bflo(w.x), bfhi(w.x), bflo(w.y), bfhi(w.y)} * DN_ALPHA + acc[ai][bj][m][n];
                        stg<u32x2>(out, (o0 + (unsigned)((ai * HALF + m * 16) * D + bj * HALF + n * 16)) * 2u, (u32x2){cvt_pk_bf16(r[0], r[1]), cvt_pk_bf16(r[2], r[3])}); }
            __builtin_amdgcn_sched_barrier(0); }
    }
};
struct EpiUp {
    static constexpr bool PERM = true; static constexpr int MID_T = 0;
    static constexpr int SCALE_B = 0x79797979, SCALE_A = 0x7C7C7C7C;
    const float* b_up; unsigned char* act;
    __device__ __forceinline__ void mid(Acc&, const Unit&, int, int, int, int) const {}
    __device__ __forceinline__ void operator()(const Acc& acc, const Unit& u, int wr, int wc, int fr, int fq) const {
        int rl = wr * 64 + fr, cl = wc * 32 + 8 * fq; EPI_SEED(rl, cl);
        const unsigned o0 = (unsigned)(u.pm * BM + rl) * DE + u.pn * HALF + (cl >> 1);
        f32x4 bv[2][2];
#pragma unroll
        for (int bj = 0; bj < 2; ++bj)
#pragma unroll
            for (int n = 0; n < 2; ++n) bv[bj][n] = ldg<f32x4>(b_up, (unsigned)(u.e * 2048 + u.pn * BM + cl + bj * HALF + 4 * n) * 4u);
#pragma unroll
        for (int ai = 0; ai < 2; ++ai)
#pragma unroll
            for (int m = 0; m < 4; ++m)
#pragma unroll
                for (int bj = 0; bj < 2; ++bj) { float o[4];
#pragma unroll
                    for (int n = 0; n < 2; ++n) { const f32x4 v = acc[ai][bj][m][n] + bv[bj][n];
#pragma unroll
                        for (int p = 0; p < 2; ++p) { const float xg = fminf(v[2 * p], 7.0f), xl = fminf(fmaxf(v[2 * p + 1], -7.0f), 7.0f);
                            o[2 * n + p] = xg * sigmoidf_(1.702f * xg) * (xl + 1.0f); } }
                    unsigned w = 0u; w = __builtin_amdgcn_cvt_pk_fp8_f32(o[0] * 8.0f, o[1] * 8.0f, w, false); w = __builtin_amdgcn_cvt_pk_fp8_f32(o[2] * 8.0f, o[3] * 8.0f, w, true);
                    __hip_atomic_store((unsigned*)(act + (o0 + (unsigned)((ai * HALF + m * 16) * DE + bj * 64))), w, __ATOMIC_RELAXED, __HIP_MEMORY_SCOPE_AGENT); }
    }
};
struct EpiDown {
    static constexpr bool PERM = true; static constexpr int MID_T = 0;
    static constexpr int SCALE_B = 0x79797979, SCALE_A = 0x7C7C7C7C;
    const float* b_dn; const int* slot; unsigned char* ys;
    __device__ __forceinline__ void mid(Acc&, const Unit&, int, int, int, int) const {}
    __device__ __forceinline__ void operator()(const Acc& acc, const Unit& u, int wr, int wc, int fr, int fq) const {
        int rl = wr * 64 + fr, cl = wc * 32 + 8 * fq; EPI_SEED(rl, cl);
        const int col0 = u.pn * BM + cl, idx0 = u.mt * BM + rl;
        f32x4 bv[2][2];
#pragma unroll
        for (int bj = 0; bj < 2; ++bj)
#pragma unroll
            for (int n = 0; n < 2; ++n) bv[bj][n] = ldg<f32x4>(b_dn, (unsigned)(u.e * D + col0 + bj * HALF + 4 * n) * 4u);
        int asg[2][4];
#pragma unroll
        for (int ai = 0; ai < 2; ++ai)
#pragma unroll
            for (int m = 0; m < 4; ++m) { const int idx = idx0 + ai * HALF + m * 16; asg[ai][m] = ldg<int>(slot, (unsigned)(u.e * SLOT_CAP + (idx < u.cnt ? idx : u.cnt - 1)) * 4u); }
#pragma unroll
        for (int ai = 0; ai < 2; ++ai)
#pragma unroll
            for (int m = 0; m < 4; ++m) { const int idx = idx0 + ai * HALF + m * 16;
                if (idx < u.cnt) { const unsigned o0 = (unsigned)asg[ai][m] * D + col0;
#pragma unroll
                    for (int bj = 0; bj < 2; ++bj) { const f32x4 v0 = (acc[ai][bj][m][0] + bv[bj][0]) * 16.0f, v1 = (acc[ai][bj][m][1] + bv[bj][1]) * 16.0f;
                        u32x2 w; w.x = __builtin_amdgcn_cvt_pk_fp8_f32(v0[0], v0[1], 0u, false); w.x = __builtin_amdgcn_cvt_pk_fp8_f32(v0[2], v0[3], w.x, true);
                        w.y = __builtin_amdgcn_cvt_pk_fp8_f32(v1[0], v1[1], 0u, false); w.y = __builtin_amdgcn_cvt_pk_fp8_f32(v1[2], v1[3], w.y, true);
                        stg<u32x2>(ys, o0 + (unsigned)(bj * HALF), w); } } }
    }
};
struct EpiUpX {
    const float* b_up; unsigned char* act;
    __device__ __forceinline__ void operator()(const Acc& acc, const Unit& u, int wr, int wc, int fr, int fq) const {
        int rl = wr * 64 + fr, cb = 64 * wc + 32 * (fq & 1) + 16 * (fq >> 1); EPI_SEED(rl, cb);
        f32x4 bv[2][2];
#pragma unroll
        for (int bj = 0; bj < 2; ++bj)
#pragma unroll
            for (int n = 0; n < 2; ++n) bv[bj][n] = ldg<f32x4>(b_up, (unsigned)(u.e * 2048 + u.pn * BM + cb + 8 * bj + 4 * n) * 4u);
        const __amdgpu_buffer_rsrc_t rs = __builtin_amdgcn_make_buffer_rsrc(act, 0, (MAX_MT * 256) * 1024, 0x00020000);
        const unsigned o0 = (unsigned)(u.pm * BM + rl + 16 * (fq >> 1)) * DE + u.pn * HALF + 32 * wc + 16 * (fq & 1);
#pragma unroll
        for (int ai = 0; ai < 2; ++ai)
#pragma unroll
            for (int j = 0; j < 2; ++j) { unsigned d[2][2];
#pragma unroll
                for (int mm = 0; mm < 2; ++mm)
#pragma unroll
                    for (int bj = 0; bj < 2; ++bj) { float o[4];
#pragma unroll
                        for (int n = 0; n < 2; ++n) { const f32x4 v = acc[ai][bj][2 * j + mm][n] + bv[bj][n];
#pragma unroll
                            for (int p = 0; p < 2; ++p) { const float xg = fminf(v[2 * p], 7.0f), xl = fminf(fmaxf(v[2 * p + 1], -7.0f), 7.0f);
                                o[2 * n + p] = (xg * __builtin_amdgcn_rcpf(1.0f + __builtin_amdgcn_exp2f(xg * (-1.702f * 1.44269504f)))) * __builtin_fmaf(xl, 8.0f, 8.0f); } }
                        unsigned w = 0u; w = __builtin_amdgcn_cvt_pk_fp8_f32(o[0], o[1], w, false); w = __builtin_amdgcn_cvt_pk_fp8_f32(o[2], o[3], w, true); d[mm][bj] = w; }
                const u32x2 s0 = __builtin_amdgcn_permlane32_swap(d[0][0], d[1][0], false, false), s1 = __builtin_amdgcn_permlane32_swap(d[0][1], d[1][1], false, false);
                const u32x4 w4 = (u32x4){s0.x, s1.x, s0.y, s1.y};
                __builtin_amdgcn_raw_buffer_store_b128(w4, rs, o0 + (unsigned)((ai * HALF + 32 * j) * DE), 0, 16); }
    }
};
struct EpiMoe {
    static constexpr bool PERM = true; static constexpr int MID_T = 0;
    static constexpr int SCALE_B = 0x79797979, SCALE_A = 0x7C7C7C7C;
    EpiUpX up; EpiDown dn;
    __device__ __forceinline__ void mid(Acc&, const Unit&, int, int, int, int) const {}
    __device__ __forceinline__ void operator()(const Acc& acc, const Unit& u, int wr, int wc, int fr, int fq) const { if (u.type == 0) up(acc, u, wr, wc, fr, fq); else dn(acc, u, wr, wc, fr, fq); }
};
}

#define XB_TMO      128
#define XB_XCNT(j)  (256  + 64 * (j))
#define XB_XSUB(j)  (1280 + 64 * (j))
#define XB_XGEN(j)  (2304 + 64 * (j))
#define XB_TOP      3328
#define XB_TOPGEN   3392
#define XCD_BAR_WORDS 3456
#define XB_SPIN_CAP (1u << 18)
__device__ __forceinline__ unsigned xb_ld(unsigned* p)              { return __hip_atomic_load(p, __ATOMIC_RELAXED, __HIP_MEMORY_SCOPE_AGENT); }
__device__ __forceinline__ unsigned xb_add(unsigned* p, unsigned v) { return __hip_atomic_fetch_add(p, v, __ATOMIC_RELAXED, __HIP_MEMORY_SCOPE_AGENT); }
__device__ __forceinline__ unsigned xb_xcc_id() { return (unsigned)__builtin_amdgcn_s_getreg((3 << 11) | 20) & 0xFu; }
#define XB_SPIN(cond, bar) do { unsigned _sp = 0; while (cond) { __builtin_amdgcn_s_sleep(1); \
    if ((++_sp & 255u) == 0u) { if (xb_ld(&(bar)[XB_TMO])) break; if (_sp > XB_SPIN_CAP) { atomicAdd(&(bar)[XB_TMO], 1u); break; } } } } while (0)
struct XcdBarrier { unsigned* bar; unsigned x; volatile LAS unsigned* st; };
__device__ __forceinline__ XcdBarrier xcd_barrier_post(unsigned* bar, volatile LAS unsigned* st) {
    XcdBarrier b; b.bar = bar; b.x = xb_xcc_id(); b.st = st;
    if (threadIdx.x == 0) (void)xb_add(&bar[XB_XCNT(b.x)], 1u);
    return b;
}
__device__ __forceinline__ void xcd_barrier_complete(unsigned* bar, unsigned x, unsigned& nloc, unsigned& nx) {
    const unsigned G = gridDim.x * gridDim.y * gridDim.z;
    unsigned sum, cnt, mine, sp = 0u;
    for (;;) {
        sum = 0u; cnt = 0u; mine = 0u;
#pragma unroll
        for (unsigned j = 0; j < 16; ++j) { const unsigned c = xb_ld(&bar[XB_XCNT(j)]); sum += c; cnt += (c > 0u) ? 1u : 0u; mine = (j == x) ? c : mine; }
        if (sum == G) break;
        __builtin_amdgcn_s_sleep(1);
        if ((++sp & 255u) == 0u) { if (xb_ld(&bar[XB_TMO])) break; if (sp > XB_SPIN_CAP) { atomicAdd(&bar[XB_TMO], 1u); break; } }
    }
    nloc = mine > 0u ? mine : 1u; nx = cnt > 0u ? cnt : 1u;
}
__device__ __forceinline__ void xcd_barrier(const XcdBarrier& b) {
    asm volatile("s_waitcnt vmcnt(0)" ::: "memory");
    __syncthreads();
    if (threadIdx.x == 64) asm volatile("buffer_inv sc1\n\ts_waitcnt vmcnt(0)" ::: "memory");
    if (threadIdx.x == 0) {
        unsigned* bar = b.bar;
        __builtin_amdgcn_s_waitcnt(0);
        unsigned nloc = b.st[0], nx = b.st[1];
        if (nloc == 0u) { xcd_barrier_complete(bar, b.x, nloc, nx); b.st[0] = nloc; b.st[1] = nx; }
        const unsigned old = xb_add(&bar[XB_XSUB(b.x)], 1u);
        const unsigned gen = old / nloc;
        if (old + 1u == (gen + 1u) * nloc) {
            __builtin_amdgcn_fence(__ATOMIC_RELEASE, "agent");
            asm volatile("s_waitcnt vmcnt(0)" ::: "memory");
            const unsigned og = xb_add(&bar[XB_TOP], 1u);
            const unsigned tg = og / nx;
            if (og + 1u == (tg + 1u) * nx) xb_add(&bar[XB_TOPGEN], 1u);
            else XB_SPIN(xb_ld(&bar[XB_TOPGEN]) == tg, bar);
            xb_add(&bar[XB_XGEN(b.x)], 1u);
            asm volatile("s_waitcnt vmcnt(0)" ::: "memory");
        } else {
            XB_SPIN(xb_ld(&bar[XB_XGEN(b.x)]) == gen, bar);
            asm volatile("s_waitcnt vmcnt(0)" ::: "memory");
        }
    }
    __syncthreads();
}


__device__ __forceinline__ void tr_item(const float* W, int ldw, int scol0, int srow0, bf16* WT, int Kd, int drow0, int dk0, LAS float* scr, int lane) {
#pragma unroll 8
    for (int i = 0; i < 32; ++i) { const int kk = 2 * i + (lane >> 5); scr[kk * 33 + (lane & 31)] = __builtin_nontemporal_load(W + (size_t)(srow0 + kk) * ldw + scol0 + (lane & 31)); }
    LDS_WAIT(); asm volatile("" ::: "memory");
    const int c = lane & 7;
#pragma unroll
    for (int j = 0; j < 4; ++j) { const int n = (lane >> 3) + 8 * j; const LAS float* s = scr + (8 * c) * 33 + n;
        u32x4 o; o.x = pk2(s[0 * 33], s[1 * 33]); o.y = pk2(s[2 * 33], s[3 * 33]); o.z = pk2(s[4 * 33], s[5 * 33]); o.w = pk2(s[6 * 33], s[7 * 33]);
        *(u32x4*)(WT + (size_t)(drow0 + n) * Kd + dk0 + 8 * c) = o; }
    LDS_WAIT(); asm volatile("" ::: "memory");
}
__device__ __forceinline__ int src_col_u(int np) {
    if (np < 768) return np;
    if (np >= 1792) { const int tt = (np - 1792) >> 8, w = (np - 1792) & 255; return w < 128 ? 1792 + 128 * tt + w : 2816 + 128 * tt + (w - 128); }
    const int tt = (np - 768) >> 8, w = (np - 768) & 255;
    return w < 128 ? 768 + 128 * tt + w : 1280 + 128 * tt + (w - 128);
}

__device__ __forceinline__ void p0_prologue(const Args& a, LAS unsigned char* lds, int gw, int NGW, int lane, int wave) {
    unsigned char* ws = a.ws;
    LAS float* scr = (LAS float*)(lds + wave * 16384);
    constexpr int J1 = 16 * 120, J2 = 8 * 32, J3 = 8 * 32, J4 = 16 * 32;
    constexpr int NITEMS = J1 + J2 + J3 + J4;
    for (int it = gw; it < NITEMS; it += NGW) {
        int r = it;
        if (r < J1) { const int kb = r / 120, nb = r % 120; tr_item(a.in[I_WIN], INW, src_col_u(32 * nb), 64 * kb, (bf16*)(ws + WS_WIN), 1024, 32 * nb, 64 * kb, scr, lane); continue; } r -= J1;
        if (r < J2) { const int kb = r / 32, nb = r % 32; tr_item(a.in[I_WATT], D, 32 * nb, 64 * kb, (bf16*)(ws + WS_WAB), 1024, 32 * nb, 64 * kb, scr, lane); continue; } r -= J2;
        if (r < J3) { const int kb = r / 32, nb = r % 32; tr_item(a.in[I_WCONV], D, 32 * nb, 64 * kb, (bf16*)(ws + WS_WAB), 1024, 32 * nb, 512 + 64 * kb, scr, lane); continue; } r -= J3;
        { const int kb = r / 32, nb = r % 32; tr_item(a.in[I_WO], D, 32 * nb, 64 * kb, (bf16*)(ws + WS_WO), 1024, 32 * nb, 64 * kb, scr, lane); }
    }
    const float* x = a.in[I_X]; bf16* xb = (bf16*)(ws + WS_XB);
    for (int m = gw; m < T; m += NGW) {
        const f32x4* xr = (const f32x4*)(x + (size_t)m * D) + lane; u32x2* o = (u32x2*)(xb + (size_t)m * D) + lane;
#pragma unroll
        for (int j = 0; j < 4; ++j) { const f32x4 v = __builtin_nontemporal_load(xr + 64 * j); u32x2 w; w.x = pk2(v[0], v[1]); w.y = pk2(v[2], v[3]); o[64 * j] = w; }
    }
    { u32x4* abz = (u32x4*)(ws + WS_AB); const u32x4 z4 = (u32x4){0u, 0u, 0u, 0u};
      for (int i = gw * 64 + lane; i < NBATCH * AB_PAD * CCH * 2 / 16; i += NGW * 64) { const int bb = i / (AB_PAD * CCH * 2 / 16), q = i % (AB_PAD * CCH * 2 / 16); abz[(size_t)bb * (AB_SEQ * CCH * 2 / 16) + q] = z4; } }
    float* bperm = (float*)(ws + WS_BPERM);
    for (int i = gw * 64 + lane; i < INW; i += NGW * 64) bperm[i] = a.in[I_BIN][src_col_u(i)];
}

constexpr int KLS = 144, VLS = 528, ATT_V_OFF = 256 * KLS, CONV_W_OFF = 70656;
__device__ __forceinline__ void attn_unit(const Args& a, int unit, LAS unsigned char* lds, int tid, int wave, int lane) {
    const bf16* qb = (const bf16*)(a.ws + WS_QB); const bf16* kb = (const bf16*)(a.ws + WS_KB); const bf16* vT = (const bf16*)(a.ws + WS_VT); bf16* ay = (bf16*)(a.ws + WS_AY);
    const int kvh = unit & 1, blk = (unit >> 1) & 31, b = unit >> 6;
    const int r = lane & 15, qd = lane >> 4, w = wave;
    const int t0 = b * SEQ + blk * 128, seq0 = b * SEQ, lo = w & ~1;
    { u32x4 kreg[4], vreg[4];
#pragma unroll
      for (int i = 0; i < 4; ++i) { const int c = tid + 512 * i;
          int tok = t0 - 128 + (c >> 3); tok = tok < seq0 ? seq0 : tok;
          kreg[i] = ldgo<u32x4>(kb, (unsigned)(tok * KVW + kvh * HD + (c & 7) * 8) * 2u);
          int sk = blk * 128 - 128 + 8 * (c & 31); sk = sk < 0 ? 0 : sk;
          vreg[i] = ldgo<u32x4>(vT, (unsigned)(((b * NKV + kvh) * HD + (c >> 5)) * SEQ + sk) * 2u); }
      __builtin_amdgcn_sched_barrier(0);
      asm volatile("" : "+v"(kreg[0]), "+v"(kreg[1]), "+v"(kreg[2]), "+v"(kreg[3]), "+v"(vreg[0]), "+v"(vreg[1]), "+v"(vreg[2]), "+v"(vreg[3]));
#pragma unroll
      for (int i = 0; i < 4; ++i) { const int c = tid + 512 * i;
          *(LAS u32x4*)(lds + (c >> 3) * KLS + (c & 7) * 16) = kreg[i];
          *(LAS u32x4*)(lds + ATT_V_OFF + (c >> 5) * VLS + (c & 31) * 16) = vreg[i]; } }
    __syncthreads();
    const int qi = 16 * w + r;
#pragma unroll 1
    for (int hh = 0; hh < 4; ++hh) {
        const int head = kvh * 4 + hh;
        u32x4 qf[2];
        { const unsigned qo = (unsigned)((t0 + qi) * AW + head * HD + 8 * qd) * 2u; qf[0] = ldgo<u32x4>(qb, qo); qf[1] = ldgo<u32x4>(qb, qo + 64u); }
        const float sinkv = a.in[I_SINK][head];
        int qiv = qi; asm volatile("" : "+v"(qiv));
        const int klo = max(qiv + 1, blk > 0 ? 0 : 128); const int kjb = lo * 16 + 4 * qd - klo; const unsigned span = (unsigned)(qiv + 128 - klo);
        f32x4 s[10];
#pragma unroll
        for (int i = 0; i < 10; ++i) {
            const LAS unsigned char* kp = lds + ((lo + i) * 16 + r) * KLS + qd * 16;
            const u32x4 k0 = *(const LAS u32x4*)kp, k1 = *(const LAS u32x4*)(kp + 64);
            f32x4 z = (f32x4){0.f, 0.f, 0.f, 0.f};
            z = __builtin_amdgcn_mfma_f32_16x16x32_bf16(__builtin_bit_cast(bf16x8, k0), __builtin_bit_cast(bf16x8, qf[0]), z, 0, 0, 0);
            s[i] = __builtin_amdgcn_mfma_f32_16x16x32_bf16(__builtin_bit_cast(bf16x8, k1), __builtin_bit_cast(bf16x8, qf[1]), z, 0, 0, 0);
        }
        float mx = sinkv;
#pragma unroll
        for (int i = 0; i < 10; ++i)
#pragma unroll
            for (int g = 0; g < 4; ++g) { const bool valid = (unsigned)(kjb + (16 * i + g)) <= span; s[i][g] = valid ? s[i][g] : -1e30f; mx = fmaxf(mx, s[i][g]); }
        mx = fmaxf(mx, __shfl_xor(mx, 16)); mx = fmaxf(mx, __shfl_xor(mx, 32));
        float sum = 0.f;
#pragma unroll
        for (int i = 0; i < 10; ++i)
#pragma unroll
            for (int g = 0; g < 4; ++g) { const float p = (s[i][g] > -1e29f) ? __expf(s[i][g] - mx) : 0.f; s[i][g] = p; sum += p; }
        sum += __shfl_xor(sum, 16); sum += __shfl_xor(sum, 32);
        const float inv = 1.0f / (sum + __expf(sinkv - mx));
        f32x4 o[4];
#pragma unroll
        for (int mt = 0; mt < 4; ++mt) o[mt] = (f32x4){0.f, 0.f, 0.f, 0.f};
#pragma unroll
        for (int ip = 0; ip < 5; ++ip) {
            u32x4 pw; pw.x = cvt_pk_bf16(s[2 * ip][0], s[2 * ip][1]); pw.y = cvt_pk_bf16(s[2 * ip][2], s[2 * ip][3]); pw.z = cvt_pk_bf16(s[2 * ip + 1][0], s[2 * ip + 1][1]); pw.w = cvt_pk_bf16(s[2 * ip + 1][2], s[2 * ip + 1][3]);
            const bf16x8 pb = __builtin_bit_cast(bf16x8, pw);
#pragma unroll
            for (int mt = 0; mt < 4; ++mt) { const LAS unsigned char* vp = lds + ATT_V_OFF + (16 * mt + r) * VLS + ((lo + 2 * ip) * 16 + 4 * qd) * 2;
                const u32x2 va = *(const LAS u32x2*)vp, vb = *(const LAS u32x2*)(vp + 32);
                u32x4 vw; vw.x = va.x; vw.y = va.y; vw.z = vb.x; vw.w = vb.y;
                o[mt] = __builtin_amdgcn_mfma_f32_16x16x32_bf16(__builtin_bit_cast(bf16x8, vw), pb, o[mt], 0, 0, 0); }
        }
        const unsigned oo = (unsigned)((t0 + qi) * D + head * HD + 4 * qd) * 2u;
#pragma unroll
        for (int mt = 0; mt < 4; ++mt) { u32x2 wv; wv.x = cvt_pk_bf16(o[mt][0] * inv, o[mt][1] * inv); wv.y = cvt_pk_bf16(o[mt][2] * inv, o[mt][3] * inv); *(u32x2*)((char*)ay + oo + 32u * mt) = wv; }
    }
    __syncthreads();
}

constexpr int CBS = 516;
__device__ __forceinline__ void conv_unit(const Args& a, int unit, LAS unsigned char* lds, int tid, int wave, int lane) {
    const bf16* ab = (const bf16*)(a.ws + WS_AB); bf16* ay = (bf16*)(a.ws + WS_AY);
    LAS float* cb = (LAS float*)lds;
    const int t0 = unit * 32, prow0 = t0 + AB_PAD * ((t0 >> 12) + 1);
    int cp = tid & 255; asm volatile("" : "+v"(cp));
    const int half = wave >> 2;
    const LAS float* wl = (const LAS float*)(lds + CONV_W_OFF) + 2 * cp;
    const f32x2 cbias = *(const f32x2*)(a.in[I_CONVB] + 2 * cp);
#pragma unroll 1
    for (int it = 0; it < 2; ++it) {
        const int tl0 = 16 * half + 8 * it;
        const unsigned o0 = (unsigned)((prow0 + tl0 - 30) * CCH + 2 * cp) * 2u;
        unsigned raw[38];
#pragma unroll
        for (int rr = 0; rr < 38; ++rr) raw[rr] = ldgo<unsigned>(ab, o0 + (unsigned)(rr * CCH * 2));
        __builtin_amdgcn_sched_barrier(0);
        asm volatile("" : "+v"(raw[0]), "+v"(raw[1]), "+v"(raw[2]), "+v"(raw[3]), "+v"(raw[4]), "+v"(raw[5]), "+v"(raw[6]), "+v"(raw[7]), "+v"(raw[8]), "+v"(raw[9]),
                          "+v"(raw[10]), "+v"(raw[11]), "+v"(raw[12]), "+v"(raw[13]), "+v"(raw[14]), "+v"(raw[15]), "+v"(raw[16]), "+v"(raw[17]), "+v"(raw[18]));
        asm volatile("" : "+v"(raw[19]), "+v"(raw[20]), "+v"(raw[21]), "+v"(raw[22]), "+v"(raw[23]), "+v"(raw[24]), "+v"(raw[25]), "+v"(raw[26]), "+v"(raw[27]), "+v"(raw[28]),
                          "+v"(raw[29]), "+v"(raw[30]), "+v"(raw[31]), "+v"(raw[32]), "+v"(raw[33]), "+v"(raw[34]), "+v"(raw[35]), "+v"(raw[36]), "+v"(raw[37]));
        float i0[38], i1[38];
#pragma unroll
        for (int rr = 0; rr < 38; ++rr) { i0[rr] = bflo(raw[rr]); i1[rr] = bfhi(raw[rr]); }
        float a0[8], a1[8];
#pragma unroll
        for (int o = 0; o < 8; ++o) { a0[o] = cbias.x; a1[o] = cbias.y; }
#pragma unroll
        for (int j = 0; j < CW; ++j) { const f32x2 wv = *(const LAS f32x2*)(wl + j * CCH);
#pragma unroll
            for (int o = 0; o < 8; ++o) { a0[o] = fmaf(i0[o + j], wv.x, a0[o]); a1[o] = fmaf(i1[o + j], wv.y, a1[o]); } }
#pragma unroll
        for (int o = 0; o < 8; ++o) *(LAS f32x2*)(cb + (tl0 + o) * CBS + 2 * cp) = (f32x2){a0[o], a1[o]};
    }
    __syncthreads();
    const f32x4 g0 = *(const f32x4*)(a.in[I_CLNG] + 8 * lane), g1 = *(const f32x4*)(a.in[I_CLNG] + 8 * lane + 4), b0 = *(const f32x4*)(a.in[I_CLNB] + 8 * lane), b1 = *(const f32x4*)(a.in[I_CLNB] + 8 * lane + 4);
#pragma unroll
    for (int tt = 0; tt < 4; ++tt) { const int tok = 4 * wave + tt;
        f32x4 v0 = *(const LAS f32x4*)(cb + tok * CBS + 8 * lane), v1 = *(const LAS f32x4*)(cb + tok * CBS + 8 * lane + 4);
        const float mean = wave_sum((v0[0] + v0[1]) + (v0[2] + v0[3]) + (v1[0] + v1[1]) + (v1[2] + v1[3])) * (1.0f / CCH);
        v0 = v0 - mean; v1 = v1 - mean;
        const float var = wave_sum((v0[0] * v0[0] + v0[1] * v0[1]) + (v0[2] * v0[2] + v0[3] * v0[3]) + (v1[0] * v1[0] + v1[1] * v1[1]) + (v1[2] * v1[2] + v1[3] * v1[3])) * (1.0f / CCH);
        const float rstd = 1.0f / sqrtf(var + LN_EPS);
        float y[8];
#pragma unroll
        for (int j = 0; j < 4; ++j) { const float y0 = v0[j] * rstd * g0[j] + b0[j], y1 = v1[j] * rstd * g1[j] + b1[j]; y[j] = y0 * sigmoidf_(y0); y[4 + j] = y1 * sigmoidf_(y1); }
        u32x4 wv; wv.x = cvt_pk_bf16(y[0], y[1]); wv.y = cvt_pk_bf16(y[2], y[3]); wv.z = cvt_pk_bf16(y[4], y[5]); wv.w = cvt_pk_bf16(y[6], y[7]);
        *(u32x4*)(ay + (size_t)(t0 + tok) * D + 512 + 8 * lane) = wv; }
    __syncthreads();
}

constexpr int HLS = 1025;
__device__ __forceinline__ void route_chunk(const Args& a, int chunk, LAS unsigned char* lds, int tid, int wave, int lane, const float (&bw)[64], const f32x4 (&g)[4], const f32x4 (&bb)[4]) {
    const bf16* hf = (const bf16*)(a.ws + WS_HF); unsigned char* hb = a.ws + WS_HB;
    int* slot = (int*)(a.ws + WS_SLOT); float* gatev = (float*)(a.ws + WS_GATE); unsigned* cursor = (unsigned*)(a.ws + WS_CTL);
    LAS float* hl = (LAS float*)lds;
    LAS float* lg = (LAS float*)(lds + MISC_OFF + MO_LG); LAS int* sel_e = (LAS int*)(lds + MISC_OFF + MO_SELE); LAS float* sel_g = (LAS float*)(lds + MISC_OFF + MO_SELG);
    LAS int* lcnt = (LAS int*)(lds + MISC_OFF + MO_LCNT); LAS int* lbase = (LAS int*)(lds + MISC_OFF + MO_LBASE);
    const int t0 = chunk * 32;
    f32x4 v[4][4];
    { u32x2 rw[4][4];
#pragma unroll
      for (int tt = 0; tt < 4; ++tt)
#pragma unroll
        for (int j = 0; j < 4; ++j) rw[tt][j] = *((const u32x2*)(hf + (size_t)(t0 + 4 * wave + tt) * D) + lane + 64 * j);
      __builtin_amdgcn_sched_barrier(0);
      asm volatile("" : "+v"(rw[0][0]), "+v"(rw[0][1]), "+v"(rw[0][2]), "+v"(rw[0][3]), "+v"(rw[1][0]), "+v"(rw[1][1]), "+v"(rw[1][2]), "+v"(rw[1][3]),
                        "+v"(rw[2][0]), "+v"(rw[2][1]), "+v"(rw[2][2]), "+v"(rw[2][3]), "+v"(rw[3][0]), "+v"(rw[3][1]), "+v"(rw[3][2]), "+v"(rw[3][3]));
#pragma unroll
      for (int tt = 0; tt < 4; ++tt)
#pragma unroll
        for (int j = 0; j < 4; ++j) v[tt][j] = (f32x4){bflo(rw[tt][j].x), bfhi(rw[tt][j].x), bflo(rw[tt][j].y), bfhi(rw[tt][j].y)}; }
#pragma unroll
    for (int tt = 0; tt < 4; ++tt) { const int tl = 4 * wave + tt;
        float sm = 0.f;
#pragma unroll
        for (int j = 0; j < 4; ++j) sm += (v[tt][j][0] + v[tt][j][1]) + (v[tt][j][2] + v[tt][j][3]);
        const float mean = wave_sum(sm) * (1.0f / D); float s2 = 0.f;
#pragma unroll
        for (int j = 0; j < 4; ++j) { v[tt][j] = v[tt][j] - mean; s2 += (v[tt][j][0] * v[tt][j][0] + v[tt][j][1] * v[tt][j][1]) + (v[tt][j][2] * v[tt][j][2] + v[tt][j][3] * v[tt][j][3]); }
        const float rstd = 1.0f / sqrtf(wave_sum(s2) * (1.0f / D) + LN_EPS);
        if (lane == 0) *(f32x2*)((float*)(a.ws + WS_LN1S) + 2 * (size_t)(t0 + tl)) = (f32x2){mean, rstd};
#pragma unroll
        for (int j = 0; j < 4; ++j) { const f32x4 h = v[tt][j] * rstd * g[j] + bb[j];
            unsigned wv = 0u; wv = __builtin_amdgcn_cvt_pk_fp8_f32(h[0] * 8.0f, h[1] * 8.0f, wv, false); wv = __builtin_amdgcn_cvt_pk_fp8_f32(h[2] * 8.0f, h[3] * 8.0f, wv, true); *((unsigned*)(hb + (size_t)(t0 + tl) * D) + lane + 64 * j) = wv;
            LAS float* hp = hl + tl * HLS + 4 * lane + 256 * j; hp[0] = h[0]; hp[1] = h[1]; hp[2] = h[2]; hp[3] = h[3]; }
    }
    if (tid < 32) lcnt[tid] = 0;
    __syncthreads();
    f32x16 acc;
#pragma unroll
    for (int i = 0; i < 16; ++i) acc[i] = 0.f;
    { const int tok = lane & 31, kp = lane >> 5; const LAS float* hp = hl + tok * HLS + 128 * wave + kp;
#pragma unroll
      for (int s = 0; s < 64; ++s) acc = __builtin_amdgcn_mfma_f32_32x32x2f32(hp[2 * s], bw[s], acc, 0, 0, 0); }
    __syncthreads();
    { LAS float* part = hl + wave * 1024;
#pragma unroll
      for (int i = 0; i < 16; ++i) { const int rowi = (i & 3) + 8 * (i >> 2) + 4 * (lane >> 5); part[rowi * 32 + (lane & 31)] = acc[i]; } }
    __syncthreads();
    for (int o = tid; o < 1024; o += 512) { float sm = a.in[I_BR][o & 31];
#pragma unroll
        for (int w = 0; w < 8; ++w) sm += hl[w * 1024 + o];
        lg[(o >> 5) * 33 + (o & 31)] = sm; }
    __syncthreads();
    if (tid < 32) { float v[NE];
#pragma unroll
        for (int e = 0; e < NE; ++e) v[e] = lg[tid * 33 + e];
        float tv[4]; int ti[4];
#pragma unroll
        for (int k = 0; k < 4; ++k) { float best = -3.0e38f; int bi = 0;
#pragma unroll
            for (int e = 0; e < NE; ++e) { const bool take = v[e] > best; best = take ? v[e] : best; bi = take ? e : bi; }
            tv[k] = best; ti[k] = bi;
#pragma unroll
            for (int e = 0; e < NE; ++e) v[e] = (e == bi) ? -3.0e38f : v[e]; }
        const float e1 = __expf(tv[1] - tv[0]), e2 = __expf(tv[2] - tv[0]), e3 = __expf(tv[3] - tv[0]); const float inv = 1.0f / (1.0f + e1 + e2 + e3);
        sel_e[4 * tid + 0] = ti[0]; sel_e[4 * tid + 1] = ti[1]; sel_e[4 * tid + 2] = ti[2]; sel_e[4 * tid + 3] = ti[3];
        sel_g[4 * tid + 0] = inv; sel_g[4 * tid + 1] = e1 * inv; sel_g[4 * tid + 2] = e2 * inv; sel_g[4 * tid + 3] = e3 * inv; }
    __syncthreads();
    int my_e = 0, my_rank = 0;
    if (tid < 128) { my_e = sel_e[tid]; my_rank = atomicAdd((int*)&lcnt[my_e], 1); }
    __syncthreads();
    if (tid < 32) { const int c = lcnt[tid]; lbase[tid] = c > 0 ? (int)atomicAdd(cursor + tid, (unsigned)c) : 0; }
    __syncthreads();
    if (tid < 128) { const int asg = (t0 + (tid >> 2)) * 4 + (tid & 3); slot[my_e * SLOT_CAP + lbase[my_e] + my_rank] = asg; gatev[asg] = sel_g[tid]; }
    __syncthreads();
}

__device__ __forceinline__ void combine_row(const Args& a, int m, int lane) {
    const bf16* hf = (const bf16*)(a.ws + WS_HF); const unsigned char* ys = a.ws + WS_YS; const float* gatev = (const float*)(a.ws + WS_GATE);
    f32x4 gt = *(const f32x4*)(gatev + 4 * (size_t)m); gt = gt * (1.0f / 16.0f);
    const f32x2 st = *(const f32x2*)((const float*)(a.ws + WS_LN1S) + 2 * (size_t)m);
    f32x4 v[4]; float sm = 0.f;
#pragma unroll
    for (int j = 0; j < 4; ++j) { const f32x4 g1 = *((const f32x4*)a.in[I_LN1G] + lane + 64 * j), b1 = *((const f32x4*)a.in[I_LN1B] + lane + 64 * j);
        const u32x2 pw = *((const u32x2*)(hf + (size_t)m * D) + lane + 64 * j); f32x4 p = (f32x4){bflo(pw.x), bfhi(pw.x), bflo(pw.y), bfhi(pw.y)}; p = p - st.x; const f32x4 h = p * st.y * g1 + b1;
        v[j] = h * DN_ALPHA;
#pragma unroll
        for (int k = 0; k < 4; ++k) { const unsigned y = *((const unsigned*)(ys + ((size_t)m * 4 + k) * D) + lane + 64 * j); const float gk = gt[k];
            const f32x2 lo = __builtin_amdgcn_cvt_pk_f32_fp8(y, false), hi = __builtin_amdgcn_cvt_pk_f32_fp8(y, true);
            v[j][0] += gk * lo.x; v[j][1] += gk * lo.y; v[j][2] += gk * hi.x; v[j][3] += gk * hi.y; }
        sm += (v[j][0] + v[j][1]) + (v[j][2] + v[j][3]); }
    const float mean = wave_sum(sm) * (1.0f / D); float s2 = 0.f;
#pragma unroll
    for (int j = 0; j < 4; ++j) { v[j] = v[j] - mean; s2 += (v[j][0] * v[j][0] + v[j][1] * v[j][1]) + (v[j][2] * v[j][2] + v[j][3] * v[j][3]); }
    const float rstd = 1.0f / sqrtf(wave_sum(s2) * (1.0f / D) + LN_EPS);
#pragma unroll
    for (int j = 0; j < 4; ++j) { const f32x4 g = *((const f32x4*)a.in[I_LN2G] + lane + 64 * j), bb = *((const f32x4*)a.in[I_LN2B] + lane + 64 * j);
        *((f32x4*)(a.out + (size_t)m * D) + lane + 64 * j) = v[j] * rstd * g + bb; }
}

__global__ void __launch_bounds__(512, 2) fwd_megakernel(Args args) {
    extern __shared__ __attribute__((aligned(16))) unsigned char lds_raw[];
    LAS unsigned char* lds = (LAS unsigned char*)lds_raw;
    const int tid = threadIdx.x, wave = __builtin_amdgcn_readfirstlane(tid >> 6);
#define FRESH_LANE int lane; { int t_ = tid; asm volatile("" : "+v"(t_)); lane = t_ & 63; }
    const int G = gridDim.x, bx = blockIdx.x;
    const int vcu = (G % 8 == 0) ? (bx % 8) * (G / 8) + bx / 8 : bx;
    const int gw = vcu * 8 + wave, NGW = G * 8;
    const int lo = args.ph_lo, hi = args.ph_hi;
    unsigned char* ws = args.ws;
    volatile LAS unsigned* bst = (volatile LAS unsigned*)(lds + MISC_OFF + MO_BAR);
    if (tid < 2) bst[tid] = 0u;
    __syncthreads();
    XcdBarrier xbar = xcd_barrier_post((unsigned*)(ws + WS_CTL) + CW_BAR, bst);
#ifndef PMASK
#define PMASK 0x1ff
#endif
#define IN(k) (((PMASK >> (k)) & 1) && lo <= (k) && (k) < hi)
#define SEAM(k) do { if (lo <= (k) && (k) + 1 < hi) xcd_barrier(xbar); } while (0)

    if (IN(0)) { FRESH_LANE; p0_prologue(args, lds, gw, NGW, lane, wave); }
    SEAM(0);
    if (IN(1)) {
        pg8::DenseOrder S; S.init(ws + WS_XB, ws + WS_WIN, T, INW, G, bx);
        pg8::EpiU E{(bf16*)(ws + WS_QB), (bf16*)(ws + WS_KB), (bf16*)(ws + WS_VT), (bf16*)(ws + WS_AB), (bf16*)(ws + WS_GATES), (const float*)(ws + WS_BPERM)};
        const int slot = vcu & 3;
        S.i0 = 0; S.i1 = slot;
        pg8::gemm_phase<pg8::EpiU, pg8::DenseOrder>(lds, S, E);
        { FRESH_LANE; side_convert(args, bx, G, wave, lane); }
        S.i0 = slot; S.i1 = 1 << 20;
        pg8::gemm_phase<pg8::EpiU, pg8::DenseOrder>(lds, S, E);
    }
    SEAM(1);
    if (IN(2)) {
        FRESH_LANE;
        __syncthreads();
        for (int i = tid; i < CW * CCH / 4; i += 512) ((LAS f32x4*)(lds + CONV_W_OFF))[i] = ((const f32x4*)args.in[I_CONVW])[i];
        __syncthreads();
        for (int u = vcu; u < 256 + 512; u += G) {
            if (u < 256) attn_unit(args, u, lds, tid, wave, lane);
            else conv_unit(args, u - 256, lds, tid, wave, lane);
        }
    }
    SEAM(2);
    if (IN(3)) {
        pg8::DenseOrder S; S.init(ws + WS_AY, ws + WS_WAB, T, D, G, bx);
        pg8::EpiMerged E{(const bf16*)(ws + WS_GATES), args.in[I_BCONV], (bf16*)(ws + WS_MERGED)};
        pg8::gemm_phase<pg8::EpiMerged, pg8::DenseOrder>(lds, S, E);
    }
    SEAM(3);
    if (IN(4)) {
        pg8::DenseOrder S; S.init(ws + WS_MERGED, ws + WS_WO, T, D, G, bx);
        pg8::EpiPre1 E{(const bf16*)(ws + WS_XB), (bf16*)(ws + WS_HF)};
        pg8::gemm_phase<pg8::EpiPre1, pg8::DenseOrder>(lds, S, E);
    }
    SEAM(4);
    if (IN(5)) {
        FRESH_LANE;
        __syncthreads();
        float bw[64]; f32x4 g1[4], b1[4];
#pragma unroll
        for (int s_ = 0; s_ < 64; ++s_) bw[s_] = args.in[I_WR][(size_t)(128 * wave + 2 * s_ + (lane >> 5)) * NE + (lane & 31)];
#pragma unroll
        for (int j = 0; j < 4; ++j) { g1[j] = *((const f32x4*)args.in[I_LN1G] + lane + 64 * j); b1[j] = *((const f32x4*)args.in[I_LN1B] + lane + 64 * j); }
        for (int c = vcu; c < T / 32; c += G) route_chunk(args, c, lds, tid, wave, lane, bw, g1, b1);
    }
    SEAM(5);
    if (IN(6) || IN(7)) {
        LAS int* tab = (LAS int*)(lds + MISC_OFF + MO_TAB);
        __syncthreads();
        if (tid == 0) { const unsigned* cursor = (const unsigned*)(ws + WS_CTL); int acc = 0;
            for (int e = 0; e < NE; ++e) { const int c = (int)__hip_atomic_load(cursor + e, __ATOMIC_RELAXED, __HIP_MEMORY_SCOPE_AGENT); tab[e] = c; const int ml = (c + 255) >> 8; tab[32 + e] = ml; tab[64 + e] = acc; acc += ml; }
            tab[64 + NE] = acc; }
        __syncthreads();
        const int total_mt = tab[64 + NE];
        if (IN(6)) {
            unsigned* ctl = (unsigned*)(ws + WS_CTL);
            pg8::MoeFusedOrder S{tab, G, vcu, total_mt * 8, total_mt * 4, (const char*)(ws + WS_HB), (const char*)(ws + WS_ACT), (const char*)(ws + WS_WUP), (const char*)(ws + WS_WDN), (const int*)(ws + WS_SLOT), ctl + 8192, ctl + 64};
            pg8::EpiMoe E{pg8::EpiUpX{args.in[I_BUP], ws + WS_ACT}, pg8::EpiDown{args.in[I_BDN], (const int*)(ws + WS_SLOT), ws + WS_YS}};
            pg8::gemm_phase<pg8::EpiMoe, pg8::MoeFusedOrder, true>(lds, S, E);
        }
    }
    SEAM(7);
    if (IN(8)) { FRESH_LANE; for (int m = gw; m < T; m += NGW) combine_row(args, m, lane); }

#undef IN
#undef SEAM
#undef FRESH_LANE
}

extern "C" void kernel_launch(void* const* d_in, const int* in_sizes, int n_in, void* d_out, int out_size, void* d_ws, size_t ws_size, hipStream_t stream) {
    static int grid = 0;
    if (grid == 0) {
        if (n_in != 22 || out_size != T * D || ws_size < WS_END) { fprintf(stderr, "kernel_launch: unexpected problem (n_in %d, out %d, ws %zu)\n", n_in, out_size, ws_size); grid = -1; return; }
        int dev = 0, cus = 0, per_cu = 0;
        hipGetDevice(&dev); hipDeviceGetAttribute(&cus, hipDeviceAttributeMultiprocessorCount, dev);
        hipFuncSetAttribute((const void*)fwd_megakernel, hipFuncAttributeMaxDynamicSharedMemorySize, LDS_BYTES);
        hipOccupancyMaxActiveBlocksPerMultiprocessor(&per_cu, (const void*)fwd_megakernel, 512, LDS_BYTES);
        if (per_cu < 1) { fprintf(stderr, "kernel_launch: occupancy query says %d blocks per CU\n", per_cu); per_cu = 1; }
        (void)hipGetLastError();
        grid = cus * 1;
        fprintf(stderr, "kernel_launch: grid %d (cus %d, occupancy %d)\n", grid, cus, per_cu);
    }
    if (grid < 0) return;
    hipMemsetAsync((char*)d_ws + WS_CTL, 0, 65536, stream);
    Args a{};
    for (int i = 0; i < 22; ++i) a.in[i] = (const float*)d_in[i];
    a.out = (float*)d_out; a.ws = (unsigned char*)d_ws; a.ph_lo = 0; a.ph_hi = 9;
    void* kargs[] = {&a};
    hipError_t e = hipLaunchCooperativeKernel((const void*)fwd_megakernel, dim3(grid), dim3(512), kargs, LDS_BYTES, stream);
    if (e != hipSuccess) fprintf(stderr, "cooperative launch failed: %s (grid %d)\n", hipGetErrorString(e), grid);
}
```

```cpp
#include <hip/hip_runtime.h>
#include <cstdio>
#include <cstdint>

#define GAS __attribute__((address_space(1)))
#define LAS __attribute__((address_space(3)))
typedef unsigned short bf16;
typedef short bf16x8 __attribute__((ext_vector_type(8)));
typedef float f32x4 __attribute__((ext_vector_type(4)));
typedef float f32x2 __attribute__((ext_vector_type(2)));
typedef float f32x16 __attribute__((ext_vector_type(16)));
typedef unsigned u32x4 __attribute__((ext_vector_type(4)));
typedef unsigned u32x2 __attribute__((ext_vector_type(2)));

constexpr int T = 16384, D = 1024, SEQ = 4096, NBATCH = 4;
constexpr int NH = 8, NKV = 2, HD = 64, AW = 512, KVW = 128, CCH = 512, CW = 31;
constexpr int INW = 3840, NE = 32, TOPK = 4, DE = 1024;
constexpr float LN_EPS = 1e-5f;
constexpr float DN_ALPHA = 1.189207115002721f;
constexpr int SLOT_CAP = 16384;
constexpr int MAX_MT = (T * TOPK) / 256 + NE;

constexpr size_t MiB = 1u << 20;
constexpr size_t WS_CTL = 0, CTL_BYTES = 65536;
constexpr int CW_BAR = 4096;
constexpr size_t WS_WIN = 1 * MiB;
constexpr size_t WS_WAB = 9 * MiB;
constexpr size_t WS_WO = 11 * MiB;
constexpr size_t WS_BPERM = 13 * MiB;
constexpr size_t WS_SLOT = 14 * MiB;
constexpr size_t WS_GATE = 16 * MiB;
constexpr size_t WS_LN1S = 17 * MiB;
constexpr size_t WS_WUP = 32 * MiB;
constexpr size_t WS_WDN = 160 * MiB;
constexpr size_t WS_XB = 224 * MiB;
constexpr size_t WS_QB = 256 * MiB;
constexpr size_t WS_KB = 272 * MiB;
constexpr size_t WS_VT = 276 * MiB;
constexpr size_t WS_AB = 792 * MiB;
constexpr size_t WS_GATES = 296 * MiB;
constexpr size_t WS_AY = 360 * MiB;
constexpr size_t WS_MERGED = 392 * MiB;
constexpr size_t WS_HF = 424 * MiB;
constexpr size_t WS_HB = 488 * MiB;
constexpr size_t WS_ACT = 520 * MiB;
constexpr size_t WS_YS = 664 * MiB;
constexpr size_t WS_END = 810 * MiB;
constexpr int AB_PAD = 32, AB_SEQ = SEQ + AB_PAD;

constexpr int LDS_SCR = 135168;
constexpr int MISC_OFF = 135168;
constexpr int MO_LG = 0, MO_SELE = 4224, MO_SELG = 4736, MO_LCNT = 5248, MO_LBASE = 5376, MO_TAB = 5504, MO_BAR = 6016;
constexpr int OFFN_OFF = 147456;
constexpr int LDS_BYTES = 155648;

#define LDS_WAIT() asm volatile("s_waitcnt lgkmcnt(0)" ::: "memory")
#define VM_WAIT() asm volatile("s_waitcnt vmcnt(0)" ::: "memory")

__device__ __forceinline__ unsigned f2bf(float f) { unsigned u = __builtin_bit_cast(unsigned, f); return (u + 0x7fffu + ((u >> 16) & 1u)) >> 16; }
__device__ __forceinline__ unsigned pk2(float lo, float hi) { return f2bf(lo) | (f2bf(hi) << 16); }
__device__ __forceinline__ float bf2f(unsigned b) { return __builtin_bit_cast(float, b << 16); }
__device__ __forceinline__ float bflo(unsigned w) { return __builtin_bit_cast(float, w << 16); }
__device__ __forceinline__ float bfhi(unsigned w) { return __builtin_bit_cast(float, w & 0xffff0000u); }
typedef __bf16 bf16x2_t __attribute__((ext_vector_type(2)));
__device__ __forceinline__ unsigned cvt_pk_bf16(float lo, float hi) { const f32x2 v = {lo, hi}; return __builtin_bit_cast(unsigned, __builtin_convertvector(v, bf16x2_t)); }
__device__ __forceinline__ float sigmoidf_(float x) { return __builtin_amdgcn_rcpf(1.0f + __expf(-x)); }
#define DPP_ADD(v, ctrl) ((v) + __builtin_bit_cast(float, __builtin_amdgcn_update_dpp(0, __builtin_bit_cast(int, (v)), (ctrl), 0xf, 0xf, true)))
__device__ __forceinline__ float wave_sum(float v) {
    v = DPP_ADD(v, 0xB1);
    v = DPP_ADD(v, 0x4E);
    v = DPP_ADD(v, 0x141);
    v = DPP_ADD(v, 0x140);
    const int vi = __builtin_bit_cast(int, v);
    const float r0 = __builtin_bit_cast(float, __builtin_amdgcn_readlane(vi, 0)), r1 = __builtin_bit_cast(float, __builtin_amdgcn_readlane(vi, 16));
    const float r2 = __builtin_bit_cast(float, __builtin_amdgcn_readlane(vi, 32)), r3 = __builtin_bit_cast(float, __builtin_amdgcn_readlane(vi, 48));
    return (r0 + r1) + (r2 + r3);
}
template <class V> __device__ __forceinline__ V ldgo(const void* base, unsigned off) { return *(const V*)((const char*)base + off); }
#define PIN10(a) asm volatile("" : "+v"((a)[0]), "+v"((a)[1]), "+v"((a)[2]), "+v"((a)[3]), "+v"((a)[4]), "+v"((a)[5]), "+v"((a)[6]), "+v"((a)[7]), "+v"((a)[8]), "+v"((a)[9]))

struct Args { const float* in[22]; float* out; unsigned char* ws; int ph_lo, ph_hi; };
enum { I_X = 0, I_WIN, I_BIN, I_SINK, I_WATT, I_CONVW, I_CONVB, I_CLNG, I_CLNB, I_WCONV, I_BCONV, I_WO, I_LN1G, I_LN1B, I_WR, I_BR, I_WUP, I_BUP, I_WDN, I_BDN, I_LN2G, I_LN2B };
constexpr int CVI_UP = NE * 64, CVI_DN = NE * 32, CVI_ITEMS = CVI_UP + CVI_DN;
__device__ __forceinline__ void cvi_decode(const Args& a, int it, const float*& src, unsigned char*& dst, int& nw) {
    if (it < CVI_UP) { const int e = it >> 6, kg = it & 63; nw = 2048; src = a.in[I_WUP] + ((size_t)e * 1024 + 16 * kg) * 2048; dst = a.ws + WS_WUP + (size_t)e * 2048 * 1024 + (size_t)kg * 2048 * 16; }
    else { const int r = it - CVI_UP, e = r >> 5, kg2 = r & 31; nw = 1024; src = a.in[I_WDN] + ((size_t)e * 1024 + 32 * kg2) * 1024; dst = a.ws + WS_WDN + (size_t)e * 1024 * 1024 + (size_t)kg2 * 2 * 1024 * 16; }
}
__device__ __forceinline__ void cvi_slice_ptrs(const Args& a, int it, int wave, int lane, const float*& sp, unsigned& pitch, unsigned char*& dp) {
    const float* src; unsigned char* dst; int nw; cvi_decode(a, it, src, dst, nw);
    const int g = nw == 2048 ? 0 : (wave >> 2), cw = nw == 2048 ? wave : (wave & 3);
    sp = src + (size_t)(16 * g) * nw + 256 * cw + 4 * lane; pitch = (unsigned)nw;
    dp = dst + ((size_t)g * nw + 256 * cw + 4 * lane) * 16;
}
__device__ __forceinline__ void cvi_slice_load(const float* sp, unsigned pitch, f32x4 (&r)[16]) {
#pragma unroll
    for (int kk = 0; kk < 16; ++kk) r[kk] = __builtin_nontemporal_load((const f32x4*)(sp + (size_t)kk * pitch));
}
__device__ __forceinline__ void cvi_slice_out(unsigned char* dp, f32x4 (&r)[16]) {
    asm volatile("" : "+v"(r[0]), "+v"(r[1]), "+v"(r[2]), "+v"(r[3]), "+v"(r[4]), "+v"(r[5]), "+v"(r[6]), "+v"(r[7]), "+v"(r[8]), "+v"(r[9]), "+v"(r[10]), "+v"(r[11]), "+v"(r[12]), "+v"(r[13]), "+v"(r[14]), "+v"(r[15]));
#pragma unroll
    for (int j = 0; j < 4; ++j) { unsigned w[4];
#pragma unroll
        for (int c = 0; c < 4; ++c) { unsigned x = 0u; x = __builtin_amdgcn_cvt_pk_fp8_f32(r[4 * c][j] * 64.0f, r[4 * c + 1][j] * 64.0f, x, false);
            x = __builtin_amdgcn_cvt_pk_fp8_f32(r[4 * c + 2][j] * 64.0f, r[4 * c + 3][j] * 64.0f, x, true); w[c] = x; }
        *(u32x4*)(dp + 16 * j) = (u32x4){w[0], w[1], w[2], w[3]}; }
}
__device__ __forceinline__ void side_convert(const Args& a, int bx, int G, int wave, int lane) {
    int base, nit;
    if (G == 256) { base = bx < 192 ? 11 * bx : 2112 + 15 * (bx - 192); nit = bx < 192 ? 11 : 15; }
    else { const int per = (CVI_ITEMS + G - 1) / G; base = bx * per; nit = base >= CVI_ITEMS ? 0 : (CVI_ITEMS - base < per ? CVI_ITEMS - base : per); }
    const int end = base + nit;
    f32x4 r0[16], r1[16];
    const float* sp0; const float* sp1; unsigned p0 = 0, p1 = 0; unsigned char* d0; unsigned char* d1;
    if (nit > 0) { cvi_slice_ptrs(a, base, wave, lane, sp0, p0, d0); cvi_slice_load(sp0, p0, r0); }
    if (nit > 1) { cvi_slice_ptrs(a, base + 1, wave, lane, sp1, p1, d1); cvi_slice_load(sp1, p1, r1); }
#pragma unroll 1
    for (int it0 = base; it0 < end; it0 += 2) {
        const int it1 = it0 + 1;
        { unsigned char* dcur = d0; cvi_slice_out(dcur, r0); if (it0 + 2 < end) { cvi_slice_ptrs(a, it0 + 2, wave, lane, sp0, p0, d0); cvi_slice_load(sp0, p0, r0); } }
        if (it1 >= end) break;
        { unsigned char* dcur = d1; cvi_slice_out(dcur, r1); if (it1 + 2 < end) { cvi_slice_ptrs(a, it1 + 2, wave, lane, sp1, p1, d1); cvi_slice_load(sp1, p1, r1); } }
    }
}

namespace pg8 {
constexpr int BM = 256, BK = 64, HALF = 128, HTB = HALF * BK * 2, STAGE_BYTES = 8 * HTB, NXCD = 8, WGM = 8;
constexpr int KD = 1024, NT_K = KD / BK;
__host__ __device__ __forceinline__ int lds_byte(int r, int c) { const int st = (r >> 4) * 2 + (c >> 5), rr = r & 15, cc = c & 31, ob = rr * 64 + cc * 2; return st * 1024 + (ob ^ (((ob >> 9) & 1) << 5)); }
__host__ __device__ __forceinline__ void stage_rc(int b, int& R, int& C) { const int st = b / 1024, sb = b % 1024, swz = sb ^ (((sb >> 9) & 1) << 5); R = (st >> 1) * 16 + swz / 64; C = (st & 1) * 32 + (swz % 64) / 2; }
__host__ __device__ __forceinline__ int perm32(int rho) { const int n = rho >> 4, i = rho & 15; return 8 * (i >> 2) + 4 * n + (i & 3); }

struct Unit { const char* A; const char* B; int pm, pn, e, mt, cnt, type; };

struct DenseOrder {
    const char* Ab; const char* Bb; int nM, nN, nwg, G, c, i0 = 0, i1 = 1 << 20; static constexpr int rowb = KD * 2; static constexpr bool PARK = false, FUSED = false;
    __device__ __forceinline__ unsigned boff(int Rb, int C) const { return (unsigned)(Rb * rowb + C * 2); }
    __device__ __forceinline__ size_t bstep_k() const { return 128; }
    __device__ __forceinline__ size_t bstep_h() const { return (size_t)HALF * rowb; }
    __device__ void init(const void* A, const void* B, int M, int N, int G_, int c_) { Ab = (const char*)A; Bb = (const char*)B; nM = M / BM; nN = N / BM; nwg = nM * nN; G = G_; c = c_; }
    __device__ __forceinline__ bool next(int i, Unit& u) const {
        if (i + i0 >= i1) return false;
        const long L = (long)(i + i0) * G + c; if (L >= nwg) return false;
        int wgid = (int)L; { const int q = nwg / NXCD, r = nwg % NXCD, xcd = wgid % NXCD, off = wgid / NXCD; wgid = (xcd < r ? xcd * (q + 1) : r * (q + 1) + (xcd - r) * q) + off; }
        const int nig = WGM * nN, gid = wgid / nig, fm = gid * WGM, gsz = (nM - fm) < WGM ? (nM - fm) : WGM;
        u.pm = fm + ((wgid % nig) % gsz); u.pn = (wgid % nig) / gsz; u.e = 0; u.mt = 0; u.cnt = 0; u.type = 0;
        u.A = Ab + (size_t)u.pm * (BM * KD * 2); u.B = Bb + (size_t)u.pn * (BM * KD * 2); return true;
    }
    __device__ __forceinline__ void offsets(const Unit&, const int (&R)[2], const int (&C)[2], unsigned (&off)[2][2]) const {
#pragma unroll
        for (int h = 0; h < 2; ++h)
#pragma unroll
            for (int i = 0; i < 2; ++i) off[h][i] = (unsigned)(((h * HALF + R[i]) * KD + C[i]) * 2);
    }
};
struct MoeOrder {
    const LAS int* tab; int NTN, G, c, total; const char* Ab; const char* Bb; size_t bexp; const int* slot; bool gather; int rowb;
    static constexpr bool PARK = true, FUSED = false;
    int bn16;
    __device__ __forceinline__ unsigned boff(int Rb, int C) const { return (unsigned)((C >> 3) * bn16 + Rb * 16); }
    __device__ __forceinline__ size_t bstep_k() const { return (size_t)8 * bn16; }
    __device__ __forceinline__ size_t bstep_h() const { return (size_t)HALF * 16; }
    __device__ __forceinline__ bool next(int i, Unit& u) const {
        const int L = i * G + c; if (L >= total) return false;
        int e = 0;
        for (int j = 1; j < NE; ++j) e += (L >= NTN * tab[64 + j]) ? 1 : 0;
        e = __builtin_amdgcn_readfirstlane(e);
        const int ms = __builtin_amdgcn_readfirstlane(tab[64 + e]), ml = __builtin_amdgcn_readfirstlane(tab[32 + e]);
        const int r = L - NTN * ms; const int nt = r / ml, mt = r - nt * ml;
        u.e = e; u.mt = mt; u.cnt = __builtin_amdgcn_readfirstlane(tab[e]); u.pm = ms + mt; u.pn = nt; u.type = 0;
        u.A = gather ? Ab : Ab + (size_t)u.pm * (size_t)(BM * rowb);
        u.B = Bb + (size_t)e * bexp + (size_t)nt * (size_t)(BM * 16); return true;
    }
    __device__ __forceinline__ void offsets(const Unit& u, const int (&R)[2], const int (&C)[2], unsigned (&off)[2][2]) const {
#pragma unroll
        for (int h = 0; h < 2; ++h)
#pragma unroll
            for (int i = 0; i < 2; ++i) {
                if (gather) { const int idx = u.mt * BM + h * HALF + R[i]; const int idc = idx < u.cnt ? idx : u.cnt - 1; int tok = slot[u.e * SLOT_CAP + idc] >> 2; tok = idx < u.cnt ? tok : 0; off[h][i] = (unsigned)(tok * rowb + C[i] * 2); }
                else off[h][i] = (unsigned)((h * HALF + R[i]) * rowb + C[i] * 2);
            }
    }
};


#define GAS_U32 __attribute__((address_space(1))) unsigned
struct MoeFusedOrder {
    const LAS int* tab; int G, c, total6, total7; const char* hb; const char* act; const char* wup; const char* wdn; const int* slot; unsigned* cnt; unsigned* tmo;
    static constexpr bool PARK = true, FUSED = true; static constexpr int rowb = 1024;
    __device__ __forceinline__ unsigned boff_t(int type, int R, int C) const {
        const int rs = 64 * (R >> 5) + 32 * ((R >> 2) & 1) + 16 * ((R >> 3) & 1) + 4 * ((R >> 4) & 1) + (R & 3), rb = (R & ~31) + perm32(R & 31);
        return type ? (unsigned)((C >> 3) * (1024 * 16) + rb * 16) : (unsigned)((C >> 3) * (2048 * 16) + rs * 16); }
    __device__ __forceinline__ unsigned boff(int R, int C) const { return boff_t(0, R, C); }
    __device__ __forceinline__ size_t bstep_kt(int type) const { return (size_t)8 * (type ? 1024 * 16 : 2048 * 16); }
    __device__ __forceinline__ size_t bstep_ht(int type) const { return type ? (size_t)HALF * 16 : (size_t)8 * 16; }
    __device__ __forceinline__ size_t bstep_k() const { return bstep_kt(0); }
    __device__ __forceinline__ size_t bstep_h() const { return bstep_ht(0); }
    __device__ __forceinline__ bool next(int i, Unit& u) const {
        int L = i * G + c; if (L >= total6 + total7) return false;
        const int type = L >= total6 ? 1 : 0; L -= type ? total6 : 0; const int NTN = type ? 4 : 8;
        int e = 0;
        for (int j = 1; j < NE; ++j) e += (L >= NTN * tab[64 + j]) ? 1 : 0;
        e = __builtin_amdgcn_readfirstlane(e);
        const int ms = __builtin_amdgcn_readfirstlane(tab[64 + e]), ml = __builtin_amdgcn_readfirstlane(tab[32 + e]);
        const int r = L - NTN * ms; const int nt = r / ml, mt = r - nt * ml;
        u.e = e; u.mt = mt; u.cnt = __builtin_amdgcn_readfirstlane(tab[e]); u.pm = ms + mt; u.pn = nt; u.type = type;
        u.A = type ? act + (size_t)u.pm * (size_t)(BM * rowb) : hb;
        u.B = (type ? wdn + (size_t)e * 1024 * 1024 : wup + (size_t)e * 2048 * 1024) + (size_t)nt * (size_t)(BM * 16); return true;
    }
    __device__ __forceinline__ void offsets(const Unit& u, const int (&R)[2], const int (&C)[2], unsigned (&off)[2][2]) const {
        if (u.type == 0) { int tok[2][2];
#pragma unroll
            for (int h = 0; h < 2; ++h)
#pragma unroll
                for (int i = 0; i < 2; ++i) { const int idx = u.mt * BM + h * HALF + R[i]; tok[h][i] = slot[u.e * SLOT_CAP + (idx < u.cnt ? idx : u.cnt - 1)]; }
#pragma unroll
            for (int h = 0; h < 2; ++h)
#pragma unroll
                for (int i = 0; i < 2; ++i) { const int idx = u.mt * BM + h * HALF + R[i]; const int t = idx < u.cnt ? (tok[h][i] >> 2) : 0; off[h][i] = (unsigned)(t * rowb + C[i] * 2); }
        } else {
#pragma unroll
            for (int h = 0; h < 2; ++h)
#pragma unroll
                for (int i = 0; i < 2; ++i) off[h][i] = (unsigned)((h * HALF + R[i]) * rowb + C[i] * 2);
        }
    }
    __device__ __forceinline__ void a_ready(const Unit& u) const {
        if (u.type) {
            if (threadIdx.x < 64) { const unsigned* p = cnt + 16 * u.pm; unsigned v, spins = 0u;
                for (;;) { asm volatile("global_load_dword %0, %1, off sc1\n\ts_waitcnt vmcnt(0)" : "=&v"(v) : "v"(p) : "memory");
                    if ((unsigned)__builtin_amdgcn_readfirstlane(v) >= 64u) break;
                    __builtin_amdgcn_s_sleep(2);
                    if (++spins > (1u << 20)) { if (threadIdx.x == 0) __hip_atomic_store(tmo, 1u, __ATOMIC_RELAXED, __HIP_MEMORY_SCOPE_AGENT); break; } }
                }
            asm volatile("" ::: "memory"); __builtin_amdgcn_s_barrier(); asm volatile("" ::: "memory");
        }
    }
    __device__ __forceinline__ void done(const Unit& u) const {
        if (u.type == 0) { asm volatile("s_waitcnt vmcnt(0)" ::: "memory");
            if ((threadIdx.x & 63) == 0) __hip_atomic_fetch_add(cnt + 16 * u.pm, 1u, __ATOMIC_RELAXED, __HIP_MEMORY_SCOPE_AGENT); }
    }
};

typedef f32x4 Acc[2][2][4][2];

typedef int i32x8 __attribute__((ext_vector_type(8)));
struct u32x4x2 { u32x4 a, b; };
template <class Epi, class Sched, bool FP8 = false>
__device__ __forceinline__ void gemm_phase(LAS unsigned char* lds, const Sched& S, const Epi& E) {
    const int tid = threadIdx.x, wid = __builtin_amdgcn_readfirstlane(tid >> 6), lane = tid & 63, wr = wid >> 2, wc = wid & 3, fr = lane & 15, fq = lane >> 4;
    constexpr int ROWB = FP8 ? KD : KD * 2, nt = FP8 ? KD / 128 : NT_K;
    int sR[2], sC[2], sRb[2]; unsigned voffB[2];
#pragma unroll
    for (int i = 0; i < 2; ++i) { int R, C; stage_rc(tid * 16 + i * 8192, R, C); sR[i] = R; sC[i] = C; const int Rb = Epi::PERM ? ((R & ~31) + perm32(R & 31)) : R; sRb[i] = Rb; voffB[i] = S.boff(Rb, C); }
    constexpr size_t kstep = (size_t)(BK * 2);
    size_t kstepB = S.bstep_k(), kstepBn = kstepB, hstepB = S.bstep_h(), hstepBn = hstepB;
    const unsigned ldsw = (unsigned)wid * 1024u;
    const int aoff = lds_byte(wr * 64 + fr, fq * 8), boff = lds_byte(wc * 32 + fr, fq * 8);
    constexpr int KST = 1024;
#define PG8_SA(b, h) (((b) * 2 + (h)) * HTB)
#define PG8_SB(b, h) ((4 + (b) * 2 + (h)) * HTB)
#define PG8_STAGE(bufoff, gbase, voff) do { const char* _gb = (const char*)(gbase); asm volatile("" : "+s"(_gb));     \
        _Pragma("unroll") for (int _i = 0; _i < 2; ++_i) \
        __builtin_amdgcn_global_load_lds((const unsigned*)(_gb + (voff)[_i]), (LAS unsigned*)(lds + (bufoff) + ldsw + _i * 8192), 16, 0, 0); } while (0)
#define PG8_STAGE_A(bufoff, gbase, voff) do { const char* _gb = (const char*)(gbase); asm volatile("" : "+s"(_gb)); \
        _Pragma("unroll") for (int _i = 0; _i < 2; ++_i) \
        __builtin_amdgcn_global_load_lds((const unsigned*)(_gb + (voff)[_i]), (LAS unsigned*)(lds + (bufoff) + ldsw + _i * 8192), 16, 0, 0); } while (0)
#define PG8_LDA(dst, b, h) do { _Pragma("unroll") for (int m = 0; m < 4; ++m) _Pragma("unroll") for (int k = 0; k < 2; ++k) dst[m][k] = *(const LAS bf16x8*)(lds + PG8_SA(b, h) + aoff + m * 2048 + k * KST); } while (0)
#define PG8_LDB(dst, b, h) do { _Pragma("unroll") for (int n = 0; n < 2; ++n) _Pragma("unroll") for (int k = 0; k < 2; ++k) dst[n][k] = *(const LAS bf16x8*)(lds + PG8_SB(b, h) + boff + n * 2048 + k * KST); } while (0)
#define PG8_CAT(x) __builtin_bit_cast(i32x8, (u32x4x2){__builtin_bit_cast(u32x4, (x)[0]), __builtin_bit_cast(u32x4, (x)[1])})
#define PG8_MMA(ai, bj, At, Bt) do { __builtin_amdgcn_s_setprio(1); \
        if constexpr (FP8) { _Pragma("unroll") for (int m = 0; m < 4; ++m) _Pragma("unroll") for (int n = 0; n < 2; ++n) \
            acc[ai][bj][m][n] = __builtin_amdgcn_mfma_scale_f32_16x16x128_f8f6f4(PG8_CAT(Bt[n]), PG8_CAT(At[m]), acc[ai][bj][m][n], 0, 0, 0, Epi::SCALE_B, 0, Epi::SCALE_A); } \
        else { _Pragma("unroll") for (int m = 0; m < 4; ++m) _Pragma("unroll") for (int n = 0; n < 2; ++n) _Pragma("unroll") for (int k = 0; k < 2; ++k) \
            acc[ai][bj][m][n] = __builtin_amdgcn_mfma_f32_16x16x32_bf16(Bt[n][k], At[m][k], acc[ai][bj][m][n], 0, 0, 0); } \
        __builtin_amdgcn_s_setprio(0); } while (0)
#define PG8_WAIT_V(n) asm volatile("s_waitcnt vmcnt(" #n ")" ::: "memory")
#define PG8_WAIT_L(n) asm volatile("s_waitcnt lgkmcnt(" #n ")" ::: "memory")
#define PG8_BAR __builtin_amdgcn_s_barrier()
#define PG8_SCHED __builtin_amdgcn_sched_barrier(0)
    Unit cur, nxt; int ui = 0;
    if (!S.next(0, cur)) return;
    Acc acc;
    bf16x8 At[4][2], B0[2][2], B1[2][2];
    unsigned offA[2][2], offN[2][2];
    S.offsets(cur, sR, sC, offA);
    if constexpr (Sched::FUSED) { kstepB = S.bstep_kt(cur.type); hstepB = S.bstep_ht(cur.type);
#pragma unroll
        for (int i = 0; i < 2; ++i) voffB[i] = S.boff_t(cur.type, sR[i], sC[i]); }
    const char* cA = cur.A; const char* cB = cur.B;
    PG8_STAGE(PG8_SB(0, 0), cB, voffB); PG8_STAGE(PG8_SB(0, 1), cB + hstepB, voffB); PG8_STAGE_A(PG8_SA(0, 0), cA, offA[0]); PG8_STAGE_A(PG8_SA(0, 1), cA, offA[1]);
    if (wr == 1) PG8_BAR;
    PG8_WAIT_V(2); PG8_BAR;
    PG8_STAGE(PG8_SB(1, 0), cB + kstepB, voffB); PG8_STAGE_A(PG8_SA(1, 0), cA + kstep, offA[0]); PG8_STAGE(PG8_SB(1, 1), cB + hstepB + kstepB, voffB);
    PG8_WAIT_V(6); PG8_BAR;
    for (;;) {
#pragma unroll
        for (int a = 0; a < 2; ++a)
#pragma unroll
            for (int b = 0; b < 2; ++b)
#pragma unroll
                for (int m = 0; m < 4; ++m)
#pragma unroll
                    for (int n = 0; n < 2; ++n) acc[a][b][m][n] = (f32x4){0.f, 0.f, 0.f, 0.f};
        const bool has_next = S.next(ui + 1, nxt);
        const char* nA = has_next ? nxt.A : cA; const char* nB = has_next ? nxt.B : cB;
        if constexpr (Sched::FUSED) { kstepBn = has_next ? S.bstep_kt(nxt.type) : kstepB; hstepBn = has_next ? S.bstep_ht(nxt.type) : hstepB; }
        if (has_next) S.offsets(nxt, sR, sC, offN);
        else {
#pragma unroll
            for (int h = 0; h < 2; ++h)
#pragma unroll
                for (int i = 0; i < 2; ++i) offN[h][i] = offA[h][i];
        }
        if constexpr (Sched::PARK) *(LAS u32x4*)(lds + OFFN_OFF + tid * 16) = (u32x4){offN[0][0], offN[0][1], offN[1][0], offN[1][1]};
#pragma unroll 1
        for (int t = 0; t < nt; t += 2) {
            const bool last = (t == nt - 2);
            const char* a1 = cA + (size_t)(t + 1) * kstep;
            const char* a2 = last ? nA : cA + (size_t)(t + 2) * kstep; const char* b2 = last ? nB : cB + (size_t)(t + 2) * kstepB;
            const char* a3 = a2 + kstep; const char* b3 = b2 + (last ? kstepBn : kstepB); const size_t hB = last ? hstepBn : hstepB;
            if constexpr (Sched::FUSED) { if (last && has_next) S.a_ready(nxt); }
            if constexpr (Epi::MID_T > 0) { if (t == Epi::MID_T) E.mid(acc, cur, wr, wc, fr, fq); }
            PG8_LDB(B0, 0, 0); PG8_LDB(B1, 0, 1); PG8_SCHED; PG8_LDA(At, 0, 0); PG8_STAGE_A(PG8_SA(1, 1), a1, offA[1]);
            PG8_WAIT_V(8); PG8_WAIT_L(0); PG8_BAR; PG8_MMA(0, 0, At, B0); PG8_MMA(0, 1, At, B1);
            asm volatile("" : "+v"(acc[0][0][0][0]), "+v"(acc[0][0][0][1]), "+v"(acc[0][0][1][0]), "+v"(acc[0][0][1][1]), "+v"(acc[0][0][2][0]), "+v"(acc[0][0][2][1]), "+v"(acc[0][0][3][0]), "+v"(acc[0][0][3][1]));
            asm volatile("" : "+v"(acc[0][1][0][0]), "+v"(acc[0][1][0][1]), "+v"(acc[0][1][1][0]), "+v"(acc[0][1][1][1]), "+v"(acc[0][1][2][0]), "+v"(acc[0][1][2][1]), "+v"(acc[0][1][3][0]), "+v"(acc[0][1][3][1]));
            PG8_BAR; PG8_SCHED;
            if (last) {
                if constexpr (Sched::FUSED) { if (has_next) {
#pragma unroll
                    for (int i = 0; i < 2; ++i) voffB[i] = S.boff_t(nxt.type, sR[i], sC[i]); } }
                if constexpr (Sched::PARK) { const u32x4 pk = *(const LAS u32x4*)(lds + OFFN_OFF + tid * 16); offA[0][0] = pk.x; offA[0][1] = pk.y; offA[1][0] = pk.z; offA[1][1] = pk.w; }
                else {
#pragma unroll
                    for (int h = 0; h < 2; ++h)
#pragma unroll
                        for (int i = 0; i < 2; ++i) offA[h][i] = offN[h][i];
                }
            }
            PG8_LDA(At, 0, 1); PG8_STAGE(PG8_SB(0, 0), b2, voffB); PG8_STAGE(PG8_SB(0, 1), b2 + hB, voffB); PG8_STAGE_A(PG8_SA(0, 0), a2, offA[0]);
            PG8_WAIT_V(8); PG8_WAIT_L(0); PG8_BAR; PG8_MMA(1, 0, At, B0); PG8_MMA(1, 1, At, B1); PG8_BAR; PG8_SCHED;
            PG8_LDB(B0, 1, 0); PG8_LDB(B1, 1, 1); PG8_SCHED; PG8_LDA(At, 1, 0); PG8_STAGE_A(PG8_SA(0, 1), a2, offA[1]);
            PG8_WAIT_V(8); PG8_WAIT_L(0); PG8_BAR; PG8_MMA(0, 0, At, B0); PG8_MMA(0, 1, At, B1); PG8_BAR; PG8_SCHED;
            PG8_LDA(At, 1, 1); PG8_STAGE(PG8_SB(1, 0), b3, voffB); PG8_STAGE(PG8_SB(1, 1), b3 + hB, voffB); PG8_STAGE_A(PG8_SA(1, 0), a3, offA[0]);
            PG8_WAIT_V(8); PG8_WAIT_L(0); PG8_BAR; PG8_MMA(1, 0, At, B0); PG8_MMA(1, 1, At, B1); PG8_BAR; PG8_SCHED;
        }
        if (wr == 0) PG8_BAR;
        E(acc, cur, wr, wc, fr, fq);
        if constexpr (Sched::FUSED) S.done(cur);
        __builtin_amdgcn_s_waitcnt(0x0F70);
        if (!has_next) break;
        cur = nxt; cA = nA; cB = nB; kstepB = kstepBn; hstepB = hstepBn; ++ui;
        if (wr == 1) PG8_BAR;
    }
    PG8_WAIT_V(0);
    PG8_BAR;
#undef PG8_SA
#undef PG8_SB
#undef PG8_STAGE
#undef PG8_STAGE_A
#undef PG8_LDA
#undef PG8_LDB
#undef PG8_MMA
#undef PG8_WAIT_V
#undef PG8_WAIT_L
#undef PG8_BAR
#undef PG8_SCHED
}

#define EPI_SEED(r, c) asm volatile("" : "+v"(r), "+v"(c))
template <class V> __device__ __forceinline__ V ldg(const void* base, unsigned off) { return *(const V*)((const char*)base + off); }
template <class V> __device__ __forceinline__ void stg(void* base, unsigned off, V v) { *(V*)((char*)base + off) = v; }
__device__ __forceinline__ u32x4 pack8(const f32x4 v0, const f32x4 v1) { u32x4 w; w.x = cvt_pk_bf16(v0[0], v0[1]); w.y = cvt_pk_bf16(v0[2], v0[3]); w.z = cvt_pk_bf16(v1[0], v1[1]); w.w = cvt_pk_bf16(v1[2], v1[3]); return w; }

struct EpiU {
    static constexpr int SCALE_B = 0, SCALE_A = 0;
    static constexpr bool PERM = true; static constexpr int MID_T = 0;
    bf16 *q, *k, *vT, *ab, *gates; const float* bias;
    __device__ __forceinline__ void mid(Acc&, const Unit&, int, int, int, int) const {}
    __device__ __forceinline__ void operator()(const Acc& acc, const Unit& u, int wr, int wc, int fr, int fq) const {
        int rl = wr * 64 + fr, cl = wc * 32 + 8 * fq; EPI_SEED(rl, cl);
        const int row0 = u.pm * BM + rl, pn = u.pn;
        f32x4 bv[2][2];
#pragma unroll
        for (int bj = 0; bj < 2; ++bj)
#pragma unroll
            for (int n = 0; n < 2; ++n) bv[bj][n] = ldg<f32x4>(bias, (unsigned)(pn * BM + bj * HALF + cl + 4 * n) * 4u);
        if (pn < 2) {
            const unsigned o0 = ((unsigned)row0 * AW + pn * BM + cl) * 2u;
#pragma unroll
            for (int ai = 0; ai < 2; ++ai)
#pragma unroll
                for (int m = 0; m < 4; ++m)
#pragma unroll
                    for (int bj = 0; bj < 2; ++bj)
                        stg<u32x4>(q, o0 + (unsigned)((ai * HALF + m * 16) * AW + bj * HALF) * 2u, pack8((acc[ai][bj][m][0] + bv[bj][0]) * 0.125f, (acc[ai][bj][m][1] + bv[bj][1]) * 0.125f));
        } else if (pn == 2) {
            const unsigned o0 = ((unsigned)row0 * KVW + cl) * 2u;
            const int b = row0 >> 12, s0 = row0 & (SEQ - 1);
#pragma unroll
            for (int ai = 0; ai < 2; ++ai)
#pragma unroll
                for (int m = 0; m < 4; ++m) {
                    stg<u32x4>(k, o0 + (unsigned)((ai * HALF + m * 16) * KVW) * 2u, pack8(acc[ai][0][m][0] + bv[0][0], acc[ai][0][m][1] + bv[0][1]));
#pragma unroll
                    for (int n = 0; n < 2; ++n) { const f32x4 v = acc[ai][1][m][n] + bv[1][n];
#pragma unroll
                        for (int j = 0; j < 4; ++j) { const int col = cl + 4 * n + j, kvh = col >> 6, dim = col & 63;
                            stg<bf16>(vT, (unsigned)(((b * NKV + kvh) * HD + dim) * SEQ + s0 + ai * HALF + m * 16) * 2u, (bf16)f2bf(v[j])); } } }
        } else if (pn < 7) {
            const unsigned o0 = ((unsigned)(row0 + AB_PAD * ((row0 >> 12) + 1)) * CCH + (pn - 3) * HALF + cl) * 2u;
#pragma unroll
            for (int ai = 0; ai < 2; ++ai)
#pragma unroll
                for (int m = 0; m < 4; ++m) { f32x4 o[2];
#pragma unroll
                    for (int n = 0; n < 2; ++n) { const f32x4 a = acc[ai][0][m][n] + bv[0][n], g = acc[ai][1][m][n] + bv[1][n];
#pragma unroll
                        for (int j = 0; j < 4; ++j) o[n][j] = a[j] * sigmoidf_(g[j]); }
                    stg<u32x4>(ab, o0 + (unsigned)((ai * HALF + m * 16) * CCH) * 2u, pack8(o[0], o[1])); }
        } else {
            const unsigned o0 = ((unsigned)row0 * 2048 + (pn - 7) * HALF + cl) * 2u;
#pragma unroll
            for (int ai = 0; ai < 2; ++ai)
#pragma unroll
                for (int m = 0; m < 4; ++m) { f32x4 ra[2], gb[2];
#pragma unroll
                    for (int n = 0; n < 2; ++n) { const f32x4 va = acc[ai][0][m][n] + bv[0][n], vb = acc[ai][1][m][n] + bv[1][n];
#pragma unroll
                        for (int j = 0; j < 4; ++j) { const float sb = sigmoidf_(vb[j]); gb[n][j] = sb; ra[n][j] = sigmoidf_(va[j]) * __builtin_amdgcn_rcpf(sb); } }
                    stg<u32x4>(gates, o0 + (unsigned)((ai * HALF + m * 16) * 2048) * 2u, pack8(ra[0], ra[1]));
                    stg<u32x4>(gates, o0 + (unsigned)((ai * HALF + m * 16) * 2048 + 1024) * 2u, pack8(gb[0], gb[1])); }
        }
    }
};
struct EpiMerged {
    static constexpr int SCALE_B = 0, SCALE_A = 0;
    static constexpr bool PERM = true; static constexpr int MID_T = 8;
    const bf16* gates; const float* bc; bf16* merged;
    __device__ __forceinline__ void mid(Acc& acc, const Unit& u, int wr, int wc, int fr, int fq) const {
        int rl = wr * 64 + fr, cl = wc * 32 + 8 * fq; EPI_SEED(rl, cl);
        const unsigned g0 = ((unsigned)(u.pm * BM + rl) * 2048 + u.pn * BM + cl) * 2u;
#pragma unroll
        for (int ai = 0; ai < 2; ++ai) { u32x4 rt[4][2];
#pragma unroll
            for (int m = 0; m < 4; ++m)
#pragma unroll
                for (int bj = 0; bj < 2; ++bj) rt[m][bj] = ldg<u32x4>(gates, g0 + (unsigned)((ai * HALF + m * 16) * 2048 + bj * HALF) * 2u);
            __builtin_amdgcn_sched_barrier(0);
#pragma unroll
            for (int m = 0; m < 4; ++m)
#pragma unroll
                for (int bj = 0; bj < 2; ++bj)
#pragma unroll
                    for (int n = 0; n < 2; ++n) { acc[ai][bj][m][n][0] *= bflo(rt[m][bj][2 * n]); acc[ai][bj][m][n][1] *= bfhi(rt[m][bj][2 * n]); acc[ai][bj][m][n][2] *= bflo(rt[m][bj][2 * n + 1]); acc[ai][bj][m][n][3] *= bfhi(rt[m][bj][2 * n + 1]); }
            __builtin_amdgcn_sched_barrier(0); }
    }
    __device__ __forceinline__ void operator()(const Acc& acc, const Unit& u, int wr, int wc, int fr, int fq) const {
        int rl = wr * 64 + fr, cl = wc * 32 + 8 * fq; EPI_SEED(rl, cl);
        const int row0 = u.pm * BM + rl, col0 = u.pn * BM + cl;
        const unsigned g0 = ((unsigned)row0 * 2048 + 1024 + col0) * 2u, m0 = ((unsigned)row0 * D + col0) * 2u;
        f32x4 bv[2][2];
#pragma unroll
        for (int bj = 0; bj < 2; ++bj)
#pragma unroll
            for (int n = 0; n < 2; ++n) bv[bj][n] = ldg<f32x4>(bc, (unsigned)(col0 + bj * HALF + 4 * n) * 4u);
#pragma unroll
        for (int ai = 0; ai < 2; ++ai)
#pragma unroll
            for (int m = 0; m < 4; ++m) {
#pragma unroll
                for (int bj = 0; bj < 2; ++bj) { const u32x4 gb = ldg<u32x4>(gates, g0 + (unsigned)((ai * HALF + m * 16) * 2048 + bj * HALF) * 2u); f32x4 o[2];
#pragma unroll
                    for (int n = 0; n < 2; ++n) { const f32x4 v = acc[ai][bj][m][n] + bv[bj][n];
                        o[n][0] = v[0] * bflo(gb[2 * n]); o[n][1] = v[1] * bfhi(gb[2 * n]); o[n][2] = v[2] * bflo(gb[2 * n + 1]); o[n][3] = v[3] * bfhi(gb[2 * n + 1]); }
                    stg<u32x4>(merged, m0 + (unsigned)((ai * HALF + m * 16) * D + bj * HALF) * 2u, pack8(o[0], o[1])); }
                if (m & 1) asm volatile("" ::: "memory"); }
    }
};
struct EpiPre1 {
    static constexpr int SCALE_B = 0, SCALE_A = 0;
    static constexpr bool PERM = true; static constexpr int MID_T = 0;
    const bf16* xb; bf16* out;
    __device__ __forceinline__ void mid(Acc&, const Unit&, int, int, int, int) const {}
    __device__ __forceinline__ void operator()(const Acc& acc, const Unit& u, int wr, int wc, int fr, int fq) const {
        int rl = wr * 64 + fr, cl = wc * 32 + 8 * fq; EPI_SEED(rl, cl);
        const unsigned o0 = ((unsigned)(u.pm * BM + rl) * D + u.pn * BM + cl) * 2u;
        u32x4 xv[2][4][2];
#pragma unroll
        for (int ai = 0; ai < 2; ++ai)
#pragma unroll
            for (int m = 0; m < 4; ++m)
#pragma unroll
                for (int bj = 0; bj < 2; ++bj) xv[ai][m][bj] = ldg<u32x4>(xb, o0 + (unsigned)((ai * HALF + m * 16) * D + bj * HALF) * 2u);
        __builtin_amdgcn_sched_barrier(0);
#pragma unroll
        for (int ai = 0; ai < 2; ++ai)
#pragma unroll
            for (int m = 0; m < 4; ++m)
#pragma unroll
                for (int bj = 0; bj < 2; ++bj) { const u32x4 w = xv[ai][m][bj];
                    const f32x4 r0 = (f32x4){bflo(w.x), bfhi(w.x), bflo(w.y), bfhi(w.y)} * DN_ALPHA + acc[ai][bj][m][0], r1 = (f32x4){bflo(w.z), bfhi(w.z), bflo(w.w), bfhi(w.w)} * DN_ALPHA + acc[ai][bj][m][1];
                    stg<u32x4>(out, o0 + (unsigned)((ai * HALF + m * 16) * D + bj * HALF) * 2u, pack8(r0, r1)); }
    }
};
struct EpiUp {
    static constexpr bool PERM = true; static constexpr int MID_T = 0;
    static constexpr int SCALE_B = 0x79797979, SCALE_A = 0x7C7C7C7C;
    const float* b_up; unsigned char* act;
    __device__ __forceinline__ void mid(Acc&, const Unit&, int, int, int, int) const {}
    __device__ __forceinline__ void operator()(const Acc& acc, const Unit& u, int wr, int wc, int fr, int fq) const {
        int rl = wr * 64 + fr, cl = wc * 32 + 8 * fq; EPI_SEED(rl, cl);
        const unsigned o0 = (unsigned)(u.pm * BM + rl) * DE + u.pn * HALF + (cl >> 1);
        f32x4 bv[2][2];
#pragma unroll
        for (int bj = 0; bj < 2; ++bj)
#pragma unroll
            for (int n = 0; n < 2; ++n) bv[bj][n] = ldg<f32x4>(b_up, (unsigned)(u.e * 2048 + u.pn * BM + cl + bj * HALF + 4 * n) * 4u);
#pragma unroll
        for (int ai = 0; ai < 2; ++ai)
#pragma unroll
            for (int m = 0; m < 4; ++m)
#pragma unroll
                for (int bj = 0; bj < 2; ++bj) { float o[4];
#pragma unroll
                    for (int n = 0; n < 2; ++n) { const f32x4 v = acc[ai][bj][m][n] + bv[bj][n];
#pragma unroll
                        for (int p = 0; p < 2; ++p) { const float xg = fminf(v[2 * p], 7.0f), xl = fminf(fmaxf(v[2 * p + 1], -7.0f), 7.0f);
                            o[2 * n + p] = xg * sigmoidf_(1.702f * xg) * (xl + 1.0f); } }
                    unsigned w = 0u; w = __builtin_amdgcn_cvt_pk_fp8_f32(o[0] * 8.0f, o[1] * 8.0f, w, false); w = __builtin_amdgcn_cvt_pk_fp8_f32(o[2] * 8.0f, o[3] * 8.0f, w, true);
                    __hip_atomic_store((unsigned*)(act + (o0 + (unsigned)((ai * HALF + m * 16) * DE + bj * 64))), w, __ATOMIC_RELAXED, __HIP_MEMORY_SCOPE_AGENT); }
    }
};
struct EpiDown {
    static constexpr bool PERM = true; static constexpr int MID_T = 0;
    static constexpr int SCALE_B = 0x79797979, SCALE_A = 0x7C7C7C7C;
    const float* b_dn; const int* slot; unsigned char* ys;
    __device__ __forceinline__ void mid(Acc&, const Unit&, int, int, int, int) const {}
    __device__ __forceinline__ void operator()(const Acc& acc, const Unit& u, int wr, int wc, int fr, int fq) const {
        int rl = wr * 64 + fr, cl = wc * 32 + 8 * fq; EPI_SEED(rl, cl);
        const int col0 = u.pn * BM + cl, idx0 = u.mt * BM + rl;
        f32x4 bv[2][2];
#pragma unroll
        for (int bj = 0; bj < 2; ++bj)
#pragma unroll
            for (int n = 0; n < 2; ++n) bv[bj][n] = ldg<f32x4>(b_dn, (unsigned)(u.e * D + col0 + bj * HALF + 4 * n) * 4u);
        int asg[2][4];
#pragma unroll
        for (int ai = 0; ai < 2; ++ai)
#pragma unroll
            for (int m = 0; m < 4; ++m) { const int idx = idx0 + ai * HALF + m * 16; asg[ai][m] = ldg<int>(slot, (unsigned)(u.e * SLOT_CAP + (idx < u.cnt ? idx : u.cnt - 1)) * 4u); }
#pragma unroll
        for (int ai = 0; ai < 2; ++ai)
#pragma unroll
            for (int m = 0; m < 4; ++m) { const int idx = idx0 + ai * HALF + m * 16;
                if (idx < u.cnt) { const unsigned o0 = (unsigned)asg[ai][m] * D + col0;
#pragma unroll
                    for (int bj = 0; bj < 2; ++bj) { const f32x4 v0 = (acc[ai][bj][m][0] + bv[bj][0]) * 16.0f, v1 = (acc[ai][bj][m][1] + bv[bj][1]) * 16.0f;
                        u32x2 w; w.x = __builtin_amdgcn_cvt_pk_fp8_f32(v0[0], v0[1], 0u, false); w.x = __builtin_amdgcn_cvt_pk_fp8_f32(v0[2], v0[3], w.x, true);
                        w.y = __builtin_amdgcn_cvt_pk_fp8_f32(v1[0], v1[1], 0u, false); w.y = __builtin_amdgcn_cvt_pk_fp8_f32(v1[2], v1[3], w.y, true);
                        stg<u32x2>(ys, o0 + (unsigned)(bj * HALF), w); } } }
    }
};
struct EpiUpX {
    const float* b_up; unsigned char* act;
    __device__ __forceinline__ void operator()(const Acc& acc, const Unit& u, int wr, int wc, int fr, int fq) const {
        int rl = wr * 64 + fr, cb = 64 * wc + 32 * (fq & 1) + 16 * (fq >> 1); EPI_SEED(rl, cb);
        f32x4 bv[2][2];
#pragma unroll
        for (int bj = 0; bj < 2; ++bj)
#pragma unroll
            for (int n = 0; n < 2; ++n) bv[bj][n] = ldg<f32x4>(b_up, (unsigned)(u.e * 2048 + u.pn * BM + cb + 8 * bj + 4 * n) * 4u);
        const __amdgpu_buffer_rsrc_t rs = __builtin_amdgcn_make_buffer_rsrc(act, 0, (MAX_MT * 256) * 1024, 0x00020000);
        const unsigned o0 = (unsigned)(u.pm * BM + rl + 16 * (fq >> 1)) * DE + u.pn * HALF + 32 * wc + 16 * (fq & 1);
#pragma unroll
        for (int ai = 0; ai < 2; ++ai)
#pragma unroll
            for (int j = 0; j < 2; ++j) { unsigned d[2][2];
#pragma unroll
                for (int mm = 0; mm < 2; ++mm)
#pragma unroll
                    for (int bj = 0; bj < 2; ++bj) { float o[4];
#pragma unroll
                        for (int n = 0; n < 2; ++n) { const f32x4 v = acc[ai][bj][2 * j + mm][n] + bv[bj][n];
#pragma unroll
                            for (int p = 0; p < 2; ++p) { const float xg = fminf(v[2 * p], 7.0f), xl = fminf(fmaxf(v[2 * p + 1], -7.0f), 7.0f);
                                o[2 * n + p] = (xg * __builtin_amdgcn_rcpf(1.0f + __builtin_amdgcn_exp2f(xg * (-1.702f * 1.44269504f)))) * __builtin_fmaf(xl, 8.0f, 8.0f); } }
                        unsigned w = 0u; w = __builtin_amdgcn_cvt_pk_fp8_f32(o[0], o[1], w, false); w = __builtin_amdgcn_cvt_pk_fp8_f32(o[2], o[3], w, true); d[mm][bj] = w; }
                const u32x2 s0 = __builtin_amdgcn_permlane32_swap(d[0][0], d[1][0], false, false), s1 = __builtin_amdgcn_permlane32_swap(d[0][1], d[1][1], false, false);
                const u32x4 w4 = (u32x4){s0.x, s1.x, s0.y, s1.y};
                __builtin_amdgcn_raw_buffer_store_b128(w4, rs, o0 + (unsigned)((ai * HALF + 32 * j) * DE), 0, 16); }
    }
};
struct EpiMoe {
    static constexpr bool PERM = true; static constexpr int MID_T = 0;
    static constexpr int SCALE_B = 0x79797979, SCALE_A = 0x7C7C7C7C;
    EpiUpX up; EpiDown dn;
    __device__ __forceinline__ void mid(Acc&, const Unit&, int, int, int, int) const {}
    __device__ __forceinline__ void operator()(const Acc& acc, const Unit& u, int wr, int wc, int fr, int fq) const { if (u.type == 0) up(acc, u, wr, wc, fr, fq); else dn(acc, u, wr, wc, fr, fq); }
};
}

#define XB_TMO      128
#define XB_XCNT(j)  (256  + 64 * (j))
#define XB_XSUB(j)  (1280 + 64 * (j))
#define XB_XGEN(j)  (2304 + 64 * (j))
#define XB_TOP      3328
#define XB_TOPGEN   3392
#define XCD_BAR_WORDS 3456
#define XB_SPIN_CAP (1u << 18)
__device__ __forceinline__ unsigned xb_ld(unsigned* p)              { return __hip_atomic_load(p, __ATOMIC_RELAXED, __HIP_MEMORY_SCOPE_AGENT); }
__device__ __forceinline__ unsigned xb_add(unsigned* p, unsigned v) { return __hip_atomic_fetch_add(p, v, __ATOMIC_RELAXED, __HIP_MEMORY_SCOPE_AGENT); }
__device__ __forceinline__ unsigned xb_xcc_id() { return (unsigned)__builtin_amdgcn_s_getreg((3 << 11) | 20) & 0xFu; }
#define XB_SPIN(cond, bar) do { unsigned _sp = 0; while (cond) { __builtin_amdgcn_s_sleep(1); \
    if ((++_sp & 255u) == 0u) { if (xb_ld(&(bar)[XB_TMO])) break; if (_sp > XB_SPIN_CAP) { atomicAdd(&(bar)[XB_TMO], 1u); break; } } } } while (0)
struct XcdBarrier { unsigned* bar; unsigned x; volatile LAS unsigned* st; };
__device__ __forceinline__ XcdBarrier xcd_barrier_post(unsigned* bar, volatile LAS unsigned* st) {
    XcdBarrier b; b.bar = bar; b.x = xb_xcc_id(); b.st = st;
    if (threadIdx.x == 0) (void)xb_add(&bar[XB_XCNT(b.x)], 1u);
    return b;
}
__device__ __forceinline__ void xcd_barrier_complete(unsigned* bar, unsigned x, unsigned& nloc, unsigned& nx) {
    const unsigned G = gridDim.x * gridDim.y * gridDim.z;
    unsigned sum, cnt, mine, sp = 0u;
    for (;;) {
        sum = 0u; cnt = 0u; mine = 0u;
#pragma unroll
        for (unsigned j = 0; j < 16; ++j) { const unsigned c = xb_ld(&bar[XB_XCNT(j)]); sum += c; cnt += (c > 0u) ? 1u : 0u; mine = (j == x) ? c : mine; }
        if (sum == G) break;
        __builtin_amdgcn_s_sleep(1);
        if ((++sp & 255u) == 0u) { if (xb_ld(&bar[XB_TMO])) break; if (sp > XB_SPIN_CAP) { atomicAdd(&bar[XB_TMO], 1u); break; } }
    }
    nloc = mine > 0u ? mine : 1u; nx = cnt > 0u ? cnt : 1u;
}
__device__ __forceinline__ void xcd_barrier(const XcdBarrier& b) {
    asm volatile("s_waitcnt vmcnt(0)" ::: "memory");
    __syncthreads();
    if (threadIdx.x == 64) asm volatile("buffer_inv sc1\n\ts_waitcnt vmcnt(0)" ::: "memory");
    if (threadIdx.x == 0) {
        unsigned* bar = b.bar;
        __builtin_amdgcn_s_waitcnt(0);
        unsigned nloc = b.st[0], nx = b.st[1];
        if (nloc == 0u) { xcd_barrier_complete(bar, b.x, nloc, nx); b.st[0] = nloc; b.st[1] = nx; }
        const unsigned old = xb_add(&bar[XB_XSUB(b.x)], 1u);
        const unsigned gen = old / nloc;
        if (old + 1u == (gen + 1u) * nloc) {
            __builtin_amdgcn_fence(__ATOMIC_RELEASE, "agent");
            asm volatile("s_waitcnt vmcnt(0)" ::: "memory");
            const unsigned og = xb_add(&bar[XB_TOP], 1u);
            const unsigned tg = og / nx;
            if (og + 1u == (tg + 1u) * nx) xb_add(&bar[XB_TOPGEN], 1u);
            else XB_SPIN(xb_ld(&bar[XB_TOPGEN]) == tg, bar);
            xb_add(&bar[XB_XGEN(b.x)], 1u);
            asm volatile("s_waitcnt vmcnt(0)" ::: "memory");
        } else {
            XB_SPIN(xb_ld(&bar[XB_XGEN(b.x)]) == gen, bar);
            asm volatile("s_waitcnt vmcnt(0)" ::: "memory");
        }
    }
    __syncthreads();
}


__device__ __forceinline__ void tr_item(const float* W, int ldw, int scol0, int srow0, bf16* WT, int Kd, int drow0, int dk0, LAS float* scr, int lane) {
#pragma unroll 8
    for (int i = 0; i < 32; ++i) { const int kk = 2 * i + (lane >> 5); scr[kk * 33 + (lane & 31)] = __builtin_nontemporal_load(W + (size_t)(srow0 + kk) * ldw + scol0 + (lane & 31)); }
    LDS_WAIT(); asm volatile("" ::: "memory");
    const int c = lane & 7;
#pragma unroll
    for (int j = 0; j < 4; ++j) { const int n = (lane >> 3) + 8 * j; const LAS float* s = scr + (8 * c) * 33 + n;
        u32x4 o; o.x = pk2(s[0 * 33], s[1 * 33]); o.y = pk2(s[2 * 33], s[3 * 33]); o.z = pk2(s[4 * 33], s[5 * 33]); o.w = pk2(s[6 * 33], s[7 * 33]);
        *(u32x4*)(WT + (size_t)(drow0 + n) * Kd + dk0 + 8 * c) = o; }
    LDS_WAIT(); asm volatile("" ::: "memory");
}
__device__ __forceinline__ int src_col_u(int np) {
    if (np < 768) return np;
    if (np >= 1792) { const int tt = (np - 1792) >> 8, w = (np - 1792) & 255; return w < 128 ? 1792 + 128 * tt + w : 2816 + 128 * tt + (w - 128); }
    const int tt = (np - 768) >> 8, w = (np - 768) & 255;
    return w < 128 ? 768 + 128 * tt + w : 1280 + 128 * tt + (w - 128);
}

__device__ __forceinline__ void p0_prologue(const Args& a, LAS unsigned char* lds, int gw, int NGW, int lane, int wave) {
    unsigned char* ws = a.ws;
    LAS float* scr = (LAS float*)(lds + wave * 16384);
    constexpr int J1 = 16 * 120, J2 = 8 * 32, J3 = 8 * 32, J4 = 16 * 32;
    constexpr int NITEMS = J1 + J2 + J3 + J4;
    for (int it = gw; it < NITEMS; it += NGW) {
        int r = it;
        if (r < J1) { const int kb = r / 120, nb = r % 120; tr_item(a.in[I_WIN], INW, src_col_u(32 * nb), 64 * kb, (bf16*)(ws + WS_WIN), 1024, 32 * nb, 64 * kb, scr, lane); continue; } r -= J1;
        if (r < J2) { const int kb = r / 32, nb = r % 32; tr_item(a.in[I_WATT], D, 32 * nb, 64 * kb, (bf16*)(ws + WS_WAB), 1024, 32 * nb, 64 * kb, scr, lane); continue; } r -= J2;
        if (r < J3) { const int kb = r / 32, nb = r % 32; tr_item(a.in[I_WCONV], D, 32 * nb, 64 * kb, (bf16*)(ws + WS_WAB), 1024, 32 * nb, 512 + 64 * kb, scr, lane); continue; } r -= J3;
        { const int kb = r / 32, nb = r % 32; tr_item(a.in[I_WO], D, 32 * nb, 64 * kb, (bf16*)(ws + WS_WO), 1024, 32 * nb, 64 * kb, scr, lane); }
    }
    const float* x = a.in[I_X]; bf16* xb = (bf16*)(ws + WS_XB);
    for (int m = gw; m < T; m += NGW) {
        const f32x4* xr = (const f32x4*)(x + (size_t)m * D) + lane; u32x2* o = (u32x2*)(xb + (size_t)m * D) + lane;
#pragma unroll
        for (int j = 0; j < 4; ++j) { const f32x4 v = __builtin_nontemporal_load(xr + 64 * j); u32x2 w; w.x = pk2(v[0], v[1]); w.y = pk2(v[2], v[3]); o[64 * j] = w; }
    }
    { u32x4* abz = (u32x4*)(ws + WS_AB); const u32x4 z4 = (u32x4){0u, 0u, 0u, 0u};
      for (int i = gw * 64 + lane; i < NBATCH * AB_PAD * CCH * 2 / 16; i += NGW * 64) { const int bb = i / (AB_PAD * CCH * 2 / 16), q = i % (AB_PAD * CCH * 2 / 16); abz[(size_t)bb * (AB_SEQ * CCH * 2 / 16) + q] = z4; } }
    float* bperm = (float*)(ws + WS_BPERM);
    for (int i = gw * 64 + lane; i < INW; i += NGW * 64) bperm[i] = a.in[I_BIN][src_col_u(i)];
}

constexpr int KLS = 144, VLS = 528, ATT_V_OFF = 256 * KLS, CONV_W_OFF = 70656;
__device__ __forceinline__ void attn_unit(const Args& a, int unit, LAS unsigned char* lds, int tid, int wave, int lane) {
    const bf16* qb = (const bf16*)(a.ws + WS_QB); const bf16* kb = (const bf16*)(a.ws + WS_KB); const bf16* vT = (const bf16*)(a.ws + WS_VT); bf16* ay = (bf16*)(a.ws + WS_AY);
    const int kvh = unit & 1, blk = (unit >> 1) & 31, b = unit >> 6;
    const int r = lane & 15, qd = lane >> 4, w = wave;
    const int t0 = b * SEQ + blk * 128, seq0 = b * SEQ, lo = w & ~1;
    { u32x4 kreg[4], vreg[4];
#pragma unroll
      for (int i = 0; i < 4; ++i) { const int c = tid + 512 * i;
          int tok = t0 - 128 + (c >> 3); tok = tok < seq0 ? seq0 : tok;
          kreg[i] = ldgo<u32x4>(kb, (unsigned)(tok * KVW + kvh * HD + (c & 7) * 8) * 2u);
          int sk = blk * 128 - 128 + 8 * (c & 31); sk = sk < 0 ? 0 : sk;
          vreg[i] = ldgo<u32x4>(vT, (unsigned)(((b * NKV + kvh) * HD + (c >> 5)) * SEQ + sk) * 2u); }
      __builtin_amdgcn_sched_barrier(0);
      asm volatile("" : "+v"(kreg[0]), "+v"(kreg[1]), "+v"(kreg[2]), "+v"(kreg[3]), "+v"(vreg[0]), "+v"(vreg[1]), "+v"(vreg[2]), "+v"(vreg[3]));
#pragma unroll
      for (int i = 0; i < 4; ++i) { const int c = tid + 512 * i;
          *(LAS u32x4*)(lds + (c >> 3) * KLS + (c & 7) * 16) = kreg[i];
          *(LAS u32x4*)(lds + ATT_V_OFF + (c >> 5) * VLS + (c & 31) * 16) = vreg[i]; } }
    __syncthreads();
    const int qi = 16 * w + r;
#pragma unroll 1
    for (int hh = 0; hh < 4; ++hh) {
        const int head = kvh * 4 + hh;
        u32x4 qf[2];
        { const unsigned qo = (unsigned)((t0 + qi) * AW + head * HD + 8 * qd) * 2u; qf[0] = ldgo<u32x4>(qb, qo); qf[1] = ldgo<u32x4>(qb, qo + 64u); }
        const float sinkv = a.in[I_SINK][head];
        int qiv = qi; asm volatile("" : "+v"(qiv));
        const int klo = max(qiv + 1, blk > 0 ? 0 : 128); const int kjb = lo * 16 + 4 * qd - klo; const unsigned span = (unsigned)(qiv + 128 - klo);
        f32x4 s[10];
#pragma unroll
        for (int i = 0; i < 10; ++i) {
            const LAS unsigned char* kp = lds + ((lo + i) * 16 + r) * KLS + qd * 16;
            const u32x4 k0 = *(const LAS u32x4*)kp, k1 = *(const LAS u32x4*)(kp + 64);
            f32x4 z = (f32x4){0.f, 0.f, 0.f, 0.f};
            z = __builtin_amdgcn_mfma_f32_16x16x32_bf16(__builtin_bit_cast(bf16x8, k0), __builtin_bit_cast(bf16x8, qf[0]), z, 0, 0, 0);
            s[i] = __builtin_amdgcn_mfma_f32_16x16x32_bf16(__builtin_bit_cast(bf16x8, k1), __builtin_bit_cast(bf16x8, qf[1]), z, 0, 0, 0);
        }
        float mx = sinkv;
#pragma unroll
        for (int i = 0; i < 10; ++i)
#pragma unroll
            for (int g = 0; g < 4; ++g) { const bool valid = (unsigned)(kjb + (16 * i + g)) <= span; s[i][g] = valid ? s[i][g] : -1e30f; mx = fmaxf(mx, s[i][g]); }
        mx = fmaxf(mx, __shfl_xor(mx, 16)); mx = fmaxf(mx, __shfl_xor(mx, 32));
        float sum = 0.f;
#pragma unroll
        for (int i = 0; i < 10; ++i)
#pragma unroll
            for (int g = 0; g < 4; ++g) { const float p = (s[i][g] > -1e29f) ? __expf(s[i][g] - mx) : 0.f; s[i][g] = p; sum += p; }
        sum += __shfl_xor(sum, 16); sum += __shfl_xor(sum, 32);
        const float inv = 1.0f / (sum + __expf(sinkv - mx));
        f32x4 o[4];
#pragma unroll
        for (int mt = 0; mt < 4; ++mt) o[mt] = (f32x4){0.f, 0.f, 0.f, 0.f};
#pragma unroll
        for (int ip = 0; ip < 5; ++ip) {
            u32x4 pw; pw.x = cvt_pk_bf16(s[2 * ip][0], s[2 * ip][1]); pw.y = cvt_pk_bf16(s[2 * ip][2], s[2 * ip][3]); pw.z = cvt_pk_bf16(s[2 * ip + 1][0], s[2 * ip + 1][1]); pw.w = cvt_pk_bf16(s[2 * ip + 1][2], s[2 * ip + 1][3]);
            const bf16x8 pb = __builtin_bit_cast(bf16x8, pw);
#pragma unroll
            for (int mt = 0; mt < 4; ++mt) { const LAS unsigned char* vp = lds + ATT_V_OFF + (16 * mt + r) * VLS + ((lo + 2 * ip) * 16 + 4 * qd) * 2;
                const u32x2 va = *(const LAS u32x2*)vp, vb = *(const LAS u32x2*)(vp + 32);
                u32x4 vw; vw.x = va.x; vw.y = va.y; vw.z = vb.x; vw.w = vb.y;
                o[mt] = __builtin_amdgcn_mfma_f32_16x16x32_bf16(__builtin_bit_cast(bf16x8, vw), pb, o[mt], 0, 0, 0); }
        }
        const unsigned oo = (unsigned)((t0 + qi) * D + head * HD + 4 * qd) * 2u;
#pragma unroll
        for (int mt = 0; mt < 4; ++mt) { u32x2 wv; wv.x = cvt_pk_bf16(o[mt][0] * inv, o[mt][1] * inv); wv.y = cvt_pk_bf16(o[mt][2] * inv, o[mt][3] * inv); *(u32x2*)((char*)ay + oo + 32u * mt) = wv; }
    }
    __syncthreads();
}

constexpr int CBS = 516;
__device__ __forceinline__ void conv_unit(const Args& a, int unit, LAS unsigned char* lds, int tid, int wave, int lane) {
    const bf16* ab = (const bf16*)(a.ws + WS_AB); bf16* ay = (bf16*)(a.ws + WS_AY);
    LAS float* cb = (LAS float*)lds;
    const int t0 = unit * 32, prow0 = t0 + AB_PAD * ((t0 >> 12) + 1);
    int cp = tid & 255; asm volatile("" : "+v"(cp));
    const int half = wave >> 2;
    const LAS float* wl = (const LAS float*)(lds + CONV_W_OFF) + 2 * cp;
    const f32x2 cbias = *(const f32x2*)(a.in[I_CONVB] + 2 * cp);
#pragma unroll 1
    for (int it = 0; it < 2; ++it) {
        const int tl0 = 16 * half + 8 * it;
        const unsigned o0 = (unsigned)((prow0 + tl0 - 30) * CCH + 2 * cp) * 2u;
        unsigned raw[38];
#pragma unroll
        for (int rr = 0; rr < 38; ++rr) raw[rr] = ldgo<unsigned>(ab, o0 + (unsigned)(rr * CCH * 2));
        __builtin_amdgcn_sched_barrier(0);
        asm volatile("" : "+v"(raw[0]), "+v"(raw[1]), "+v"(raw[2]), "+v"(raw[3]), "+v"(raw[4]), "+v"(raw[5]), "+v"(raw[6]), "+v"(raw[7]), "+v"(raw[8]), "+v"(raw[9]),
                          "+v"(raw[10]), "+v"(raw[11]), "+v"(raw[12]), "+v"(raw[13]), "+v"(raw[14]), "+v"(raw[15]), "+v"(raw[16]), "+v"(raw[17]), "+v"(raw[18]));
        asm volatile("" : "+v"(raw[19]), "+v"(raw[20]), "+v"(raw[21]), "+v"(raw[22]), "+v"(raw[23]), "+v"(raw[24]), "+v"(raw[25]), "+v"(raw[26]), "+v"(raw[27]), "+v"(raw[28]),
                          "+v"(raw[29]), "+v"(raw[30]), "+v"(raw[31]), "+v"(raw[32]), "+v"(raw[33]), "+v"(raw[34]), "+v"(raw[35]), "+v"(raw[36]), "+v"(raw[37]));
        float i0[38], i1[38];
#pragma unroll
        for (int rr = 0; rr < 38; ++rr) { i0[rr] = bflo(raw[rr]); i1[rr] = bfhi(raw[rr]); }
        float a0[8], a1[8];
#pragma unroll
        for (int o = 0; o < 8; ++o) { a0[o] = cbias.x; a1[o] = cbias.y; }
#pragma unroll
        for (int j = 0; j < CW; ++j) { const f32x2 wv = *(const LAS f32x2*)(wl + j * CCH);
#pragma unroll
            for (int o = 0; o < 8; ++o) { a0[o] = fmaf(i0[o + j], wv.x, a0[o]); a1[o] = fmaf(i1[o + j], wv.y, a1[o]); } }
#pragma unroll
        for (int o = 0; o < 8; ++o) *(LAS f32x2*)(cb + (tl0 + o) * CBS + 2 * cp) = (f32x2){a0[o], a1[o]};
    }
    __syncthreads();
    const f32x4 g0 = *(const f32x4*)(a.in[I_CLNG] + 8 * lane), g1 = *(const f32x4*)(a.in[I_CLNG] + 8 * lane + 4), b0 = *(const f32x4*)(a.in[I_CLNB] + 8 * lane), b1 = *(const f32x4*)(a.in[I_CLNB] + 8 * lane + 4);
#pragma unroll
    for (int tt = 0; tt < 4; ++tt) { const int tok = 4 * wave + tt;
        f32x4 v0 = *(const LAS f32x4*)(cb + tok * CBS + 8 * lane), v1 = *(const LAS f32x4*)(cb + tok * CBS + 8 * lane + 4);
        const float mean = wave_sum((v0[0] + v0[1]) + (v0[2] + v0[3]) + (v1[0] + v1[1]) + (v1[2] + v1[3])) * (1.0f / CCH);
        v0 = v0 - mean; v1 = v1 - mean;
        const float var = wave_sum((v0[0] * v0[0] + v0[1] * v0[1]) + (v0[2] * v0[2] + v0[3] * v0[3]) + (v1[0] * v1[0] + v1[1] * v1[1]) + (v1[2] * v1[2] + v1[3] * v1[3])) * (1.0f / CCH);
        const float rstd = 1.0f / sqrtf(var + LN_EPS);
        float y[8];
#pragma unroll
        for (int j = 0; j < 4; ++j) { const float y0 = v0[j] * rstd * g0[j] + b0[j], y1 = v1[j] * rstd * g1[j] + b1[j]; y[j] = y0 * sigmoidf_(y0); y[4 + j] = y1 * sigmoidf_(y1); }
        u32x4 wv; wv.x = cvt_pk_bf16(y[0], y[1]); wv.y = cvt_pk_bf16(y[2], y[3]); wv.z = cvt_pk_bf16(y[4], y[5]); wv.w = cvt_pk_bf16(y[6], y[7]);
        *(u32x4*)(ay + (size_t)(t0 + tok) * D + 512 + 8 * lane) = wv; }
    __syncthreads();
}

constexpr int HLS = 1025;
__device__ __forceinline__ void route_chunk(const Args& a, int chunk, LAS unsigned char* lds, int tid, int wave, int lane, const float (&bw)[64], const f32x4 (&g)[4], const f32x4 (&bb)[4]) {
    const bf16* hf = (const bf16*)(a.ws + WS_HF); unsigned char* hb = a.ws + WS_HB;
    int* slot = (int*)(a.ws + WS_SLOT); float* gatev = (float*)(a.ws + WS_GATE); unsigned* cursor = (unsigned*)(a.ws + WS_CTL);
    LAS float* hl = (LAS float*)lds;
    LAS float* lg = (LAS float*)(lds + MISC_OFF + MO_LG); LAS int* sel_e = (LAS int*)(lds + MISC_OFF + MO_SELE); LAS float* sel_g = (LAS float*)(lds + MISC_OFF + MO_SELG);
    LAS int* lcnt = (LAS int*)(lds + MISC_OFF + MO_LCNT); LAS int* lbase = (LAS int*)(lds + MISC_OFF + MO_LBASE);
    const int t0 = chunk * 32;
    f32x4 v[4][4];
    { u32x2 rw[4][4];
#pragma unroll
      for (int tt = 0; tt < 4; ++tt)
#pragma unroll
        for (int j = 0; j < 4; ++j) rw[tt][j] = *((const u32x2*)(hf + (size_t)(t0 + 4 * wave + tt) * D) + lane + 64 * j);
      __builtin_amdgcn_sched_barrier(0);
      asm volatile("" : "+v"(rw[0][0]), "+v"(rw[0][1]), "+v"(rw[0][2]), "+v"(rw[0][3]), "+v"(rw[1][0]), "+v"(rw[1][1]), "+v"(rw[1][2]), "+v"(rw[1][3]),
                        "+v"(rw[2][0]), "+v"(rw[2][1]), "+v"(rw[2][2]), "+v"(rw[2][3]), "+v"(rw[3][0]), "+v"(rw[3][1]), "+v"(rw[3][2]), "+v"(rw[3][3]));
#pragma unroll
      for (int tt = 0; tt < 4; ++tt)
#pragma unroll
        for (int j = 0; j < 4; ++j) v[tt][j] = (f32x4){bflo(rw[tt][j].x), bfhi(rw[tt][j].x), bflo(rw[tt][j].y), bfhi(rw[tt][j].y)}; }
#pragma unroll
    for (int tt = 0; tt < 4; ++tt) { const int tl = 4 * wave + tt;
        float sm = 0.f;
#pragma unroll
        for (int j = 0; j < 4; ++j) sm += (v[tt][j][0] + v[tt][j][1]) + (v[tt][j][2] + v[tt][j][3]);
        const float mean = wave_sum(sm) * (1.0f / D); float s2 = 0.f;
#pragma unroll
        for (int j = 0; j < 4; ++j) { v[tt][j] = v[tt][j] - mean; s2 += (v[tt][j][0] * v[tt][j][0] + v[tt][j][1] * v[tt][j][1]) + (v[tt][j][2] * v[tt][j][2] + v[tt][j][3] * v[tt][j][3]); }
        const float rstd = 1.0f / sqrtf(wave_sum(s2) * (1.0f / D) + LN_EPS);
        if (lane == 0) *(f32x2*)((float*)(a.ws + WS_LN1S) + 2 * (size_t)(t0 + tl)) = (f32x2){mean, rstd};
#pragma unroll
        for (int j = 0; j < 4; ++j) { const f32x4 h = v[tt][j] * rstd * g[j] + bb[j];
            unsigned wv = 0u; wv = __builtin_amdgcn_cvt_pk_fp8_f32(h[0] * 8.0f, h[1] * 8.0f, wv, false); wv = __builtin_amdgcn_cvt_pk_fp8_f32(h[2] * 8.0f, h[3] * 8.0f, wv, true); *((unsigned*)(hb + (size_t)(t0 + tl) * D) + lane + 64 * j) = wv;
            LAS float* hp = hl + tl * HLS + 4 * lane + 256 * j; hp[0] = h[0]; hp[1] = h[1]; hp[2] = h[2]; hp[3] = h[3]; }
    }
    if (tid < 32) lcnt[tid] = 0;
    __syncthreads();
    f32x16 acc;
#pragma unroll
    for (int i = 0; i < 16; ++i) acc[i] = 0.f;
    { const int tok = lane & 31, kp = lane >> 5; const LAS float* hp = hl + tok * HLS + 128 * wave + kp;
#pragma unroll
      for (int s = 0; s < 64; ++s) acc = __builtin_amdgcn_mfma_f32_32x32x2f32(hp[2 * s], bw[s], acc, 0, 0, 0); }
    __syncthreads();
    { LAS float* part = hl + wave * 1024;
#pragma unroll
      for (int i = 0; i < 16; ++i) { const int rowi = (i & 3) + 8 * (i >> 2) + 4 * (lane >> 5); part[rowi * 32 + (lane & 31)] = acc[i]; } }
    __syncthreads();
    for (int o = tid; o < 1024; o += 512) { float sm = a.in[I_BR][o & 31];
#pragma unroll
        for (int w = 0; w < 8; ++w) sm += hl[w * 1024 + o];
        lg[(o >> 5) * 33 + (o & 31)] = sm; }
    __syncthreads();
    if (tid < 32) { float v[NE];
#pragma unroll
        for (int e = 0; e < NE; ++e) v[e] = lg[tid * 33 + e];
        float tv[4]; int ti[4];
#pragma unroll
        for (int k = 0; k < 4; ++k) { float best = -3.0e38f; int bi = 0;
#pragma unroll
            for (int e = 0; e < NE; ++e) { const bool take = v[e] > best; best = take ? v[e] : best; bi = take ? e : bi; }
            tv[k] = best; ti[k] = bi;
#pragma unroll
            for (int e = 0; e < NE; ++e) v[e] = (e == bi) ? -3.0e38f : v[e]; }
        const float e1 = __expf(tv[1] - tv[0]), e2 = __expf(tv[2] - tv[0]), e3 = __expf(tv[3] - tv[0]); const float inv = 1.0f / (1.0f + e1 + e2 + e3);
        sel_e[4 * tid + 0] = ti[0]; sel_e[4 * tid + 1] = ti[1]; sel_e[4 * tid + 2] = ti[2]; sel_e[4 * tid + 3] = ti[3];
        sel_g[4 * tid + 0] = inv; sel_g[4 * tid + 1] = e1 * inv; sel_g[4 * tid + 2] = e2 * inv; sel_g[4 * tid + 3] = e3 * inv; }
    __syncthreads();
    int my_e = 0, my_rank = 0;
    if (tid < 128) { my_e = sel_e[tid]; my_rank = atomicAdd((int*)&lcnt[my_e], 1); }
    __syncthreads();
    if (tid < 32) { const int c = lcnt[tid]; lbase[tid] = c > 0 ? (int)atomicAdd(cursor + tid, (unsigned)c) : 0; }
    __syncthreads();
    if (tid < 128) { const int asg = (t0 + (tid >> 2)) * 4 + (tid & 3); slot[my_e * SLOT_CAP + lbase[my_e] + my_rank] = asg; gatev[asg] = sel_g[tid]; }
    __syncthreads();
}

__device__ __forceinline__ void combine_row(const Args& a, int m, int lane) {
    const bf16* hf = (const bf16*)(a.ws + WS_HF); const unsigned char* ys = a.ws + WS_YS; const float* gatev = (const float*)(a.ws + WS_GATE);
    f32x4 gt = *(const f32x4*)(gatev + 4 * (size_t)m); gt = gt * (1.0f / 16.0f);
    const f32x2 st = *(const f32x2*)((const float*)(a.ws + WS_LN1S) + 2 * (size_t)m);
    f32x4 v[4]; float sm = 0.f;
#pragma unroll
    for (int j = 0; j < 4; ++j) { const f32x4 g1 = *((const f32x4*)a.in[I_LN1G] + lane + 64 * j), b1 = *((const f32x4*)a.in[I_LN1B] + lane + 64 * j);
        const u32x2 pw = *((const u32x2*)(hf + (size_t)m * D) + lane + 64 * j); f32x4 p = (f32x4){bflo(pw.x), bfhi(pw.x), bflo(pw.y), bfhi(pw.y)}; p = p - st.x; const f32x4 h = p * st.y * g1 + b1;
        v[j] = h * DN_ALPHA;
#pragma unroll
        for (int k = 0; k < 4; ++k) { const unsigned y = *((const unsigned*)(ys + ((size_t)m * 4 + k) * D) + lane + 64 * j); const float gk = gt[k];
            const f32x2 lo = __builtin_amdgcn_cvt_pk_f32_fp8(y, false), hi = __builtin_amdgcn_cvt_pk_f32_fp8(y, true);
            v[j][0] += gk * lo.x; v[j][1] += gk * lo.y; v[j][2] += gk * hi.x; v[j][3] += gk * hi.y; }
        sm += (v[j][0] + v[j][1]) + (v[j][2] + v[j][3]); }
    const float mean = wave_sum(sm) * (1.0f / D); float s2 = 0.f;
#pragma unroll
    for (int j = 0; j < 4; ++j) { v[j] = v[j] - mean; s2 += (v[j][0] * v[j][0] + v[j][1] * v[j][1]) + (v[j][2] * v[j][2] + v[j][3] * v[j][3]); }
    const float rstd = 1.0f / sqrtf(wave_sum(s2) * (1.0f / D) + LN_EPS);
#pragma unroll
    for (int j = 0; j < 4; ++j) { const f32x4 g = *((const f32x4*)a.in[I_LN2G] + lane + 64 * j), bb = *((const f32x4*)a.in[I_LN2B] + lane + 64 * j);
        *((f32x4*)(a.out + (size_t)m * D) + lane + 64 * j) = v[j] * rstd * g + bb; }
}

__global__ void __launch_bounds__(512, 2) fwd_megakernel(Args args) {
    extern __shared__ __attribute__((aligned(16))) unsigned char lds_raw[];
    LAS unsigned char* lds = (LAS unsigned char*)lds_raw;
    const int tid = threadIdx.x, wave = __builtin_amdgcn_readfirstlane(tid >> 6);
#define FRESH_LANE int lane; { int t_ = tid; asm volatile("" : "+v"(t_)); lane = t_ & 63; }
    const int G = gridDim.x, bx = blockIdx.x;
    const int vcu = (G % 8 == 0) ? (bx % 8) * (G / 8) + bx / 8 : bx;
    const int gw = vcu * 8 + wave, NGW = G * 8;
    const int lo = args.ph_lo, hi = args.ph_hi;
    unsigned char* ws = args.ws;
    volatile LAS unsigned* bst = (volatile LAS unsigned*)(lds + MISC_OFF + MO_BAR);
    if (tid < 2) bst[tid] = 0u;
    __syncthreads();
    XcdBarrier xbar = xcd_barrier_post((unsigned*)(ws + WS_CTL) + CW_BAR, bst);
#ifndef PMASK
#define PMASK 0x1ff
#endif
#define IN(k) (((PMASK >> (k)) & 1) && lo <= (k) && (k) < hi)
#define SEAM(k) do { if (lo <= (k) && (k) + 1 < hi) xcd_barrier(xbar); } while (0)

    if (IN(0)) { FRESH_LANE; p0_prologue(args, lds, gw, NGW, lane, wave); }
    SEAM(0);
    if (IN(1)) {
        pg8::DenseOrder S; S.init(ws + WS_XB, ws + WS_WIN, T, INW, G, bx);
        pg8::EpiU E{(bf16*)(ws + WS_QB), (bf16*)(ws + WS_KB), (bf16*)(ws + WS_VT), (bf16*)(ws + WS_AB), (bf16*)(ws + WS_GATES), (const float*)(ws + WS_BPERM)};
        const int slot = vcu & 3;
        S.i0 = 0; S.i1 = slot;
        pg8::gemm_phase<pg8::EpiU, pg8::DenseOrder>(lds, S, E);
        { FRESH_LANE; side_convert(args, bx, G, wave, lane); }
        S.i0 = slot; S.i1 = 1 << 20;
        pg8::gemm_phase<pg8::EpiU, pg8::DenseOrder>(lds, S, E);
    }
    SEAM(1);
    if (IN(2)) {
        FRESH_LANE;
        __syncthreads();
        for (int i = tid; i < CW * CCH / 4; i += 512) ((LAS f32x4*)(lds + CONV_W_OFF))[i] = ((const f32x4*)args.in[I_CONVW])[i];
        __syncthreads();
        for (int u = vcu; u < 256 + 512; u += G) {
            if (u < 256) attn_unit(args, u, lds, tid, wave, lane);
            else conv_unit(args, u - 256, lds, tid, wave, lane);
        }
    }
    SEAM(2);
    if (IN(3)) {
        pg8::DenseOrder S; S.init(ws + WS_AY, ws + WS_WAB, T, D, G, bx);
        pg8::EpiMerged E{(const bf16*)(ws + WS_GATES), args.in[I_BCONV], (bf16*)(ws + WS_MERGED)};
        pg8::gemm_phase<pg8::EpiMerged, pg8::DenseOrder>(lds, S, E);
    }
    SEAM(3);
    if (IN(4)) {
        pg8::DenseOrder S; S.init(ws + WS_MERGED, ws + WS_WO, T, D, G, bx);
        pg8::EpiPre1 E{(const bf16*)(ws + WS_XB), (bf16*)(ws + WS_HF)};
        pg8::gemm_phase<pg8::EpiPre1, pg8::DenseOrder>(lds, S, E);
    }
    SEAM(4);
    if (IN(5)) {
        FRESH_LANE;
        __syncthreads();
        float bw[64]; f32x4 g1[4], b1[4];
#pragma unroll
        for (int s_ = 0; s_ < 64; ++s_) bw[s_] = args.in[I_WR][(size_t)(128 * wave + 2 * s_ + (lane >> 5)) * NE + (lane & 31)];
#pragma unroll
        for (int j = 0; j < 4; ++j) { g1[j] = *((const f32x4*)args.in[I_LN1G] + lane + 64 * j); b1[j] = *((const f32x4*)args.in[I_LN1B] + lane + 64 * j); }
        for (int c = vcu; c < T / 32; c += G) route_chunk(args, c, lds, tid, wave, lane, bw, g1, b1);
    }
    SEAM(5);
    if (IN(6) || IN(7)) {
        LAS int* tab = (LAS int*)(lds + MISC_OFF + MO_TAB);
        __syncthreads();
        if (tid == 0) { const unsigned* cursor = (const unsigned*)(ws + WS_CTL); int acc = 0;
            for (int e = 0; e < NE; ++e) { const int c = (int)__hip_atomic_load(cursor + e, __ATOMIC_RELAXED, __HIP_MEMORY_SCOPE_AGENT); tab[e] = c; const int ml = (c + 255) >> 8; tab[32 + e] = ml; tab[64 + e] = acc; acc += ml; }
            tab[64 + NE] = acc; }
        __syncthreads();
        const int total_mt = tab[64 + NE];
        if (IN(6)) {
            unsigned* ctl = (unsigned*)(ws + WS_CTL);
            pg8::MoeFusedOrder S{tab, G, vcu, total_mt * 8, total_mt * 4, (const char*)(ws + WS_HB), (const char*)(ws + WS_ACT), (const char*)(ws + WS_WUP), (const char*)(ws + WS_WDN), (const int*)(ws + WS_SLOT), ctl + 8192, ctl + 64};
            pg8::EpiMoe E{pg8::EpiUpX{args.in[I_BUP], ws + WS_ACT}, pg8::EpiDown{args.in[I_BDN], (const int*)(ws + WS_SLOT), ws + WS_YS}};
            pg8::gemm_phase<pg8::EpiMoe, pg8::MoeFusedOrder, true>(lds, S, E);
        }
    }
    SEAM(7);
    if (IN(8)) { FRESH_LANE; for (int m = gw; m < T; m += NGW) combine_row(args, m, lane); }

#undef IN
#undef SEAM
#undef FRESH_LANE
}

extern "C" void kernel_launch(void* const* d_in, const int* in_sizes, int n_in, void* d_out, int out_size, void* d_ws, size_t ws_size, hipStream_t stream) {
    static int grid = 0;
    if (grid == 0) {
        if (n_in != 22 || out_size != T * D || ws_size < WS_END) { fprintf(stderr, "kernel_launch: unexpected problem (n_in %d, out %d, ws %zu)\n", n_in, out_size, ws_size); grid = -1; return; }
        int dev = 0, cus = 0, per_cu = 0;
        hipGetDevice(&dev); hipDeviceGetAttribute(&cus, hipDeviceAttributeMultiprocessorCount, dev);
        hipFuncSetAttribute((const void*)fwd_megakernel, hipFuncAttributeMaxDynamicSharedMemorySize, LDS_BYTES);
        hipOccupancyMaxActiveBlocksPerMultiprocessor(&per_cu, (const void*)fwd_megakernel, 512, LDS_BYTES);
        if (per_cu < 1) { fprintf(stderr, "kernel_launch: occupancy query says %d blocks per CU\n", per_cu); per_cu = 1; }
        (void)hipGetLastError();
        grid = cus * 1;
        fprintf(stderr, "kernel_launch: grid %d (cus %d, occupancy %d)\n", grid, cus, per_cu);
    }
    if (grid < 0) return;
    hipMemsetAsync((char*)d_ws + WS_CTL, 0, 65536, stream);
    Args a{};
    for (int i = 0; i < 22; ++i) a.in[i] = (const float*)d_in[i];
    a.out = (float*)d_out; a.ws = (unsigned char*)d_ws; a.ph_lo = 0; a.ph_hi = 9;
    void* kargs[] = {&a};
    hipError_t e = hipLaunchCooperativeKernel((const void*)fwd_megakernel, dim3(grid), dim3(512), kargs, LDS_BYTES, stream);
    if (e != hipSuccess) fprintf(stderr, "cooperative launch failed: %s (grid %d)\n", hipGetErrorString(e), grid);
}
```

```cpp
#include <hip/hip_runtime.h>
#include <cstdio>
#include <cstdint>

#define GAS __attribute__((address_space(1)))
#define LAS __attribute__((address_space(3)))
typedef unsigned short bf16;
typedef short bf16x8 __attribute__((ext_vector_type(8)));
typedef float f32x4 __attribute__((ext_vector_type(4)));
typedef float f32x2 __attribute__((ext_vector_type(2)));
typedef float f32x16 __attribute__((ext_vector_type(16)));
typedef unsigned u32x4 __attribute__((ext_vector_type(4)));
typedef unsigned u32x2 __attribute__((ext_vector_type(2)));

constexpr int T = 16384, D = 1024, SEQ = 4096, NBATCH = 4;
constexpr int NH = 8, NKV = 2, HD = 64, AW = 512, KVW = 128, CCH = 512, CW = 31;
constexpr int INW = 3840, NE = 32, TOPK = 4, DE = 1024;
constexpr float LN_EPS = 1e-5f;
constexpr float DN_ALPHA = 1.189207115002721f;
constexpr int SLOT_CAP = 16384;
constexpr int MAX_MT = (T * TOPK) / 256 + NE;

constexpr size_t MiB = 1u << 20;
constexpr size_t WS_CTL = 0, CTL_BYTES = 65536;
constexpr int CW_BAR = 4096;
constexpr size_t WS_WIN = 1 * MiB;
constexpr size_t WS_WAB = 9 * MiB;
constexpr size_t WS_WO = 11 * MiB;
constexpr size_t WS_BPERM = 13 * MiB;
constexpr size_t WS_SLOT = 14 * MiB;
constexpr size_t WS_GATE = 16 * MiB;
constexpr size_t WS_LN1S = 17 * MiB;
constexpr size_t WS_WUP = 32 * MiB;
constexpr size_t WS_WDN = 160 * MiB;
constexpr size_t WS_XB = 224 * MiB;
constexpr size_t WS_QB = 256 * MiB;
constexpr size_t WS_KB = 272 * MiB;
constexpr size_t WS_VT = 276 * MiB;
constexpr size_t WS_AB = 792 * MiB;
constexpr size_t WS_GATES = 296 * MiB;
constexpr size_t WS_AY = 360 * MiB;
constexpr size_t WS_MERGED = 392 * MiB;
constexpr size_t WS_HF = 424 * MiB;
constexpr size_t WS_HB = 488 * MiB;
constexpr size_t WS_ACT = 520 * MiB;
constexpr size_t WS_YS = 664 * MiB;
constexpr size_t WS_END = 810 * MiB;
constexpr int AB_PAD = 32, AB_SEQ = SEQ + AB_PAD;

constexpr int LDS_SCR = 135168;
constexpr int MISC_OFF = 135168;
constexpr int MO_LG = 0, MO_SELE = 4224, MO_SELG = 4736, MO_LCNT = 5248, MO_LBASE = 5376, MO_TAB = 5504, MO_BAR = 6016;
constexpr int OFFN_OFF = 147456;
constexpr int LDS_BYTES = 155648;

#define LDS_WAIT() asm volatile("s_waitcnt lgkmcnt(0)" ::: "memory")
#define VM_WAIT() asm volatile("s_waitcnt vmcnt(0)" ::: "memory")

__device__ __forceinline__ unsigned f2bf(float f) { unsigned u = __builtin_bit_cast(unsigned, f); return (u + 0x7fffu + ((u >> 16) & 1u)) >> 16; }
__device__ __forceinline__ unsigned pk2(float lo, float hi) { return f2bf(lo) | (f2bf(hi) << 16); }
__device__ __forceinline__ float bf2f(unsigned b) { return __builtin_bit_cast(float, b << 16); }
__device__ __forceinline__ float bflo(unsigned w) { return __builtin_bit_cast(float, w << 16); }
__device__ __forceinline__ float bfhi(unsigned w) { return __builtin_bit_cast(float, w & 0xffff0000u); }
typedef __bf16 bf16x2_t __attribute__((ext_vector_type(2)));
__device__ __forceinline__ unsigned cvt_pk_bf16(float lo, float hi) { const f32x2 v = {lo, hi}; return __builtin_bit_cast(unsigned, __builtin_convertvector(v, bf16x2_t)); }
__device__ __forceinline__ float sigmoidf_(float x) { return __builtin_amdgcn_rcpf(1.0f + __expf(-x)); }
#define DPP_ADD(v, ctrl) ((v) + __builtin_bit_cast(float, __builtin_amdgcn_update_dpp(0, __builtin_bit_cast(int, (v)), (ctrl), 0xf, 0xf, true)))
__device__ __forceinline__ float wave_sum(float v) {
    v = DPP_ADD(v, 0xB1);
    v = DPP_ADD(v, 0x4E);
    v = DPP_ADD(v, 0x141);
    v = DPP_ADD(v, 0x140);
    const int vi = __builtin_bit_cast(int, v);
    const float r0 = __builtin_bit_cast(float, __builtin_amdgcn_readlane(vi, 0)), r1 = __builtin_bit_cast(float, __builtin_amdgcn_readlane(vi, 16));
    const float r2 = __builtin_bit_cast(float, __builtin_amdgcn_readlane(vi, 32)), r3 = __builtin_bit_cast(float, __builtin_amdgcn_readlane(vi, 48));
    return (r0 + r1) + (r2 + r3);
}
template <class V> __device__ __forceinline__ V ldgo(const void* base, unsigned off) { return *(const V*)((const char*)base + off); }
#define PIN10(a) asm volatile("" : "+v"((a)[0]), "+v"((a)[1]), "+v"((a)[2]), "+v"((a)[3]), "+v"((a)[4]), "+v"((a)[5]), "+v"((a)[6]), "+v"((a)[7]), "+v"((a)[8]), "+v"((a)[9]))

struct Args { const float* in[22]; float* out; unsigned char* ws; int ph_lo, ph_hi; };
enum { I_X = 0, I_WIN, I_BIN, I_SINK, I_WATT, I_CONVW, I_CONVB, I_CLNG, I_CLNB, I_WCONV, I_BCONV, I_WO, I_LN1G, I_LN1B, I_WR, I_BR, I_WUP, I_BUP, I_WDN, I_BDN, I_LN2G, I_LN2B };
constexpr int CVI_UP = NE * 64, CVI_DN = NE * 32, CVI_ITEMS = CVI_UP + CVI_DN;
__device__ __forceinline__ void cvi_decode(const Args& a, int it, const float*& src, unsigned char*& dst, int& nw) {
    if (it < CVI_UP) { const int e = it >> 6, kg = it & 63; nw = 2048; src = a.in[I_WUP] + ((size_t)e * 1024 + 16 * kg) * 2048; dst = a.ws + WS_WUP + (size_t)e * 2048 * 1024 + (size_t)kg * 2048 * 16; }
    else { const int r = it - CVI_UP, e = r >> 5, kg2 = r & 31; nw = 1024; src = a.in[I_WDN] + ((size_t)e * 1024 + 32 * kg2) * 1024; dst = a.ws + WS_WDN + (size_t)e * 1024 * 1024 + (size_t)kg2 * 2 * 1024 * 16; }
}
__device__ __forceinline__ void cvi_slice_ptrs(const Args& a, int it, int wave, int lane, const float*& sp, unsigned& pitch, unsigned char*& dp) {
    const float* src; unsigned char* dst; int nw; cvi_decode(a, it, src, dst, nw);
    const int g = nw == 2048 ? 0 : (wave >> 2), cw = nw == 2048 ? wave : (wave & 3);
    sp = src + (size_t)(16 * g) * nw + 256 * cw + 4 * lane; pitch = (unsigned)nw;
    dp = dst + ((size_t)g * nw + 256 * cw + 4 * lane) * 16;
}
__device__ __forceinline__ void cvi_slice_load(const float* sp, unsigned pitch, f32x4 (&r)[16]) {
#pragma unroll
    for (int kk = 0; kk < 16; ++kk) r[kk] = __builtin_nontemporal_load((const f32x4*)(sp + (size_t)kk * pitch));
}
__device__ __forceinline__ void cvi_slice_out(unsigned char* dp, f32x4 (&r)[16]) {
    asm volatile("" : "+v"(r[0]), "+v"(r[1]), "+v"(r[2]), "+v"(r[3]), "+v"(r[4]), "+v"(r[5]), "+v"(r[6]), "+v"(r[7]), "+v"(r[8]), "+v"(r[9]), "+v"(r[10]), "+v"(r[11]), "+v"(r[12]), "+v"(r[13]), "+v"(r[14]), "+v"(r[15]));
#pragma unroll
    for (int j = 0; j < 4; ++j) { unsigned w[4];
#pragma unroll
        for (int c = 0; c < 4; ++c) { unsigned x = 0u; x = __builtin_amdgcn_cvt_pk_fp8_f32(r[4 * c][j] * 64.0f, r[4 * c + 1][j] * 64.0f, x, false);
            x = __builtin_amdgcn_cvt_pk_fp8_f32(r[4 * c + 2][j] * 64.0f, r[4 * c + 3][j] * 64.0f, x, true); w[c] = x; }
        *(u32x4*)(dp + 16 * j) = (u32x4){w[0], w[1], w[2], w[3]}; }
}
__device__ __forceinline__ void side_convert(const Args& a, int bx, int G, int wave, int lane) {
    int base, nit;
    if (G == 256) { base = bx < 192 ? 11 * bx : 2112 + 15 * (bx - 192); nit = bx < 192 ? 11 : 15; }
    else { const int per = (CVI_ITEMS + G - 1) / G; base = bx * per; nit = base >= CVI_ITEMS ? 0 : (CVI_ITEMS - base < per ? CVI_ITEMS - base : per); }
    const int end = base + nit;
    f32x4 r0[16], r1[16];
    const float* sp0; const float* sp1; unsigned p0 = 0, p1 = 0; unsigned char* d0; unsigned char* d1;
    if (nit > 0) { cvi_slice_ptrs(a, base, wave, lane, sp0, p0, d0); cvi_slice_load(sp0, p0, r0); }
    if (nit > 1) { cvi_slice_ptrs(a, base + 1, wave, lane, sp1, p1, d1); cvi_slice_load(sp1, p1, r1); }
#pragma unroll 1
    for (int it0 = base; it0 < end; it0 += 2) {
        const int it1 = it0 + 1;
        { unsigned char* dcur = d0; cvi_slice_out(dcur, r0); if (it0 + 2 < end) { cvi_slice_ptrs(a, it0 + 2, wave, lane, sp0, p0, d0); cvi_slice_load(sp0, p0, r0); } }
        if (it1 >= end) break;
        { unsigned char* dcur = d1; cvi_slice_out(dcur, r1); if (it1 + 2 < end) { cvi_slice_ptrs(a, it1 + 2, wave, lane, sp1, p1, d1); cvi_slice_load(sp1, p1, r1); } }
    }
}

namespace pg8 {
constexpr int BM = 256, BK = 64, HALF = 128, HTB = HALF * BK * 2, STAGE_BYTES = 8 * HTB, NXCD = 8, WGM = 8;
constexpr int KD = 1024, NT_K = KD / BK;
__host__ __device__ __forceinline__ int lds_byte(int r, int c) { const int st = (r >> 4) * 2 + (c >> 5), rr = r & 15, cc = c & 31, ob = rr * 64 + cc * 2; return st * 1024 + (ob ^ (((ob >> 9) & 1) << 5)); }
__host__ __device__ __forceinline__ void stage_rc(int b, int& R, int& C) { const int st = b / 1024, sb = b % 1024, swz = sb ^ (((sb >> 9) & 1) << 5); R = (st >> 1) * 16 + swz / 64; C = (st & 1) * 32 + (swz % 64) / 2; }
__host__ __device__ __forceinline__ int perm32(int rho) { const int n = rho >> 4, i = rho & 15; return 8 * (i >> 2) + 4 * n + (i & 3); }

struct Unit { const char* A; const char* B; int pm, pn, e, mt, cnt, type; };

struct DenseOrder {
    const char* Ab; const char* Bb; int nM, nN, nwg, G, c, i0 = 0, i1 = 1 << 20; static constexpr int rowb = KD * 2; static constexpr bool PARK = false, FUSED = false;
    __device__ __forceinline__ unsigned boff(int Rb, int C) const { return (unsigned)(Rb * rowb + C * 2); }
    __device__ __forceinline__ size_t bstep_k() const { return 128; }
    __device__ __forceinline__ size_t bstep_h() const { return (size_t)HALF * rowb; }
    __device__ void init(const void* A, const void* B, int M, int N, int G_, int c_) { Ab = (const char*)A; Bb = (const char*)B; nM = M / BM; nN = N / BM; nwg = nM * nN; G = G_; c = c_; }
    __device__ __forceinline__ bool next(int i, Unit& u) const {
        if (i + i0 >= i1) return false;
        const long L = (long)(i + i0) * G + c; if (L >= nwg) return false;
        int wgid = (int)L; { const int q = nwg / NXCD, r = nwg % NXCD, xcd = wgid % NXCD, off = wgid / NXCD; wgid = (xcd < r ? xcd * (q + 1) : r * (q + 1) + (xcd - r) * q) + off; }
        const int nig = WGM * nN, gid = wgid / nig, fm = gid * WGM, gsz = (nM - fm) < WGM ? (nM - fm) : WGM;
        u.pm = fm + ((wgid % nig) % gsz); u.pn = (wgid % nig) / gsz; u.e = 0; u.mt = 0; u.cnt = 0; u.type = 0;
        u.A = Ab + (size_t)u.pm * (BM * KD * 2); u.B = Bb + (size_t)u.pn * (BM * KD * 2); return true;
    }
    __device__ __forceinline__ void offsets(const Unit&, const int (&R)[2], const int (&C)[2], unsigned (&off)[2][2]) const {
#pragma unroll
        for (int h = 0; h < 2; ++h)
#pragma unroll
            for (int i = 0; i < 2; ++i) off[h][i] = (unsigned)(((h * HALF + R[i]) * KD + C[i]) * 2);
    }
};
struct MoeOrder {
    const LAS int* tab; int NTN, G, c, total; const char* Ab; const char* Bb; size_t bexp; const int* slot; bool gather; int rowb;
    static constexpr bool PARK = true, FUSED = false;
    int bn16;
    __device__ __forceinline__ unsigned boff(int Rb, int C) const { return (unsigned)((C >> 3) * bn16 + Rb * 16); }
    __device__ __forceinline__ size_t bstep_k() const { return (size_t)8 * bn16; }
    __device__ __forceinline__ size_t bstep_h() const { return (size_t)HALF * 16; }
    __device__ __forceinline__ bool next(int i, Unit& u) const {
        const int L = i * G + c; if (L >= total) return false;
        int e = 0;
        for (int j = 1; j < NE; ++j) e += (L >= NTN * tab[64 + j]) ? 1 : 0;
        e = __builtin_amdgcn_readfirstlane(e);
        const int ms = __builtin_amdgcn_readfirstlane(tab[64 + e]), ml = __builtin_amdgcn_readfirstlane(tab[32 + e]);
        const int r = L - NTN * ms; const int nt = r / ml, mt = r - nt * ml;
        u.e = e; u.mt = mt; u.cnt = __builtin_amdgcn_readfirstlane(tab[e]); u.pm = ms + mt; u.pn = nt; u.type = 0;
        u.A = gather ? Ab : Ab + (size_t)u.pm * (size_t)(BM * rowb);
        u.B = Bb + (size_t)e * bexp + (size_t)nt * (size_t)(BM * 16); return true;
    }
    __device__ __forceinline__ void offsets(const Unit& u, const int (&R)[2], const int (&C)[2], unsigned (&off)[2][2]) const {
#pragma unroll
        for (int h = 0; h < 2; ++h)
#pragma unroll
            for (int i = 0; i < 2; ++i) {
                if (gather) { const int idx = u.mt * BM + h * HALF + R[i]; const int idc = idx < u.cnt ? idx : u.cnt - 1; int tok = slot[u.e * SLOT_CAP + idc] >> 2; tok = idx < u.cnt ? tok : 0; off[h][i] = (unsigned)(tok * rowb + C[i] * 2); }
                else off[h][i] = (unsigned)((h * HALF + R[i]) * rowb + C[i] * 2);
            }
    }
};


#define GAS_U32 __attribute__((address_space(1))) unsigned
struct MoeFusedOrder {
    const LAS int* tab; int G, c, total6, total7; const char* hb; const char* act; const char* wup; const char* wdn; const int* slot; unsigned* cnt; unsigned* tmo;
    static constexpr bool PARK = true, FUSED = true; static constexpr int rowb = 1024;
    __device__ __forceinline__ unsigned boff_t(int type, int R, int C) const {
        const int rs = 64 * (R >> 5) + 32 * ((R >> 2) & 1) + 16 * ((R >> 3) & 1) + 4 * ((R >> 4) & 1) + (R & 3);
        return (unsigned)((C >> 3) * ((type ? 1024 : 2048) * 16) + rs * 16); }
    __device__ __forceinline__ unsigned boff(int R, int C) const { return boff_t(0, R, C); }
    __device__ __forceinline__ size_t bstep_kt(int type) const { return (size_t)8 * (type ? 1024 * 16 : 2048 * 16); }
    __device__ __forceinline__ size_t bstep_ht(int) const { return (size_t)8 * 16; }
    __device__ __forceinline__ size_t bstep_k() const { return bstep_kt(0); }
    __device__ __forceinline__ size_t bstep_h() const { return bstep_ht(0); }
    __device__ __forceinline__ bool next(int i, Unit& u) const {
        int L = i * G + c; if (L >= total6 + total7) return false;
        const int type = L >= total6 ? 1 : 0; L -= type ? total6 : 0; const int NTN = type ? 4 : 8;
        int e = 0;
        for (int j = 1; j < NE; ++j) e += (L >= NTN * tab[64 + j]) ? 1 : 0;
        e = __builtin_amdgcn_readfirstlane(e);
        const int ms = __builtin_amdgcn_readfirstlane(tab[64 + e]), ml = __builtin_amdgcn_readfirstlane(tab[32 + e]);
        const int r = L - NTN * ms; const int nt = r / ml, mt = r - nt * ml;
        u.e = e; u.mt = mt; u.cnt = __builtin_amdgcn_readfirstlane(tab[e]); u.pm = ms + mt; u.pn = nt; u.type = type;
        u.A = type ? act + (size_t)u.pm * (size_t)(BM * rowb) : hb;
        u.B = (type ? wdn + (size_t)e * 1024 * 1024 : wup + (size_t)e * 2048 * 1024) + (size_t)nt * (size_t)(BM * 16); return true;
    }
    __device__ __forceinline__ void offsets(const Unit& u, const int (&R)[2], const int (&C)[2], unsigned (&off)[2][2]) const {
        if (u.type == 0) { int tok[2][2];
#pragma unroll
            for (int h = 0; h < 2; ++h)
#pragma unroll
                for (int i = 0; i < 2; ++i) { const int idx = u.mt * BM + h * HALF + R[i]; tok[h][i] = slot[u.e * SLOT_CAP + (idx < u.cnt ? idx : u.cnt - 1)]; }
#pragma unroll
            for (int h = 0; h < 2; ++h)
#pragma unroll
                for (int i = 0; i < 2; ++i) { const int idx = u.mt * BM + h * HALF + R[i]; const int t = idx < u.cnt ? (tok[h][i] >> 2) : 0; off[h][i] = (unsigned)(t * rowb + C[i] * 2); }
        } else {
#pragma unroll
            for (int h = 0; h < 2; ++h)
#pragma unroll
                for (int i = 0; i < 2; ++i) off[h][i] = (unsigned)((h * HALF + R[i]) * rowb + C[i] * 2);
        }
    }
    __device__ __forceinline__ void a_ready(const Unit& u) const {
        if (u.type) {
            if (threadIdx.x < 64) { const unsigned* p = cnt + 16 * u.pm; unsigned v, spins = 0u;
                for (;;) { asm volatile("global_load_dword %0, %1, off sc1\n\ts_waitcnt vmcnt(0)" : "=&v"(v) : "v"(p) : "memory");
                    if ((unsigned)__builtin_amdgcn_readfirstlane(v) >= 64u) break;
                    __builtin_amdgcn_s_sleep(2);
                    if (++spins > (1u << 20)) { if (threadIdx.x == 0) __hip_atomic_store(tmo, 1u, __ATOMIC_RELAXED, __HIP_MEMORY_SCOPE_AGENT); break; } }
                }
            asm volatile("" ::: "memory"); __builtin_amdgcn_s_barrier(); asm volatile("" ::: "memory");
        }
    }
    __device__ __forceinline__ void done(const Unit& u) const {
        if (u.type == 0) { asm volatile("s_waitcnt vmcnt(0)" ::: "memory");
            if ((threadIdx.x & 63) == 0) __hip_atomic_fetch_add(cnt + 16 * u.pm, 1u, __ATOMIC_RELAXED, __HIP_MEMORY_SCOPE_AGENT); }
    }
};

typedef f32x4 Acc[2][2][4][2];

typedef int i32x8 __attribute__((ext_vector_type(8)));
struct u32x4x2 { u32x4 a, b; };
template <class Epi, class Sched, bool FP8 = false>
__device__ __forceinline__ void gemm_phase(LAS unsigned char* lds, const Sched& S, const Epi& E) {
    const int tid = threadIdx.x, wid = __builtin_amdgcn_readfirstlane(tid >> 6), lane = tid & 63, wr = wid >> 2, wc = wid & 3, fr = lane & 15, fq = lane >> 4;
    constexpr int ROWB = FP8 ? KD : KD * 2, nt = FP8 ? KD / 128 : NT_K;
    int sR[2], sC[2], sRb[2]; unsigned voffB[2];
#pragma unroll
    for (int i = 0; i < 2; ++i) { int R, C; stage_rc(tid * 16 + i * 8192, R, C); sR[i] = R; sC[i] = C; const int Rb = Epi::PERM ? ((R & ~31) + perm32(R & 31)) : R; sRb[i] = Rb; voffB[i] = S.boff(Rb, C); }
    constexpr size_t kstep = (size_t)(BK * 2);
    size_t kstepB = S.bstep_k(), kstepBn = kstepB, hstepB = S.bstep_h(), hstepBn = hstepB;
    const unsigned ldsw = (unsigned)wid * 1024u;
    const int aoff = lds_byte(wr * 64 + fr, fq * 8), boff = lds_byte(wc * 32 + fr, fq * 8);
    constexpr int KST = 1024;
#define PG8_SA(b, h) (((b) * 2 + (h)) * HTB)
#define PG8_SB(b, h) ((4 + (b) * 2 + (h)) * HTB)
#define PG8_STAGE(bufoff, gbase, voff) do { const char* _gb = (const char*)(gbase); asm volatile("" : "+s"(_gb));     \
        _Pragma("unroll") for (int _i = 0; _i < 2; ++_i) \
        __builtin_amdgcn_global_load_lds((const unsigned*)(_gb + (voff)[_i]), (LAS unsigned*)(lds + (bufoff) + ldsw + _i * 8192), 16, 0, 0); } while (0)
#define PG8_STAGE_A(bufoff, gbase, voff) do { const char* _gb = (const char*)(gbase); asm volatile("" : "+s"(_gb)); \
        _Pragma("unroll") for (int _i = 0; _i < 2; ++_i) \
        __builtin_amdgcn_global_load_lds((const unsigned*)(_gb + (voff)[_i]), (LAS unsigned*)(lds + (bufoff) + ldsw + _i * 8192), 16, 0, 0); } while (0)
#define PG8_LDA(dst, b, h) do { _Pragma("unroll") for (int m = 0; m < 4; ++m) _Pragma("unroll") for (int k = 0; k < 2; ++k) dst[m][k] = *(const LAS bf16x8*)(lds + PG8_SA(b, h) + aoff + m * 2048 + k * KST); } while (0)
#define PG8_LDB(dst, b, h) do { _Pragma("unroll") for (int n = 0; n < 2; ++n) _Pragma("unroll") for (int k = 0; k < 2; ++k) dst[n][k] = *(const LAS bf16x8*)(lds + PG8_SB(b, h) + boff + n * 2048 + k * KST); } while (0)
#define PG8_CAT(x) __builtin_bit_cast(i32x8, (u32x4x2){__builtin_bit_cast(u32x4, (x)[0]), __builtin_bit_cast(u32x4, (x)[1])})
#define PG8_MMA(ai, bj, At, Bt) do { __builtin_amdgcn_s_setprio(1); \
        if constexpr (FP8) { _Pragma("unroll") for (int m = 0; m < 4; ++m) _Pragma("unroll") for (int n = 0; n < 2; ++n) \
            acc[ai][bj][m][n] = __builtin_amdgcn_mfma_scale_f32_16x16x128_f8f6f4(PG8_CAT(Bt[n]), PG8_CAT(At[m]), acc[ai][bj][m][n], 0, 0, 0, Epi::SCALE_B, 0, Epi::SCALE_A); } \
        else { _Pragma("unroll") for (int m = 0; m < 4; ++m) _Pragma("unroll") for (int n = 0; n < 2; ++n) _Pragma("unroll") for (int k = 0; k < 2; ++k) \
            acc[ai][bj][m][n] = __builtin_amdgcn_mfma_f32_16x16x32_bf16(Bt[n][k], At[m][k], acc[ai][bj][m][n], 0, 0, 0); } \
        __builtin_amdgcn_s_setprio(0); } while (0)
#define PG8_WAIT_V(n) asm volatile("s_waitcnt vmcnt(" #n ")" ::: "memory")
#define PG8_WAIT_L(n) asm volatile("s_waitcnt lgkmcnt(" #n ")" ::: "memory")
#define PG8_BAR __builtin_amdgcn_s_barrier()
#define PG8_SCHED __builtin_amdgcn_sched_barrier(0)
    Unit cur, nxt; int ui = 0;
    if (!S.next(0, cur)) return;
    Acc acc;
    bf16x8 At[4][2], B0[2][2], B1[2][2];
    unsigned offA[2][2], offN[2][2];
    S.offsets(cur, sR, sC, offA);
    if constexpr (Sched::FUSED) { kstepB = S.bstep_kt(cur.type); hstepB = S.bstep_ht(cur.type);
#pragma unroll
        for (int i = 0; i < 2; ++i) voffB[i] = S.boff_t(cur.type, sR[i], sC[i]); }
    const char* cA = cur.A; const char* cB = cur.B;
    PG8_STAGE(PG8_SB(0, 0), cB, voffB); PG8_STAGE(PG8_SB(0, 1), cB + hstepB, voffB); PG8_STAGE_A(PG8_SA(0, 0), cA, offA[0]); PG8_STAGE_A(PG8_SA(0, 1), cA, offA[1]);
    if (wr == 1) PG8_BAR;
    PG8_WAIT_V(2); PG8_BAR;
    PG8_STAGE(PG8_SB(1, 0), cB + kstepB, voffB); PG8_STAGE_A(PG8_SA(1, 0), cA + kstep, offA[0]); PG8_STAGE(PG8_SB(1, 1), cB + hstepB + kstepB, voffB);
    PG8_WAIT_V(6); PG8_BAR;
    for (;;) {
#pragma unroll
        for (int a = 0; a < 2; ++a)
#pragma unroll
            for (int b = 0; b < 2; ++b)
#pragma unroll
                for (int m = 0; m < 4; ++m)
#pragma unroll
                    for (int n = 0; n < 2; ++n) acc[a][b][m][n] = (f32x4){0.f, 0.f, 0.f, 0.f};
        const bool has_next = S.next(ui + 1, nxt);
        const char* nA = has_next ? nxt.A : cA; const char* nB = has_next ? nxt.B : cB;
        if constexpr (Sched::FUSED) { kstepBn = has_next ? S.bstep_kt(nxt.type) : kstepB; hstepBn = has_next ? S.bstep_ht(nxt.type) : hstepB; }
        if (has_next) S.offsets(nxt, sR, sC, offN);
        else {
#pragma unroll
            for (int h = 0; h < 2; ++h)
#pragma unroll
                for (int i = 0; i < 2; ++i) offN[h][i] = offA[h][i];
        }
        if constexpr (Sched::PARK) *(LAS u32x4*)(lds + OFFN_OFF + tid * 16) = (u32x4){offN[0][0], offN[0][1], offN[1][0], offN[1][1]};
#pragma unroll 1
        for (int t = 0; t < nt; t += 2) {
            const bool last = (t == nt - 2);
            const char* a1 = cA + (size_t)(t + 1) * kstep;
            const char* a2 = last ? nA : cA + (size_t)(t + 2) * kstep; const char* b2 = last ? nB : cB + (size_t)(t + 2) * kstepB;
            const char* a3 = a2 + kstep; const char* b3 = b2 + (last ? kstepBn : kstepB); const size_t hB = last ? hstepBn : hstepB;
            if constexpr (Sched::FUSED) { if (last && has_next) S.a_ready(nxt); }
            if constexpr (Epi::MID_T > 0) { if (t == Epi::MID_T) E.mid(acc, cur, wr, wc, fr, fq); }
            PG8_LDB(B0, 0, 0); PG8_LDB(B1, 0, 1); PG8_SCHED; PG8_LDA(At, 0, 0); PG8_STAGE_A(PG8_SA(1, 1), a1, offA[1]);
            PG8_WAIT_V(8); PG8_WAIT_L(0); PG8_BAR; PG8_MMA(0, 0, At, B0); PG8_MMA(0, 1, At, B1);
            asm volatile("" : "+v"(acc[0][0][0][0]), "+v"(acc[0][0][0][1]), "+v"(acc[0][0][1][0]), "+v"(acc[0][0][1][1]), "+v"(acc[0][0][2][0]), "+v"(acc[0][0][2][1]), "+v"(acc[0][0][3][0]), "+v"(acc[0][0][3][1]));
            asm volatile("" : "+v"(acc[0][1][0][0]), "+v"(acc[0][1][0][1]), "+v"(acc[0][1][1][0]), "+v"(acc[0][1][1][1]), "+v"(acc[0][1][2][0]), "+v"(acc[0][1][2][1]), "+v"(acc[0][1][3][0]), "+v"(acc[0][1][3][1]));
            PG8_BAR; PG8_SCHED;
            if (last) {
                if constexpr (Sched::FUSED) { if (has_next) {
#pragma unroll
                    for (int i = 0; i < 2; ++i) voffB[i] = S.boff_t(nxt.type, sR[i], sC[i]); } }
                if constexpr (Sched::PARK) { const u32x4 pk = *(const LAS u32x4*)(lds + OFFN_OFF + tid * 16); offA[0][0] = pk.x; offA[0][1] = pk.y; offA[1][0] = pk.z; offA[1][1] = pk.w; }
                else {
#pragma unroll
                    for (int h = 0; h < 2; ++h)
#pragma unroll
                        for (int i = 0; i < 2; ++i) offA[h][i] = offN[h][i];
                }
            }
            PG8_LDA(At, 0, 1); PG8_STAGE(PG8_SB(0, 0), b2, voffB); PG8_STAGE(PG8_SB(0, 1), b2 + hB, voffB); PG8_STAGE_A(PG8_SA(0, 0), a2, offA[0]);
            PG8_WAIT_V(8); PG8_WAIT_L(0); PG8_BAR; PG8_MMA(1, 0, At, B0); PG8_MMA(1, 1, At, B1); PG8_BAR; PG8_SCHED;
            PG8_LDB(B0, 1, 0); PG8_LDB(B1, 1, 1); PG8_SCHED; PG8_LDA(At, 1, 0); PG8_STAGE_A(PG8_SA(0, 1), a2, offA[1]);
            PG8_WAIT_V(8); PG8_WAIT_L(0); PG8_BAR; PG8_MMA(0, 0, At, B0); PG8_MMA(0, 1, At, B1); PG8_BAR; PG8_SCHED;
            PG8_LDA(At, 1, 1); PG8_STAGE(PG8_SB(1, 0), b3, voffB); PG8_STAGE(PG8_SB(1, 1), b3 + hB, voffB); PG8_STAGE_A(PG8_SA(1, 0), a3, offA[0]);
            PG8_WAIT_V(8); PG8_WAIT_L(0); PG8_BAR; PG8_MMA(1, 0, At, B0); PG8_MMA(1, 1, At, B1); PG8_BAR; PG8_SCHED;
        }
        if (wr == 0) PG8_BAR;
        E(acc, cur, wr, wc, fr, fq);
        if constexpr (Sched::FUSED) S.done(cur);
        __builtin_amdgcn_s_waitcnt(0x0F70);
        if (!has_next) break;
        cur = nxt; cA = nA; cB = nB; kstepB = kstepBn; hstepB = hstepBn; ++ui;
        if (wr == 1) PG8_BAR;
    }
    PG8_WAIT_V(0);
    PG8_BAR;
#undef PG8_SA
#undef PG8_SB
#undef PG8_STAGE
#undef PG8_STAGE_A
#undef PG8_LDA
#undef PG8_LDB
#undef PG8_MMA
#undef PG8_WAIT_V
#undef PG8_WAIT_L
#undef PG8_BAR
#undef PG8_SCHED
}

#define EPI_SEED(r, c) asm volatile("" : "+v"(r), "+v"(c))
template <class V> __device__ __forceinline__ V ldg(const void* base, unsigned off) { return *(const V*)((const char*)base + off); }
template <class V> __device__ __forceinline__ void stg(void* base, unsigned off, V v) { *(V*)((char*)base + off) = v; }
__device__ __forceinline__ u32x4 pack8(const f32x4 v0, const f32x4 v1) { u32x4 w; w.x = cvt_pk_bf16(v0[0], v0[1]); w.y = cvt_pk_bf16(v0[2], v0[3]); w.z = cvt_pk_bf16(v1[0], v1[1]); w.w = cvt_pk_bf16(v1[2], v1[3]); return w; }

struct EpiU {
    static constexpr int SCALE_B = 0, SCALE_A = 0;
    static constexpr bool PERM = true; static constexpr int MID_T = 0;
    bf16 *q, *k, *vT, *ab, *gates; const float* bias;
    __device__ __forceinline__ void mid(Acc&, const Unit&, int, int, int, int) const {}
    __device__ __forceinline__ void operator()(const Acc& acc, const Unit& u, int wr, int wc, int fr, int fq) const {
        int rl = wr * 64 + fr, cl = wc * 32 + 8 * fq; EPI_SEED(rl, cl);
        const int row0 = u.pm * BM + rl, pn = u.pn;
        f32x4 bv[2][2];
#pragma unroll
        for (int bj = 0; bj < 2; ++bj)
#pragma unroll
            for (int n = 0; n < 2; ++n) bv[bj][n] = ldg<f32x4>(bias, (unsigned)(pn * BM + bj * HALF + cl + 4 * n) * 4u);
        if (pn < 2) {
            const unsigned o0 = ((unsigned)row0 * AW + pn * BM + cl) * 2u;
#pragma unroll
            for (int ai = 0; ai < 2; ++ai)
#pragma unroll
                for (int m = 0; m < 4; ++m)
#pragma unroll
                    for (int bj = 0; bj < 2; ++bj)
                        stg<u32x4>(q, o0 + (unsigned)((ai * HALF + m * 16) * AW + bj * HALF) * 2u, pack8((acc[ai][bj][m][0] + bv[bj][0]) * 0.125f, (acc[ai][bj][m][1] + bv[bj][1]) * 0.125f));
        } else if (pn == 2) {
            const unsigned o0 = ((unsigned)row0 * KVW + cl) * 2u;
            const int b = row0 >> 12, s0 = row0 & (SEQ - 1);
#pragma unroll
            for (int ai = 0; ai < 2; ++ai)
#pragma unroll
                for (int m = 0; m < 4; ++m) {
                    stg<u32x4>(k, o0 + (unsigned)((ai * HALF + m * 16) * KVW) * 2u, pack8(acc[ai][0][m][0] + bv[0][0], acc[ai][0][m][1] + bv[0][1]));
#pragma unroll
                    for (int n = 0; n < 2; ++n) { const f32x4 v = acc[ai][1][m][n] + bv[1][n];
#pragma unroll
                        for (int j = 0; j < 4; ++j) { const int col = cl + 4 * n + j, kvh = col >> 6, dim = col & 63;
                            stg<bf16>(vT, (unsigned)(((b * NKV + kvh) * HD + dim) * SEQ + s0 + ai * HALF + m * 16) * 2u, (bf16)f2bf(v[j])); } } }
        } else if (pn < 7) {
            const unsigned o0 = ((unsigned)(row0 + AB_PAD * ((row0 >> 12) + 1)) * CCH + (pn - 3) * HALF + cl) * 2u;
#pragma unroll
            for (int ai = 0; ai < 2; ++ai)
#pragma unroll
                for (int m = 0; m < 4; ++m) { f32x4 o[2];
#pragma unroll
                    for (int n = 0; n < 2; ++n) { const f32x4 a = acc[ai][0][m][n] + bv[0][n], g = acc[ai][1][m][n] + bv[1][n];
#pragma unroll
                        for (int j = 0; j < 4; ++j) o[n][j] = a[j] * sigmoidf_(g[j]); }
                    stg<u32x4>(ab, o0 + (unsigned)((ai * HALF + m * 16) * CCH) * 2u, pack8(o[0], o[1])); }
        } else {
            const unsigned o0 = ((unsigned)row0 * 2048 + (pn - 7) * HALF + cl) * 2u;
#pragma unroll
            for (int ai = 0; ai < 2; ++ai)
#pragma unroll
                for (int m = 0; m < 4; ++m) { f32x4 ra[2], gb[2];
#pragma unroll
                    for (int n = 0; n < 2; ++n) { const f32x4 va = acc[ai][0][m][n] + bv[0][n], vb = acc[ai][1][m][n] + bv[1][n];
#pragma unroll
                        for (int j = 0; j < 4; ++j) { const float sb = sigmoidf_(vb[j]); gb[n][j] = sb; ra[n][j] = sigmoidf_(va[j]) * __builtin_amdgcn_rcpf(sb); } }
                    stg<u32x4>(gates, o0 + (unsigned)((ai * HALF + m * 16) * 2048) * 2u, pack8(ra[0], ra[1]));
                    stg<u32x4>(gates, o0 + (unsigned)((ai * HALF + m * 16) * 2048 + 1024) * 2u, pack8(gb[0], gb[1])); }
        }
    }
};
struct EpiMerged {
    static constexpr int SCALE_B = 0, SCALE_A = 0;
    static constexpr bool PERM = true; static constexpr int MID_T = 8;
    const bf16* gates; const float* bc; bf16* merged;
    __device__ __forceinline__ void mid(Acc& acc, const Unit& u, int wr, int wc, int fr, int fq) const {
        int rl = wr * 64 + fr, cl = wc * 32 + 8 * fq; EPI_SEED(rl, cl);
        const unsigned g0 = ((unsigned)(u.pm * BM + rl) * 2048 + u.pn * BM + cl) * 2u;
#pragma unroll
        for (int ai = 0; ai < 2; ++ai) { u32x4 rt[4][2];
#pragma unroll
            for (int m = 0; m < 4; ++m)
#pragma unroll
                for (int bj = 0; bj < 2; ++bj) rt[m][bj] = ldg<u32x4>(gates, g0 + (unsigned)((ai * HALF + m * 16) * 2048 + bj * HALF) * 2u);
            __builtin_amdgcn_sched_barrier(0);
#pragma unroll
            for (int m = 0; m < 4; ++m)
#pragma unroll
                for (int bj = 0; bj < 2; ++bj)
#pragma unroll
                    for (int n = 0; n < 2; ++n) { acc[ai][bj][m][n][0] *= bflo(rt[m][bj][2 * n]); acc[ai][bj][m][n][1] *= bfhi(rt[m][bj][2 * n]); acc[ai][bj][m][n][2] *= bflo(rt[m][bj][2 * n + 1]); acc[ai][bj][m][n][3] *= bfhi(rt[m][bj][2 * n + 1]); }
            __builtin_amdgcn_sched_barrier(0); }
    }
    __device__ __forceinline__ void operator()(const Acc& acc, const Unit& u, int wr, int wc, int fr, int fq) const {
        int rl = wr * 64 + fr, cl = wc * 32 + 8 * fq; EPI_SEED(rl, cl);
        const int row0 = u.pm * BM + rl, col0 = u.pn * BM + cl;
        const unsigned g0 = ((unsigned)row0 * 2048 + 1024 + col0) * 2u, m0 = ((unsigned)row0 * D + col0) * 2u;
        f32x4 bv[2][2];
#pragma unroll
        for (int bj = 0; bj < 2; ++bj)
#pragma unroll
            for (int n = 0; n < 2; ++n) bv[bj][n] = ldg<f32x4>(bc, (unsigned)(col0 + bj * HALF + 4 * n) * 4u);
#pragma unroll
        for (int ai = 0; ai < 2; ++ai)
#pragma unroll
            for (int m = 0; m < 4; ++m) {
#pragma unroll
                for (int bj = 0; bj < 2; ++bj) { const u32x4 gb = ldg<u32x4>(gates, g0 + (unsigned)((ai * HALF + m * 16) * 2048 + bj * HALF) * 2u); f32x4 o[2];
#pragma unroll
                    for (int n = 0; n < 2; ++n) { const f32x4 v = acc[ai][bj][m][n] + bv[bj][n];
                        o[n][0] = v[0] * bflo(gb[2 * n]); o[n][1] = v[1] * bfhi(gb[2 * n]); o[n][2] = v[2] * bflo(gb[2 * n + 1]); o[n][3] = v[3] * bfhi(gb[2 * n + 1]); }
                    stg<u32x4>(merged, m0 + (unsigned)((ai * HALF + m * 16) * D + bj * HALF) * 2u, pack8(o[0], o[1])); }
                if (m & 1) asm volatile("" ::: "memory"); }
    }
};
struct EpiPre1 {
    static constexpr int SCALE_B = 0, SCALE_A = 0;
    static constexpr bool PERM = true; static constexpr int MID_T = 0;
    const bf16* xb; bf16* out;
    __device__ __forceinline__ void mid(Acc&, const Unit&, int, int, int, int) const {}
    __device__ __forceinline__ void operator()(const Acc& acc, const Unit& u, int wr, int wc, int fr, int fq) const {
        int rl = wr * 64 + fr, cl = wc * 32 + 8 * fq; EPI_SEED(rl, cl);
        const unsigned o0 = ((unsigned)(u.pm * BM + rl) * D + u.pn * BM + cl) * 2u;
        u32x4 xv[2][4][2];
#pragma unroll
        for (int ai = 0; ai < 2; ++ai)
#pragma unroll
            for (int m = 0; m < 4; ++m)
#pragma unroll
                for (int bj = 0; bj < 2; ++bj) xv[ai][m][bj] = ldg<u32x4>(xb, o0 + (unsigned)((ai * HALF + m * 16) * D + bj * HALF) * 2u);
        __builtin_amdgcn_sched_barrier(0);
#pragma unroll
        for (int ai = 0; ai < 2; ++ai)
#pragma unroll
            for (int m = 0; m < 4; ++m)
#pragma unroll
                for (int bj = 0; bj < 2; ++bj) { const u32x4 w = xv[ai][m][bj];
                    const f32x4 r0 = (f32x4){bflo(w.x), bfhi(w.x), bflo(w.y), bfhi(w.y)} * DN_ALPHA + acc[ai][bj][m][0], r1 = (f32x4){bflo(w.z), bfhi(w.z), bflo(w.w), bfhi(w.w)} * DN_ALPHA + acc[ai][bj][m][1];
                    stg<u32x4>(out, o0 + (unsigned)((ai * HALF + m * 16) * D + bj * HALF) * 2u, pack8(r0, r1)); }
    }
};
struct EpiUp {
    static constexpr bool PERM = true; static constexpr int MID_T = 0;
    static constexpr int SCALE_B = 0x79797979, SCALE_A = 0x7C7C7C7C;
    const float* b_up; unsigned char* act;
    __device__ __forceinline__ void mid(Acc&, const Unit&, int, int, int, int) const {}
    __device__ __forceinline__ void operator()(const Acc& acc, const Unit& u, int wr, int wc, int fr, int fq) const {
        int rl = wr * 64 + fr, cl = wc * 32 + 8 * fq; EPI_SEED(rl, cl);
        const unsigned o0 = (unsigned)(u.pm * BM + rl) * DE + u.pn * HALF + (cl >> 1);
        f32x4 bv[2][2];
#pragma unroll
        for (int bj = 0; bj < 2; ++bj)
#pragma unroll
            for (int n = 0; n < 2; ++n) bv[bj][n] = ldg<f32x4>(b_up, (unsigned)(u.e * 2048 + u.pn * BM + cl + bj * HALF + 4 * n) * 4u);
#pragma unroll
        for (int ai = 0; ai < 2; ++ai)
#pragma unroll
            for (int m = 0; m < 4; ++m)
#pragma unroll
                for (int bj = 0; bj < 2; ++bj) { float o[4];
#pragma unroll
                    for (int n = 0; n < 2; ++n) { const f32x4 v = acc[ai][bj][m][n] + bv[bj][n];
#pragma unroll
                        for (int p = 0; p < 2; ++p) { const float xg = fminf(v[2 * p], 7.0f), xl = fminf(fmaxf(v[2 * p + 1], -7.0f), 7.0f);
                            o[2 * n + p] = xg * sigmoidf_(1.702f * xg) * (xl + 1.0f); } }
                    unsigned w = 0u; w = __builtin_amdgcn_cvt_pk_fp8_f32(o[0] * 8.0f, o[1] * 8.0f, w, false); w = __builtin_amdgcn_cvt_pk_fp8_f32(o[2] * 8.0f, o[3] * 8.0f, w, true);
                    __hip_atomic_store((unsigned*)(act + (o0 + (unsigned)((ai * HALF + m * 16) * DE + bj * 64))), w, __ATOMIC_RELAXED, __HIP_MEMORY_SCOPE_AGENT); }
    }
};
struct EpiDown {
    static constexpr bool PERM = true; static constexpr int MID_T = 0;
    static constexpr int SCALE_B = 0x79797979, SCALE_A = 0x7C7C7C7C;
    const float* b_dn; const int* slot; unsigned char* ys;
    __device__ __forceinline__ void mid(Acc&, const Unit&, int, int, int, int) const {}
    __device__ __forceinline__ void operator()(const Acc& acc, const Unit& u, int wr, int wc, int fr, int fq) const {
        int rl = wr * 64 + fr, cb = 64 * wc + 32 * (fq & 1) + 16 * (fq >> 1); EPI_SEED(rl, cb);
        const int col0 = u.pn * BM + cb, idx0 = u.mt * BM + rl;
        f32x4 bv[2][2];
#pragma unroll
        for (int bj = 0; bj < 2; ++bj)
#pragma unroll
            for (int n = 0; n < 2; ++n) bv[bj][n] = ldg<f32x4>(b_dn, (unsigned)(u.e * D + col0 + 8 * bj + 4 * n) * 4u);
        int asg[2][4];
#pragma unroll
        for (int ai = 0; ai < 2; ++ai)
#pragma unroll
            for (int m = 0; m < 4; ++m) { const int idx = idx0 + ai * HALF + m * 16; asg[ai][m] = ldg<int>(slot, (unsigned)(u.e * SLOT_CAP + (idx < u.cnt ? idx : u.cnt - 1)) * 4u); }
#pragma unroll
        for (int ai = 0; ai < 2; ++ai)
#pragma unroll
            for (int m = 0; m < 4; ++m) { const int idx = idx0 + ai * HALF + m * 16;
                if (idx < u.cnt) { u32x4 w;
#pragma unroll
                    for (int bj = 0; bj < 2; ++bj)
#pragma unroll
                        for (int n = 0; n < 2; ++n) { const f32x4 v = (acc[ai][bj][m][n] + bv[bj][n]) * 16.0f;
                            unsigned x = __builtin_amdgcn_cvt_pk_fp8_f32(v[0], v[1], 0u, false); x = __builtin_amdgcn_cvt_pk_fp8_f32(v[2], v[3], x, true); w[2 * bj + n] = x; }
                    stg<u32x4>(ys, (unsigned)asg[ai][m] * D + col0, w); } }
    }
};
struct EpiUpX {
    const float* b_up; unsigned char* act;
    __device__ __forceinline__ void operator()(const Acc& acc, const Unit& u, int wr, int wc, int fr, int fq) const {
        int rl = wr * 64 + fr, cb = 64 * wc + 32 * (fq & 1) + 16 * (fq >> 1); EPI_SEED(rl, cb);
        f32x4 bv[2][2];
#pragma unroll
        for (int bj = 0; bj < 2; ++bj)
#pragma unroll
            for (int n = 0; n < 2; ++n) bv[bj][n] = ldg<f32x4>(b_up, (unsigned)(u.e * 2048 + u.pn * BM + cb + 8 * bj + 4 * n) * 4u);
        const __amdgpu_buffer_rsrc_t rs = __builtin_amdgcn_make_buffer_rsrc(act, 0, (MAX_MT * 256) * 1024, 0x00020000);
        const unsigned o0 = (unsigned)(u.pm * BM + rl + 16 * (fq >> 1)) * DE + u.pn * HALF + 32 * wc + 16 * (fq & 1);
#pragma unroll
        for (int ai = 0; ai < 2; ++ai)
#pragma unroll
            for (int j = 0; j < 2; ++j) { unsigned d[2][2];
#pragma unroll
                for (int mm = 0; mm < 2; ++mm)
#pragma unroll
                    for (int bj = 0; bj < 2; ++bj) { float o[4];
#pragma unroll
                        for (int n = 0; n < 2; ++n) { const f32x4 v = acc[ai][bj][2 * j + mm][n] + bv[bj][n];
#pragma unroll
                            for (int p = 0; p < 2; ++p) { const float xg = fminf(v[2 * p], 7.0f), xl = fminf(fmaxf(v[2 * p + 1], -7.0f), 7.0f);
                                o[2 * n + p] = (xg * __builtin_amdgcn_rcpf(1.0f + __builtin_amdgcn_exp2f(xg * (-1.702f * 1.44269504f)))) * __builtin_fmaf(xl, 8.0f, 8.0f); } }
                        unsigned w = 0u; w = __builtin_amdgcn_cvt_pk_fp8_f32(o[0], o[1], w, false); w = __builtin_amdgcn_cvt_pk_fp8_f32(o[2], o[3], w, true); d[mm][bj] = w; }
                const u32x2 s0 = __builtin_amdgcn_permlane32_swap(d[0][0], d[1][0], false, false), s1 = __builtin_amdgcn_permlane32_swap(d[0][1], d[1][1], false, false);
                const u32x4 w4 = (u32x4){s0.x, s1.x, s0.y, s1.y};
                __builtin_amdgcn_raw_buffer_store_b128(w4, rs, o0 + (unsigned)((ai * HALF + 32 * j) * DE), 0, 16); }
    }
};
struct EpiMoe {
    static constexpr bool PERM = true; static constexpr int MID_T = 0;
    static constexpr int SCALE_B = 0x79797979, SCALE_A = 0x7C7C7C7C;
    EpiUpX up; EpiDown dn;
    __device__ __forceinline__ void mid(Acc&, const Unit&, int, int, int, int) const {}
    __device__ __forceinline__ void operator()(const Acc& acc, const Unit& u, int wr, int wc, int fr, int fq) const { if (u.type == 0) up(acc, u, wr, wc, fr, fq); else dn(acc, u, wr, wc, fr, fq); }
};
}

#define XB_TMO      128
#define XB_XCNT(j)  (256  + 64 * (j))
#define XB_XSUB(j)  (1280 + 64 * (j))
#define XB_XGEN(j)  (2304 + 64 * (j))
#define XB_TOP      3328
#define XB_TOPGEN   3392
#define XCD_BAR_WORDS 3456
#define XB_SPIN_CAP (1u << 18)
__device__ __forceinline__ unsigned xb_ld(unsigned* p)              { return __hip_atomic_load(p, __ATOMIC_RELAXED, __HIP_MEMORY_SCOPE_AGENT); }
__device__ __forceinline__ unsigned xb_add(unsigned* p, unsigned v) { return __hip_atomic_fetch_add(p, v, __ATOMIC_RELAXED, __HIP_MEMORY_SCOPE_AGENT); }
__device__ __forceinline__ unsigned xb_xcc_id() { return (unsigned)__builtin_amdgcn_s_getreg((3 << 11) | 20) & 0xFu; }
#define XB_SPIN(cond, bar) do { unsigned _sp = 0; while (cond) { __builtin_amdgcn_s_sleep(1); \
    if ((++_sp & 255u) == 0u) { if (xb_ld(&(bar)[XB_TMO])) break; if (_sp > XB_SPIN_CAP) { atomicAdd(&(bar)[XB_TMO], 1u); break; } } } } while (0)
struct XcdBarrier { unsigned* bar; unsigned x; volatile LAS unsigned* st; };
__device__ __forceinline__ XcdBarrier xcd_barrier_post(unsigned* bar, volatile LAS unsigned* st) {
    XcdBarrier b; b.bar = bar; b.x = xb_xcc_id(); b.st = st;
    if (threadIdx.x == 0) (void)xb_add(&bar[XB_XCNT(b.x)], 1u);
    return b;
}
__device__ __forceinline__ void xcd_barrier_complete(unsigned* bar, unsigned x, unsigned& nloc, unsigned& nx) {
    const unsigned G = gridDim.x * gridDim.y * gridDim.z;
    unsigned sum, cnt, mine, sp = 0u;
    for (;;) {
        sum = 0u; cnt = 0u; mine = 0u;
#pragma unroll
        for (unsigned j = 0; j < 16; ++j) { const unsigned c = xb_ld(&bar[XB_XCNT(j)]); sum += c; cnt += (c > 0u) ? 1u : 0u; mine = (j == x) ? c : mine; }
        if (sum == G) break;
        __builtin_amdgcn_s_sleep(1);
        if ((++sp & 255u) == 0u) { if (xb_ld(&bar[XB_TMO])) break; if (sp > XB_SPIN_CAP) { atomicAdd(&bar[XB_TMO], 1u); break; } }
    }
    nloc = mine > 0u ? mine : 1u; nx = cnt > 0u ? cnt : 1u;
}
__device__ __forceinline__ void xcd_barrier(const XcdBarrier& b) {
    asm volatile("s_waitcnt vmcnt(0)" ::: "memory");
    __syncthreads();
    if (threadIdx.x == 64) asm volatile("buffer_inv sc1\n\ts_waitcnt vmcnt(0)" ::: "memory");
    if (threadIdx.x == 0) {
        unsigned* bar = b.bar;
        __builtin_amdgcn_s_waitcnt(0);
        unsigned nloc = b.st[0], nx = b.st[1];
        if (nloc == 0u) { xcd_barrier_complete(bar, b.x, nloc, nx); b.st[0] = nloc; b.st[1] = nx; }
        const unsigned old = xb_add(&bar[XB_XSUB(b.x)], 1u);
        const unsigned gen = old / nloc;
        if (old + 1u == (gen + 1u) * nloc) {
            __builtin_amdgcn_fence(__ATOMIC_RELEASE, "agent");
            asm volatile("s_waitcnt vmcnt(0)" ::: "memory");
            const unsigned og = xb_add(&bar[XB_TOP], 1u);
            const unsigned tg = og / nx;
            if (og + 1u == (tg + 1u) * nx) xb_add(&bar[XB_TOPGEN], 1u);
            else XB_SPIN(xb_ld(&bar[XB_TOPGEN]) == tg, bar);
            xb_add(&bar[XB_XGEN(b.x)], 1u);
            asm volatile("s_waitcnt vmcnt(0)" ::: "memory");
        } else {
            XB_SPIN(xb_ld(&bar[XB_XGEN(b.x)]) == gen, bar);
            asm volatile("s_waitcnt vmcnt(0)" ::: "memory");
        }
    }
    __syncthreads();
}


__device__ __forceinline__ void tr_item(const float* W, int ldw, int scol0, int srow0, bf16* WT, int Kd, int drow0, int dk0, LAS float* scr, int lane) {
#pragma unroll 8
    for (int i = 0; i < 32; ++i) { const int kk = 2 * i + (lane >> 5); scr[kk * 33 + (lane & 31)] = __builtin_nontemporal_load(W + (size_t)(srow0 + kk) * ldw + scol0 + (lane & 31)); }
    LDS_WAIT(); asm volatile("" ::: "memory");
    const int c = lane & 7;
#pragma unroll
    for (int j = 0; j < 4; ++j) { const int n = (lane >> 3) + 8 * j; const LAS float* s = scr + (8 * c) * 33 + n;
        u32x4 o; o.x = pk2(s[0 * 33], s[1 * 33]); o.y = pk2(s[2 * 33], s[3 * 33]); o.z = pk2(s[4 * 33], s[5 * 33]); o.w = pk2(s[6 * 33], s[7 * 33]);
        *(u32x4*)(WT + (size_t)(drow0 + n) * Kd + dk0 + 8 * c) = o; }
    LDS_WAIT(); asm volatile("" ::: "memory");
}
__device__ __forceinline__ int src_col_u(int np) {
    if (np < 768) return np;
    if (np >= 1792) { const int tt = (np - 1792) >> 8, w = (np - 1792) & 255; return w < 128 ? 1792 + 128 * tt + w : 2816 + 128 * tt + (w - 128); }
    const int tt = (np - 768) >> 8, w = (np - 768) & 255;
    return w < 128 ? 768 + 128 * tt + w : 1280 + 128 * tt + (w - 128);
}

__device__ __forceinline__ void p0_prologue(const Args& a, LAS unsigned char* lds, int gw, int NGW, int lane, int wave) {
    unsigned char* ws = a.ws;
    LAS float* scr = (LAS float*)(lds + wave * 16384);
    constexpr int J1 = 16 * 120, J2 = 8 * 32, J3 = 8 * 32, J4 = 16 * 32;
    constexpr int NITEMS = J1 + J2 + J3 + J4;
    for (int it = gw; it < NITEMS; it += NGW) {
        int r = it;
        if (r < J1) { const int kb = r / 120, nb = r % 120; tr_item(a.in[I_WIN], INW, src_col_u(32 * nb), 64 * kb, (bf16*)(ws + WS_WIN), 1024, 32 * nb, 64 * kb, scr, lane); continue; } r -= J1;
        if (r < J2) { const int kb = r / 32, nb = r % 32; tr_item(a.in[I_WATT], D, 32 * nb, 64 * kb, (bf16*)(ws + WS_WAB), 1024, 32 * nb, 64 * kb, scr, lane); continue; } r -= J2;
        if (r < J3) { const int kb = r / 32, nb = r % 32; tr_item(a.in[I_WCONV], D, 32 * nb, 64 * kb, (bf16*)(ws + WS_WAB), 1024, 32 * nb, 512 + 64 * kb, scr, lane); continue; } r -= J3;
        { const int kb = r / 32, nb = r % 32; tr_item(a.in[I_WO], D, 32 * nb, 64 * kb, (bf16*)(ws + WS_WO), 1024, 32 * nb, 64 * kb, scr, lane); }
    }
    const float* x = a.in[I_X]; bf16* xb = (bf16*)(ws + WS_XB);
    for (int m = gw; m < T; m += NGW) {
        const f32x4* xr = (const f32x4*)(x + (size_t)m * D) + lane; u32x2* o = (u32x2*)(xb + (size_t)m * D) + lane;
#pragma unroll
        for (int j = 0; j < 4; ++j) { const f32x4 v = __builtin_nontemporal_load(xr + 64 * j); u32x2 w; w.x = pk2(v[0], v[1]); w.y = pk2(v[2], v[3]); o[64 * j] = w; }
    }
    { u32x4* abz = (u32x4*)(ws + WS_AB); const u32x4 z4 = (u32x4){0u, 0u, 0u, 0u};
      for (int i = gw * 64 + lane; i < NBATCH * AB_PAD * CCH * 2 / 16; i += NGW * 64) { const int bb = i / (AB_PAD * CCH * 2 / 16), q = i % (AB_PAD * CCH * 2 / 16); abz[(size_t)bb * (AB_SEQ * CCH * 2 / 16) + q] = z4; } }
    float* bperm = (float*)(ws + WS_BPERM);
    for (int i = gw * 64 + lane; i < INW; i += NGW * 64) bperm[i] = a.in[I_BIN][src_col_u(i)];
}

constexpr int KLS = 144, VLS = 528, ATT_V_OFF = 256 * KLS, CONV_W_OFF = 70656;
__device__ __forceinline__ void attn_unit(const Args& a, int unit, LAS unsigned char* lds, int tid, int wave, int lane) {
    const bf16* qb = (const bf16*)(a.ws + WS_QB); const bf16* kb = (const bf16*)(a.ws + WS_KB); const bf16* vT = (const bf16*)(a.ws + WS_VT); bf16* ay = (bf16*)(a.ws + WS_AY);
    const int kvh = unit & 1, blk = (unit >> 1) & 31, b = unit >> 6;
    const int r = lane & 15, qd = lane >> 4, w = wave;
    const int t0 = b * SEQ + blk * 128, seq0 = b * SEQ, lo = w & ~1;
    { u32x4 kreg[4], vreg[4];
#pragma unroll
      for (int i = 0; i < 4; ++i) { const int c = tid + 512 * i;
          int tok = t0 - 128 + (c >> 3); tok = tok < seq0 ? seq0 : tok;
          kreg[i] = ldgo<u32x4>(kb, (unsigned)(tok * KVW + kvh * HD + (c & 7) * 8) * 2u);
          int sk = blk * 128 - 128 + 8 * (c & 31); sk = sk < 0 ? 0 : sk;
          vreg[i] = ldgo<u32x4>(vT, (unsigned)(((b * NKV + kvh) * HD + (c >> 5)) * SEQ + sk) * 2u); }
      __builtin_amdgcn_sched_barrier(0);
      asm volatile("" : "+v"(kreg[0]), "+v"(kreg[1]), "+v"(kreg[2]), "+v"(kreg[3]), "+v"(vreg[0]), "+v"(vreg[1]), "+v"(vreg[2]), "+v"(vreg[3]));
#pragma unroll
      for (int i = 0; i < 4; ++i) { const int c = tid + 512 * i;
          *(LAS u32x4*)(lds + (c >> 3) * KLS + (c & 7) * 16) = kreg[i];
          *(LAS u32x4*)(lds + ATT_V_OFF + (c >> 5) * VLS + (c & 31) * 16) = vreg[i]; } }
    __syncthreads();
    const int qi = 16 * w + r;
#pragma unroll 1
    for (int hh = 0; hh < 4; ++hh) {
        const int head = kvh * 4 + hh;
        u32x4 qf[2];
        { const unsigned qo = (unsigned)((t0 + qi) * AW + head * HD + 8 * qd) * 2u; qf[0] = ldgo<u32x4>(qb, qo); qf[1] = ldgo<u32x4>(qb, qo + 64u); }
        const float sinkv = a.in[I_SINK][head];
        int qiv = qi; asm volatile("" : "+v"(qiv));
        const int klo = max(qiv + 1, blk > 0 ? 0 : 128); const int kjb = lo * 16 + 4 * qd - klo; const unsigned span = (unsigned)(qiv + 128 - klo);
        f32x4 s[10];
#pragma unroll
        for (int i = 0; i < 10; ++i) {
            const LAS unsigned char* kp = lds + ((lo + i) * 16 + r) * KLS + qd * 16;
            const u32x4 k0 = *(const LAS u32x4*)kp, k1 = *(const LAS u32x4*)(kp + 64);
            f32x4 z = (f32x4){0.f, 0.f, 0.f, 0.f};
            z = __builtin_amdgcn_mfma_f32_16x16x32_bf16(__builtin_bit_cast(bf16x8, k0), __builtin_bit_cast(bf16x8, qf[0]), z, 0, 0, 0);
            s[i] = __builtin_amdgcn_mfma_f32_16x16x32_bf16(__builtin_bit_cast(bf16x8, k1), __builtin_bit_cast(bf16x8, qf[1]), z, 0, 0, 0);
        }
        float mx = sinkv;
#pragma unroll
        for (int i = 0; i < 10; ++i)
#pragma unroll
            for (int g = 0; g < 4; ++g) { const bool valid = (unsigned)(kjb + (16 * i + g)) <= span; s[i][g] = valid ? s[i][g] : -1e30f; mx = fmaxf(mx, s[i][g]); }
        mx = fmaxf(mx, __shfl_xor(mx, 16)); mx = fmaxf(mx, __shfl_xor(mx, 32));
        float sum = 0.f;
#pragma unroll
        for (int i = 0; i < 10; ++i)
#pragma unroll
            for (int g = 0; g < 4; ++g) { const float p = (s[i][g] > -1e29f) ? __expf(s[i][g] - mx) : 0.f; s[i][g] = p; sum += p; }
        sum += __shfl_xor(sum, 16); sum += __shfl_xor(sum, 32);
        const float inv = 1.0f / (sum + __expf(sinkv - mx));
        f32x4 o[4];
#pragma unroll
        for (int mt = 0; mt < 4; ++mt) o[mt] = (f32x4){0.f, 0.f, 0.f, 0.f};
#pragma unroll
        for (int ip = 0; ip < 5; ++ip) {
            u32x4 pw; pw.x = cvt_pk_bf16(s[2 * ip][0], s[2 * ip][1]); pw.y = cvt_pk_bf16(s[2 * ip][2], s[2 * ip][3]); pw.z = cvt_pk_bf16(s[2 * ip + 1][0], s[2 * ip + 1][1]); pw.w = cvt_pk_bf16(s[2 * ip + 1][2], s[2 * ip + 1][3]);
            const bf16x8 pb = __builtin_bit_cast(bf16x8, pw);
#pragma unroll
            for (int mt = 0; mt < 4; ++mt) { const LAS unsigned char* vp = lds + ATT_V_OFF + (16 * mt + r) * VLS + ((lo + 2 * ip) * 16 + 4 * qd) * 2;
                const u32x2 va = *(const LAS u32x2*)vp, vb = *(const LAS u32x2*)(vp + 32);
                u32x4 vw; vw.x = va.x; vw.y = va.y; vw.z = vb.x; vw.w = vb.y;
                o[mt] = __builtin_amdgcn_mfma_f32_16x16x32_bf16(__builtin_bit_cast(bf16x8, vw), pb, o[mt], 0, 0, 0); }
        }
        const unsigned oo = (unsigned)((t0 + qi) * D + head * HD + 4 * qd) * 2u;
#pragma unroll
        for (int mt = 0; mt < 4; ++mt) { u32x2 wv; wv.x = cvt_pk_bf16(o[mt][0] * inv, o[mt][1] * inv); wv.y = cvt_pk_bf16(o[mt][2] * inv, o[mt][3] * inv); *(u32x2*)((char*)ay + oo + 32u * mt) = wv; }
    }
    __syncthreads();
}

constexpr int CBS = 516;
__device__ __forceinline__ void conv_unit(const Args& a, int unit, LAS unsigned char* lds, int tid, int wave, int lane) {
    const bf16* ab = (const bf16*)(a.ws + WS_AB); bf16* ay = (bf16*)(a.ws + WS_AY);
    LAS float* cb = (LAS float*)lds;
    const int t0 = unit * 32, prow0 = t0 + AB_PAD * ((t0 >> 12) + 1);
    int cp = tid & 255; asm volatile("" : "+v"(cp));
    const int half = wave >> 2;
    const LAS float* wl = (const LAS float*)(lds + CONV_W_OFF) + 2 * cp;
    const f32x2 cbias = *(const f32x2*)(a.in[I_CONVB] + 2 * cp);
#pragma unroll 1
    for (int it = 0; it < 2; ++it) {
        const int tl0 = 16 * half + 8 * it;
        const unsigned o0 = (unsigned)((prow0 + tl0 - 30) * CCH + 2 * cp) * 2u;
        unsigned raw[38];
#pragma unroll
        for (int rr = 0; rr < 38; ++rr) raw[rr] = ldgo<unsigned>(ab, o0 + (unsigned)(rr * CCH * 2));
        __builtin_amdgcn_sched_barrier(0);
        asm volatile("" : "+v"(raw[0]), "+v"(raw[1]), "+v"(raw[2]), "+v"(raw[3]), "+v"(raw[4]), "+v"(raw[5]), "+v"(raw[6]), "+v"(raw[7]), "+v"(raw[8]), "+v"(raw[9]),
                          "+v"(raw[10]), "+v"(raw[11]), "+v"(raw[12]), "+v"(raw[13]), "+v"(raw[14]), "+v"(raw[15]), "+v"(raw[16]), "+v"(raw[17]), "+v"(raw[18]));
        asm volatile("" : "+v"(raw[19]), "+v"(raw[20]), "+v"(raw[21]), "+v"(raw[22]), "+v"(raw[23]), "+v"(raw[24]), "+v"(raw[25]), "+v"(raw[26]), "+v"(raw[27]), "+v"(raw[28]),
                          "+v"(raw[29]), "+v"(raw[30]), "+v"(raw[31]), "+v"(raw[32]), "+v"(raw[33]), "+v"(raw[34]), "+v"(raw[35]), "+v"(raw[36]), "+v"(raw[37]));
        float i0[38], i1[38];
#pragma unroll
        for (int rr = 0; rr < 38; ++rr) { i0[rr] = bflo(raw[rr]); i1[rr] = bfhi(raw[rr]); }
        float a0[8], a1[8];
#pragma unroll
        for (int o = 0; o < 8; ++o) { a0[o] = cbias.x; a1[o] = cbias.y; }
#pragma unroll
        for (int j = 0; j < CW; ++j) { const f32x2 wv = *(const LAS f32x2*)(wl + j * CCH);
#pragma unroll
            for (int o = 0; o < 8; ++o) { a0[o] = fmaf(i0[o + j], wv.x, a0[o]); a1[o] = fmaf(i1[o + j], wv.y, a1[o]); } }
#pragma unroll
        for (int o = 0; o < 8; ++o) *(LAS f32x2*)(cb + (tl0 + o) * CBS + 2 * cp) = (f32x2){a0[o], a1[o]};
    }
    __syncthreads();
    const f32x4 g0 = *(const f32x4*)(a.in[I_CLNG] + 8 * lane), g1 = *(const f32x4*)(a.in[I_CLNG] + 8 * lane + 4), b0 = *(const f32x4*)(a.in[I_CLNB] + 8 * lane), b1 = *(const f32x4*)(a.in[I_CLNB] + 8 * lane + 4);
#pragma unroll
    for (int tt = 0; tt < 4; ++tt) { const int tok = 4 * wave + tt;
        f32x4 v0 = *(const LAS f32x4*)(cb + tok * CBS + 8 * lane), v1 = *(const LAS f32x4*)(cb + tok * CBS + 8 * lane + 4);
        const float mean = wave_sum((v0[0] + v0[1]) + (v0[2] + v0[3]) + (v1[0] + v1[1]) + (v1[2] + v1[3])) * (1.0f / CCH);
        v0 = v0 - mean; v1 = v1 - mean;
        const float var = wave_sum((v0[0] * v0[0] + v0[1] * v0[1]) + (v0[2] * v0[2] + v0[3] * v0[3]) + (v1[0] * v1[0] + v1[1] * v1[1]) + (v1[2] * v1[2] + v1[3] * v1[3])) * (1.0f / CCH);
        const float rstd = 1.0f / sqrtf(var + LN_EPS);
        float y[8];
#pragma unroll
        for (int j = 0; j < 4; ++j) { const float y0 = v0[j] * rstd * g0[j] + b0[j], y1 = v1[j] * rstd * g1[j] + b1[j]; y[j] = y0 * sigmoidf_(y0); y[4 + j] = y1 * sigmoidf_(y1); }
        u32x4 wv; wv.x = cvt_pk_bf16(y[0], y[1]); wv.y = cvt_pk_bf16(y[2], y[3]); wv.z = cvt_pk_bf16(y[4], y[5]); wv.w = cvt_pk_bf16(y[6], y[7]);
        *(u32x4*)(ay + (size_t)(t0 + tok) * D + 512 + 8 * lane) = wv; }
    __syncthreads();
}

constexpr int HLS = 1025;
__device__ __forceinline__ void route_chunk(const Args& a, int chunk, LAS unsigned char* lds, int tid, int wave, int lane, const float (&bw)[64], const f32x4 (&g)[4], const f32x4 (&bb)[4]) {
    const bf16* hf = (const bf16*)(a.ws + WS_HF); unsigned char* hb = a.ws + WS_HB;
    int* slot = (int*)(a.ws + WS_SLOT); float* gatev = (float*)(a.ws + WS_GATE); unsigned* cursor = (unsigned*)(a.ws + WS_CTL);
    LAS float* hl = (LAS float*)lds;
    LAS float* lg = (LAS float*)(lds + MISC_OFF + MO_LG); LAS int* sel_e = (LAS int*)(lds + MISC_OFF + MO_SELE); LAS float* sel_g = (LAS float*)(lds + MISC_OFF + MO_SELG);
    LAS int* lcnt = (LAS int*)(lds + MISC_OFF + MO_LCNT); LAS int* lbase = (LAS int*)(lds + MISC_OFF + MO_LBASE);
    const int t0 = chunk * 32;
    f32x4 v[4][4];
    { u32x2 rw[4][4];
#pragma unroll
      for (int tt = 0; tt < 4; ++tt)
#pragma unroll
        for (int j = 0; j < 4; ++j) rw[tt][j] = *((const u32x2*)(hf + (size_t)(t0 + 4 * wave + tt) * D) + lane + 64 * j);
      __builtin_amdgcn_sched_barrier(0);
      asm volatile("" : "+v"(rw[0][0]), "+v"(rw[0][1]), "+v"(rw[0][2]), "+v"(rw[0][3]), "+v"(rw[1][0]), "+v"(rw[1][1]), "+v"(rw[1][2]), "+v"(rw[1][3]),
                        "+v"(rw[2][0]), "+v"(rw[2][1]), "+v"(rw[2][2]), "+v"(rw[2][3]), "+v"(rw[3][0]), "+v"(rw[3][1]), "+v"(rw[3][2]), "+v"(rw[3][3]));
#pragma unroll
      for (int tt = 0; tt < 4; ++tt)
#pragma unroll
        for (int j = 0; j < 4; ++j) v[tt][j] = (f32x4){bflo(rw[tt][j].x), bfhi(rw[tt][j].x), bflo(rw[tt][j].y), bfhi(rw[tt][j].y)}; }
#pragma unroll
    for (int tt = 0; tt < 4; ++tt) { const int tl = 4 * wave + tt;
        float sm = 0.f;
#pragma unroll
        for (int j = 0; j < 4; ++j) sm += (v[tt][j][0] + v[tt][j][1]) + (v[tt][j][2] + v[tt][j][3]);
        const float mean = wave_sum(sm) * (1.0f / D); float s2 = 0.f;
#pragma unroll
        for (int j = 0; j < 4; ++j) { v[tt][j] = v[tt][j] - mean; s2 += (v[tt][j][0] * v[tt][j][0] + v[tt][j][1] * v[tt][j][1]) + (v[tt][j][2] * v[tt][j][2] + v[tt][j][3] * v[tt][j][3]); }
        const float rstd = 1.0f / sqrtf(wave_sum(s2) * (1.0f / D) + LN_EPS);
        if (lane == 0) *(f32x2*)((float*)(a.ws + WS_LN1S) + 2 * (size_t)(t0 + tl)) = (f32x2){mean, rstd};
#pragma unroll
        for (int j = 0; j < 4; ++j) { const f32x4 h = v[tt][j] * rstd * g[j] + bb[j];
            unsigned wv = 0u; wv = __builtin_amdgcn_cvt_pk_fp8_f32(h[0] * 8.0f, h[1] * 8.0f, wv, false); wv = __builtin_amdgcn_cvt_pk_fp8_f32(h[2] * 8.0f, h[3] * 8.0f, wv, true); *((unsigned*)(hb + (size_t)(t0 + tl) * D) + lane + 64 * j) = wv;
            LAS float* hp = hl + tl * HLS + 4 * lane + 256 * j; hp[0] = h[0]; hp[1] = h[1]; hp[2] = h[2]; hp[3] = h[3]; }
    }
    if (tid < 32) lcnt[tid] = 0;
    __syncthreads();
    f32x16 acc;
#pragma unroll
    for (int i = 0; i < 16; ++i) acc[i] = 0.f;
    { const int tok = lane & 31, kp = lane >> 5; const LAS float* hp = hl + tok * HLS + 128 * wave + kp;
#pragma unroll
      for (int s = 0; s < 64; ++s) acc = __builtin_amdgcn_mfma_f32_32x32x2f32(hp[2 * s], bw[s], acc, 0, 0, 0); }
    __syncthreads();
    { LAS float* part = hl + wave * 1024;
#pragma unroll
      for (int i = 0; i < 16; ++i) { const int rowi = (i & 3) + 8 * (i >> 2) + 4 * (lane >> 5); part[rowi * 32 + (lane & 31)] = acc[i]; } }
    __syncthreads();
    for (int o = tid; o < 1024; o += 512) { float sm = a.in[I_BR][o & 31];
#pragma unroll
        for (int w = 0; w < 8; ++w) sm += hl[w * 1024 + o];
        lg[(o >> 5) * 33 + (o & 31)] = sm; }
    __syncthreads();
    if (tid < 32) { float v[NE];
#pragma unroll
        for (int e = 0; e < NE; ++e) v[e] = lg[tid * 33 + e];
        float tv[4]; int ti[4];
#pragma unroll
        for (int k = 0; k < 4; ++k) { float best = -3.0e38f; int bi = 0;
#pragma unroll
            for (int e = 0; e < NE; ++e) { const bool take = v[e] > best; best = take ? v[e] : best; bi = take ? e : bi; }
            tv[k] = best; ti[k] = bi;
#pragma unroll
            for (int e = 0; e < NE; ++e) v[e] = (e == bi) ? -3.0e38f : v[e]; }
        const float e1 = __expf(tv[1] - tv[0]), e2 = __expf(tv[2] - tv[0]), e3 = __expf(tv[3] - tv[0]); const float inv = 1.0f / (1.0f + e1 + e2 + e3);
        sel_e[4 * tid + 0] = ti[0]; sel_e[4 * tid + 1] = ti[1]; sel_e[4 * tid + 2] = ti[2]; sel_e[4 * tid + 3] = ti[3];
        sel_g[4 * tid + 0] = inv; sel_g[4 * tid + 1] = e1 * inv; sel_g[4 * tid + 2] = e2 * inv; sel_g[4 * tid + 3] = e3 * inv; }
    __syncthreads();
    int my_e = 0, my_rank = 0;
    if (tid < 128) { my_e = sel_e[tid]; my_rank = atomicAdd((int*)&lcnt[my_e], 1); }
    __syncthreads();
    if (tid < 32) { const int c = lcnt[tid]; lbase[tid] = c > 0 ? (int)atomicAdd(cursor + tid, (unsigned)c) : 0; }
    __syncthreads();
    if (tid < 128) { const int asg = (t0 + (tid >> 2)) * 4 + (tid & 3); slot[my_e * SLOT_CAP + lbase[my_e] + my_rank] = asg; gatev[asg] = sel_g[tid]; }
    __syncthreads();
}

__device__ __forceinline__ void combine_row(const Args& a, int m, int lane) {
    const bf16* hf = (const bf16*)(a.ws + WS_HF); const unsigned char* ys = a.ws + WS_YS; const float* gatev = (const float*)(a.ws + WS_GATE);
    f32x4 gt = *(const f32x4*)(gatev + 4 * (size_t)m); gt = gt * (1.0f / 16.0f);
    const f32x2 st = *(const f32x2*)((const float*)(a.ws + WS_LN1S) + 2 * (size_t)m);
    f32x4 v[4]; float sm = 0.f;
#pragma unroll
    for (int j = 0; j < 4; ++j) { const f32x4 g1 = *((const f32x4*)a.in[I_LN1G] + lane + 64 * j), b1 = *((const f32x4*)a.in[I_LN1B] + lane + 64 * j);
        const u32x2 pw = *((const u32x2*)(hf + (size_t)m * D) + lane + 64 * j); f32x4 p = (f32x4){bflo(pw.x), bfhi(pw.x), bflo(pw.y), bfhi(pw.y)}; p = p - st.x; const f32x4 h = p * st.y * g1 + b1;
        v[j] = h * DN_ALPHA;
#pragma unroll
        for (int k = 0; k < 4; ++k) { const unsigned y = *((const unsigned*)(ys + ((size_t)m * 4 + k) * D) + lane + 64 * j); const float gk = gt[k];
            const f32x2 lo = __builtin_amdgcn_cvt_pk_f32_fp8(y, false), hi = __builtin_amdgcn_cvt_pk_f32_fp8(y, true);
            v[j][0] += gk * lo.x; v[j][1] += gk * lo.y; v[j][2] += gk * hi.x; v[j][3] += gk * hi.y; }
        sm += (v[j][0] + v[j][1]) + (v[j][2] + v[j][3]); }
    const float mean = wave_sum(sm) * (1.0f / D); float s2 = 0.f;
#pragma unroll
    for (int j = 0; j < 4; ++j) { v[j] = v[j] - mean; s2 += (v[j][0] * v[j][0] + v[j][1] * v[j][1]) + (v[j][2] * v[j][2] + v[j][3] * v[j][3]); }
    const float rstd = 1.0f / sqrtf(wave_sum(s2) * (1.0f / D) + LN_EPS);
#pragma unroll
    for (int j = 0; j < 4; ++j) { const f32x4 g = *((const f32x4*)a.in[I_LN2G] + lane + 64 * j), bb = *((const f32x4*)a.in[I_LN2B] + lane + 64 * j);
        *((f32x4*)(a.out + (size_t)m * D) + lane + 64 * j) = v[j] * rstd * g + bb; }
}

__global__ void __launch_bounds__(512, 2) fwd_megakernel(Args args) {
    extern __shared__ __attribute__((aligned(16))) unsigned char lds_raw[];
    LAS unsigned char* lds = (LAS unsigned char*)lds_raw;
    const int tid = threadIdx.x, wave = __builtin_amdgcn_readfirstlane(tid >> 6);
#define FRESH_LANE int lane; { int t_ = tid; asm volatile("" : "+v"(t_)); lane = t_ & 63; }
    const int G = gridDim.x, bx = blockIdx.x;
    const int vcu = (G % 8 == 0) ? (bx % 8) * (G / 8) + bx / 8 : bx;
    const int gw = vcu * 8 + wave, NGW = G * 8;
    const int lo = args.ph_lo, hi = args.ph_hi;
    unsigned char* ws = args.ws;
    volatile LAS unsigned* bst = (volatile LAS unsigned*)(lds + MISC_OFF + MO_BAR);
    if (tid < 2) bst[tid] = 0u;
    __syncthreads();
    XcdBarrier xbar = xcd_barrier_post((unsigned*)(ws + WS_CTL) + CW_BAR, bst);
#ifndef PMASK
#define PMASK 0x1ff
#endif
#define IN(k) (((PMASK >> (k)) & 1) && lo <= (k) && (k) < hi)
#define SEAM(k) do { if (lo <= (k) && (k) + 1 < hi) xcd_barrier(xbar); } while (0)

    if (IN(0)) { FRESH_LANE; p0_prologue(args, lds, gw, NGW, lane, wave); }
    SEAM(0);
    if (IN(1)) {
        pg8::DenseOrder S; S.init(ws + WS_XB, ws + WS_WIN, T, INW, G, bx);
        pg8::EpiU E{(bf16*)(ws + WS_QB), (bf16*)(ws + WS_KB), (bf16*)(ws + WS_VT), (bf16*)(ws + WS_AB), (bf16*)(ws + WS_GATES), (const float*)(ws + WS_BPERM)};
        const int slot = vcu & 3;
        S.i0 = 0; S.i1 = slot;
        pg8::gemm_phase<pg8::EpiU, pg8::DenseOrder>(lds, S, E);
        { FRESH_LANE; side_convert(args, bx, G, wave, lane); }
        S.i0 = slot; S.i1 = 1 << 20;
        pg8::gemm_phase<pg8::EpiU, pg8::DenseOrder>(lds, S, E);
    }
    SEAM(1);
    if (IN(2)) {
        FRESH_LANE;
        __syncthreads();
        for (int i = tid; i < CW * CCH / 4; i += 512) ((LAS f32x4*)(lds + CONV_W_OFF))[i] = ((const f32x4*)args.in[I_CONVW])[i];
        __syncthreads();
        for (int u = vcu; u < 256 + 512; u += G) {
            if (u < 256) attn_unit(args, u, lds, tid, wave, lane);
            else conv_unit(args, u - 256, lds, tid, wave, lane);
        }
    }
    SEAM(2);
    if (IN(3)) {
        pg8::DenseOrder S; S.init(ws + WS_AY, ws + WS_WAB, T, D, G, bx);
        pg8::EpiMerged E{(const bf16*)(ws + WS_GATES), args.in[I_BCONV], (bf16*)(ws + WS_MERGED)};
        pg8::gemm_phase<pg8::EpiMerged, pg8::DenseOrder>(lds, S, E);
    }
    SEAM(3);
    if (IN(4)) {
        pg8::DenseOrder S; S.init(ws + WS_MERGED, ws + WS_WO, T, D, G, bx);
        pg8::EpiPre1 E{(const bf16*)(ws + WS_XB), (bf16*)(ws + WS_HF)};
        pg8::gemm_phase<pg8::EpiPre1, pg8::DenseOrder>(lds, S, E);
    }
    SEAM(4);
    if (IN(5)) {
        FRESH_LANE;
        __syncthreads();
        float bw[64]; f32x4 g1[4], b1[4];
#pragma unroll
        for (int s_ = 0; s_ < 64; ++s_) bw[s_] = args.in[I_WR][(size_t)(128 * wave + 2 * s_ + (lane >> 5)) * NE + (lane & 31)];
#pragma unroll
        for (int j = 0; j < 4; ++j) { g1[j] = *((const f32x4*)args.in[I_LN1G] + lane + 64 * j); b1[j] = *((const f32x4*)args.in[I_LN1B] + lane + 64 * j); }
        for (int c = vcu; c < T / 32; c += G) route_chunk(args, c, lds, tid, wave, lane, bw, g1, b1);
    }
    SEAM(5);
    if (IN(6) || IN(7)) {
        LAS int* tab = (LAS int*)(lds + MISC_OFF + MO_TAB);
        __syncthreads();
        if (tid == 0) { const unsigned* cursor = (const unsigned*)(ws + WS_CTL); int acc = 0;
            for (int e = 0; e < NE; ++e) { const int c = (int)__hip_atomic_load(cursor + e, __ATOMIC_RELAXED, __HIP_MEMORY_SCOPE_AGENT); tab[e] = c; const int ml = (c + 255) >> 8; tab[32 + e] = ml; tab[64 + e] = acc; acc += ml; }
            tab[64 + NE] = acc; }
        __syncthreads();
        const int total_mt = tab[64 + NE];
        if (IN(6)) {
            unsigned* ctl = (unsigned*)(ws + WS_CTL);
            pg8::MoeFusedOrder S{tab, G, vcu, total_mt * 8, total_mt * 4, (const char*)(ws + WS_HB), (const char*)(ws + WS_ACT), (const char*)(ws + WS_WUP), (const char*)(ws + WS_WDN), (const int*)(ws + WS_SLOT), ctl + 8192, ctl + 64};
            pg8::EpiMoe E{pg8::EpiUpX{args.in[I_BUP], ws + WS_ACT}, pg8::EpiDown{args.in[I_BDN], (const int*)(ws + WS_SLOT), ws + WS_YS}};
            pg8::gemm_phase<pg8::EpiMoe, pg8::MoeFusedOrder, true>(lds, S, E);
        }
    }
    SEAM(7);
    if (IN(8)) { FRESH_LANE; for (int m = gw; m < T; m += NGW) combine_row(args, m, lane); }

#undef IN
#undef SEAM
#undef FRESH_LANE
}

extern "C" void kernel_launch(void* const* d_in, const int* in_sizes, int n_in, void* d_out, int out_size, void* d_ws, size_t ws_size, hipStream_t stream) {
    static int grid = 0;
    if (grid == 0) {
        if (n_in != 22 || out_size != T * D || ws_size < WS_END) { fprintf(stderr, "kernel_launch: unexpected problem (n_in %d, out %d, ws %zu)\n", n_in, out_size, ws_size); grid = -1; return; }
        int dev = 0, cus = 0, per_cu = 0;
        hipGetDevice(&dev); hipDeviceGetAttribute(&cus, hipDeviceAttributeMultiprocessorCount, dev);
        hipFuncSetAttribute((const void*)fwd_megakernel, hipFuncAttributeMaxDynamicSharedMemorySize, LDS_BYTES);
        hipOccupancyMaxActiveBlocksPerMultiprocessor(&per_cu, (const void*)fwd_megakernel, 512, LDS_BYTES);
        if (per_cu < 1) { fprintf(stderr, "kernel_launch: occupancy query says %d blocks per CU\n", per_cu); per_cu = 1; }
        (void)hipGetLastError();
        grid = cus * 1;
        fprintf(stderr, "kernel_launch: grid %d (cus %d, occupancy %d)\n", grid, cus, per_cu);
    }
    if (grid < 0) return;
    hipMemsetAsync((char*)d_ws + WS_CTL, 0, 65536, stream);
    Args a{};
    for (int i = 0; i < 22; ++i) a.in[i] = (const float*)d_in[i];
    a.out = (float*)d_out; a.ws = (unsigned char*)d_ws; a.ph_lo = 0; a.ph_hi = 9;
    void* kargs[] = {&a};
    hipError_t e = hipLaunchCooperativeKernel((const void*)fwd_megakernel, dim3(grid), dim3(512), kargs, LDS_BYTES, stream);
    if (e != hipSuccess) fprintf(stderr, "cooperative launch failed: %s (grid %d)\n", hipGetErrorString(e), grid);
}
```

```cpp
#include <hip/hip_runtime.h>
#include <cstdio>
#include <cstdint>

#define GAS __attribute__((address_space(1)))
#define LAS __attribute__((address_space(3)))
typedef unsigned short bf16;
typedef short bf16x8 __attribute__((ext_vector_type(8)));
typedef float f32x4 __attribute__((ext_vector_type(4)));
typedef float f32x2 __attribute__((ext_vector_type(2)));
typedef float f32x16 __attribute__((ext_vector_type(16)));
typedef unsigned u32x4 __attribute__((ext_vector_type(4)));
typedef unsigned u32x2 __attribute__((ext_vector_type(2)));

constexpr int T = 16384, D = 1024, SEQ = 4096, NBATCH = 4;
constexpr int NH = 8, NKV = 2, HD = 64, AW = 512, KVW = 128, CCH = 512, CW = 31;
constexpr int INW = 3840, NE = 32, TOPK = 4, DE = 1024;
constexpr float LN_EPS = 1e-5f;
constexpr float DN_ALPHA = 1.189207115002721f;
constexpr int SLOT_CAP = 16384;
constexpr int MAX_MT = (T * TOPK) / 256 + NE;

constexpr size_t MiB = 1u << 20;
constexpr size_t WS_CTL = 0, CTL_BYTES = 65536;
constexpr int CW_BAR = 4096;
constexpr size_t WS_WIN = 1 * MiB;
constexpr size_t WS_WAB = 9 * MiB;
constexpr size_t WS_WO = 11 * MiB;
constexpr size_t WS_BPERM = 13 * MiB;
constexpr size_t WS_SLOT = 14 * MiB;
constexpr size_t WS_GATE = 16 * MiB;
constexpr size_t WS_LN1S = 17 * MiB;
constexpr size_t WS_WUP = 32 * MiB;
constexpr size_t WS_WDN = 160 * MiB;
constexpr size_t WS_XB = 224 * MiB;
constexpr size_t WS_QB = 256 * MiB;
constexpr size_t WS_KB = 272 * MiB;
constexpr size_t WS_VT = 276 * MiB;
constexpr size_t WS_AB = 792 * MiB;
constexpr size_t WS_GATES = 296 * MiB;
constexpr size_t WS_AY = 360 * MiB;
constexpr size_t WS_MERGED = 392 * MiB;
constexpr size_t WS_HF = 424 * MiB;
constexpr size_t WS_HB = 488 * MiB;
constexpr size_t WS_ACT = 520 * MiB;
constexpr size_t WS_YS = 664 * MiB;
constexpr size_t WS_END = 810 * MiB;
constexpr int AB_PAD = 32, AB_SEQ = SEQ + AB_PAD;

constexpr int LDS_SCR = 135168;
constexpr int MISC_OFF = 135168;
constexpr int MO_LG = 0, MO_SELE = 4224, MO_SELG = 4736, MO_LCNT = 5248, MO_LBASE = 5376, MO_TAB = 5504, MO_BAR = 6016, MO_RDY = 6080;
constexpr int OFFN_OFF = 147456;
constexpr int LDS_BYTES = 155648;

#define LDS_WAIT() asm volatile("s_waitcnt lgkmcnt(0)" ::: "memory")
#define VM_WAIT() asm volatile("s_waitcnt vmcnt(0)" ::: "memory")

__device__ __forceinline__ unsigned f2bf(float f) { unsigned u = __builtin_bit_cast(unsigned, f); return (u + 0x7fffu + ((u >> 16) & 1u)) >> 16; }
__device__ __forceinline__ unsigned pk2(float lo, float hi) { return f2bf(lo) | (f2bf(hi) << 16); }
__device__ __forceinline__ float bf2f(unsigned b) { return __builtin_bit_cast(float, b << 16); }
__device__ __forceinline__ float bflo(unsigned w) { return __builtin_bit_cast(float, w << 16); }
__device__ __forceinline__ float bfhi(unsigned w) { return __builtin_bit_cast(float, w & 0xffff0000u); }
typedef __bf16 bf16x2_t __attribute__((ext_vector_type(2)));
__device__ __forceinline__ unsigned cvt_pk_bf16(float lo, float hi) { const f32x2 v = {lo, hi}; return __builtin_bit_cast(unsigned, __builtin_convertvector(v, bf16x2_t)); }
__device__ __forceinline__ float sigmoidf_(float x) { return __builtin_amdgcn_rcpf(1.0f + __expf(-x)); }
#define DPP_ADD(v, ctrl) ((v) + __builtin_bit_cast(float, __builtin_amdgcn_update_dpp(0, __builtin_bit_cast(int, (v)), (ctrl), 0xf, 0xf, true)))
__device__ __forceinline__ float wave_sum(float v) {
    v = DPP_ADD(v, 0xB1);
    v = DPP_ADD(v, 0x4E);
    v = DPP_ADD(v, 0x141);
    v = DPP_ADD(v, 0x140);
    const int vi = __builtin_bit_cast(int, v);
    const float r0 = __builtin_bit_cast(float, __builtin_amdgcn_readlane(vi, 0)), r1 = __builtin_bit_cast(float, __builtin_amdgcn_readlane(vi, 16));
    const float r2 = __builtin_bit_cast(float, __builtin_amdgcn_readlane(vi, 32)), r3 = __builtin_bit_cast(float, __builtin_amdgcn_readlane(vi, 48));
    return (r0 + r1) + (r2 + r3);
}
template <class V> __device__ __forceinline__ V ldgo(const void* base, unsigned off) { return *(const V*)((const char*)base + off); }
#define PIN10(a) asm volatile("" : "+v"((a)[0]), "+v"((a)[1]), "+v"((a)[2]), "+v"((a)[3]), "+v"((a)[4]), "+v"((a)[5]), "+v"((a)[6]), "+v"((a)[7]), "+v"((a)[8]), "+v"((a)[9]))

struct Args { const float* in[22]; float* out; unsigned char* ws; int ph_lo, ph_hi; };
enum { I_X = 0, I_WIN, I_BIN, I_SINK, I_WATT, I_CONVW, I_CONVB, I_CLNG, I_CLNB, I_WCONV, I_BCONV, I_WO, I_LN1G, I_LN1B, I_WR, I_BR, I_WUP, I_BUP, I_WDN, I_BDN, I_LN2G, I_LN2B };
constexpr int CVI_UP = NE * 64, CVI_DN = NE * 32, CVI_ITEMS = CVI_UP + CVI_DN;
__device__ __forceinline__ void cvi_decode(const Args& a, int it, const float*& src, unsigned char*& dst, int& nw) {
    if (it < CVI_UP) { const int e = it >> 6, kg = it & 63; nw = 2048; src = a.in[I_WUP] + ((size_t)e * 1024 + 16 * kg) * 2048; dst = a.ws + WS_WUP + (size_t)e * 2048 * 1024 + (size_t)kg * 2048 * 16; }
    else { const int r = it - CVI_UP, e = r >> 5, kg2 = r & 31; nw = 1024; src = a.in[I_WDN] + ((size_t)e * 1024 + 32 * kg2) * 1024; dst = a.ws + WS_WDN + (size_t)e * 1024 * 1024 + (size_t)kg2 * 2 * 1024 * 16; }
}
__device__ __forceinline__ void cvi_slice_ptrs(const Args& a, int it, int wave, int lane, const float*& sp, unsigned& pitch, unsigned char*& dp) {
    const float* src; unsigned char* dst; int nw; cvi_decode(a, it, src, dst, nw);
    const int g = nw == 2048 ? 0 : (wave >> 2), cw = nw == 2048 ? wave : (wave & 3);
    sp = src + (size_t)(16 * g) * nw + 256 * cw + 4 * lane; pitch = (unsigned)nw;
    dp = dst + ((size_t)g * nw + 256 * cw + 4 * lane) * 16;
}
__device__ __forceinline__ void cvi_slice_load(const float* sp, unsigned pitch, f32x4 (&r)[16]) {
#pragma unroll
    for (int kk = 0; kk < 16; ++kk) r[kk] = __builtin_nontemporal_load((const f32x4*)(sp + (size_t)kk * pitch));
}
__device__ __forceinline__ void cvi_slice_out(unsigned char* dp, f32x4 (&r)[16]) {
    asm volatile("" : "+v"(r[0]), "+v"(r[1]), "+v"(r[2]), "+v"(r[3]), "+v"(r[4]), "+v"(r[5]), "+v"(r[6]), "+v"(r[7]), "+v"(r[8]), "+v"(r[9]), "+v"(r[10]), "+v"(r[11]), "+v"(r[12]), "+v"(r[13]), "+v"(r[14]), "+v"(r[15]));
#pragma unroll
    for (int j = 0; j < 4; ++j) { unsigned w[4];
#pragma unroll
        for (int c = 0; c < 4; ++c) { unsigned x = 0u; x = __builtin_amdgcn_cvt_pk_fp8_f32(r[4 * c][j] * 64.0f, r[4 * c + 1][j] * 64.0f, x, false);
            x = __builtin_amdgcn_cvt_pk_fp8_f32(r[4 * c + 2][j] * 64.0f, r[4 * c + 3][j] * 64.0f, x, true); w[c] = x; }
        *(u32x4*)(dp + 16 * j) = (u32x4){w[0], w[1], w[2], w[3]}; }
}
__device__ __forceinline__ void side_convert(const Args& a, int bx, int G, int wave, int lane) {
    int base, nit;
    if (G == 256) { base = bx < 192 ? 11 * bx : 2112 + 15 * (bx - 192); nit = bx < 192 ? 11 : 15; }
    else { const int per = (CVI_ITEMS + G - 1) / G; base = bx * per; nit = base >= CVI_ITEMS ? 0 : (CVI_ITEMS - base < per ? CVI_ITEMS - base : per); }
    const int end = base + nit;
    f32x4 r0[16], r1[16];
    const float* sp0; const float* sp1; unsigned p0 = 0, p1 = 0; unsigned char* d0; unsigned char* d1;
    if (nit > 0) { cvi_slice_ptrs(a, base, wave, lane, sp0, p0, d0); cvi_slice_load(sp0, p0, r0); }
    if (nit > 1) { cvi_slice_ptrs(a, base + 1, wave, lane, sp1, p1, d1); cvi_slice_load(sp1, p1, r1); }
#pragma unroll 1
    for (int it0 = base; it0 < end; it0 += 2) {
        const int it1 = it0 + 1;
        { unsigned char* dcur = d0; cvi_slice_out(dcur, r0); if (it0 + 2 < end) { cvi_slice_ptrs(a, it0 + 2, wave, lane, sp0, p0, d0); cvi_slice_load(sp0, p0, r0); } }
        if (it1 >= end) break;
        { unsigned char* dcur = d1; cvi_slice_out(dcur, r1); if (it1 + 2 < end) { cvi_slice_ptrs(a, it1 + 2, wave, lane, sp1, p1, d1); cvi_slice_load(sp1, p1, r1); } }
    }
}

namespace pg8 {
constexpr int BM = 256, BK = 64, HALF = 128, HTB = HALF * BK * 2, STAGE_BYTES = 8 * HTB, NXCD = 8, WGM = 8;
constexpr int KD = 1024, NT_K = KD / BK;
__host__ __device__ __forceinline__ int lds_byte(int r, int c) { const int st = (r >> 4) * 2 + (c >> 5), rr = r & 15, cc = c & 31, ob = rr * 64 + cc * 2; return st * 1024 + (ob ^ (((ob >> 9) & 1) << 5)); }
__host__ __device__ __forceinline__ void stage_rc(int b, int& R, int& C) { const int st = b / 1024, sb = b % 1024, swz = sb ^ (((sb >> 9) & 1) << 5); R = (st >> 1) * 16 + swz / 64; C = (st & 1) * 32 + (swz % 64) / 2; }
__host__ __device__ __forceinline__ int perm32(int rho) { const int n = rho >> 4, i = rho & 15; return 8 * (i >> 2) + 4 * n + (i & 3); }

struct Unit { const char* A; const char* B; int pm, pn, e, mt, cnt, type; };

struct DenseOrder {
    const char* Ab; const char* Bb; int nM, nN, nwg, G, c, i0 = 0, i1 = 1 << 20; static constexpr int rowb = KD * 2; static constexpr bool PARK = false, FUSED = false;
    __device__ __forceinline__ unsigned boff(int Rb, int C) const { return (unsigned)(Rb * rowb + C * 2); }
    __device__ __forceinline__ size_t bstep_k() const { return 128; }
    __device__ __forceinline__ size_t bstep_h() const { return (size_t)HALF * rowb; }
    __device__ void init(const void* A, const void* B, int M, int N, int G_, int c_) { Ab = (const char*)A; Bb = (const char*)B; nM = M / BM; nN = N / BM; nwg = nM * nN; G = G_; c = c_; }
    __device__ __forceinline__ bool next(int i, Unit& u) const {
        if (i + i0 >= i1) return false;
        const long L = (long)(i + i0) * G + c; if (L >= nwg) return false;
        int wgid = (int)L; { const int q = nwg / NXCD, r = nwg % NXCD, xcd = wgid % NXCD, off = wgid / NXCD; wgid = (xcd < r ? xcd * (q + 1) : r * (q + 1) + (xcd - r) * q) + off; }
        const int nig = WGM * nN, gid = wgid / nig, fm = gid * WGM, gsz = (nM - fm) < WGM ? (nM - fm) : WGM;
        u.pm = fm + ((wgid % nig) % gsz); u.pn = (wgid % nig) / gsz; u.e = 0; u.mt = 0; u.cnt = 0; u.type = 0;
        u.A = Ab + (size_t)u.pm * (BM * KD * 2); u.B = Bb + (size_t)u.pn * (BM * KD * 2); return true;
    }
    __device__ __forceinline__ void offsets(const Unit&, const int (&R)[2], const int (&C)[2], unsigned (&off)[2][2]) const {
#pragma unroll
        for (int h = 0; h < 2; ++h)
#pragma unroll
            for (int i = 0; i < 2; ++i) off[h][i] = (unsigned)(((h * HALF + R[i]) * KD + C[i]) * 2);
    }
};
struct MoeOrder {
    const LAS int* tab; int NTN, G, c, total; const char* Ab; const char* Bb; size_t bexp; const int* slot; bool gather; int rowb;
    static constexpr bool PARK = true, FUSED = false;
    int bn16;
    __device__ __forceinline__ unsigned boff(int Rb, int C) const { return (unsigned)((C >> 3) * bn16 + Rb * 16); }
    __device__ __forceinline__ size_t bstep_k() const { return (size_t)8 * bn16; }
    __device__ __forceinline__ size_t bstep_h() const { return (size_t)HALF * 16; }
    __device__ __forceinline__ bool next(int i, Unit& u) const {
        const int L = i * G + c; if (L >= total) return false;
        int e = 0;
        for (int j = 1; j < NE; ++j) e += (L >= NTN * tab[64 + j]) ? 1 : 0;
        e = __builtin_amdgcn_readfirstlane(e);
        const int ms = __builtin_amdgcn_readfirstlane(tab[64 + e]), ml = __builtin_amdgcn_readfirstlane(tab[32 + e]);
        const int r = L - NTN * ms; const int nt = r / ml, mt = r - nt * ml;
        u.e = e; u.mt = mt; u.cnt = __builtin_amdgcn_readfirstlane(tab[e]); u.pm = ms + mt; u.pn = nt; u.type = 0;
        u.A = gather ? Ab : Ab + (size_t)u.pm * (size_t)(BM * rowb);
        u.B = Bb + (size_t)e * bexp + (size_t)nt * (size_t)(BM * 16); return true;
    }
    __device__ __forceinline__ void offsets(const Unit& u, const int (&R)[2], const int (&C)[2], unsigned (&off)[2][2]) const {
#pragma unroll
        for (int h = 0; h < 2; ++h)
#pragma unroll
            for (int i = 0; i < 2; ++i) {
                if (gather) { const int idx = u.mt * BM + h * HALF + R[i]; const int idc = idx < u.cnt ? idx : u.cnt - 1; int tok = slot[u.e * SLOT_CAP + idc] >> 2; tok = idx < u.cnt ? tok : 0; off[h][i] = (unsigned)(tok * rowb + C[i] * 2); }
                else off[h][i] = (unsigned)((h * HALF + R[i]) * rowb + C[i] * 2);
            }
    }
};


#define GAS_U32 __attribute__((address_space(1))) unsigned
struct MoeFusedOrder {
    const LAS int* tab; int G, c, total6, total7; const char* hb; const char* act; const char* wup; const char* wdn; const int* slot; unsigned* cnt; unsigned* tmo;
    static constexpr bool PARK = true, FUSED = true; static constexpr int rowb = 1024;
    __device__ __forceinline__ unsigned boff_t(int type, int R, int C) const {
        const int rs = 64 * (R >> 5) + 32 * ((R >> 2) & 1) + 16 * ((R >> 3) & 1) + 4 * ((R >> 4) & 1) + (R & 3);
        return (unsigned)((C >> 3) * ((type ? 1024 : 2048) * 16) + rs * 16); }
    __device__ __forceinline__ unsigned boff(int R, int C) const { return boff_t(0, R, C); }
    __device__ __forceinline__ size_t bstep_kt(int type) const { return (size_t)8 * (type ? 1024 * 16 : 2048 * 16); }
    __device__ __forceinline__ size_t bstep_ht(int) const { return (size_t)8 * 16; }
    __device__ __forceinline__ size_t bstep_k() const { return bstep_kt(0); }
    __device__ __forceinline__ size_t bstep_h() const { return bstep_ht(0); }
    __device__ __forceinline__ bool next(int i, Unit& u) const {
        int L = i * G + c; if (L >= total6 + total7) return false;
        const int type = L >= total6 ? 1 : 0; L -= type ? total6 : 0; const int NTN = type ? 4 : 8;
        int e = 0;
        for (int j = 1; j < NE; ++j) e += (L >= NTN * tab[64 + j]) ? 1 : 0;
        e = __builtin_amdgcn_readfirstlane(e);
        const int ms = __builtin_amdgcn_readfirstlane(tab[64 + e]), ml = __builtin_amdgcn_readfirstlane(tab[32 + e]);
        const int r = L - NTN * ms; const int nt = r / ml, mt = r - nt * ml;
        u.e = e; u.mt = mt; u.cnt = __builtin_amdgcn_readfirstlane(tab[e]); u.pm = ms + mt; u.pn = nt; u.type = type;
        u.A = type ? act + (size_t)u.pm * (size_t)(BM * rowb) : hb;
        u.B = (type ? wdn + (size_t)e * 1024 * 1024 : wup + (size_t)e * 2048 * 1024) + (size_t)nt * (size_t)(BM * 16); return true;
    }
    __device__ __forceinline__ void offsets(const Unit& u, const int (&R)[2], const int (&C)[2], unsigned (&off)[2][2]) const {
        if (u.type == 0) { int tok[2][2];
#pragma unroll
            for (int h = 0; h < 2; ++h)
#pragma unroll
                for (int i = 0; i < 2; ++i) { const int idx = u.mt * BM + h * HALF + R[i]; tok[h][i] = slot[u.e * SLOT_CAP + (idx < u.cnt ? idx : u.cnt - 1)]; }
#pragma unroll
            for (int h = 0; h < 2; ++h)
#pragma unroll
                for (int i = 0; i < 2; ++i) { const int idx = u.mt * BM + h * HALF + R[i]; const int t = idx < u.cnt ? (tok[h][i] >> 2) : 0; off[h][i] = (unsigned)(t * rowb + C[i] * 2); }
        } else {
#pragma unroll
            for (int h = 0; h < 2; ++h)
#pragma unroll
                for (int i = 0; i < 2; ++i) off[h][i] = (unsigned)((h * HALF + R[i]) * rowb + C[i] * 2);
        }
    }
    __device__ __forceinline__ void early_poll(const Unit& u, LAS unsigned char* lds) const {
        if (threadIdx.x < 64) { const unsigned* p = cnt + 16 * u.pm; unsigned v;
            asm volatile("global_load_dword %0, %1, off sc1\n\ts_waitcnt vmcnt(0)" : "=&v"(v) : "v"(p) : "memory");
            if (threadIdx.x == 0) *(LAS unsigned*)(lds + MISC_OFF + MO_RDY) = v >= 64u ? 1u : 0u; }
    }
    __device__ __forceinline__ void a_ready(const Unit& u) const {
        if (u.type) {
            if (threadIdx.x < 64) { const unsigned* p = cnt + 16 * u.pm; unsigned v, spins = 0u;
                for (;;) { asm volatile("global_load_dword %0, %1, off sc1\n\ts_waitcnt vmcnt(0)" : "=&v"(v) : "v"(p) : "memory");
                    if ((unsigned)__builtin_amdgcn_readfirstlane(v) >= 64u) break;
                    __builtin_amdgcn_s_sleep(2);
                    if (++spins > (1u << 20)) { if (threadIdx.x == 0) __hip_atomic_store(tmo, 1u, __ATOMIC_RELAXED, __HIP_MEMORY_SCOPE_AGENT); break; } }
                }
            asm volatile("" ::: "memory"); __builtin_amdgcn_s_barrier(); asm volatile("" ::: "memory");
        }
    }
    __device__ __forceinline__ void done(const Unit& u) const {
        if (u.type == 0) { asm volatile("s_waitcnt vmcnt(0)" ::: "memory");
            if ((threadIdx.x & 63) == 0) __hip_atomic_fetch_add(cnt + 16 * u.pm, 1u, __ATOMIC_RELAXED, __HIP_MEMORY_SCOPE_AGENT); }
    }
};

typedef f32x4 Acc[2][2][4][2];

typedef int i32x8 __attribute__((ext_vector_type(8)));
struct u32x4x2 { u32x4 a, b; };
template <class Epi, class Sched, bool FP8 = false>
__device__ __forceinline__ void gemm_phase(LAS unsigned char* lds, const Sched& S, const Epi& E) {
    const int tid = threadIdx.x, wid = __builtin_amdgcn_readfirstlane(tid >> 6), lane = tid & 63, wr = wid >> 2, wc = wid & 3, fr = lane & 15, fq = lane >> 4;
    constexpr int ROWB = FP8 ? KD : KD * 2, nt = FP8 ? KD / 128 : NT_K;
    int sR[2], sC[2], sRb[2]; unsigned voffB[2];
#pragma unroll
    for (int i = 0; i < 2; ++i) { int R, C; stage_rc(tid * 16 + i * 8192, R, C); sR[i] = R; sC[i] = C; const int Rb = Epi::PERM ? ((R & ~31) + perm32(R & 31)) : R; sRb[i] = Rb; voffB[i] = S.boff(Rb, C); }
    constexpr size_t kstep = (size_t)(BK * 2);
    size_t kstepB = S.bstep_k(), kstepBn = kstepB, hstepB = S.bstep_h(), hstepBn = hstepB;
    const unsigned ldsw = (unsigned)wid * 1024u;
    const int aoff = lds_byte(wr * 64 + fr, fq * 8), boff = lds_byte(wc * 32 + fr, fq * 8);
    constexpr int KST = 1024;
#define PG8_SA(b, h) (((b) * 2 + (h)) * HTB)
#define PG8_SB(b, h) ((4 + (b) * 2 + (h)) * HTB)
#define PG8_STAGE(bufoff, gbase, voff) do { const char* _gb = (const char*)(gbase); asm volatile("" : "+s"(_gb));     \
        _Pragma("unroll") for (int _i = 0; _i < 2; ++_i) \
        __builtin_amdgcn_global_load_lds((const unsigned*)(_gb + (voff)[_i]), (LAS unsigned*)(lds + (bufoff) + ldsw + _i * 8192), 16, 0, 0); } while (0)
#define PG8_STAGE_A(bufoff, gbase, voff) do { const char* _gb = (const char*)(gbase); asm volatile("" : "+s"(_gb)); \
        _Pragma("unroll") for (int _i = 0; _i < 2; ++_i) \
        __builtin_amdgcn_global_load_lds((const unsigned*)(_gb + (voff)[_i]), (LAS unsigned*)(lds + (bufoff) + ldsw + _i * 8192), 16, 0, 0); } while (0)
#define PG8_LDA(dst, b, h) do { _Pragma("unroll") for (int m = 0; m < 4; ++m) _Pragma("unroll") for (int k = 0; k < 2; ++k) dst[m][k] = *(const LAS bf16x8*)(lds + PG8_SA(b, h) + aoff + m * 2048 + k * KST); } while (0)
#define PG8_LDB(dst, b, h) do { _Pragma("unroll") for (int n = 0; n < 2; ++n) _Pragma("unroll") for (int k = 0; k < 2; ++k) dst[n][k] = *(const LAS bf16x8*)(lds + PG8_SB(b, h) + boff + n * 2048 + k * KST); } while (0)
#define PG8_CAT(x) __builtin_bit_cast(i32x8, (u32x4x2){__builtin_bit_cast(u32x4, (x)[0]), __builtin_bit_cast(u32x4, (x)[1])})
#define PG8_MMA(ai, bj, At, Bt) do { __builtin_amdgcn_s_setprio(1); \
        if constexpr (FP8) { _Pragma("unroll") for (int m = 0; m < 4; ++m) _Pragma("unroll") for (int n = 0; n < 2; ++n) \
            acc[ai][bj][m][n] = __builtin_amdgcn_mfma_scale_f32_16x16x128_f8f6f4(PG8_CAT(Bt[n]), PG8_CAT(At[m]), acc[ai][bj][m][n], 0, 0, 0, Epi::SCALE_B, 0, Epi::SCALE_A); } \
        else { _Pragma("unroll") for (int m = 0; m < 4; ++m) _Pragma("unroll") for (int n = 0; n < 2; ++n) _Pragma("unroll") for (int k = 0; k < 2; ++k) \
            acc[ai][bj][m][n] = __builtin_amdgcn_mfma_f32_16x16x32_bf16(Bt[n][k], At[m][k], acc[ai][bj][m][n], 0, 0, 0); } \
        __builtin_amdgcn_s_setprio(0); } while (0)
#define PG8_WAIT_V(n) asm volatile("s_waitcnt vmcnt(" #n ")" ::: "memory")
#define PG8_WAIT_L(n) asm volatile("s_waitcnt lgkmcnt(" #n ")" ::: "memory")
#define PG8_BAR __builtin_amdgcn_s_barrier()
#define PG8_SCHED __builtin_amdgcn_sched_barrier(0)
    Unit cur, nxt; int ui = 0;
    if (!S.next(0, cur)) return;
    Acc acc;
    bf16x8 At[4][2], B0[2][2], B1[2][2];
    unsigned offA[2][2], offN[2][2];
    S.offsets(cur, sR, sC, offA);
    if constexpr (Sched::FUSED) { kstepB = S.bstep_kt(cur.type); hstepB = S.bstep_ht(cur.type);
#pragma unroll
        for (int i = 0; i < 2; ++i) voffB[i] = S.boff_t(cur.type, sR[i], sC[i]); }
    const char* cA = cur.A; const char* cB = cur.B;
    PG8_STAGE(PG8_SB(0, 0), cB, voffB); PG8_STAGE(PG8_SB(0, 1), cB + hstepB, voffB); PG8_STAGE_A(PG8_SA(0, 0), cA, offA[0]); PG8_STAGE_A(PG8_SA(0, 1), cA, offA[1]);
    if (wr == 1) PG8_BAR;
    PG8_WAIT_V(2); PG8_BAR;
    PG8_STAGE(PG8_SB(1, 0), cB + kstepB, voffB); PG8_STAGE_A(PG8_SA(1, 0), cA + kstep, offA[0]); PG8_STAGE(PG8_SB(1, 1), cB + hstepB + kstepB, voffB);
    PG8_WAIT_V(6); PG8_BAR;
    for (;;) {
#pragma unroll
        for (int a = 0; a < 2; ++a)
#pragma unroll
            for (int b = 0; b < 2; ++b)
#pragma unroll
                for (int m = 0; m < 4; ++m)
#pragma unroll
                    for (int n = 0; n < 2; ++n) acc[a][b][m][n] = (f32x4){0.f, 0.f, 0.f, 0.f};
        const bool has_next = S.next(ui + 1, nxt);
        const char* nA = has_next ? nxt.A : cA; const char* nB = has_next ? nxt.B : cB;
        if constexpr (Sched::FUSED) { kstepBn = has_next ? S.bstep_kt(nxt.type) : kstepB; hstepBn = has_next ? S.bstep_ht(nxt.type) : hstepB; }
        if (has_next) S.offsets(nxt, sR, sC, offN);
        else {
#pragma unroll
            for (int h = 0; h < 2; ++h)
#pragma unroll
                for (int i = 0; i < 2; ++i) offN[h][i] = offA[h][i];
        }
        if constexpr (Sched::PARK) *(LAS u32x4*)(lds + OFFN_OFF + tid * 16) = (u32x4){offN[0][0], offN[0][1], offN[1][0], offN[1][1]};
        if constexpr (Sched::FUSED) { if (has_next && nxt.type) S.early_poll(nxt, lds); }
#pragma unroll 1
        for (int t = 0; t < nt; t += 2) {
            const bool last = (t == nt - 2);
            const char* a1 = cA + (size_t)(t + 1) * kstep;
            const char* a2 = last ? nA : cA + (size_t)(t + 2) * kstep; const char* b2 = last ? nB : cB + (size_t)(t + 2) * kstepB;
            const char* a3 = a2 + kstep; const char* b3 = b2 + (last ? kstepBn : kstepB); const size_t hB = last ? hstepBn : hstepB;
            if constexpr (Sched::FUSED) { if (last && has_next && nxt.type) { const unsigned rdy = __builtin_amdgcn_readfirstlane(*(const LAS unsigned*)(lds + MISC_OFF + MO_RDY)); if (!rdy) S.a_ready(nxt); } }
            if constexpr (Epi::MID_T > 0) { if (t == Epi::MID_T) E.mid(acc, cur, wr, wc, fr, fq); }
            PG8_LDB(B0, 0, 0); PG8_LDB(B1, 0, 1); PG8_SCHED; PG8_LDA(At, 0, 0); PG8_STAGE_A(PG8_SA(1, 1), a1, offA[1]);
            PG8_WAIT_V(8); PG8_WAIT_L(0); PG8_BAR; PG8_MMA(0, 0, At, B0); PG8_MMA(0, 1, At, B1);
            asm volatile("" : "+v"(acc[0][0][0][0]), "+v"(acc[0][0][0][1]), "+v"(acc[0][0][1][0]), "+v"(acc[0][0][1][1]), "+v"(acc[0][0][2][0]), "+v"(acc[0][0][2][1]), "+v"(acc[0][0][3][0]), "+v"(acc[0][0][3][1]));
            asm volatile("" : "+v"(acc[0][1][0][0]), "+v"(acc[0][1][0][1]), "+v"(acc[0][1][1][0]), "+v"(acc[0][1][1][1]), "+v"(acc[0][1][2][0]), "+v"(acc[0][1][2][1]), "+v"(acc[0][1][3][0]), "+v"(acc[0][1][3][1]));
            PG8_BAR; PG8_SCHED;
            if (last) {
                if constexpr (Sched::FUSED) { if (has_next) {
#pragma unroll
                    for (int i = 0; i < 2; ++i) voffB[i] = S.boff_t(nxt.type, sR[i], sC[i]); } }
                if constexpr (Sched::PARK) { const u32x4 pk = *(const LAS u32x4*)(lds + OFFN_OFF + tid * 16); offA[0][0] = pk.x; offA[0][1] = pk.y; offA[1][0] = pk.z; offA[1][1] = pk.w; }
                else {
#pragma unroll
                    for (int h = 0; h < 2; ++h)
#pragma unroll
                        for (int i = 0; i < 2; ++i) offA[h][i] = offN[h][i];
                }
            }
            PG8_LDA(At, 0, 1); PG8_STAGE(PG8_SB(0, 0), b2, voffB); PG8_STAGE(PG8_SB(0, 1), b2 + hB, voffB); PG8_STAGE_A(PG8_SA(0, 0), a2, offA[0]);
            PG8_WAIT_V(8); PG8_WAIT_L(0); PG8_BAR; PG8_MMA(1, 0, At, B0); PG8_MMA(1, 1, At, B1); PG8_BAR; PG8_SCHED;
            PG8_LDB(B0, 1, 0); PG8_LDB(B1, 1, 1); PG8_SCHED; PG8_LDA(At, 1, 0); PG8_STAGE_A(PG8_SA(0, 1), a2, offA[1]);
            PG8_WAIT_V(8); PG8_WAIT_L(0); PG8_BAR; PG8_MMA(0, 0, At, B0); PG8_MMA(0, 1, At, B1); PG8_BAR; PG8_SCHED;
            PG8_LDA(At, 1, 1); PG8_STAGE(PG8_SB(1, 0), b3, voffB); PG8_STAGE(PG8_SB(1, 1), b3 + hB, voffB); PG8_STAGE_A(PG8_SA(1, 0), a3, offA[0]);
            PG8_WAIT_V(8); PG8_WAIT_L(0); PG8_BAR; PG8_MMA(1, 0, At, B0); PG8_MMA(1, 1, At, B1); PG8_BAR; PG8_SCHED;
        }
        if (wr == 0) PG8_BAR;
        E(acc, cur, wr, wc, fr, fq);
        if constexpr (Sched::FUSED) S.done(cur);
        __builtin_amdgcn_s_waitcnt(0x0F70);
        if (!has_next) break;
        cur = nxt; cA = nA; cB = nB; kstepB = kstepBn; hstepB = hstepBn; ++ui;
        if (wr == 1) PG8_BAR;
    }
    PG8_WAIT_V(0);
    PG8_BAR;
#undef PG8_SA
#undef PG8_SB
#undef PG8_STAGE
#undef PG8_STAGE_A
#undef PG8_LDA
#undef PG8_LDB
#undef PG8_MMA
#undef PG8_WAIT_V
#undef PG8_WAIT_L
#undef PG8_BAR
#undef PG8_SCHED
}

#define EPI_SEED(r, c) asm volatile("" : "+v"(r), "+v"(c))
template <class V> __device__ __forceinline__ V ldg(const void* base, unsigned off) { return *(const V*)((const char*)base + off); }
template <class V> __device__ __forceinline__ void stg(void* base, unsigned off, V v) { *(V*)((char*)base + off) = v; }
__device__ __forceinline__ u32x4 pack8(const f32x4 v0, const f32x4 v1) { u32x4 w; w.x = cvt_pk_bf16(v0[0], v0[1]); w.y = cvt_pk_bf16(v0[2], v0[3]); w.z = cvt_pk_bf16(v1[0], v1[1]); w.w = cvt_pk_bf16(v1[2], v1[3]); return w; }

struct EpiU {
    static constexpr int SCALE_B = 0, SCALE_A = 0;
    static constexpr bool PERM = true; static constexpr int MID_T = 0;
    bf16 *q, *k, *vT, *ab, *gates; const float* bias;
    __device__ __forceinline__ void mid(Acc&, const Unit&, int, int, int, int) const {}
    __device__ __forceinline__ void operator()(const Acc& acc, const Unit& u, int wr, int wc, int fr, int fq) const {
        int rl = wr * 64 + fr, cl = wc * 32 + 8 * fq; EPI_SEED(rl, cl);
        const int row0 = u.pm * BM + rl, pn = u.pn;
        f32x4 bv[2][2];
#pragma unroll
        for (int bj = 0; bj < 2; ++bj)
#pragma unroll
            for (int n = 0; n < 2; ++n) bv[bj][n] = ldg<f32x4>(bias, (unsigned)(pn * BM + bj * HALF + cl + 4 * n) * 4u);
        if (pn < 2) {
            const unsigned o0 = ((unsigned)row0 * AW + pn * BM + cl) * 2u;
#pragma unroll
            for (int ai = 0; ai < 2; ++ai)
#pragma unroll
                for (int m = 0; m < 4; ++m)
#pragma unroll
                    for (int bj = 0; bj < 2; ++bj)
                        stg<u32x4>(q, o0 + (unsigned)((ai * HALF + m * 16) * AW + bj * HALF) * 2u, pack8((acc[ai][bj][m][0] + bv[bj][0]) * 0.125f, (acc[ai][bj][m][1] + bv[bj][1]) * 0.125f));
        } else if (pn == 2) {
            const unsigned o0 = ((unsigned)row0 * KVW + cl) * 2u;
            const int b = row0 >> 12, s0 = row0 & (SEQ - 1);
#pragma unroll
            for (int ai = 0; ai < 2; ++ai)
#pragma unroll
                for (int m = 0; m < 4; ++m) {
                    stg<u32x4>(k, o0 + (unsigned)((ai * HALF + m * 16) * KVW) * 2u, pack8(acc[ai][0][m][0] + bv[0][0], acc[ai][0][m][1] + bv[0][1]));
#pragma unroll
                    for (int n = 0; n < 2; ++n) { const f32x4 v = acc[ai][1][m][n] + bv[1][n];
#pragma unroll
                        for (int j = 0; j < 4; ++j) { const int col = cl + 4 * n + j, kvh = col >> 6, dim = col & 63;
                            stg<bf16>(vT, (unsigned)(((b * NKV + kvh) * HD + dim) * SEQ + s0 + ai * HALF + m * 16) * 2u, (bf16)f2bf(v[j])); } } }
        } else if (pn < 7) {
            const unsigned o0 = ((unsigned)(row0 + AB_PAD * ((row0 >> 12) + 1)) * CCH + (pn - 3) * HALF + cl) * 2u;
#pragma unroll
            for (int ai = 0; ai < 2; ++ai)
#pragma unroll
                for (int m = 0; m < 4; ++m) { f32x4 o[2];
#pragma unroll
                    for (int n = 0; n < 2; ++n) { const f32x4 a = acc[ai][0][m][n] + bv[0][n], g = acc[ai][1][m][n] + bv[1][n];
#pragma unroll
                        for (int j = 0; j < 4; ++j) o[n][j] = a[j] * sigmoidf_(g[j]); }
                    stg<u32x4>(ab, o0 + (unsigned)((ai * HALF + m * 16) * CCH) * 2u, pack8(o[0], o[1])); }
        } else {
            const unsigned o0 = ((unsigned)row0 * 2048 + (pn - 7) * HALF + cl) * 2u;
#pragma unroll
            for (int ai = 0; ai < 2; ++ai)
#pragma unroll
                for (int m = 0; m < 4; ++m) { f32x4 ra[2], gb[2];
#pragma unroll
                    for (int n = 0; n < 2; ++n) { const f32x4 va = acc[ai][0][m][n] + bv[0][n], vb = acc[ai][1][m][n] + bv[1][n];
#pragma unroll
                        for (int j = 0; j < 4; ++j) { const float sb = sigmoidf_(vb[j]); gb[n][j] = sb; ra[n][j] = sigmoidf_(va[j]) * __builtin_amdgcn_rcpf(sb); } }
                    stg<u32x4>(gates, o0 + (unsigned)((ai * HALF + m * 16) * 2048) * 2u, pack8(ra[0], ra[1]));
                    stg<u32x4>(gates, o0 + (unsigned)((ai * HALF + m * 16) * 2048 + 1024) * 2u, pack8(gb[0], gb[1])); }
        }
    }
};
struct EpiMerged {
    static constexpr int SCALE_B = 0, SCALE_A = 0;
    static constexpr bool PERM = true; static constexpr int MID_T = 8;
    const bf16* gates; const float* bc; bf16* merged;
    __device__ __forceinline__ void mid(Acc& acc, const Unit& u, int wr, int wc, int fr, int fq) const {
        int rl = wr * 64 + fr, cl = wc * 32 + 8 * fq; EPI_SEED(rl, cl);
        const unsigned g0 = ((unsigned)(u.pm * BM + rl) * 2048 + u.pn * BM + cl) * 2u;
#pragma unroll
        for (int ai = 0; ai < 2; ++ai) { u32x4 rt[4][2];
#pragma unroll
            for (int m = 0; m < 4; ++m)
#pragma unroll
                for (int bj = 0; bj < 2; ++bj) rt[m][bj] = ldg<u32x4>(gates, g0 + (unsigned)((ai * HALF + m * 16) * 2048 + bj * HALF) * 2u);
            __builtin_amdgcn_sched_barrier(0);
#pragma unroll
            for (int m = 0; m < 4; ++m)
#pragma unroll
                for (int bj = 0; bj < 2; ++bj)
#pragma unroll
                    for (int n = 0; n < 2; ++n) { acc[ai][bj][m][n][0] *= bflo(rt[m][bj][2 * n]); acc[ai][bj][m][n][1] *= bfhi(rt[m][bj][2 * n]); acc[ai][bj][m][n][2] *= bflo(rt[m][bj][2 * n + 1]); acc[ai][bj][m][n][3] *= bfhi(rt[m][bj][2 * n + 1]); }
            __builtin_amdgcn_sched_barrier(0); }
    }
    __device__ __forceinline__ void operator()(const Acc& acc, const Unit& u, int wr, int wc, int fr, int fq) const {
        int rl = wr * 64 + fr, cl = wc * 32 + 8 * fq; EPI_SEED(rl, cl);
        const int row0 = u.pm * BM + rl, col0 = u.pn * BM + cl;
        const unsigned g0 = ((unsigned)row0 * 2048 + 1024 + col0) * 2u, m0 = ((unsigned)row0 * D + col0) * 2u;
        f32x4 bv[2][2];
#pragma unroll
        for (int bj = 0; bj < 2; ++bj)
#pragma unroll
            for (int n = 0; n < 2; ++n) bv[bj][n] = ldg<f32x4>(bc, (unsigned)(col0 + bj * HALF + 4 * n) * 4u);
#pragma unroll
        for (int ai = 0; ai < 2; ++ai)
#pragma unroll
            for (int m = 0; m < 4; ++m) {
#pragma unroll
                for (int bj = 0; bj < 2; ++bj) { const u32x4 gb = ldg<u32x4>(gates, g0 + (unsigned)((ai * HALF + m * 16) * 2048 + bj * HALF) * 2u); f32x4 o[2];
#pragma unroll
                    for (int n = 0; n < 2; ++n) { const f32x4 v = acc[ai][bj][m][n] + bv[bj][n];
                        o[n][0] = v[0] * bflo(gb[2 * n]); o[n][1] = v[1] * bfhi(gb[2 * n]); o[n][2] = v[2] * bflo(gb[2 * n + 1]); o[n][3] = v[3] * bfhi(gb[2 * n + 1]); }
                    stg<u32x4>(merged, m0 + (unsigned)((ai * HALF + m * 16) * D + bj * HALF) * 2u, pack8(o[0], o[1])); }
                if (m & 1) asm volatile("" ::: "memory"); }
    }
};
struct EpiPre1 {
    static constexpr int SCALE_B = 0, SCALE_A = 0;
    static constexpr bool PERM = true; static constexpr int MID_T = 0;
    const bf16* xb; bf16* out;
    __device__ __forceinline__ void mid(Acc&, const Unit&, int, int, int, int) const {}
    __device__ __forceinline__ void operator()(const Acc& acc, const Unit& u, int wr, int wc, int fr, int fq) const {
        int rl = wr * 64 + fr, cl = wc * 32 + 8 * fq; EPI_SEED(rl, cl);
        const unsigned o0 = ((unsigned)(u.pm * BM + rl) * D + u.pn * BM + cl) * 2u;
        u32x4 xv[2][4][2];
#pragma unroll
        for (int ai = 0; ai < 2; ++ai)
#pragma unroll
            for (int m = 0; m < 4; ++m)
#pragma unroll
                for (int bj = 0; bj < 2; ++bj) xv[ai][m][bj] = ldg<u32x4>(xb, o0 + (unsigned)((ai * HALF + m * 16) * D + bj * HALF) * 2u);
        __builtin_amdgcn_sched_barrier(0);
#pragma unroll
        for (int ai = 0; ai < 2; ++ai)
#pragma unroll
            for (int m = 0; m < 4; ++m)
#pragma unroll
                for (int bj = 0; bj < 2; ++bj) { const u32x4 w = xv[ai][m][bj];
                    const f32x4 r0 = (f32x4){bflo(w.x), bfhi(w.x), bflo(w.y), bfhi(w.y)} * DN_ALPHA + acc[ai][bj][m][0], r1 = (f32x4){bflo(w.z), bfhi(w.z), bflo(w.w), bfhi(w.w)} * DN_ALPHA + acc[ai][bj][m][1];
                    stg<u32x4>(out, o0 + (unsigned)((ai * HALF + m * 16) * D + bj * HALF) * 2u, pack8(r0, r1)); }
    }
};
struct EpiUp {
    static constexpr bool PERM = true; static constexpr int MID_T = 0;
    static constexpr int SCALE_B = 0x79797979, SCALE_A = 0x7C7C7C7C;
    const float* b_up; unsigned char* act;
    __device__ __forceinline__ void mid(Acc&, const Unit&, int, int, int, int) const {}
    __device__ __forceinline__ void operator()(const Acc& acc, const Unit& u, int wr, int wc, int fr, int fq) const {
        int rl = wr * 64 + fr, cl = wc * 32 + 8 * fq; EPI_SEED(rl, cl);
        const unsigned o0 = (unsigned)(u.pm * BM + rl) * DE + u.pn * HALF + (cl >> 1);
        f32x4 bv[2][2];
#pragma unroll
        for (int bj = 0; bj < 2; ++bj)
#pragma unroll
            for (int n = 0; n < 2; ++n) bv[bj][n] = ldg<f32x4>(b_up, (unsigned)(u.e * 2048 + u.pn * BM + cl + bj * HALF + 4 * n) * 4u);
#pragma unroll
        for (int ai = 0; ai < 2; ++ai)
#pragma unroll
            for (int m = 0; m < 4; ++m)
#pragma unroll
                for (int bj = 0; bj < 2; ++bj) { float o[4];
#pragma unroll
                    for (int n = 0; n < 2; ++n) { const f32x4 v = acc[ai][bj][m][n] + bv[bj][n];
#pragma unroll
                        for (int p = 0; p < 2; ++p) { const float xg = fminf(v[2 * p], 7.0f), xl = fminf(fmaxf(v[2 * p + 1], -7.0f), 7.0f);
                            o[2 * n + p] = xg * sigmoidf_(1.702f * xg) * (xl + 1.0f); } }
                    unsigned w = 0u; w = __builtin_amdgcn_cvt_pk_fp8_f32(o[0] * 8.0f, o[1] * 8.0f, w, false); w = __builtin_amdgcn_cvt_pk_fp8_f32(o[2] * 8.0f, o[3] * 8.0f, w, true);
                    __hip_atomic_store((unsigned*)(act + (o0 + (unsigned)((ai * HALF + m * 16) * DE + bj * 64))), w, __ATOMIC_RELAXED, __HIP_MEMORY_SCOPE_AGENT); }
    }
};
struct EpiDown {
    static constexpr bool PERM = true; static constexpr int MID_T = 0;
    static constexpr int SCALE_B = 0x79797979, SCALE_A = 0x7C7C7C7C;
    const float* b_dn; const int* slot; unsigned char* ys;
    __device__ __forceinline__ void mid(Acc&, const Unit&, int, int, int, int) const {}
    __device__ __forceinline__ void operator()(const Acc& acc, const Unit& u, int wr, int wc, int fr, int fq) const {
        int rl = wr * 64 + fr, cb = 64 * wc + 32 * (fq & 1) + 16 * (fq >> 1); EPI_SEED(rl, cb);
        const int col0 = u.pn * BM + cb, idx0 = u.mt * BM + rl;
        f32x4 bv[2][2];
#pragma unroll
        for (int bj = 0; bj < 2; ++bj)
#pragma unroll
            for (int n = 0; n < 2; ++n) bv[bj][n] = ldg<f32x4>(b_dn, (unsigned)(u.e * D + col0 + 8 * bj + 4 * n) * 4u);
        int asg[2][4];
#pragma unroll
        for (int ai = 0; ai < 2; ++ai)
#pragma unroll
            for (int m = 0; m < 4; ++m) { const int idx = idx0 + ai * HALF + m * 16; asg[ai][m] = ldg<int>(slot, (unsigned)(u.e * SLOT_CAP + (idx < u.cnt ? idx : u.cnt - 1)) * 4u); }
#pragma unroll
        for (int ai = 0; ai < 2; ++ai)
#pragma unroll
            for (int m = 0; m < 4; ++m) { const int idx = idx0 + ai * HALF + m * 16;
                if (idx < u.cnt) { u32x4 w;
#pragma unroll
                    for (int bj = 0; bj < 2; ++bj)
#pragma unroll
                        for (int n = 0; n < 2; ++n) { const f32x4 v = (acc[ai][bj][m][n] + bv[bj][n]) * 16.0f;
                            unsigned x = __builtin_amdgcn_cvt_pk_fp8_f32(v[0], v[1], 0u, false); x = __builtin_amdgcn_cvt_pk_fp8_f32(v[2], v[3], x, true); w[2 * bj + n] = x; }
                    stg<u32x4>(ys, (unsigned)asg[ai][m] * D + col0, w); } }
    }
};
struct EpiUpX {
    const float* b_up; unsigned char* act;
    __device__ __forceinline__ void operator()(const Acc& acc, const Unit& u, int wr, int wc, int fr, int fq) const {
        int rl = wr * 64 + fr, cb = 64 * wc + 32 * (fq & 1) + 16 * (fq >> 1); EPI_SEED(rl, cb);
        f32x4 bv[2][2];
#pragma unroll
        for (int bj = 0; bj < 2; ++bj)
#pragma unroll
            for (int n = 0; n < 2; ++n) bv[bj][n] = ldg<f32x4>(b_up, (unsigned)(u.e * 2048 + u.pn * BM + cb + 8 * bj + 4 * n) * 4u);
        const __amdgpu_buffer_rsrc_t rs = __builtin_amdgcn_make_buffer_rsrc(act, 0, (MAX_MT * 256) * 1024, 0x00020000);
        const unsigned o0 = (unsigned)(u.pm * BM + rl + 16 * (fq >> 1)) * DE + u.pn * HALF + 32 * wc + 16 * (fq & 1);
#pragma unroll
        for (int ai = 0; ai < 2; ++ai)
#pragma unroll
            for (int j = 0; j < 2; ++j) { unsigned d[2][2];
#pragma unroll
                for (int mm = 0; mm < 2; ++mm)
#pragma unroll
                    for (int bj = 0; bj < 2; ++bj) { float o[4];
#pragma unroll
                        for (int n = 0; n < 2; ++n) { const f32x4 v = acc[ai][bj][2 * j + mm][n] + bv[bj][n];
#pragma unroll
                            for (int p = 0; p < 2; ++p) { const float xg = fminf(v[2 * p], 7.0f), xl = fminf(fmaxf(v[2 * p + 1], -7.0f), 7.0f);
                                o[2 * n + p] = (xg * __builtin_amdgcn_rcpf(1.0f + __builtin_amdgcn_exp2f(xg * (-1.702f * 1.44269504f)))) * __builtin_fmaf(xl, 8.0f, 8.0f); } }
                        unsigned w = 0u; w = __builtin_amdgcn_cvt_pk_fp8_f32(o[0], o[1], w, false); w = __builtin_amdgcn_cvt_pk_fp8_f32(o[2], o[3], w, true); d[mm][bj] = w; }
                const u32x2 s0 = __builtin_amdgcn_permlane32_swap(d[0][0], d[1][0], false, false), s1 = __builtin_amdgcn_permlane32_swap(d[0][1], d[1][1], false, false);
                const u32x4 w4 = (u32x4){s0.x, s1.x, s0.y, s1.y};
                __builtin_amdgcn_raw_buffer_store_b128(w4, rs, o0 + (unsigned)((ai * HALF + 32 * j) * DE), 0, 16); }
    }
};
struct EpiMoe {
    static constexpr bool PERM = true; static constexpr int MID_T = 0;
    static constexpr int SCALE_B = 0x79797979, SCALE_A = 0x7C7C7C7C;
    EpiUpX up; EpiDown dn;
    __device__ __forceinline__ void mid(Acc&, const Unit&, int, int, int, int) const {}
    __device__ __forceinline__ void operator()(const Acc& acc, const Unit& u, int wr, int wc, int fr, int fq) const { if (u.type == 0) up(acc, u, wr, wc, fr, fq); else dn(acc, u, wr, wc, fr, fq); }
};
}

#define XB_TMO      128
#define XB_XCNT(j)  (256  + 64 * (j))
#define XB_XSUB(j)  (1280 + 64 * (j))
#define XB_XGEN(j)  (2304 + 64 * (j))
#define XB_TOP      3328
#define XB_TOPGEN   3392
#define XCD_BAR_WORDS 3456
#define XB_SPIN_CAP (1u << 18)
__device__ __forceinline__ unsigned xb_ld(unsigned* p)              { return __hip_atomic_load(p, __ATOMIC_RELAXED, __HIP_MEMORY_SCOPE_AGENT); }
__device__ __forceinline__ unsigned xb_add(unsigned* p, unsigned v) { return __hip_atomic_fetch_add(p, v, __ATOMIC_RELAXED, __HIP_MEMORY_SCOPE_AGENT); }
__device__ __forceinline__ unsigned xb_xcc_id() { return (unsigned)__builtin_amdgcn_s_getreg((3 << 11) | 20) & 0xFu; }
#define XB_SPIN(cond, bar) do { unsigned _sp = 0; while (cond) { __builtin_amdgcn_s_sleep(1); \
    if ((++_sp & 255u) == 0u) { if (xb_ld(&(bar)[XB_TMO])) break; if (_sp > XB_SPIN_CAP) { atomicAdd(&(bar)[XB_TMO], 1u); break; } } } } while (0)
struct XcdBarrier { unsigned* bar; unsigned x; volatile LAS unsigned* st; };
__device__ __forceinline__ XcdBarrier xcd_barrier_post(unsigned* bar, volatile LAS unsigned* st) {
    XcdBarrier b; b.bar = bar; b.x = xb_xcc_id(); b.st = st;
    if (threadIdx.x == 0) (void)xb_add(&bar[XB_XCNT(b.x)], 1u);
    return b;
}
__device__ __forceinline__ void xcd_barrier_complete(unsigned* bar, unsigned x, unsigned& nloc, unsigned& nx) {
    const unsigned G = gridDim.x * gridDim.y * gridDim.z;
    unsigned sum, cnt, mine, sp = 0u;
    for (;;) {
        sum = 0u; cnt = 0u; mine = 0u;
#pragma unroll
        for (unsigned j = 0; j < 16; ++j) { const unsigned c = xb_ld(&bar[XB_XCNT(j)]); sum += c; cnt += (c > 0u) ? 1u : 0u; mine = (j == x) ? c : mine; }
        if (sum == G) break;
        __builtin_amdgcn_s_sleep(1);
        if ((++sp & 255u) == 0u) { if (xb_ld(&bar[XB_TMO])) break; if (sp > XB_SPIN_CAP) { atomicAdd(&bar[XB_TMO], 1u); break; } }
    }
    nloc = mine > 0u ? mine : 1u; nx = cnt > 0u ? cnt : 1u;
}
__device__ __forceinline__ void xcd_barrier(const XcdBarrier& b) {
    asm volatile("s_waitcnt vmcnt(0)" ::: "memory");
    __syncthreads();
    if (threadIdx.x == 64) asm volatile("buffer_inv sc1\n\ts_waitcnt vmcnt(0)" ::: "memory");
    if (threadIdx.x == 0) {
        unsigned* bar = b.bar;
        __builtin_amdgcn_s_waitcnt(0);
        unsigned nloc = b.st[0], nx = b.st[1];
        if (nloc == 0u) { xcd_barrier_complete(bar, b.x, nloc, nx); b.st[0] = nloc; b.st[1] = nx; }
        const unsigned old = xb_add(&bar[XB_XSUB(b.x)], 1u);
        const unsigned gen = old / nloc;
        if (old + 1u == (gen + 1u) * nloc) {
            __builtin_amdgcn_fence(__ATOMIC_RELEASE, "agent");
            asm volatile("s_waitcnt vmcnt(0)" ::: "memory");
            const unsigned og = xb_add(&bar[XB_TOP], 1u);
            const unsigned tg = og / nx;
            if (og + 1u == (tg + 1u) * nx) xb_add(&bar[XB_TOPGEN], 1u);
            else XB_SPIN(xb_ld(&bar[XB_TOPGEN]) == tg, bar);
            xb_add(&bar[XB_XGEN(b.x)], 1u);
            asm volatile("s_waitcnt vmcnt(0)" ::: "memory");
        } else {
            XB_SPIN(xb_ld(&bar[XB_XGEN(b.x)]) == gen, bar);
            asm volatile("s_waitcnt vmcnt(0)" ::: "memory");
        }
    }
    __syncthreads();
}


__device__ __forceinline__ void tr_item(const float* W, int ldw, int scol0, int srow0, bf16* WT, int Kd, int drow0, int dk0, LAS float* scr, int lane) {
#pragma unroll 8
    for (int i = 0; i < 32; ++i) { const int kk = 2 * i + (lane >> 5); scr[kk * 33 + (lane & 31)] = __builtin_nontemporal_load(W + (size_t)(srow0 + kk) * ldw + scol0 + (lane & 31)); }
    LDS_WAIT(); asm volatile("" ::: "memory");
    const int c = lane & 7;
#pragma unroll
    for (int j = 0; j < 4; ++j) { const int n = (lane >> 3) + 8 * j; const LAS float* s = scr + (8 * c) * 33 + n;
        u32x4 o; o.x = pk2(s[0 * 33], s[1 * 33]); o.y = pk2(s[2 * 33], s[3 * 33]); o.z = pk2(s[4 * 33], s[5 * 33]); o.w = pk2(s[6 * 33], s[7 * 33]);
        *(u32x4*)(WT + (size_t)(drow0 + n) * Kd + dk0 + 8 * c) = o; }
    LDS_WAIT(); asm volatile("" ::: "memory");
}
__device__ __forceinline__ int src_col_u(int np) {
    if (np < 768) return np;
    if (np >= 1792) { const int tt = (np - 1792) >> 8, w = (np - 1792) & 255; return w < 128 ? 1792 + 128 * tt + w : 2816 + 128 * tt + (w - 128); }
    const int tt = (np - 768) >> 8, w = (np - 768) & 255;
    return w < 128 ? 768 + 128 * tt + w : 1280 + 128 * tt + (w - 128);
}

__device__ __forceinline__ void p0_prologue(const Args& a, LAS unsigned char* lds, int gw, int NGW, int lane, int wave) {
    unsigned char* ws = a.ws;
    LAS float* scr = (LAS float*)(lds + wave * 16384);
    constexpr int J1 = 16 * 120, J2 = 8 * 32, J3 = 8 * 32, J4 = 16 * 32;
    constexpr int NITEMS = J1 + J2 + J3 + J4;
    for (int it = gw; it < NITEMS; it += NGW) {
        int r = it;
        if (r < J1) { const int kb = r / 120, nb = r % 120; tr_item(a.in[I_WIN], INW, src_col_u(32 * nb), 64 * kb, (bf16*)(ws + WS_WIN), 1024, 32 * nb, 64 * kb, scr, lane); continue; } r -= J1;
        if (r < J2) { const int kb = r / 32, nb = r % 32; tr_item(a.in[I_WATT], D, 32 * nb, 64 * kb, (bf16*)(ws + WS_WAB), 1024, 32 * nb, 64 * kb, scr, lane); continue; } r -= J2;
        if (r < J3) { const int kb = r / 32, nb = r % 32; tr_item(a.in[I_WCONV], D, 32 * nb, 64 * kb, (bf16*)(ws + WS_WAB), 1024, 32 * nb, 512 + 64 * kb, scr, lane); continue; } r -= J3;
        { const int kb = r / 32, nb = r % 32; tr_item(a.in[I_WO], D, 32 * nb, 64 * kb, (bf16*)(ws + WS_WO), 1024, 32 * nb, 64 * kb, scr, lane); }
    }
    const float* x = a.in[I_X]; bf16* xb = (bf16*)(ws + WS_XB);
    for (int m = gw; m < T; m += NGW) {
        const f32x4* xr = (const f32x4*)(x + (size_t)m * D) + lane; u32x2* o = (u32x2*)(xb + (size_t)m * D) + lane;
#pragma unroll
        for (int j = 0; j < 4; ++j) { const f32x4 v = __builtin_nontemporal_load(xr + 64 * j); u32x2 w; w.x = pk2(v[0], v[1]); w.y = pk2(v[2], v[3]); o[64 * j] = w; }
    }
    { u32x4* abz = (u32x4*)(ws + WS_AB); const u32x4 z4 = (u32x4){0u, 0u, 0u, 0u};
      for (int i = gw * 64 + lane; i < NBATCH * AB_PAD * CCH * 2 / 16; i += NGW * 64) { const int bb = i / (AB_PAD * CCH * 2 / 16), q = i % (AB_PAD * CCH * 2 / 16); abz[(size_t)bb * (AB_SEQ * CCH * 2 / 16) + q] = z4; } }
    float* bperm = (float*)(ws + WS_BPERM);
    for (int i = gw * 64 + lane; i < INW; i += NGW * 64) bperm[i] = a.in[I_BIN][src_col_u(i)];
}

constexpr int KLS = 144, VLS = 528, ATT_V_OFF = 256 * KLS, CONV_W_OFF = 70656;
__device__ __forceinline__ void attn_unit(const Args& a, int unit, LAS unsigned char* lds, int tid, int wave, int lane) {
    const bf16* qb = (const bf16*)(a.ws + WS_QB); const bf16* kb = (const bf16*)(a.ws + WS_KB); const bf16* vT = (const bf16*)(a.ws + WS_VT); bf16* ay = (bf16*)(a.ws + WS_AY);
    const int kvh = unit & 1, blk = (unit >> 1) & 31, b = unit >> 6;
    const int r = lane & 15, qd = lane >> 4, w = wave;
    const int t0 = b * SEQ + blk * 128, seq0 = b * SEQ, lo = w & ~1;
    { u32x4 kreg[4], vreg[4];
#pragma unroll
      for (int i = 0; i < 4; ++i) { const int c = tid + 512 * i;
          int tok = t0 - 128 + (c >> 3); tok = tok < seq0 ? seq0 : tok;
          kreg[i] = ldgo<u32x4>(kb, (unsigned)(tok * KVW + kvh * HD + (c & 7) * 8) * 2u);
          int sk = blk * 128 - 128 + 8 * (c & 31); sk = sk < 0 ? 0 : sk;
          vreg[i] = ldgo<u32x4>(vT, (unsigned)(((b * NKV + kvh) * HD + (c >> 5)) * SEQ + sk) * 2u); }
      __builtin_amdgcn_sched_barrier(0);
      asm volatile("" : "+v"(kreg[0]), "+v"(kreg[1]), "+v"(kreg[2]), "+v"(kreg[3]), "+v"(vreg[0]), "+v"(vreg[1]), "+v"(vreg[2]), "+v"(vreg[3]));
#pragma unroll
      for (int i = 0; i < 4; ++i) { const int c = tid + 512 * i;
          *(LAS u32x4*)(lds + (c >> 3) * KLS + (c & 7) * 16) = kreg[i];
          *(LAS u32x4*)(lds + ATT_V_OFF + (c >> 5) * VLS + (c & 31) * 16) = vreg[i]; } }
    __syncthreads();
    const int qi = 16 * w + r;
#pragma unroll 1
    for (int hh = 0; hh < 4; ++hh) {
        const int head = kvh * 4 + hh;
        u32x4 qf[2];
        { const unsigned qo = (unsigned)((t0 + qi) * AW + head * HD + 8 * qd) * 2u; qf[0] = ldgo<u32x4>(qb, qo); qf[1] = ldgo<u32x4>(qb, qo + 64u); }
        const float sinkv = a.in[I_SINK][head];
        int qiv = qi; asm volatile("" : "+v"(qiv));
        const int klo = max(qiv + 1, blk > 0 ? 0 : 128); const int kjb = lo * 16 + 4 * qd - klo; const unsigned span = (unsigned)(qiv + 128 - klo);
        f32x4 s[10];
#pragma unroll
        for (int i = 0; i < 10; ++i) {
            const LAS unsigned char* kp = lds + ((lo + i) * 16 + r) * KLS + qd * 16;
            const u32x4 k0 = *(const LAS u32x4*)kp, k1 = *(const LAS u32x4*)(kp + 64);
            f32x4 z = (f32x4){0.f, 0.f, 0.f, 0.f};
            z = __builtin_amdgcn_mfma_f32_16x16x32_bf16(__builtin_bit_cast(bf16x8, k0), __builtin_bit_cast(bf16x8, qf[0]), z, 0, 0, 0);
            s[i] = __builtin_amdgcn_mfma_f32_16x16x32_bf16(__builtin_bit_cast(bf16x8, k1), __builtin_bit_cast(bf16x8, qf[1]), z, 0, 0, 0);
        }
        float mx = sinkv;
#pragma unroll
        for (int i = 0; i < 10; ++i)
#pragma unroll
            for (int g = 0; g < 4; ++g) { const bool valid = (unsigned)(kjb + (16 * i + g)) <= span; s[i][g] = valid ? s[i][g] : -1e30f; mx = fmaxf(mx, s[i][g]); }
        mx = fmaxf(mx, __shfl_xor(mx, 16)); mx = fmaxf(mx, __shfl_xor(mx, 32));
        float sum = 0.f;
#pragma unroll
        for (int i = 0; i < 10; ++i)
#pragma unroll
            for (int g = 0; g < 4; ++g) { const float p = (s[i][g] > -1e29f) ? __expf(s[i][g] - mx) : 0.f; s[i][g] = p; sum += p; }
        sum += __shfl_xor(sum, 16); sum += __shfl_xor(sum, 32);
        const float inv = 1.0f / (sum + __expf(sinkv - mx));
        f32x4 o[4];
#pragma unroll
        for (int mt = 0; mt < 4; ++mt) o[mt] = (f32x4){0.f, 0.f, 0.f, 0.f};
#pragma unroll
        for (int ip = 0; ip < 5; ++ip) {
            u32x4 pw; pw.x = cvt_pk_bf16(s[2 * ip][0], s[2 * ip][1]); pw.y = cvt_pk_bf16(s[2 * ip][2], s[2 * ip][3]); pw.z = cvt_pk_bf16(s[2 * ip + 1][0], s[2 * ip + 1][1]); pw.w = cvt_pk_bf16(s[2 * ip + 1][2], s[2 * ip + 1][3]);
            const bf16x8 pb = __builtin_bit_cast(bf16x8, pw);
#pragma unroll
            for (int mt = 0; mt < 4; ++mt) { const LAS unsigned char* vp = lds + ATT_V_OFF + (16 * mt + r) * VLS + ((lo + 2 * ip) * 16 + 4 * qd) * 2;
                const u32x2 va = *(const LAS u32x2*)vp, vb = *(const LAS u32x2*)(vp + 32);
                u32x4 vw; vw.x = va.x; vw.y = va.y; vw.z = vb.x; vw.w = vb.y;
                o[mt] = __builtin_amdgcn_mfma_f32_16x16x32_bf16(__builtin_bit_cast(bf16x8, vw), pb, o[mt], 0, 0, 0); }
        }
        const unsigned oo = (unsigned)((t0 + qi) * D + head * HD + 4 * qd) * 2u;
#pragma unroll
        for (int mt = 0; mt < 4; ++mt) { u32x2 wv; wv.x = cvt_pk_bf16(o[mt][0] * inv, o[mt][1] * inv); wv.y = cvt_pk_bf16(o[mt][2] * inv, o[mt][3] * inv); *(u32x2*)((char*)ay + oo + 32u * mt) = wv; }
    }
    __syncthreads();
}

constexpr int CBS = 516;
__device__ __forceinline__ void conv_unit(const Args& a, int unit, LAS unsigned char* lds, int tid, int wave, int lane) {
    const bf16* ab = (const bf16*)(a.ws + WS_AB); bf16* ay = (bf16*)(a.ws + WS_AY);
    LAS float* cb = (LAS float*)lds;
    const int t0 = unit * 32, prow0 = t0 + AB_PAD * ((t0 >> 12) + 1);
    int cp = tid & 255; asm volatile("" : "+v"(cp));
    const int half = wave >> 2;
    const LAS float* wl = (const LAS float*)(lds + CONV_W_OFF) + 2 * cp;
    const f32x2 cbias = *(const f32x2*)(a.in[I_CONVB] + 2 * cp);
#pragma unroll 1
    for (int it = 0; it < 2; ++it) {
        const int tl0 = 16 * half + 8 * it;
        const unsigned o0 = (unsigned)((prow0 + tl0 - 30) * CCH + 2 * cp) * 2u;
        unsigned raw[38];
#pragma unroll
        for (int rr = 0; rr < 38; ++rr) raw[rr] = ldgo<unsigned>(ab, o0 + (unsigned)(rr * CCH * 2));
        __builtin_amdgcn_sched_barrier(0);
        asm volatile("" : "+v"(raw[0]), "+v"(raw[1]), "+v"(raw[2]), "+v"(raw[3]), "+v"(raw[4]), "+v"(raw[5]), "+v"(raw[6]), "+v"(raw[7]), "+v"(raw[8]), "+v"(raw[9]),
                          "+v"(raw[10]), "+v"(raw[11]), "+v"(raw[12]), "+v"(raw[13]), "+v"(raw[14]), "+v"(raw[15]), "+v"(raw[16]), "+v"(raw[17]), "+v"(raw[18]));
        asm volatile("" : "+v"(raw[19]), "+v"(raw[20]), "+v"(raw[21]), "+v"(raw[22]), "+v"(raw[23]), "+v"(raw[24]), "+v"(raw[25]), "+v"(raw[26]), "+v"(raw[27]), "+v"(raw[28]),
                          "+v"(raw[29]), "+v"(raw[30]), "+v"(raw[31]), "+v"(raw[32]), "+v"(raw[33]), "+v"(raw[34]), "+v"(raw[35]), "+v"(raw[36]), "+v"(raw[37]));
        float i0[38], i1[38];
#pragma unroll
        for (int rr = 0; rr < 38; ++rr) { i0[rr] = bflo(raw[rr]); i1[rr] = bfhi(raw[rr]); }
        float a0[8], a1[8];
#pragma unroll
        for (int o = 0; o < 8; ++o) { a0[o] = cbias.x; a1[o] = cbias.y; }
#pragma unroll
        for (int j = 0; j < CW; ++j) { const f32x2 wv = *(const LAS f32x2*)(wl + j * CCH);
#pragma unroll
            for (int o = 0; o < 8; ++o) { a0[o] = fmaf(i0[o + j], wv.x, a0[o]); a1[o] = fmaf(i1[o + j], wv.y, a1[o]); } }
#pragma unroll
        for (int o = 0; o < 8; ++o) *(LAS f32x2*)(cb + (tl0 + o) * CBS + 2 * cp) = (f32x2){a0[o], a1[o]};
    }
    __syncthreads();
    const f32x4 g0 = *(const f32x4*)(a.in[I_CLNG] + 8 * lane), g1 = *(const f32x4*)(a.in[I_CLNG] + 8 * lane + 4), b0 = *(const f32x4*)(a.in[I_CLNB] + 8 * lane), b1 = *(const f32x4*)(a.in[I_CLNB] + 8 * lane + 4);
#pragma unroll
    for (int tt = 0; tt < 4; ++tt) { const int tok = 4 * wave + tt;
        f32x4 v0 = *(const LAS f32x4*)(cb + tok * CBS + 8 * lane), v1 = *(const LAS f32x4*)(cb + tok * CBS + 8 * lane + 4);
        const float mean = wave_sum((v0[0] + v0[1]) + (v0[2] + v0[3]) + (v1[0] + v1[1]) + (v1[2] + v1[3])) * (1.0f / CCH);
        v0 = v0 - mean; v1 = v1 - mean;
        const float var = wave_sum((v0[0] * v0[0] + v0[1] * v0[1]) + (v0[2] * v0[2] + v0[3] * v0[3]) + (v1[0] * v1[0] + v1[1] * v1[1]) + (v1[2] * v1[2] + v1[3] * v1[3])) * (1.0f / CCH);
        const float rstd = 1.0f / sqrtf(var + LN_EPS);
        float y[8];
#pragma unroll
        for (int j = 0; j < 4; ++j) { const float y0 = v0[j] * rstd * g0[j] + b0[j], y1 = v1[j] * rstd * g1[j] + b1[j]; y[j] = y0 * sigmoidf_(y0); y[4 + j] = y1 * sigmoidf_(y1); }
        u32x4 wv; wv.x = cvt_pk_bf16(y[0], y[1]); wv.y = cvt_pk_bf16(y[2], y[3]); wv.z = cvt_pk_bf16(y[4], y[5]); wv.w = cvt_pk_bf16(y[6], y[7]);
        *(u32x4*)(ay + (size_t)(t0 + tok) * D + 512 + 8 * lane) = wv; }
    __syncthreads();
}

constexpr int HLS = 1025;
__device__ __forceinline__ void route_chunk(const Args& a, int chunk, LAS unsigned char* lds, int tid, int wave, int lane, const float (&bw)[64], const f32x4 (&g)[4], const f32x4 (&bb)[4]) {
    const bf16* hf = (const bf16*)(a.ws + WS_HF); unsigned char* hb = a.ws + WS_HB;
    int* slot = (int*)(a.ws + WS_SLOT); float* gatev = (float*)(a.ws + WS_GATE); unsigned* cursor = (unsigned*)(a.ws + WS_CTL);
    LAS float* hl = (LAS float*)lds;
    LAS float* lg = (LAS float*)(lds + MISC_OFF + MO_LG); LAS int* sel_e = (LAS int*)(lds + MISC_OFF + MO_SELE); LAS float* sel_g = (LAS float*)(lds + MISC_OFF + MO_SELG);
    LAS int* lcnt = (LAS int*)(lds + MISC_OFF + MO_LCNT); LAS int* lbase = (LAS int*)(lds + MISC_OFF + MO_LBASE);
    const int t0 = chunk * 32;
    f32x4 v[4][4];
    { u32x2 rw[4][4];
#pragma unroll
      for (int tt = 0; tt < 4; ++tt)
#pragma unroll
        for (int j = 0; j < 4; ++j) rw[tt][j] = *((const u32x2*)(hf + (size_t)(t0 + 4 * wave + tt) * D) + lane + 64 * j);
      __builtin_amdgcn_sched_barrier(0);
      asm volatile("" : "+v"(rw[0][0]), "+v"(rw[0][1]), "+v"(rw[0][2]), "+v"(rw[0][3]), "+v"(rw[1][0]), "+v"(rw[1][1]), "+v"(rw[1][2]), "+v"(rw[1][3]),
                        "+v"(rw[2][0]), "+v"(rw[2][1]), "+v"(rw[2][2]), "+v"(rw[2][3]), "+v"(rw[3][0]), "+v"(rw[3][1]), "+v"(rw[3][2]), "+v"(rw[3][3]));
#pragma unroll
      for (int tt = 0; tt < 4; ++tt)
#pragma unroll
        for (int j = 0; j < 4; ++j) v[tt][j] = (f32x4){bflo(rw[tt][j].x), bfhi(rw[tt][j].x), bflo(rw[tt][j].y), bfhi(rw[tt][j].y)}; }
#pragma unroll
    for (int tt = 0; tt < 4; ++tt) { const int tl = 4 * wave + tt;
        float sm = 0.f;
#pragma unroll
        for (int j = 0; j < 4; ++j) sm += (v[tt][j][0] + v[tt][j][1]) + (v[tt][j][2] + v[tt][j][3]);
        const float mean = wave_sum(sm) * (1.0f / D); float s2 = 0.f;
#pragma unroll
        for (int j = 0; j < 4; ++j) { v[tt][j] = v[tt][j] - mean; s2 += (v[tt][j][0] * v[tt][j][0] + v[tt][j][1] * v[tt][j][1]) + (v[tt][j][2] * v[tt][j][2] + v[tt][j][3] * v[tt][j][3]); }
        const float rstd = 1.0f / sqrtf(wave_sum(s2) * (1.0f / D) + LN_EPS);
        if (lane == 0) *(f32x2*)((float*)(a.ws + WS_LN1S) + 2 * (size_t)(t0 + tl)) = (f32x2){mean, rstd};
#pragma unroll
        for (int j = 0; j < 4; ++j) { const f32x4 h = v[tt][j] * rstd * g[j] + bb[j];
            unsigned wv = 0u; wv = __builtin_amdgcn_cvt_pk_fp8_f32(h[0] * 8.0f, h[1] * 8.0f, wv, false); wv = __builtin_amdgcn_cvt_pk_fp8_f32(h[2] * 8.0f, h[3] * 8.0f, wv, true); *((unsigned*)(hb + (size_t)(t0 + tl) * D) + lane + 64 * j) = wv;
            LAS float* hp = hl + tl * HLS + 4 * lane + 256 * j; hp[0] = h[0]; hp[1] = h[1]; hp[2] = h[2]; hp[3] = h[3]; }
    }
    if (tid < 32) lcnt[tid] = 0;
    __syncthreads();
    f32x16 acc;
#pragma unroll
    for (int i = 0; i < 16; ++i) acc[i] = 0.f;
    { const int tok = lane & 31, kp = lane >> 5; const LAS float* hp = hl + tok * HLS + 128 * wave + kp;
#pragma unroll
      for (int s = 0; s < 64; ++s) acc = __builtin_amdgcn_mfma_f32_32x32x2f32(hp[2 * s], bw[s], acc, 0, 0, 0); }
    __syncthreads();
    { LAS float* part = hl + wave * 1024;
#pragma unroll
      for (int i = 0; i < 16; ++i) { const int rowi = (i & 3) + 8 * (i >> 2) + 4 * (lane >> 5); part[rowi * 32 + (lane & 31)] = acc[i]; } }
    __syncthreads();
    for (int o = tid; o < 1024; o += 512) { float sm = a.in[I_BR][o & 31];
#pragma unroll
        for (int w = 0; w < 8; ++w) sm += hl[w * 1024 + o];
        lg[(o >> 5) * 33 + (o & 31)] = sm; }
    __syncthreads();
    if (tid < 32) { float v[NE];
#pragma unroll
        for (int e = 0; e < NE; ++e) v[e] = lg[tid * 33 + e];
        float tv[4]; int ti[4];
#pragma unroll
        for (int k = 0; k < 4; ++k) { float best = -3.0e38f; int bi = 0;
#pragma unroll
            for (int e = 0; e < NE; ++e) { const bool take = v[e] > best; best = take ? v[e] : best; bi = take ? e : bi; }
            tv[k] = best; ti[k] = bi;
#pragma unroll
            for (int e = 0; e < NE; ++e) v[e] = (e == bi) ? -3.0e38f : v[e]; }
        const float e1 = __expf(tv[1] - tv[0]), e2 = __expf(tv[2] - tv[0]), e3 = __expf(tv[3] - tv[0]); const float inv = 1.0f / (1.0f + e1 + e2 + e3);
        sel_e[4 * tid + 0] = ti[0]; sel_e[4 * tid + 1] = ti[1]; sel_e[4 * tid + 2] = ti[2]; sel_e[4 * tid + 3] = ti[3];
        sel_g[4 * tid + 0] = inv; sel_g[4 * tid + 1] = e1 * inv; sel_g[4 * tid + 2] = e2 * inv; sel_g[4 * tid + 3] = e3 * inv; }
    __syncthreads();
    int my_e = 0, my_rank = 0;
    if (tid < 128) { my_e = sel_e[tid]; my_rank = atomicAdd((int*)&lcnt[my_e], 1); }
    __syncthreads();
    if (tid < 32) { const int c = lcnt[tid]; lbase[tid] = c > 0 ? (int)atomicAdd(cursor + tid, (unsigned)c) : 0; }
    __syncthreads();
    if (tid < 128) { const int asg = (t0 + (tid >> 2)) * 4 + (tid & 3); slot[my_e * SLOT_CAP + lbase[my_e] + my_rank] = asg; gatev[asg] = sel_g[tid]; }
    __syncthreads();
}

__device__ __forceinline__ void combine_row(const Args& a, int m, int lane) {
    const bf16* hf = (const bf16*)(a.ws + WS_HF); const unsigned char* ys = a.ws + WS_YS; const float* gatev = (const float*)(a.ws + WS_GATE);
    f32x4 gt = *(const f32x4*)(gatev + 4 * (size_t)m); gt = gt * (1.0f / 16.0f);
    const f32x2 st = *(const f32x2*)((const float*)(a.ws + WS_LN1S) + 2 * (size_t)m);
    f32x4 v[4]; float sm = 0.f;
#pragma unroll
    for (int j = 0; j < 4; ++j) { const f32x4 g1 = *((const f32x4*)a.in[I_LN1G] + lane + 64 * j), b1 = *((const f32x4*)a.in[I_LN1B] + lane + 64 * j);
        const u32x2 pw = *((const u32x2*)(hf + (size_t)m * D) + lane + 64 * j); f32x4 p = (f32x4){bflo(pw.x), bfhi(pw.x), bflo(pw.y), bfhi(pw.y)}; p = p - st.x; const f32x4 h = p * st.y * g1 + b1;
        v[j] = h * DN_ALPHA;
#pragma unroll
        for (int k = 0; k < 4; ++k) { const unsigned y = *((const unsigned*)(ys + ((size_t)m * 4 + k) * D) + lane + 64 * j); const float gk = gt[k];
            const f32x2 lo = __builtin_amdgcn_cvt_pk_f32_fp8(y, false), hi = __builtin_amdgcn_cvt_pk_f32_fp8(y, true);
            v[j][0] += gk * lo.x; v[j][1] += gk * lo.y; v[j][2] += gk * hi.x; v[j][3] += gk * hi.y; }
        sm += (v[j][0] + v[j][1]) + (v[j][2] + v[j][3]); }
    const float mean = wave_sum(sm) * (1.0f / D); float s2 = 0.f;
#pragma unroll
    for (int j = 0; j < 4; ++j) { v[j] = v[j] - mean; s2 += (v[j][0] * v[j][0] + v[j][1] * v[j][1]) + (v[j][2] * v[j][2] + v[j][3] * v[j][3]); }
    const float rstd = 1.0f / sqrtf(wave_sum(s2) * (1.0f / D) + LN_EPS);
#pragma unroll
    for (int j = 0; j < 4; ++j) { const f32x4 g = *((const f32x4*)a.in[I_LN2G] + lane + 64 * j), bb = *((const f32x4*)a.in[I_LN2B] + lane + 64 * j);
        *((f32x4*)(a.out + (size_t)m * D) + lane + 64 * j) = v[j] * rstd * g + bb; }
}

__global__ void __launch_bounds__(512, 2) fwd_megakernel(Args args) {
    extern __shared__ __attribute__((aligned(16))) unsigned char lds_raw[];
    LAS unsigned char* lds = (LAS unsigned char*)lds_raw;
    const int tid = threadIdx.x, wave = __builtin_amdgcn_readfirstlane(tid >> 6);
#define FRESH_LANE int lane; { int t_ = tid; asm volatile("" : "+v"(t_)); lane = t_ & 63; }
    const int G = gridDim.x, bx = blockIdx.x;
    const int vcu = (G % 8 == 0) ? (bx % 8) * (G / 8) + bx / 8 : bx;
    const int gw = vcu * 8 + wave, NGW = G * 8;
    const int lo = args.ph_lo, hi = args.ph_hi;
    unsigned char* ws = args.ws;
    volatile LAS unsigned* bst = (volatile LAS unsigned*)(lds + MISC_OFF + MO_BAR);
    if (tid < 2) bst[tid] = 0u;
    __syncthreads();
    XcdBarrier xbar = xcd_barrier_post((unsigned*)(ws + WS_CTL) + CW_BAR, bst);
#ifndef PMASK
#define PMASK 0x1ff
#endif
#define IN(k) (((PMASK >> (k)) & 1) && lo <= (k) && (k) < hi)
#define SEAM(k) do { if (lo <= (k) && (k) + 1 < hi) xcd_barrier(xbar); } while (0)

    if (IN(0)) { FRESH_LANE; p0_prologue(args, lds, gw, NGW, lane, wave); }
    SEAM(0);
    if (IN(1)) {
        pg8::DenseOrder S; S.init(ws + WS_XB, ws + WS_WIN, T, INW, G, bx);
        pg8::EpiU E{(bf16*)(ws + WS_QB), (bf16*)(ws + WS_KB), (bf16*)(ws + WS_VT), (bf16*)(ws + WS_AB), (bf16*)(ws + WS_GATES), (const float*)(ws + WS_BPERM)};
        const int slot = vcu & 3;
        S.i0 = 0; S.i1 = slot;
        pg8::gemm_phase<pg8::EpiU, pg8::DenseOrder>(lds, S, E);
        { FRESH_LANE; side_convert(args, bx, G, wave, lane); }
        S.i0 = slot; S.i1 = 1 << 20;
        pg8::gemm_phase<pg8::EpiU, pg8::DenseOrder>(lds, S, E);
    }
    SEAM(1);
    if (IN(2)) {
        FRESH_LANE;
        __syncthreads();
        for (int i = tid; i < CW * CCH / 4; i += 512) ((LAS f32x4*)(lds + CONV_W_OFF))[i] = ((const f32x4*)args.in[I_CONVW])[i];
        __syncthreads();
        for (int u = vcu; u < 256 + 512; u += G) {
            if (u < 256) attn_unit(args, u, lds, tid, wave, lane);
            else conv_unit(args, u - 256, lds, tid, wave, lane);
        }
    }
    SEAM(2);
    if (IN(3)) {
        pg8::DenseOrder S; S.init(ws + WS_AY, ws + WS_WAB, T, D, G, bx);
        pg8::EpiMerged E{(const bf16*)(ws + WS_GATES), args.in[I_BCONV], (bf16*)(ws + WS_MERGED)};
        pg8::gemm_phase<pg8::EpiMerged, pg8::DenseOrder>(lds, S, E);
    }
    SEAM(3);
    if (IN(4)) {
        pg8::DenseOrder S; S.init(ws + WS_MERGED, ws + WS_WO, T, D, G, bx);
        pg8::EpiPre1 E{(const bf16*)(ws + WS_XB), (bf16*)(ws + WS_HF)};
        pg8::gemm_phase<pg8::EpiPre1, pg8::DenseOrder>(lds, S, E);
    }
    SEAM(4);
    if (IN(5)) {
        FRESH_LANE;
        __syncthreads();
        float bw[64]; f32x4 g1[4], b1[4];
#pragma unroll
        for (int s_ = 0; s_ < 64; ++s_) bw[s_] = args.in[I_WR][(size_t)(128 * wave + 2 * s_ + (lane >> 5)) * NE + (lane & 31)];
#pragma unroll
        for (int j = 0; j < 4; ++j) { g1[j] = *((const f32x4*)args.in[I_LN1G] + lane + 64 * j); b1[j] = *((const f32x4*)args.in[I_LN1B] + lane + 64 * j); }
        for (int c = vcu; c < T / 32; c += G) route_chunk(args, c, lds, tid, wave, lane, bw, g1, b1);
    }
    SEAM(5);
    if (IN(6) || IN(7)) {
        LAS int* tab = (LAS int*)(lds + MISC_OFF + MO_TAB);
        __syncthreads();
        if (tid == 0) { const unsigned* cursor = (const unsigned*)(ws + WS_CTL); int acc = 0;
            for (int e = 0; e < NE; ++e) { const int c = (int)__hip_atomic_load(cursor + e, __ATOMIC_RELAXED, __HIP_MEMORY_SCOPE_AGENT); tab[e] = c; const int ml = (c + 255) >> 8; tab[32 + e] = ml; tab[64 + e] = acc; acc += ml; }
            tab[64 + NE] = acc; }
        __syncthreads();
        const int total_mt = tab[64 + NE];
        if (IN(6)) {
            unsigned* ctl = (unsigned*)(ws + WS_CTL);
            pg8::MoeFusedOrder S{tab, G, vcu, total_mt * 8, total_mt * 4, (const char*)(ws + WS_HB), (const char*)(ws + WS_ACT), (const char*)(ws + WS_WUP), (const char*)(ws + WS_WDN), (const int*)(ws + WS_SLOT), ctl + 8192, ctl + 64};
            pg8::EpiMoe E{pg8::EpiUpX{args.in[I_BUP], ws + WS_ACT}, pg8::EpiDown{args.in[I_BDN], (const int*)(ws + WS_SLOT), ws + WS_YS}};
            pg8::gemm_phase<pg8::EpiMoe, pg8::MoeFusedOrder, true>(lds, S, E);
        }
    }
    SEAM(7);
    if (IN(8)) { FRESH_LANE; for (int m = gw; m < T; m += NGW) combine_row(args, m, lane); }

#undef IN
#undef SEAM
#undef FRESH_LANE
}

extern "C" void kernel_launch(void* const* d_in, const int* in_sizes, int n_in, void* d_out, int out_size, void* d_ws, size_t ws_size, hipStream_t stream) {
    static int grid = 0;
    if (grid == 0) {
        if (n_in != 22 || out_size != T * D || ws_size < WS_END) { fprintf(stderr, "kernel_launch: unexpected problem (n_in %d, out %d, ws %zu)\n", n_in, out_size, ws_size); grid = -1; return; }
        int dev = 0, cus = 0, per_cu = 0;
        hipGetDevice(&dev); hipDeviceGetAttribute(&cus, hipDeviceAttributeMultiprocessorCount, dev);
        hipFuncSetAttribute((const void*)fwd_megakernel, hipFuncAttributeMaxDynamicSharedMemorySize, LDS_BYTES);
        hipOccupancyMaxActiveBlocksPerMultiprocessor(&per_cu, (const void*)fwd_megakernel, 512, LDS_BYTES);
        if (per_cu < 1) { fprintf(stderr, "kernel_launch: occupancy query says %d blocks per CU\n", per_cu); per_cu = 1; }
        (void)hipGetLastError();
        grid = cus * 1;
        fprintf(stderr, "kernel_launch: grid %d (cus %d, occupancy %d)\n", grid, cus, per_cu);
    }
    if (grid < 0) return;
    hipMemsetAsync((char*)d_ws + WS_CTL, 0, 65536, stream);
    Args a{};
    for (int i = 0; i < 22; ++i) a.in[i] = (const float*)d_in[i];
    a.out = (float*)d_out; a.ws = (unsigned char*)d_ws; a.ph_lo = 0; a.ph_hi = 9;
    void* kargs[] = {&a};
    hipError_t e = hipLaunchCooperativeKernel((const void*)fwd_megakernel, dim3(grid), dim3(512), kargs, LDS_BYTES, stream);
    if (e != hipSuccess) fprintf(stderr, "cooperative launch failed: %s (grid %d)\n", hipGetErrorString(e), grid);
}
```

```cpp
#include <hip/hip_runtime.h>
#include <cstdio>
#include <cstdint>

#define GAS __attribute__((address_space(1)))
#define LAS __attribute__((address_space(3)))
typedef unsigned short bf16;
typedef short bf16x8 __attribute__((ext_vector_type(8)));
typedef float f32x4 __attribute__((ext_vector_type(4)));
typedef float f32x2 __attribute__((ext_vector_type(2)));
typedef float f32x16 __attribute__((ext_vector_type(16)));
typedef unsigned u32x4 __attribute__((ext_vector_type(4)));
typedef unsigned u32x2 __attribute__((ext_vector_type(2)));

constexpr int T = 16384, D = 1024, SEQ = 4096, NBATCH = 4;
constexpr int NH = 8, NKV = 2, HD = 64, AW = 512, KVW = 128, CCH = 512, CW = 31;
constexpr int INW = 3840, NE = 32, TOPK = 4, DE = 1024;
constexpr float LN_EPS = 1e-5f;
constexpr float DN_ALPHA = 1.189207115002721f;
constexpr int SLOT_CAP = 16384;
constexpr int MAX_MT = (T * TOPK) / 256 + NE;

constexpr size_t MiB = 1u << 20;
constexpr size_t WS_CTL = 0, CTL_BYTES = 65536;
constexpr int CW_BAR = 4096;
constexpr size_t WS_WIN = 1 * MiB;
constexpr size_t WS_WAB = 9 * MiB;
constexpr size_t WS_WO = 11 * MiB;
constexpr size_t WS_BPERM = 13 * MiB;
constexpr size_t WS_SLOT = 14 * MiB;
constexpr size_t WS_GATE = 16 * MiB;
constexpr size_t WS_LN1S = 17 * MiB;
constexpr size_t WS_WUP = 32 * MiB;
constexpr size_t WS_WDN = 160 * MiB;
constexpr size_t WS_XB = 224 * MiB;
constexpr size_t WS_QB = 256 * MiB;
constexpr size_t WS_KB = 272 * MiB;
constexpr size_t WS_VT = 276 * MiB;
constexpr size_t WS_AB = 792 * MiB;
constexpr size_t WS_GATES = 296 * MiB;
constexpr size_t WS_AY = 360 * MiB;
constexpr size_t WS_MERGED = 392 * MiB;
constexpr size_t WS_HF = 424 * MiB;
constexpr size_t WS_HB = 488 * MiB;
constexpr size_t WS_ACT = 520 * MiB;
constexpr size_t WS_YS = 664 * MiB;
constexpr size_t WS_END = 810 * MiB;
constexpr int AB_PAD = 32, AB_SEQ = SEQ + AB_PAD;

constexpr int LDS_SCR = 135168;
constexpr int MISC_OFF = 135168;
constexpr int MO_LG = 0, MO_SELE = 4224, MO_SELG = 4736, MO_LCNT = 5248, MO_LBASE = 5376, MO_TAB = 5504, MO_BAR = 6016, MO_RDY = 6080;
constexpr int OFFN_OFF = 147456;
constexpr int LDS_BYTES = 155648;

#define LDS_WAIT() asm volatile("s_waitcnt lgkmcnt(0)" ::: "memory")
#define VM_WAIT() asm volatile("s_waitcnt vmcnt(0)" ::: "memory")

__device__ __forceinline__ unsigned f2bf(float f) { unsigned u = __builtin_bit_cast(unsigned, f); return (u + 0x7fffu + ((u >> 16) & 1u)) >> 16; }
__device__ __forceinline__ unsigned pk2(float lo, float hi) { return f2bf(lo) | (f2bf(hi) << 16); }
__device__ __forceinline__ float bf2f(unsigned b) { return __builtin_bit_cast(float, b << 16); }
__device__ __forceinline__ float bflo(unsigned w) { return __builtin_bit_cast(float, w << 16); }
__device__ __forceinline__ float bfhi(unsigned w) { return __builtin_bit_cast(float, w & 0xffff0000u); }
typedef __bf16 bf16x2_t __attribute__((ext_vector_type(2)));
__device__ __forceinline__ unsigned cvt_pk_bf16(float lo, float hi) { const f32x2 v = {lo, hi}; return __builtin_bit_cast(unsigned, __builtin_convertvector(v, bf16x2_t)); }
__device__ __forceinline__ float sigmoidf_(float x) { return __builtin_amdgcn_rcpf(1.0f + __expf(-x)); }
#define DPP_ADD(v, ctrl) ((v) + __builtin_bit_cast(float, __builtin_amdgcn_update_dpp(0, __builtin_bit_cast(int, (v)), (ctrl), 0xf, 0xf, true)))
__device__ __forceinline__ float wave_sum(float v) {
    v = DPP_ADD(v, 0xB1);
    v = DPP_ADD(v, 0x4E);
    v = DPP_ADD(v, 0x141);
    v = DPP_ADD(v, 0x140);
    const int vi = __builtin_bit_cast(int, v);
    const float r0 = __builtin_bit_cast(float, __builtin_amdgcn_readlane(vi, 0)), r1 = __builtin_bit_cast(float, __builtin_amdgcn_readlane(vi, 16));
    const float r2 = __builtin_bit_cast(float, __builtin_amdgcn_readlane(vi, 32)), r3 = __builtin_bit_cast(float, __builtin_amdgcn_readlane(vi, 48));
    return (r0 + r1) + (r2 + r3);
}
template <class V> __device__ __forceinline__ V ldgo(const void* base, unsigned off) { return *(const V*)((const char*)base + off); }
#define PIN10(a) asm volatile("" : "+v"((a)[0]), "+v"((a)[1]), "+v"((a)[2]), "+v"((a)[3]), "+v"((a)[4]), "+v"((a)[5]), "+v"((a)[6]), "+v"((a)[7]), "+v"((a)[8]), "+v"((a)[9]))

struct Args { const float* in[22]; float* out; unsigned char* ws; int ph_lo, ph_hi; };
enum { I_X = 0, I_WIN, I_BIN, I_SINK, I_WATT, I_CONVW, I_CONVB, I_CLNG, I_CLNB, I_WCONV, I_BCONV, I_WO, I_LN1G, I_LN1B, I_WR, I_BR, I_WUP, I_BUP, I_WDN, I_BDN, I_LN2G, I_LN2B };
constexpr int CVI_UP = NE * 64, CVI_DN = NE * 32, CVI_ITEMS = CVI_UP + CVI_DN;
__device__ __forceinline__ void cvi_decode(const Args& a, int it, const float*& src, unsigned char*& dst, int& nw) {
    if (it < CVI_UP) { const int e = it >> 6, kg = it & 63; nw = 2048; src = a.in[I_WUP] + ((size_t)e * 1024 + 16 * kg) * 2048; dst = a.ws + WS_WUP + (size_t)e * 2048 * 1024 + (size_t)kg * 2048 * 16; }
    else { const int r = it - CVI_UP, e = r >> 5, kg2 = r & 31; nw = 1024; src = a.in[I_WDN] + ((size_t)e * 1024 + 32 * kg2) * 1024; dst = a.ws + WS_WDN + (size_t)e * 1024 * 1024 + (size_t)kg2 * 2 * 1024 * 16; }
}
__device__ __forceinline__ void cvi_slice_ptrs(const Args& a, int it, int wave, int lane, const float*& sp, unsigned& pitch, unsigned char*& dp) {
    const float* src; unsigned char* dst; int nw; cvi_decode(a, it, src, dst, nw);
    const int g = nw == 2048 ? 0 : (wave >> 2), cw = nw == 2048 ? wave : (wave & 3);
    sp = src + (size_t)(16 * g) * nw + 256 * cw + 4 * lane; pitch = (unsigned)nw;
    dp = dst + ((size_t)g * nw + 256 * cw + 4 * lane) * 16;
}
__device__ __forceinline__ void cvi_slice_load(const float* sp, unsigned pitch, f32x4 (&r)[16]) {
#pragma unroll
    for (int kk = 0; kk < 16; ++kk) r[kk] = __builtin_nontemporal_load((const f32x4*)(sp + (size_t)kk * pitch));
}
__device__ __forceinline__ void cvi_slice_out(unsigned char* dp, f32x4 (&r)[16]) {
    asm volatile("" : "+v"(r[0]), "+v"(r[1]), "+v"(r[2]), "+v"(r[3]), "+v"(r[4]), "+v"(r[5]), "+v"(r[6]), "+v"(r[7]), "+v"(r[8]), "+v"(r[9]), "+v"(r[10]), "+v"(r[11]), "+v"(r[12]), "+v"(r[13]), "+v"(r[14]), "+v"(r[15]));
#pragma unroll
    for (int j = 0; j < 4; ++j) { unsigned w[4];
#pragma unroll
        for (int c = 0; c < 4; ++c) { unsigned x = 0u; x = __builtin_amdgcn_cvt_pk_fp8_f32(r[4 * c][j] * 64.0f, r[4 * c + 1][j] * 64.0f, x, false);
            x = __builtin_amdgcn_cvt_pk_fp8_f32(r[4 * c + 2][j] * 64.0f, r[4 * c + 3][j] * 64.0f, x, true); w[c] = x; }
        *(u32x4*)(dp + 16 * j) = (u32x4){w[0], w[1], w[2], w[3]}; }
}
__device__ __forceinline__ void side_convert(const Args& a, int bx, int G, int wave, int lane) {
    int base, nit;
    if (G == 256) { base = bx < 192 ? 11 * bx : 2112 + 15 * (bx - 192); nit = bx < 192 ? 11 : 15; }
    else { const int per = (CVI_ITEMS + G - 1) / G; base = bx * per; nit = base >= CVI_ITEMS ? 0 : (CVI_ITEMS - base < per ? CVI_ITEMS - base : per); }
    const int end = base + nit;
    f32x4 r0[16], r1[16];
    const float* sp0; const float* sp1; unsigned p0 = 0, p1 = 0; unsigned char* d0; unsigned char* d1;
    if (nit > 0) { cvi_slice_ptrs(a, base, wave, lane, sp0, p0, d0); cvi_slice_load(sp0, p0, r0); }
    if (nit > 1) { cvi_slice_ptrs(a, base + 1, wave, lane, sp1, p1, d1); cvi_slice_load(sp1, p1, r1); }
#pragma unroll 1
    for (int it0 = base; it0 < end; it0 += 2) {
        const int it1 = it0 + 1;
        { unsigned char* dcur = d0; cvi_slice_out(dcur, r0); if (it0 + 2 < end) { cvi_slice_ptrs(a, it0 + 2, wave, lane, sp0, p0, d0); cvi_slice_load(sp0, p0, r0); } }
        if (it1 >= end) break;
        { unsigned char* dcur = d1; cvi_slice_out(dcur, r1); if (it1 + 2 < end) { cvi_slice_ptrs(a, it1 + 2, wave, lane, sp1, p1, d1); cvi_slice_load(sp1, p1, r1); } }
    }
}

__device__ __forceinline__ void side_convert_dma(const Args& a, int bx, int G, int wave, int lane, LAS unsigned char* lds) {
    int base, nit;
    if (G == 256) { base = bx < 192 ? 11 * bx : 2112 + 15 * (bx - 192); nit = bx < 192 ? 11 : 15; }
    else { const int per = (CVI_ITEMS + G - 1) / G; base = bx * per; nit = base >= CVI_ITEMS ? 0 : (CVI_ITEMS - base < per ? CVI_ITEMS - base : per); }
    const int end = base + nit;
    LAS unsigned char* wb = lds + wave * 16384;
    const float* sp; unsigned pitch = 0; unsigned char* dnext = nullptr;
#define CVD_DMA(h) do { _Pragma("unroll") for (int kk = 8 * (h); kk < 8 * (h) + 8; ++kk) \
        __builtin_amdgcn_global_load_lds((const unsigned*)(sp + (size_t)kk * pitch), (LAS unsigned*)(wb + kk * 1024), 16, 0, 2); } while (0)
    if (nit > 0) { cvi_slice_ptrs(a, base, wave, lane, sp, pitch, dnext); CVD_DMA(0); CVD_DMA(1); }
#pragma unroll 1
    for (int it = base; it < end; ++it) {
        unsigned char* dcur = dnext;
        f32x4 r[16];
        asm volatile("s_waitcnt vmcnt(8)" ::: "memory");
#pragma unroll
        for (int kk = 0; kk < 8; ++kk) r[kk] = *(const LAS f32x4*)(wb + kk * 1024 + lane * 16);
        asm volatile("s_waitcnt lgkmcnt(0)" ::: "memory");
        asm volatile("" : "+v"(r[0]), "+v"(r[1]), "+v"(r[2]), "+v"(r[3]), "+v"(r[4]), "+v"(r[5]), "+v"(r[6]), "+v"(r[7]));
        const bool more = it + 1 < end;
        if (more) { cvi_slice_ptrs(a, it + 1, wave, lane, sp, pitch, dnext); CVD_DMA(0); }
        if (more) asm volatile("s_waitcnt vmcnt(8)" ::: "memory"); else asm volatile("s_waitcnt vmcnt(0)" ::: "memory");
#pragma unroll
        for (int kk = 8; kk < 16; ++kk) r[kk] = *(const LAS f32x4*)(wb + kk * 1024 + lane * 16);
        asm volatile("s_waitcnt lgkmcnt(0)" ::: "memory");
        asm volatile("" : "+v"(r[8]), "+v"(r[9]), "+v"(r[10]), "+v"(r[11]), "+v"(r[12]), "+v"(r[13]), "+v"(r[14]), "+v"(r[15]));
        if (more) CVD_DMA(1);
        cvi_slice_out(dcur, r);
    }
#undef CVD_DMA
    asm volatile("s_waitcnt vmcnt(0)" ::: "memory");
}

namespace pg8 {
constexpr int BM = 256, BK = 64, HALF = 128, HTB = HALF * BK * 2, STAGE_BYTES = 8 * HTB, NXCD = 8, WGM = 8;
constexpr int KD = 1024, NT_K = KD / BK;
__host__ __device__ __forceinline__ int lds_byte(int r, int c) { const int st = (r >> 4) * 2 + (c >> 5), rr = r & 15, cc = c & 31, ob = rr * 64 + cc * 2; return st * 1024 + (ob ^ (((ob >> 9) & 1) << 5)); }
__host__ __device__ __forceinline__ void stage_rc(int b, int& R, int& C) { const int st = b / 1024, sb = b % 1024, swz = sb ^ (((sb >> 9) & 1) << 5); R = (st >> 1) * 16 + swz / 64; C = (st & 1) * 32 + (swz % 64) / 2; }
__host__ __device__ __forceinline__ int perm32(int rho) { const int n = rho >> 4, i = rho & 15; return 8 * (i >> 2) + 4 * n + (i & 3); }

struct Unit { const char* A; const char* B; int pm, pn, e, mt, cnt, type; };

struct DenseOrder {
    const char* Ab; const char* Bb; int nM, nN, nwg, G, c, i0 = 0, i1 = 1 << 20; static constexpr int rowb = KD * 2; static constexpr bool PARK = false, FUSED = false;
    __device__ __forceinline__ unsigned boff(int Rb, int C) const { return (unsigned)(Rb * rowb + C * 2); }
    __device__ __forceinline__ size_t bstep_k() const { return 128; }
    __device__ __forceinline__ size_t bstep_h() const { return (size_t)HALF * rowb; }
    __device__ void init(const void* A, const void* B, int M, int N, int G_, int c_) { Ab = (const char*)A; Bb = (const char*)B; nM = M / BM; nN = N / BM; nwg = nM * nN; G = G_; c = c_; }
    __device__ __forceinline__ bool next(int i, Unit& u) const {
        if (i + i0 >= i1) return false;
        const long L = (long)(i + i0) * G + c; if (L >= nwg) return false;
        int wgid = (int)L; { const int q = nwg / NXCD, r = nwg % NXCD, xcd = wgid % NXCD, off = wgid / NXCD; wgid = (xcd < r ? xcd * (q + 1) : r * (q + 1) + (xcd - r) * q) + off; }
        const int nig = WGM * nN, gid = wgid / nig, fm = gid * WGM, gsz = (nM - fm) < WGM ? (nM - fm) : WGM;
        u.pm = fm + ((wgid % nig) % gsz); u.pn = (wgid % nig) / gsz; u.e = 0; u.mt = 0; u.cnt = 0; u.type = 0;
        u.A = Ab + (size_t)u.pm * (BM * KD * 2); u.B = Bb + (size_t)u.pn * (BM * KD * 2); return true;
    }
    __device__ __forceinline__ void offsets(const Unit&, const int (&R)[2], const int (&C)[2], unsigned (&off)[2][2]) const {
#pragma unroll
        for (int h = 0; h < 2; ++h)
#pragma unroll
            for (int i = 0; i < 2; ++i) off[h][i] = (unsigned)(((h * HALF + R[i]) * KD + C[i]) * 2);
    }
};
struct MoeOrder {
    const LAS int* tab; int NTN, G, c, total; const char* Ab; const char* Bb; size_t bexp; const int* slot; bool gather; int rowb;
    static constexpr bool PARK = true, FUSED = false;
    int bn16;
    __device__ __forceinline__ unsigned boff(int Rb, int C) const { return (unsigned)((C >> 3) * bn16 + Rb * 16); }
    __device__ __forceinline__ size_t bstep_k() const { return (size_t)8 * bn16; }
    __device__ __forceinline__ size_t bstep_h() const { return (size_t)HALF * 16; }
    __device__ __forceinline__ bool next(int i, Unit& u) const {
        const int L = i * G + c; if (L >= total) return false;
        int e = 0;
        for (int j = 1; j < NE; ++j) e += (L >= NTN * tab[64 + j]) ? 1 : 0;
        e = __builtin_amdgcn_readfirstlane(e);
        const int ms = __builtin_amdgcn_readfirstlane(tab[64 + e]), ml = __builtin_amdgcn_readfirstlane(tab[32 + e]);
        const int r = L - NTN * ms; const int nt = r / ml, mt = r - nt * ml;
        u.e = e; u.mt = mt; u.cnt = __builtin_amdgcn_readfirstlane(tab[e]); u.pm = ms + mt; u.pn = nt; u.type = 0;
        u.A = gather ? Ab : Ab + (size_t)u.pm * (size_t)(BM * rowb);
        u.B = Bb + (size_t)e * bexp + (size_t)nt * (size_t)(BM * 16); return true;
    }
    __device__ __forceinline__ void offsets(const Unit& u, const int (&R)[2], const int (&C)[2], unsigned (&off)[2][2]) const {
#pragma unroll
        for (int h = 0; h < 2; ++h)
#pragma unroll
            for (int i = 0; i < 2; ++i) {
                if (gather) { const int idx = u.mt * BM + h * HALF + R[i]; const int idc = idx < u.cnt ? idx : u.cnt - 1; int tok = slot[u.e * SLOT_CAP + idc] >> 2; tok = idx < u.cnt ? tok : 0; off[h][i] = (unsigned)(tok * rowb + C[i] * 2); }
                else off[h][i] = (unsigned)((h * HALF + R[i]) * rowb + C[i] * 2);
            }
    }
};


#define GAS_U32 __attribute__((address_space(1))) unsigned
struct MoeFusedOrder {
    const LAS int* tab; int G, c, total6, total7; const char* hb; const char* act; const char* wup; const char* wdn; const int* slot; unsigned* cnt; unsigned* tmo;
    static constexpr bool PARK = true, FUSED = true; static constexpr int rowb = 1024;
    __device__ __forceinline__ unsigned boff_t(int type, int R, int C) const {
        const int rs = 64 * (R >> 5) + 32 * ((R >> 2) & 1) + 16 * ((R >> 3) & 1) + 4 * ((R >> 4) & 1) + (R & 3);
        return (unsigned)((C >> 3) * ((type ? 1024 : 2048) * 16) + rs * 16); }
    __device__ __forceinline__ unsigned boff(int R, int C) const { return boff_t(0, R, C); }
    __device__ __forceinline__ size_t bstep_kt(int type) const { return (size_t)8 * (type ? 1024 * 16 : 2048 * 16); }
    __device__ __forceinline__ size_t bstep_ht(int) const { return (size_t)8 * 16; }
    __device__ __forceinline__ size_t bstep_k() const { return bstep_kt(0); }
    __device__ __forceinline__ size_t bstep_h() const { return bstep_ht(0); }
    __device__ __forceinline__ bool next(int i, Unit& u) const {
        int L = i * G + c; if (L >= total6 + total7) return false;
        const int type = L >= total6 ? 1 : 0; L -= type ? total6 : 0; const int NTN = type ? 4 : 8;
        int e = 0;
        for (int j = 1; j < NE; ++j) e += (L >= NTN * tab[64 + j]) ? 1 : 0;
        e = __builtin_amdgcn_readfirstlane(e);
        const int ms = __builtin_amdgcn_readfirstlane(tab[64 + e]), ml = __builtin_amdgcn_readfirstlane(tab[32 + e]);
        const int r = L - NTN * ms; const int nt = r / ml, mt = r - nt * ml;
        u.e = e; u.mt = mt; u.cnt = __builtin_amdgcn_readfirstlane(tab[e]); u.pm = ms + mt; u.pn = nt; u.type = type;
        u.A = type ? act + (size_t)u.pm * (size_t)(BM * rowb) : hb;
        u.B = (type ? wdn + (size_t)e * 1024 * 1024 : wup + (size_t)e * 2048 * 1024) + (size_t)nt * (size_t)(BM * 16); return true;
    }
    __device__ __forceinline__ void offsets(const Unit& u, const int (&R)[2], const int (&C)[2], unsigned (&off)[2][2]) const {
        if (u.type == 0) { int tok[2][2];
#pragma unroll
            for (int h = 0; h < 2; ++h)
#pragma unroll
                for (int i = 0; i < 2; ++i) { const int idx = u.mt * BM + h * HALF + R[i]; tok[h][i] = slot[u.e * SLOT_CAP + (idx < u.cnt ? idx : u.cnt - 1)]; }
#pragma unroll
            for (int h = 0; h < 2; ++h)
#pragma unroll
                for (int i = 0; i < 2; ++i) { const int idx = u.mt * BM + h * HALF + R[i]; const int t = idx < u.cnt ? (tok[h][i] >> 2) : 0; off[h][i] = (unsigned)(t * rowb + C[i] * 2); }
        } else {
#pragma unroll
            for (int h = 0; h < 2; ++h)
#pragma unroll
                for (int i = 0; i < 2; ++i) off[h][i] = (unsigned)((h * HALF + R[i]) * rowb + C[i] * 2);
        }
    }
    __device__ __forceinline__ void early_poll(const Unit& u, LAS unsigned char* lds) const {
        if (threadIdx.x < 64) { const unsigned* p = cnt + 16 * u.pm; unsigned v;
            asm volatile("global_load_dword %0, %1, off sc1\n\ts_waitcnt vmcnt(0)" : "=&v"(v) : "v"(p) : "memory");
            if (threadIdx.x == 0) *(LAS unsigned*)(lds + MISC_OFF + MO_RDY) = v >= 64u ? 1u : 0u; }
    }
    __device__ __forceinline__ void a_ready(const Unit& u) const {
        if (u.type) {
            if (threadIdx.x < 64) { const unsigned* p = cnt + 16 * u.pm; unsigned v, spins = 0u;
                for (;;) { asm volatile("global_load_dword %0, %1, off sc1\n\ts_waitcnt vmcnt(0)" : "=&v"(v) : "v"(p) : "memory");
                    if ((unsigned)__builtin_amdgcn_readfirstlane(v) >= 64u) break;
                    __builtin_amdgcn_s_sleep(2);
                    if (++spins > (1u << 20)) { if (threadIdx.x == 0) __hip_atomic_store(tmo, 1u, __ATOMIC_RELAXED, __HIP_MEMORY_SCOPE_AGENT); break; } }
                }
            asm volatile("" ::: "memory"); __builtin_amdgcn_s_barrier(); asm volatile("" ::: "memory");
        }
    }
    __device__ __forceinline__ void done(const Unit& u) const {
        if (u.type == 0) { asm volatile("s_waitcnt vmcnt(0)" ::: "memory");
            if ((threadIdx.x & 63) == 0) __hip_atomic_fetch_add(cnt + 16 * u.pm, 1u, __ATOMIC_RELAXED, __HIP_MEMORY_SCOPE_AGENT); }
    }
};

typedef f32x4 Acc[2][2][4][2];

typedef int i32x8 __attribute__((ext_vector_type(8)));
struct u32x4x2 { u32x4 a, b; };
template <class Epi, class Sched, bool FP8 = false>
__device__ __forceinline__ void gemm_phase(LAS unsigned char* lds, const Sched& S, const Epi& E) {
    const int tid = threadIdx.x, wid = __builtin_amdgcn_readfirstlane(tid >> 6), lane = tid & 63, wr = wid >> 2, wc = wid & 3, fr = lane & 15, fq = lane >> 4;
    constexpr int ROWB = FP8 ? KD : KD * 2, nt = FP8 ? KD / 128 : NT_K;
    int sR[2], sC[2], sRb[2]; unsigned voffB[2];
#pragma unroll
    for (int i = 0; i < 2; ++i) { int R, C; stage_rc(tid * 16 + i * 8192, R, C); sR[i] = R; sC[i] = C; const int Rb = Epi::PERM ? ((R & ~31) + perm32(R & 31)) : R; sRb[i] = Rb; voffB[i] = S.boff(Rb, C); }
    constexpr size_t kstep = (size_t)(BK * 2);
    size_t kstepB = S.bstep_k(), kstepBn = kstepB, hstepB = S.bstep_h(), hstepBn = hstepB;
    const unsigned ldsw = (unsigned)wid * 1024u;
    const int aoff = lds_byte(wr * 64 + fr, fq * 8), boff = lds_byte(wc * 32 + fr, fq * 8);
    constexpr int KST = 1024;
#define PG8_SA(b, h) (((b) * 2 + (h)) * HTB)
#define PG8_SB(b, h) ((4 + (b) * 2 + (h)) * HTB)
#define PG8_STAGE(bufoff, gbase, voff) do { const char* _gb = (const char*)(gbase); asm volatile("" : "+s"(_gb));     \
        _Pragma("unroll") for (int _i = 0; _i < 2; ++_i) \
        __builtin_amdgcn_global_load_lds((const unsigned*)(_gb + (voff)[_i]), (LAS unsigned*)(lds + (bufoff) + ldsw + _i * 8192), 16, 0, 0); } while (0)
#define PG8_STAGE_A(bufoff, gbase, voff) do { const char* _gb = (const char*)(gbase); asm volatile("" : "+s"(_gb)); \
        _Pragma("unroll") for (int _i = 0; _i < 2; ++_i) \
        __builtin_amdgcn_global_load_lds((const unsigned*)(_gb + (voff)[_i]), (LAS unsigned*)(lds + (bufoff) + ldsw + _i * 8192), 16, 0, 0); } while (0)
#define PG8_LDA(dst, b, h) do { _Pragma("unroll") for (int m = 0; m < 4; ++m) _Pragma("unroll") for (int k = 0; k < 2; ++k) dst[m][k] = *(const LAS bf16x8*)(lds + PG8_SA(b, h) + aoff + m * 2048 + k * KST); } while (0)
#define PG8_LDB(dst, b, h) do { _Pragma("unroll") for (int n = 0; n < 2; ++n) _Pragma("unroll") for (int k = 0; k < 2; ++k) dst[n][k] = *(const LAS bf16x8*)(lds + PG8_SB(b, h) + boff + n * 2048 + k * KST); } while (0)
#define PG8_CAT(x) __builtin_bit_cast(i32x8, (u32x4x2){__builtin_bit_cast(u32x4, (x)[0]), __builtin_bit_cast(u32x4, (x)[1])})
#define PG8_MMA(ai, bj, At, Bt) do { __builtin_amdgcn_s_setprio(1); \
        if constexpr (FP8) { _Pragma("unroll") for (int m = 0; m < 4; ++m) _Pragma("unroll") for (int n = 0; n < 2; ++n) \
            acc[ai][bj][m][n] = __builtin_amdgcn_mfma_scale_f32_16x16x128_f8f6f4(PG8_CAT(Bt[n]), PG8_CAT(At[m]), acc[ai][bj][m][n], 0, 0, 0, Epi::SCALE_B, 0, Epi::SCALE_A); } \
        else { _Pragma("unroll") for (int m = 0; m < 4; ++m) _Pragma("unroll") for (int n = 0; n < 2; ++n) _Pragma("unroll") for (int k = 0; k < 2; ++k) \
            acc[ai][bj][m][n] = __builtin_amdgcn_mfma_f32_16x16x32_bf16(Bt[n][k], At[m][k], acc[ai][bj][m][n], 0, 0, 0); } \
        __builtin_amdgcn_s_setprio(0); } while (0)
#define PG8_WAIT_V(n) asm volatile("s_waitcnt vmcnt(" #n ")" ::: "memory")
#define PG8_WAIT_L(n) asm volatile("s_waitcnt lgkmcnt(" #n ")" ::: "memory")
#define PG8_BAR __builtin_amdgcn_s_barrier()
#define PG8_SCHED __builtin_amdgcn_sched_barrier(0)
    Unit cur, nxt; int ui = 0;
    if (!S.next(0, cur)) return;
    Acc acc;
    bf16x8 At[4][2], B0[2][2], B1[2][2];
    unsigned offA[2][2], offN[2][2];
    S.offsets(cur, sR, sC, offA);
    if constexpr (Sched::FUSED) { kstepB = S.bstep_kt(cur.type); hstepB = S.bstep_ht(cur.type);
#pragma unroll
        for (int i = 0; i < 2; ++i) voffB[i] = S.boff_t(cur.type, sR[i], sC[i]); }
    const char* cA = cur.A; const char* cB = cur.B;
    PG8_STAGE(PG8_SB(0, 0), cB, voffB); PG8_STAGE(PG8_SB(0, 1), cB + hstepB, voffB); PG8_STAGE_A(PG8_SA(0, 0), cA, offA[0]); PG8_STAGE_A(PG8_SA(0, 1), cA, offA[1]);
    if (wr == 1) PG8_BAR;
    PG8_WAIT_V(2); PG8_BAR;
    PG8_STAGE(PG8_SB(1, 0), cB + kstepB, voffB); PG8_STAGE_A(PG8_SA(1, 0), cA + kstep, offA[0]); PG8_STAGE(PG8_SB(1, 1), cB + hstepB + kstepB, voffB);
    PG8_WAIT_V(6); PG8_BAR;
    for (;;) {
#pragma unroll
        for (int a = 0; a < 2; ++a)
#pragma unroll
            for (int b = 0; b < 2; ++b)
#pragma unroll
                for (int m = 0; m < 4; ++m)
#pragma unroll
                    for (int n = 0; n < 2; ++n) acc[a][b][m][n] = (f32x4){0.f, 0.f, 0.f, 0.f};
        const bool has_next = S.next(ui + 1, nxt);
        const char* nA = has_next ? nxt.A : cA; const char* nB = has_next ? nxt.B : cB;
        if constexpr (Sched::FUSED) { kstepBn = has_next ? S.bstep_kt(nxt.type) : kstepB; hstepBn = has_next ? S.bstep_ht(nxt.type) : hstepB; }
        if (has_next) S.offsets(nxt, sR, sC, offN);
        else {
#pragma unroll
            for (int h = 0; h < 2; ++h)
#pragma unroll
                for (int i = 0; i < 2; ++i) offN[h][i] = offA[h][i];
        }
        if constexpr (Sched::PARK) *(LAS u32x4*)(lds + OFFN_OFF + tid * 16) = (u32x4){offN[0][0], offN[0][1], offN[1][0], offN[1][1]};
        if constexpr (Sched::FUSED) { if (has_next && nxt.type) S.early_poll(nxt, lds); }
#pragma unroll 1
        for (int t = 0; t < nt; t += 2) {
            const bool last = (t == nt - 2);
            const char* a1 = cA + (size_t)(t + 1) * kstep;
            const char* a2 = last ? nA : cA + (size_t)(t + 2) * kstep; const char* b2 = last ? nB : cB + (size_t)(t + 2) * kstepB;
            const char* a3 = a2 + kstep; const char* b3 = b2 + (last ? kstepBn : kstepB); const size_t hB = last ? hstepBn : hstepB;
            if constexpr (Sched::FUSED) { if (last && has_next && nxt.type) { const unsigned rdy = __builtin_amdgcn_readfirstlane(*(const LAS unsigned*)(lds + MISC_OFF + MO_RDY)); if (!rdy) S.a_ready(nxt); } }
            if constexpr (Epi::MID_T > 0) { if (t == Epi::MID_T) E.mid(acc, cur, wr, wc, fr, fq); }
            PG8_LDB(B0, 0, 0); PG8_LDB(B1, 0, 1); PG8_SCHED; PG8_LDA(At, 0, 0); PG8_STAGE_A(PG8_SA(1, 1), a1, offA[1]);
            PG8_WAIT_V(8); PG8_WAIT_L(0); PG8_BAR; PG8_MMA(0, 0, At, B0); PG8_MMA(0, 1, At, B1);
            asm volatile("" : "+v"(acc[0][0][0][0]), "+v"(acc[0][0][0][1]), "+v"(acc[0][0][1][0]), "+v"(acc[0][0][1][1]), "+v"(acc[0][0][2][0]), "+v"(acc[0][0][2][1]), "+v"(acc[0][0][3][0]), "+v"(acc[0][0][3][1]));
            asm volatile("" : "+v"(acc[0][1][0][0]), "+v"(acc[0][1][0][1]), "+v"(acc[0][1][1][0]), "+v"(acc[0][1][1][1]), "+v"(acc[0][1][2][0]), "+v"(acc[0][1][2][1]), "+v"(acc[0][1][3][0]), "+v"(acc[0][1][3][1]));
            PG8_BAR; PG8_SCHED;
            if (last) {
                if constexpr (Sched::FUSED) { if (has_next) {
#pragma unroll
                    for (int i = 0; i < 2; ++i) voffB[i] = S.boff_t(nxt.type, sR[i], sC[i]); } }
                if constexpr (Sched::PARK) { const u32x4 pk = *(const LAS u32x4*)(lds + OFFN_OFF + tid * 16); offA[0][0] = pk.x; offA[0][1] = pk.y; offA[1][0] = pk.z; offA[1][1] = pk.w; }
                else {
#pragma unroll
                    for (int h = 0; h < 2; ++h)
#pragma unroll
                        for (int i = 0; i < 2; ++i) offA[h][i] = offN[h][i];
                }
            }
            PG8_LDA(At, 0, 1); PG8_STAGE(PG8_SB(0, 0), b2, voffB); PG8_STAGE(PG8_SB(0, 1), b2 + hB, voffB); PG8_STAGE_A(PG8_SA(0, 0), a2, offA[0]);
            PG8_WAIT_V(8); PG8_WAIT_L(0); PG8_BAR; PG8_MMA(1, 0, At, B0); PG8_MMA(1, 1, At, B1); PG8_BAR; PG8_SCHED;
            PG8_LDB(B0, 1, 0); PG8_LDB(B1, 1, 1); PG8_SCHED; PG8_LDA(At, 1, 0); PG8_STAGE_A(PG8_SA(0, 1), a2, offA[1]);
            PG8_WAIT_V(8); PG8_WAIT_L(0); PG8_BAR; PG8_MMA(0, 0, At, B0); PG8_MMA(0, 1, At, B1); PG8_BAR; PG8_SCHED;
            PG8_LDA(At, 1, 1); PG8_STAGE(PG8_SB(1, 0), b3, voffB); PG8_STAGE(PG8_SB(1, 1), b3 + hB, voffB); PG8_STAGE_A(PG8_SA(1, 0), a3, offA[0]);
            PG8_WAIT_V(8); PG8_WAIT_L(0); PG8_BAR; PG8_MMA(1, 0, At, B0); PG8_MMA(1, 1, At, B1); PG8_BAR; PG8_SCHED;
        }
        if (wr == 0) PG8_BAR;
        E(acc, cur, wr, wc, fr, fq);
        if constexpr (Sched::FUSED) S.done(cur);
        __builtin_amdgcn_s_waitcnt(0x0F70);
        if (!has_next) break;
        cur = nxt; cA = nA; cB = nB; kstepB = kstepBn; hstepB = hstepBn; ++ui;
        if (wr == 1) PG8_BAR;
    }
    PG8_WAIT_V(0);
    PG8_BAR;
#undef PG8_SA
#undef PG8_SB
#undef PG8_STAGE
#undef PG8_STAGE_A
#undef PG8_LDA
#undef PG8_LDB
#undef PG8_MMA
#undef PG8_WAIT_V
#undef PG8_WAIT_L
#undef PG8_BAR
#undef PG8_SCHED
}

#define EPI_SEED(r, c) asm volatile("" : "+v"(r), "+v"(c))
template <class V> __device__ __forceinline__ V ldg(const void* base, unsigned off) { return *(const V*)((const char*)base + off); }
template <class V> __device__ __forceinline__ void stg(void* base, unsigned off, V v) { *(V*)((char*)base + off) = v; }
__device__ __forceinline__ u32x4 pack8(const f32x4 v0, const f32x4 v1) { u32x4 w; w.x = cvt_pk_bf16(v0[0], v0[1]); w.y = cvt_pk_bf16(v0[2], v0[3]); w.z = cvt_pk_bf16(v1[0], v1[1]); w.w = cvt_pk_bf16(v1[2], v1[3]); return w; }

struct EpiU {
    static constexpr int SCALE_B = 0, SCALE_A = 0;
    static constexpr bool PERM = true; static constexpr int MID_T = 0;
    bf16 *q, *k, *vT, *ab, *gates; const float* bias;
    __device__ __forceinline__ void mid(Acc&, const Unit&, int, int, int, int) const {}
    __device__ __forceinline__ void operator()(const Acc& acc, const Unit& u, int wr, int wc, int fr, int fq) const {
        int rl = wr * 64 + fr, cl = wc * 32 + 8 * fq; EPI_SEED(rl, cl);
        const int row0 = u.pm * BM + rl, pn = u.pn;
        f32x4 bv[2][2];
#pragma unroll
        for (int bj = 0; bj < 2; ++bj)
#pragma unroll
            for (int n = 0; n < 2; ++n) bv[bj][n] = ldg<f32x4>(bias, (unsigned)(pn * BM + bj * HALF + cl + 4 * n) * 4u);
        if (pn < 2) {
            const unsigned o0 = ((unsigned)row0 * AW + pn * BM + cl) * 2u;
#pragma unroll
            for (int ai = 0; ai < 2; ++ai)
#pragma unroll
                for (int m = 0; m < 4; ++m)
#pragma unroll
                    for (int bj = 0; bj < 2; ++bj)
                        stg<u32x4>(q, o0 + (unsigned)((ai * HALF + m * 16) * AW + bj * HALF) * 2u, pack8((acc[ai][bj][m][0] + bv[bj][0]) * 0.125f, (acc[ai][bj][m][1] + bv[bj][1]) * 0.125f));
        } else if (pn == 2) {
            const unsigned o0 = ((unsigned)row0 * KVW + cl) * 2u;
            const int b = row0 >> 12, s0 = row0 & (SEQ - 1);
#pragma unroll
            for (int ai = 0; ai < 2; ++ai)
#pragma unroll
                for (int m = 0; m < 4; ++m) {
                    stg<u32x4>(k, o0 + (unsigned)((ai * HALF + m * 16) * KVW) * 2u, pack8(acc[ai][0][m][0] + bv[0][0], acc[ai][0][m][1] + bv[0][1]));
#pragma unroll
                    for (int n = 0; n < 2; ++n) { const f32x4 v = acc[ai][1][m][n] + bv[1][n];
#pragma unroll
                        for (int j = 0; j < 4; ++j) { const int col = cl + 4 * n + j, kvh = col >> 6, dim = col & 63;
                            stg<bf16>(vT, (unsigned)(((b * NKV + kvh) * HD + dim) * SEQ + s0 + ai * HALF + m * 16) * 2u, (bf16)f2bf(v[j])); } } }
        } else if (pn < 7) {
            const unsigned o0 = ((unsigned)(row0 + AB_PAD * ((row0 >> 12) + 1)) * CCH + (pn - 3) * HALF + cl) * 2u;
#pragma unroll
            for (int ai = 0; ai < 2; ++ai)
#pragma unroll
                for (int m = 0; m < 4; ++m) { f32x4 o[2];
#pragma unroll
                    for (int n = 0; n < 2; ++n) { const f32x4 a = acc[ai][0][m][n] + bv[0][n], g = acc[ai][1][m][n] + bv[1][n];
#pragma unroll
                        for (int j = 0; j < 4; ++j) o[n][j] = a[j] * sigmoidf_(g[j]); }
                    stg<u32x4>(ab, o0 + (unsigned)((ai * HALF + m * 16) * CCH) * 2u, pack8(o[0], o[1])); }
        } else {
            const unsigned o0 = ((unsigned)row0 * 2048 + (pn - 7) * HALF + cl) * 2u;
#pragma unroll
            for (int ai = 0; ai < 2; ++ai)
#pragma unroll
                for (int m = 0; m < 4; ++m) { f32x4 ra[2], gb[2];
#pragma unroll
                    for (int n = 0; n < 2; ++n) { const f32x4 va = acc[ai][0][m][n] + bv[0][n], vb = acc[ai][1][m][n] + bv[1][n];
#pragma unroll
                        for (int j = 0; j < 4; ++j) { const float sb = sigmoidf_(vb[j]); gb[n][j] = sb; ra[n][j] = sigmoidf_(va[j]) * __builtin_amdgcn_rcpf(sb); } }
                    stg<u32x4>(gates, o0 + (unsigned)((ai * HALF + m * 16) * 2048) * 2u, pack8(ra[0], ra[1]));
                    stg<u32x4>(gates, o0 + (unsigned)((ai * HALF + m * 16) * 2048 + 1024) * 2u, pack8(gb[0], gb[1])); }
        }
    }
};
struct EpiMerged {
    static constexpr int SCALE_B = 0, SCALE_A = 0;
    static constexpr bool PERM = true; static constexpr int MID_T = 8;
    const bf16* gates; const float* bc; bf16* merged;
    __device__ __forceinline__ void mid(Acc& acc, const Unit& u, int wr, int wc, int fr, int fq) const {
        int rl = wr * 64 + fr, cl = wc * 32 + 8 * fq; EPI_SEED(rl, cl);
        const unsigned g0 = ((unsigned)(u.pm * BM + rl) * 2048 + u.pn * BM + cl) * 2u;
#pragma unroll
        for (int ai = 0; ai < 2; ++ai) { u32x4 rt[4][2];
#pragma unroll
            for (int m = 0; m < 4; ++m)
#pragma unroll
                for (int bj = 0; bj < 2; ++bj) rt[m][bj] = ldg<u32x4>(gates, g0 + (unsigned)((ai * HALF + m * 16) * 2048 + bj * HALF) * 2u);
            __builtin_amdgcn_sched_barrier(0);
#pragma unroll
            for (int m = 0; m < 4; ++m)
#pragma unroll
                for (int bj = 0; bj < 2; ++bj)
#pragma unroll
                    for (int n = 0; n < 2; ++n) { acc[ai][bj][m][n][0] *= bflo(rt[m][bj][2 * n]); acc[ai][bj][m][n][1] *= bfhi(rt[m][bj][2 * n]); acc[ai][bj][m][n][2] *= bflo(rt[m][bj][2 * n + 1]); acc[ai][bj][m][n][3] *= bfhi(rt[m][bj][2 * n + 1]); }
            __builtin_amdgcn_sched_barrier(0); }
    }
    __device__ __forceinline__ void operator()(const Acc& acc, const Unit& u, int wr, int wc, int fr, int fq) const {
        int rl = wr * 64 + fr, cl = wc * 32 + 8 * fq; EPI_SEED(rl, cl);
        const int row0 = u.pm * BM + rl, col0 = u.pn * BM + cl;
        const unsigned g0 = ((unsigned)row0 * 2048 + 1024 + col0) * 2u, m0 = ((unsigned)row0 * D + col0) * 2u;
        f32x4 bv[2][2];
#pragma unroll
        for (int bj = 0; bj < 2; ++bj)
#pragma unroll
            for (int n = 0; n < 2; ++n) bv[bj][n] = ldg<f32x4>(bc, (unsigned)(col0 + bj * HALF + 4 * n) * 4u);
#pragma unroll
        for (int ai = 0; ai < 2; ++ai)
#pragma unroll
            for (int m = 0; m < 4; ++m) {
#pragma unroll
                for (int bj = 0; bj < 2; ++bj) { const u32x4 gb = ldg<u32x4>(gates, g0 + (unsigned)((ai * HALF + m * 16) * 2048 + bj * HALF) * 2u); f32x4 o[2];
#pragma unroll
                    for (int n = 0; n < 2; ++n) { const f32x4 v = acc[ai][bj][m][n] + bv[bj][n];
                        o[n][0] = v[0] * bflo(gb[2 * n]); o[n][1] = v[1] * bfhi(gb[2 * n]); o[n][2] = v[2] * bflo(gb[2 * n + 1]); o[n][3] = v[3] * bfhi(gb[2 * n + 1]); }
                    stg<u32x4>(merged, m0 + (unsigned)((ai * HALF + m * 16) * D + bj * HALF) * 2u, pack8(o[0], o[1])); }
                if (m & 1) asm volatile("" ::: "memory"); }
    }
};
struct EpiPre1 {
    static constexpr int SCALE_B = 0, SCALE_A = 0;
    static constexpr bool PERM = true; static constexpr int MID_T = 0;
    const bf16* xb; bf16* out;
    __device__ __forceinline__ void mid(Acc&, const Unit&, int, int, int, int) const {}
    __device__ __forceinline__ void operator()(const Acc& acc, const Unit& u, int wr, int wc, int fr, int fq) const {
        int rl = wr * 64 + fr, cl = wc * 32 + 8 * fq; EPI_SEED(rl, cl);
        const unsigned o0 = ((unsigned)(u.pm * BM + rl) * D + u.pn * BM + cl) * 2u;
        u32x4 xv[2][4][2];
#pragma unroll
        for (int ai = 0; ai < 2; ++ai)
#pragma unroll
            for (int m = 0; m < 4; ++m)
#pragma unroll
                for (int bj = 0; bj < 2; ++bj) xv[ai][m][bj] = ldg<u32x4>(xb, o0 + (unsigned)((ai * HALF + m * 16) * D + bj * HALF) * 2u);
        __builtin_amdgcn_sched_barrier(0);
#pragma unroll
        for (int ai = 0; ai < 2; ++ai)
#pragma unroll
            for (int m = 0; m < 4; ++m)
#pragma unroll
                for (int bj = 0; bj < 2; ++bj) { const u32x4 w = xv[ai][m][bj];
                    const f32x4 r0 = (f32x4){bflo(w.x), bfhi(w.x), bflo(w.y), bfhi(w.y)} * DN_ALPHA + acc[ai][bj][m][0], r1 = (f32x4){bflo(w.z), bfhi(w.z), bflo(w.w), bfhi(w.w)} * DN_ALPHA + acc[ai][bj][m][1];
                    stg<u32x4>(out, o0 + (unsigned)((ai * HALF + m * 16) * D + bj * HALF) * 2u, pack8(r0, r1)); }
    }
};
struct EpiUp {
    static constexpr bool PERM = true; static constexpr int MID_T = 0;
    static constexpr int SCALE_B = 0x79797979, SCALE_A = 0x7C7C7C7C;
    const float* b_up; unsigned char* act;
    __device__ __forceinline__ void mid(Acc&, const Unit&, int, int, int, int) const {}
    __device__ __forceinline__ void operator()(const Acc& acc, const Unit& u, int wr, int wc, int fr, int fq) const {
        int rl = wr * 64 + fr, cl = wc * 32 + 8 * fq; EPI_SEED(rl, cl);
        const unsigned o0 = (unsigned)(u.pm * BM + rl) * DE + u.pn * HALF + (cl >> 1);
        f32x4 bv[2][2];
#pragma unroll
        for (int bj = 0; bj < 2; ++bj)
#pragma unroll
            for (int n = 0; n < 2; ++n) bv[bj][n] = ldg<f32x4>(b_up, (unsigned)(u.e * 2048 + u.pn * BM + cl + bj * HALF + 4 * n) * 4u);
#pragma unroll
        for (int ai = 0; ai < 2; ++ai)
#pragma unroll
            for (int m = 0; m < 4; ++m)
#pragma unroll
                for (int bj = 0; bj < 2; ++bj) { float o[4];
#pragma unroll
                    for (int n = 0; n < 2; ++n) { const f32x4 v = acc[ai][bj][m][n] + bv[bj][n];
#pragma unroll
                        for (int p = 0; p < 2; ++p) { const float xg = fminf(v[2 * p], 7.0f), xl = fminf(fmaxf(v[2 * p + 1], -7.0f), 7.0f);
                            o[2 * n + p] = xg * sigmoidf_(1.702f * xg) * (xl + 1.0f); } }
                    unsigned w = 0u; w = __builtin_amdgcn_cvt_pk_fp8_f32(o[0] * 8.0f, o[1] * 8.0f, w, false); w = __builtin_amdgcn_cvt_pk_fp8_f32(o[2] * 8.0f, o[3] * 8.0f, w, true);
                    __hip_atomic_store((unsigned*)(act + (o0 + (unsigned)((ai * HALF + m * 16) * DE + bj * 64))), w, __ATOMIC_RELAXED, __HIP_MEMORY_SCOPE_AGENT); }
    }
};
struct EpiDown {
    static constexpr bool PERM = true; static constexpr int MID_T = 0;
    static constexpr int SCALE_B = 0x79797979, SCALE_A = 0x7C7C7C7C;
    const float* b_dn; const int* slot; unsigned char* ys;
    __device__ __forceinline__ void mid(Acc&, const Unit&, int, int, int, int) const {}
    __device__ __forceinline__ void operator()(const Acc& acc, const Unit& u, int wr, int wc, int fr, int fq) const {
        int rl = wr * 64 + fr, cb = 64 * wc + 32 * (fq & 1) + 16 * (fq >> 1); EPI_SEED(rl, cb);
        const int col0 = u.pn * BM + cb, idx0 = u.mt * BM + rl;
        f32x4 bv[2][2];
#pragma unroll
        for (int bj = 0; bj < 2; ++bj)
#pragma unroll
            for (int n = 0; n < 2; ++n) bv[bj][n] = ldg<f32x4>(b_dn, (unsigned)(u.e * D + col0 + 8 * bj + 4 * n) * 4u);
        int asg[2][4];
#pragma unroll
        for (int ai = 0; ai < 2; ++ai)
#pragma unroll
            for (int m = 0; m < 4; ++m) { const int idx = idx0 + ai * HALF + m * 16; asg[ai][m] = ldg<int>(slot, (unsigned)(u.e * SLOT_CAP + (idx < u.cnt ? idx : u.cnt - 1)) * 4u); }
#pragma unroll
        for (int ai = 0; ai < 2; ++ai)
#pragma unroll
            for (int m = 0; m < 4; ++m) { const int idx = idx0 + ai * HALF + m * 16;
                if (idx < u.cnt) { u32x4 w;
#pragma unroll
                    for (int bj = 0; bj < 2; ++bj)
#pragma unroll
                        for (int n = 0; n < 2; ++n) { const f32x4 v = (acc[ai][bj][m][n] + bv[bj][n]) * 16.0f;
                            unsigned x = __builtin_amdgcn_cvt_pk_fp8_f32(v[0], v[1], 0u, false); x = __builtin_amdgcn_cvt_pk_fp8_f32(v[2], v[3], x, true); w[2 * bj + n] = x; }
                    stg<u32x4>(ys, (unsigned)asg[ai][m] * D + col0, w); } }
    }
};
struct EpiUpX {
    const float* b_up; unsigned char* act;
    __device__ __forceinline__ void operator()(const Acc& acc, const Unit& u, int wr, int wc, int fr, int fq) const {
        int rl = wr * 64 + fr, cb = 64 * wc + 32 * (fq & 1) + 16 * (fq >> 1); EPI_SEED(rl, cb);
        f32x4 bv[2][2];
#pragma unroll
        for (int bj = 0; bj < 2; ++bj)
#pragma unroll
            for (int n = 0; n < 2; ++n) bv[bj][n] = ldg<f32x4>(b_up, (unsigned)(u.e * 2048 + u.pn * BM + cb + 8 * bj + 4 * n) * 4u);
        const __amdgpu_buffer_rsrc_t rs = __builtin_amdgcn_make_buffer_rsrc(act, 0, (MAX_MT * 256) * 1024, 0x00020000);
        const unsigned o0 = (unsigned)(u.pm * BM + rl + 16 * (fq >> 1)) * DE + u.pn * HALF + 32 * wc + 16 * (fq & 1);
#pragma unroll
        for (int ai = 0; ai < 2; ++ai)
#pragma unroll
            for (int j = 0; j < 2; ++j) { unsigned d[2][2];
#pragma unroll
                for (int mm = 0; mm < 2; ++mm)
#pragma unroll
                    for (int bj = 0; bj < 2; ++bj) { float o[4];
#pragma unroll
                        for (int n = 0; n < 2; ++n) { const f32x4 v = acc[ai][bj][2 * j + mm][n] + bv[bj][n];
#pragma unroll
                            for (int p = 0; p < 2; ++p) { const float xg = fminf(v[2 * p], 7.0f), xl = fminf(fmaxf(v[2 * p + 1], -7.0f), 7.0f);
                                o[2 * n + p] = (xg * __builtin_amdgcn_rcpf(1.0f + __builtin_amdgcn_exp2f(xg * (-1.702f * 1.44269504f)))) * __builtin_fmaf(xl, 8.0f, 8.0f); } }
                        unsigned w = 0u; w = __builtin_amdgcn_cvt_pk_fp8_f32(o[0], o[1], w, false); w = __builtin_amdgcn_cvt_pk_fp8_f32(o[2], o[3], w, true); d[mm][bj] = w; }
                const u32x2 s0 = __builtin_amdgcn_permlane32_swap(d[0][0], d[1][0], false, false), s1 = __builtin_amdgcn_permlane32_swap(d[0][1], d[1][1], false, false);
                const u32x4 w4 = (u32x4){s0.x, s1.x, s0.y, s1.y};
                __builtin_amdgcn_raw_buffer_store_b128(w4, rs, o0 + (unsigned)((ai * HALF + 32 * j) * DE), 0, 16); }
    }
};
struct EpiMoe {
    static constexpr bool PERM = true; static constexpr int MID_T = 0;
    static constexpr int SCALE_B = 0x79797979, SCALE_A = 0x7C7C7C7C;
    EpiUpX up; EpiDown dn;
    __device__ __forceinline__ void mid(Acc&, const Unit&, int, int, int, int) const {}
    __device__ __forceinline__ void operator()(const Acc& acc, const Unit& u, int wr, int wc, int fr, int fq) const { if (u.type == 0) up(acc, u, wr, wc, fr, fq); else dn(acc, u, wr, wc, fr, fq); }
};
}

#define XB_TMO      128
#define XB_XCNT(j)  (256  + 64 * (j))
#define XB_XSUB(j)  (1280 + 64 * (j))
#define XB_XGEN(j)  (2304 + 64 * (j))
#define XB_TOP      3328
#define XB_TOPGEN   3392
#define XCD_BAR_WORDS 3456
#define XB_SPIN_CAP (1u << 18)
__device__ __forceinline__ unsigned xb_ld(unsigned* p)              { return __hip_atomic_load(p, __ATOMIC_RELAXED, __HIP_MEMORY_SCOPE_AGENT); }
__device__ __forceinline__ unsigned xb_add(unsigned* p, unsigned v) { return __hip_atomic_fetch_add(p, v, __ATOMIC_RELAXED, __HIP_MEMORY_SCOPE_AGENT); }
__device__ __forceinline__ unsigned xb_xcc_id() { return (unsigned)__builtin_amdgcn_s_getreg((3 << 11) | 20) & 0xFu; }
#define XB_SPIN(cond, bar) do { unsigned _sp = 0; while (cond) { __builtin_amdgcn_s_sleep(1); \
    if ((++_sp & 255u) == 0u) { if (xb_ld(&(bar)[XB_TMO])) break; if (_sp > XB_SPIN_CAP) { atomicAdd(&(bar)[XB_TMO], 1u); break; } } } } while (0)
struct XcdBarrier { unsigned* bar; unsigned x; volatile LAS unsigned* st; };
__device__ __forceinline__ XcdBarrier xcd_barrier_post(unsigned* bar, volatile LAS unsigned* st) {
    XcdBarrier b; b.bar = bar; b.x = xb_xcc_id(); b.st = st;
    if (threadIdx.x == 0) (void)xb_add(&bar[XB_XCNT(b.x)], 1u);
    return b;
}
__device__ __forceinline__ void xcd_barrier_complete(unsigned* bar, unsigned x, unsigned& nloc, unsigned& nx) {
    const unsigned G = gridDim.x * gridDim.y * gridDim.z;
    unsigned sum, cnt, mine, sp = 0u;
    for (;;) {
        sum = 0u; cnt = 0u; mine = 0u;
#pragma unroll
        for (unsigned j = 0; j < 16; ++j) { const unsigned c = xb_ld(&bar[XB_XCNT(j)]); sum += c; cnt += (c > 0u) ? 1u : 0u; mine = (j == x) ? c : mine; }
        if (sum == G) break;
        __builtin_amdgcn_s_sleep(1);
        if ((++sp & 255u) == 0u) { if (xb_ld(&bar[XB_TMO])) break; if (sp > XB_SPIN_CAP) { atomicAdd(&bar[XB_TMO], 1u); break; } }
    }
    nloc = mine > 0u ? mine : 1u; nx = cnt > 0u ? cnt : 1u;
}
__device__ __forceinline__ void xcd_barrier(const XcdBarrier& b) {
    asm volatile("s_waitcnt vmcnt(0)" ::: "memory");
    __syncthreads();
    if (threadIdx.x == 64) asm volatile("buffer_inv sc1\n\ts_waitcnt vmcnt(0)" ::: "memory");
    if (threadIdx.x == 0) {
        unsigned* bar = b.bar;
        __builtin_amdgcn_s_waitcnt(0);
        unsigned nloc = b.st[0], nx = b.st[1];
        if (nloc == 0u) { xcd_barrier_complete(bar, b.x, nloc, nx); b.st[0] = nloc; b.st[1] = nx; }
        const unsigned old = xb_add(&bar[XB_XSUB(b.x)], 1u);
        const unsigned gen = old / nloc;
        if (old + 1u == (gen + 1u) * nloc) {
            __builtin_amdgcn_fence(__ATOMIC_RELEASE, "agent");
            asm volatile("s_waitcnt vmcnt(0)" ::: "memory");
            const unsigned og = xb_add(&bar[XB_TOP], 1u);
            const unsigned tg = og / nx;
            if (og + 1u == (tg + 1u) * nx) xb_add(&bar[XB_TOPGEN], 1u);
            else XB_SPIN(xb_ld(&bar[XB_TOPGEN]) == tg, bar);
            xb_add(&bar[XB_XGEN(b.x)], 1u);
            asm volatile("s_waitcnt vmcnt(0)" ::: "memory");
        } else {
            XB_SPIN(xb_ld(&bar[XB_XGEN(b.x)]) == gen, bar);
            asm volatile("s_waitcnt vmcnt(0)" ::: "memory");
        }
    }
    __syncthreads();
}


__device__ __forceinline__ void tr_item(const float* W, int ldw, int scol0, int srow0, bf16* WT, int Kd, int drow0, int dk0, LAS float* scr, int lane) {
#pragma unroll 8
    for (int i = 0; i < 32; ++i) { const int kk = 2 * i + (lane >> 5); scr[kk * 33 + (lane & 31)] = __builtin_nontemporal_load(W + (size_t)(srow0 + kk) * ldw + scol0 + (lane & 31)); }
    LDS_WAIT(); asm volatile("" ::: "memory");
    const int c = lane & 7;
#pragma unroll
    for (int j = 0; j < 4; ++j) { const int n = (lane >> 3) + 8 * j; const LAS float* s = scr + (8 * c) * 33 + n;
        u32x4 o; o.x = pk2(s[0 * 33], s[1 * 33]); o.y = pk2(s[2 * 33], s[3 * 33]); o.z = pk2(s[4 * 33], s[5 * 33]); o.w = pk2(s[6 * 33], s[7 * 33]);
        *(u32x4*)(WT + (size_t)(drow0 + n) * Kd + dk0 + 8 * c) = o; }
    LDS_WAIT(); asm volatile("" ::: "memory");
}
__device__ __forceinline__ int src_col_u(int np) {
    if (np < 768) return np;
    if (np >= 1792) { const int tt = (np - 1792) >> 8, w = (np - 1792) & 255; return w < 128 ? 1792 + 128 * tt + w : 2816 + 128 * tt + (w - 128); }
    const int tt = (np - 768) >> 8, w = (np - 768) & 255;
    return w < 128 ? 768 + 128 * tt + w : 1280 + 128 * tt + (w - 128);
}

__device__ __forceinline__ void p0_prologue(const Args& a, LAS unsigned char* lds, int gw, int NGW, int lane, int wave) {
    unsigned char* ws = a.ws;
    LAS float* scr = (LAS float*)(lds + wave * 16384);
    constexpr int J1 = 16 * 120, J2 = 8 * 32, J3 = 8 * 32, J4 = 16 * 32;
    constexpr int NITEMS = J1 + J2 + J3 + J4;
    for (int it = gw; it < NITEMS; it += NGW) {
        int r = it;
        if (r < J1) { const int kb = r / 120, nb = r % 120; tr_item(a.in[I_WIN], INW, src_col_u(32 * nb), 64 * kb, (bf16*)(ws + WS_WIN), 1024, 32 * nb, 64 * kb, scr, lane); continue; } r -= J1;
        if (r < J2) { const int kb = r / 32, nb = r % 32; tr_item(a.in[I_WATT], D, 32 * nb, 64 * kb, (bf16*)(ws + WS_WAB), 1024, 32 * nb, 64 * kb, scr, lane); continue; } r -= J2;
        if (r < J3) { const int kb = r / 32, nb = r % 32; tr_item(a.in[I_WCONV], D, 32 * nb, 64 * kb, (bf16*)(ws + WS_WAB), 1024, 32 * nb, 512 + 64 * kb, scr, lane); continue; } r -= J3;
        { const int kb = r / 32, nb = r % 32; tr_item(a.in[I_WO], D, 32 * nb, 64 * kb, (bf16*)(ws + WS_WO), 1024, 32 * nb, 64 * kb, scr, lane); }
    }
    const float* x = a.in[I_X]; bf16* xb = (bf16*)(ws + WS_XB);
    for (int m = gw; m < T; m += NGW) {
        const f32x4* xr = (const f32x4*)(x + (size_t)m * D) + lane; u32x2* o = (u32x2*)(xb + (size_t)m * D) + lane;
#pragma unroll
        for (int j = 0; j < 4; ++j) { const f32x4 v = __builtin_nontemporal_load(xr + 64 * j); u32x2 w; w.x = pk2(v[0], v[1]); w.y = pk2(v[2], v[3]); o[64 * j] = w; }
    }
    { u32x4* abz = (u32x4*)(ws + WS_AB); const u32x4 z4 = (u32x4){0u, 0u, 0u, 0u};
      for (int i = gw * 64 + lane; i < NBATCH * AB_PAD * CCH * 2 / 16; i += NGW * 64) { const int bb = i / (AB_PAD * CCH * 2 / 16), q = i % (AB_PAD * CCH * 2 / 16); abz[(size_t)bb * (AB_SEQ * CCH * 2 / 16) + q] = z4; } }
    float* bperm = (float*)(ws + WS_BPERM);
    for (int i = gw * 64 + lane; i < INW; i += NGW * 64) bperm[i] = a.in[I_BIN][src_col_u(i)];
}

constexpr int KLS = 144, VLS = 528, ATT_V_OFF = 256 * KLS, CONV_W_OFF = 70656;
__device__ __forceinline__ void attn_unit(const Args& a, int unit, LAS unsigned char* lds, int tid, int wave, int lane) {
    const bf16* qb = (const bf16*)(a.ws + WS_QB); const bf16* kb = (const bf16*)(a.ws + WS_KB); const bf16* vT = (const bf16*)(a.ws + WS_VT); bf16* ay = (bf16*)(a.ws + WS_AY);
    const int kvh = unit & 1, blk = (unit >> 1) & 31, b = unit >> 6;
    const int r = lane & 15, qd = lane >> 4, w = wave;
    const int t0 = b * SEQ + blk * 128, seq0 = b * SEQ, lo = w & ~1;
    { u32x4 kreg[4], vreg[4];
#pragma unroll
      for (int i = 0; i < 4; ++i) { const int c = tid + 512 * i;
          int tok = t0 - 128 + (c >> 3); tok = tok < seq0 ? seq0 : tok;
          kreg[i] = ldgo<u32x4>(kb, (unsigned)(tok * KVW + kvh * HD + (c & 7) * 8) * 2u);
          int sk = blk * 128 - 128 + 8 * (c & 31); sk = sk < 0 ? 0 : sk;
          vreg[i] = ldgo<u32x4>(vT, (unsigned)(((b * NKV + kvh) * HD + (c >> 5)) * SEQ + sk) * 2u); }
      __builtin_amdgcn_sched_barrier(0);
      asm volatile("" : "+v"(kreg[0]), "+v"(kreg[1]), "+v"(kreg[2]), "+v"(kreg[3]), "+v"(vreg[0]), "+v"(vreg[1]), "+v"(vreg[2]), "+v"(vreg[3]));
#pragma unroll
      for (int i = 0; i < 4; ++i) { const int c = tid + 512 * i;
          *(LAS u32x4*)(lds + (c >> 3) * KLS + (c & 7) * 16) = kreg[i];
          *(LAS u32x4*)(lds + ATT_V_OFF + (c >> 5) * VLS + (c & 31) * 16) = vreg[i]; } }
    __syncthreads();
    const int qi = 16 * w + r;
#pragma unroll 1
    for (int hh = 0; hh < 4; ++hh) {
        const int head = kvh * 4 + hh;
        u32x4 qf[2];
        { const unsigned qo = (unsigned)((t0 + qi) * AW + head * HD + 8 * qd) * 2u; qf[0] = ldgo<u32x4>(qb, qo); qf[1] = ldgo<u32x4>(qb, qo + 64u); }
        const float sinkv = a.in[I_SINK][head];
        int qiv = qi; asm volatile("" : "+v"(qiv));
        const int klo = max(qiv + 1, blk > 0 ? 0 : 128); const int kjb = lo * 16 + 4 * qd - klo; const unsigned span = (unsigned)(qiv + 128 - klo);
        f32x4 s[10];
#pragma unroll
        for (int i = 0; i < 10; ++i) {
            const LAS unsigned char* kp = lds + ((lo + i) * 16 + r) * KLS + qd * 16;
            const u32x4 k0 = *(const LAS u32x4*)kp, k1 = *(const LAS u32x4*)(kp + 64);
            f32x4 z = (f32x4){0.f, 0.f, 0.f, 0.f};
            z = __builtin_amdgcn_mfma_f32_16x16x32_bf16(__builtin_bit_cast(bf16x8, k0), __builtin_bit_cast(bf16x8, qf[0]), z, 0, 0, 0);
            s[i] = __builtin_amdgcn_mfma_f32_16x16x32_bf16(__builtin_bit_cast(bf16x8, k1), __builtin_bit_cast(bf16x8, qf[1]), z, 0, 0, 0);
        }
        float mx = sinkv;
#pragma unroll
        for (int i = 0; i < 10; ++i)
#pragma unroll
            for (int g = 0; g < 4; ++g) { const bool valid = (unsigned)(kjb + (16 * i + g)) <= span; s[i][g] = valid ? s[i][g] : -1e30f; mx = fmaxf(mx, s[i][g]); }
        mx = fmaxf(mx, __shfl_xor(mx, 16)); mx = fmaxf(mx, __shfl_xor(mx, 32));
        float sum = 0.f;
#pragma unroll
        for (int i = 0; i < 10; ++i)
#pragma unroll
            for (int g = 0; g < 4; ++g) { const float p = (s[i][g] > -1e29f) ? __expf(s[i][g] - mx) : 0.f; s[i][g] = p; sum += p; }
        sum += __shfl_xor(sum, 16); sum += __shfl_xor(sum, 32);
        const float inv = 1.0f / (sum + __expf(sinkv - mx));
        f32x4 o[4];
#pragma unroll
        for (int mt = 0; mt < 4; ++mt) o[mt] = (f32x4){0.f, 0.f, 0.f, 0.f};
#pragma unroll
        for (int ip = 0; ip < 5; ++ip) {
            u32x4 pw; pw.x = cvt_pk_bf16(s[2 * ip][0], s[2 * ip][1]); pw.y = cvt_pk_bf16(s[2 * ip][2], s[2 * ip][3]); pw.z = cvt_pk_bf16(s[2 * ip + 1][0], s[2 * ip + 1][1]); pw.w = cvt_pk_bf16(s[2 * ip + 1][2], s[2 * ip + 1][3]);
            const bf16x8 pb = __builtin_bit_cast(bf16x8, pw);
#pragma unroll
            for (int mt = 0; mt < 4; ++mt) { const LAS unsigned char* vp = lds + ATT_V_OFF + (16 * mt + r) * VLS + ((lo + 2 * ip) * 16 + 4 * qd) * 2;
                const u32x2 va = *(const LAS u32x2*)vp, vb = *(const LAS u32x2*)(vp + 32);
                u32x4 vw; vw.x = va.x; vw.y = va.y; vw.z = vb.x; vw.w = vb.y;
                o[mt] = __builtin_amdgcn_mfma_f32_16x16x32_bf16(__builtin_bit_cast(bf16x8, vw), pb, o[mt], 0, 0, 0); }
        }
        const unsigned oo = (unsigned)((t0 + qi) * D + head * HD + 4 * qd) * 2u;
#pragma unroll
        for (int mt = 0; mt < 4; ++mt) { u32x2 wv; wv.x = cvt_pk_bf16(o[mt][0] * inv, o[mt][1] * inv); wv.y = cvt_pk_bf16(o[mt][2] * inv, o[mt][3] * inv); *(u32x2*)((char*)ay + oo + 32u * mt) = wv; }
    }
    __syncthreads();
}

constexpr int CBS = 516;
__device__ __forceinline__ void conv_unit(const Args& a, int unit, LAS unsigned char* lds, int tid, int wave, int lane) {
    const bf16* ab = (const bf16*)(a.ws + WS_AB); bf16* ay = (bf16*)(a.ws + WS_AY);
    LAS float* cb = (LAS float*)lds;
    const int t0 = unit * 32, prow0 = t0 + AB_PAD * ((t0 >> 12) + 1);
    int cp = tid & 255; asm volatile("" : "+v"(cp));
    const int half = wave >> 2;
    const LAS float* wl = (const LAS float*)(lds + CONV_W_OFF) + 2 * cp;
    const f32x2 cbias = *(const f32x2*)(a.in[I_CONVB] + 2 * cp);
#pragma unroll 1
    for (int it = 0; it < 2; ++it) {
        const int tl0 = 16 * half + 8 * it;
        const unsigned o0 = (unsigned)((prow0 + tl0 - 30) * CCH + 2 * cp) * 2u;
        unsigned raw[38];
#pragma unroll
        for (int rr = 0; rr < 38; ++rr) raw[rr] = ldgo<unsigned>(ab, o0 + (unsigned)(rr * CCH * 2));
        __builtin_amdgcn_sched_barrier(0);
        asm volatile("" : "+v"(raw[0]), "+v"(raw[1]), "+v"(raw[2]), "+v"(raw[3]), "+v"(raw[4]), "+v"(raw[5]), "+v"(raw[6]), "+v"(raw[7]), "+v"(raw[8]), "+v"(raw[9]),
                          "+v"(raw[10]), "+v"(raw[11]), "+v"(raw[12]), "+v"(raw[13]), "+v"(raw[14]), "+v"(raw[15]), "+v"(raw[16]), "+v"(raw[17]), "+v"(raw[18]));
        asm volatile("" : "+v"(raw[19]), "+v"(raw[20]), "+v"(raw[21]), "+v"(raw[22]), "+v"(raw[23]), "+v"(raw[24]), "+v"(raw[25]), "+v"(raw[26]), "+v"(raw[27]), "+v"(raw[28]),
                          "+v"(raw[29]), "+v"(raw[30]), "+v"(raw[31]), "+v"(raw[32]), "+v"(raw[33]), "+v"(raw[34]), "+v"(raw[35]), "+v"(raw[36]), "+v"(raw[37]));
        float i0[38], i1[38];
#pragma unroll
        for (int rr = 0; rr < 38; ++rr) { i0[rr] = bflo(raw[rr]); i1[rr] = bfhi(raw[rr]); }
        float a0[8], a1[8];
#pragma unroll
        for (int o = 0; o < 8; ++o) { a0[o] = cbias.x; a1[o] = cbias.y; }
#pragma unroll
        for (int j = 0; j < CW; ++j) { const f32x2 wv = *(const LAS f32x2*)(wl + j * CCH);
#pragma unroll
            for (int o = 0; o < 8; ++o) { a0[o] = fmaf(i0[o + j], wv.x, a0[o]); a1[o] = fmaf(i1[o + j], wv.y, a1[o]); } }
#pragma unroll
        for (int o = 0; o < 8; ++o) *(LAS f32x2*)(cb + (tl0 + o) * CBS + 2 * cp) = (f32x2){a0[o], a1[o]};
    }
    __syncthreads();
    const f32x4 g0 = *(const f32x4*)(a.in[I_CLNG] + 8 * lane), g1 = *(const f32x4*)(a.in[I_CLNG] + 8 * lane + 4), b0 = *(const f32x4*)(a.in[I_CLNB] + 8 * lane), b1 = *(const f32x4*)(a.in[I_CLNB] + 8 * lane + 4);
#pragma unroll
    for (int tt = 0; tt < 4; ++tt) { const int tok = 4 * wave + tt;
        f32x4 v0 = *(const LAS f32x4*)(cb + tok * CBS + 8 * lane), v1 = *(const LAS f32x4*)(cb + tok * CBS + 8 * lane + 4);
        const float mean = wave_sum((v0[0] + v0[1]) + (v0[2] + v0[3]) + (v1[0] + v1[1]) + (v1[2] + v1[3])) * (1.0f / CCH);
        v0 = v0 - mean; v1 = v1 - mean;
        const float var = wave_sum((v0[0] * v0[0] + v0[1] * v0[1]) + (v0[2] * v0[2] + v0[3] * v0[3]) + (v1[0] * v1[0] + v1[1] * v1[1]) + (v1[2] * v1[2] + v1[3] * v1[3])) * (1.0f / CCH);
        const float rstd = 1.0f / sqrtf(var + LN_EPS);
        float y[8];
#pragma unroll
        for (int j = 0; j < 4; ++j) { const float y0 = v0[j] * rstd * g0[j] + b0[j], y1 = v1[j] * rstd * g1[j] + b1[j]; y[j] = y0 * sigmoidf_(y0); y[4 + j] = y1 * sigmoidf_(y1); }
        u32x4 wv; wv.x = cvt_pk_bf16(y[0], y[1]); wv.y = cvt_pk_bf16(y[2], y[3]); wv.z = cvt_pk_bf16(y[4], y[5]); wv.w = cvt_pk_bf16(y[6], y[7]);
        *(u32x4*)(ay + (size_t)(t0 + tok) * D + 512 + 8 * lane) = wv; }
    __syncthreads();
}

constexpr int HLS = 1025;
__device__ __forceinline__ void route_chunk(const Args& a, int chunk, LAS unsigned char* lds, int tid, int wave, int lane, const float (&bw)[64], const f32x4 (&g)[4], const f32x4 (&bb)[4]) {
    const bf16* hf = (const bf16*)(a.ws + WS_HF); unsigned char* hb = a.ws + WS_HB;
    int* slot = (int*)(a.ws + WS_SLOT); float* gatev = (float*)(a.ws + WS_GATE); unsigned* cursor = (unsigned*)(a.ws + WS_CTL);
    LAS float* hl = (LAS float*)lds;
    LAS float* lg = (LAS float*)(lds + MISC_OFF + MO_LG); LAS int* sel_e = (LAS int*)(lds + MISC_OFF + MO_SELE); LAS float* sel_g = (LAS float*)(lds + MISC_OFF + MO_SELG);
    LAS int* lcnt = (LAS int*)(lds + MISC_OFF + MO_LCNT); LAS int* lbase = (LAS int*)(lds + MISC_OFF + MO_LBASE);
    const int t0 = chunk * 32;
    f32x4 v[4][4];
    { u32x2 rw[4][4];
#pragma unroll
      for (int tt = 0; tt < 4; ++tt)
#pragma unroll
        for (int j = 0; j < 4; ++j) rw[tt][j] = *((const u32x2*)(hf + (size_t)(t0 + 4 * wave + tt) * D) + lane + 64 * j);
      __builtin_amdgcn_sched_barrier(0);
      asm volatile("" : "+v"(rw[0][0]), "+v"(rw[0][1]), "+v"(rw[0][2]), "+v"(rw[0][3]), "+v"(rw[1][0]), "+v"(rw[1][1]), "+v"(rw[1][2]), "+v"(rw[1][3]),
                        "+v"(rw[2][0]), "+v"(rw[2][1]), "+v"(rw[2][2]), "+v"(rw[2][3]), "+v"(rw[3][0]), "+v"(rw[3][1]), "+v"(rw[3][2]), "+v"(rw[3][3]));
#pragma unroll
      for (int tt = 0; tt < 4; ++tt)
#pragma unroll
        for (int j = 0; j < 4; ++j) v[tt][j] = (f32x4){bflo(rw[tt][j].x), bfhi(rw[tt][j].x), bflo(rw[tt][j].y), bfhi(rw[tt][j].y)}; }
#pragma unroll
    for (int tt = 0; tt < 4; ++tt) { const int tl = 4 * wave + tt;
        float sm = 0.f;
#pragma unroll
        for (int j = 0; j < 4; ++j) sm += (v[tt][j][0] + v[tt][j][1]) + (v[tt][j][2] + v[tt][j][3]);
        const float mean = wave_sum(sm) * (1.0f / D); float s2 = 0.f;
#pragma unroll
        for (int j = 0; j < 4; ++j) { v[tt][j] = v[tt][j] - mean; s2 += (v[tt][j][0] * v[tt][j][0] + v[tt][j][1] * v[tt][j][1]) + (v[tt][j][2] * v[tt][j][2] + v[tt][j][3] * v[tt][j][3]); }
        const float rstd = 1.0f / sqrtf(wave_sum(s2) * (1.0f / D) + LN_EPS);
        if (lane == 0) *(f32x2*)((float*)(a.ws + WS_LN1S) + 2 * (size_t)(t0 + tl)) = (f32x2){mean, rstd};
#pragma unroll
        for (int j = 0; j < 4; ++j) { const f32x4 h = v[tt][j] * rstd * g[j] + bb[j];
            unsigned wv = 0u; wv = __builtin_amdgcn_cvt_pk_fp8_f32(h[0] * 8.0f, h[1] * 8.0f, wv, false); wv = __builtin_amdgcn_cvt_pk_fp8_f32(h[2] * 8.0f, h[3] * 8.0f, wv, true); *((unsigned*)(hb + (size_t)(t0 + tl) * D) + lane + 64 * j) = wv;
            LAS float* hp = hl + tl * HLS + 4 * lane + 256 * j; hp[0] = h[0]; hp[1] = h[1]; hp[2] = h[2]; hp[3] = h[3]; }
    }
    if (tid < 32) lcnt[tid] = 0;
    __syncthreads();
    f32x16 acc;
#pragma unroll
    for (int i = 0; i < 16; ++i) acc[i] = 0.f;
    { const int tok = lane & 31, kp = lane >> 5; const LAS float* hp = hl + tok * HLS + 128 * wave + kp;
#pragma unroll
      for (int s = 0; s < 64; ++s) acc = __builtin_amdgcn_mfma_f32_32x32x2f32(hp[2 * s], bw[s], acc, 0, 0, 0); }
    __syncthreads();
    { LAS float* part = hl + wave * 1024;
#pragma unroll
      for (int i = 0; i < 16; ++i) { const int rowi = (i & 3) + 8 * (i >> 2) + 4 * (lane >> 5); part[rowi * 32 + (lane & 31)] = acc[i]; } }
    __syncthreads();
    for (int o = tid; o < 1024; o += 512) { float sm = a.in[I_BR][o & 31];
#pragma unroll
        for (int w = 0; w < 8; ++w) sm += hl[w * 1024 + o];
        lg[(o >> 5) * 33 + (o & 31)] = sm; }
    __syncthreads();
    if (tid < 32) { float v[NE];
#pragma unroll
        for (int e = 0; e < NE; ++e) v[e] = lg[tid * 33 + e];
        float tv[4]; int ti[4];
#pragma unroll
        for (int k = 0; k < 4; ++k) { float best = -3.0e38f; int bi = 0;
#pragma unroll
            for (int e = 0; e < NE; ++e) { const bool take = v[e] > best; best = take ? v[e] : best; bi = take ? e : bi; }
            tv[k] = best; ti[k] = bi;
#pragma unroll
            for (int e = 0; e < NE; ++e) v[e] = (e == bi) ? -3.0e38f : v[e]; }
        const float e1 = __expf(tv[1] - tv[0]), e2 = __expf(tv[2] - tv[0]), e3 = __expf(tv[3] - tv[0]); const float inv = 1.0f / (1.0f + e1 + e2 + e3);
        sel_e[4 * tid + 0] = ti[0]; sel_e[4 * tid + 1] = ti[1]; sel_e[4 * tid + 2] = ti[2]; sel_e[4 * tid + 3] = ti[3];
        sel_g[4 * tid + 0] = inv; sel_g[4 * tid + 1] = e1 * inv; sel_g[4 * tid + 2] = e2 * inv; sel_g[4 * tid + 3] = e3 * inv; }
    __syncthreads();
    int my_e = 0, my_rank = 0;
    if (tid < 128) { my_e = sel_e[tid]; my_rank = atomicAdd((int*)&lcnt[my_e], 1); }
    __syncthreads();
    if (tid < 32) { const int c = lcnt[tid]; lbase[tid] = c > 0 ? (int)atomicAdd(cursor + tid, (unsigned)c) : 0; }
    __syncthreads();
    if (tid < 128) { const int asg = (t0 + (tid >> 2)) * 4 + (tid & 3); slot[my_e * SLOT_CAP + lbase[my_e] + my_rank] = asg; gatev[asg] = sel_g[tid]; }
    __syncthreads();
}

__device__ __forceinline__ void combine_row(const Args& a, int m, int lane) {
    const bf16* hf = (const bf16*)(a.ws + WS_HF); const unsigned char* ys = a.ws + WS_YS; const float* gatev = (const float*)(a.ws + WS_GATE);
    f32x4 gt = *(const f32x4*)(gatev + 4 * (size_t)m); gt = gt * (1.0f / 16.0f);
    const f32x2 st = *(const f32x2*)((const float*)(a.ws + WS_LN1S) + 2 * (size_t)m);
    f32x4 v[4]; float sm = 0.f;
#pragma unroll
    for (int j = 0; j < 4; ++j) { const f32x4 g1 = *((const f32x4*)a.in[I_LN1G] + lane + 64 * j), b1 = *((const f32x4*)a.in[I_LN1B] + lane + 64 * j);
        const u32x2 pw = *((const u32x2*)(hf + (size_t)m * D) + lane + 64 * j); f32x4 p = (f32x4){bflo(pw.x), bfhi(pw.x), bflo(pw.y), bfhi(pw.y)}; p = p - st.x; const f32x4 h = p * st.y * g1 + b1;
        v[j] = h * DN_ALPHA;
#pragma unroll
        for (int k = 0; k < 4; ++k) { const unsigned y = *((const unsigned*)(ys + ((size_t)m * 4 + k) * D) + lane + 64 * j); const float gk = gt[k];
            const f32x2 lo = __builtin_amdgcn_cvt_pk_f32_fp8(y, false), hi = __builtin_amdgcn_cvt_pk_f32_fp8(y, true);
            v[j][0] += gk * lo.x; v[j][1] += gk * lo.y; v[j][2] += gk * hi.x; v[j][3] += gk * hi.y; }
        sm += (v[j][0] + v[j][1]) + (v[j][2] + v[j][3]); }
    const float mean = wave_sum(sm) * (1.0f / D); float s2 = 0.f;
#pragma unroll
    for (int j = 0; j < 4; ++j) { v[j] = v[j] - mean; s2 += (v[j][0] * v[j][0] + v[j][1] * v[j][1]) + (v[j][2] * v[j][2] + v[j][3] * v[j][3]); }
    const float rstd = 1.0f / sqrtf(wave_sum(s2) * (1.0f / D) + LN_EPS);
#pragma unroll
    for (int j = 0; j < 4; ++j) { const f32x4 g = *((const f32x4*)a.in[I_LN2G] + lane + 64 * j), bb = *((const f32x4*)a.in[I_LN2B] + lane + 64 * j);
        *((f32x4*)(a.out + (size_t)m * D) + lane + 64 * j) = v[j] * rstd * g + bb; }
}

__global__ void __launch_bounds__(512, 2) fwd_megakernel(Args args) {
    extern __shared__ __attribute__((aligned(16))) unsigned char lds_raw[];
    LAS unsigned char* lds = (LAS unsigned char*)lds_raw;
    const int tid = threadIdx.x, wave = __builtin_amdgcn_readfirstlane(tid >> 6);
#define FRESH_LANE int lane; { int t_ = tid; asm volatile("" : "+v"(t_)); lane = t_ & 63; }
    const int G = gridDim.x, bx = blockIdx.x;
    const int vcu = (G % 8 == 0) ? (bx % 8) * (G / 8) + bx / 8 : bx;
    const int gw = vcu * 8 + wave, NGW = G * 8;
    const int lo = args.ph_lo, hi = args.ph_hi;
    unsigned char* ws = args.ws;
    volatile LAS unsigned* bst = (volatile LAS unsigned*)(lds + MISC_OFF + MO_BAR);
    if (tid < 2) bst[tid] = 0u;
    __syncthreads();
    XcdBarrier xbar = xcd_barrier_post((unsigned*)(ws + WS_CTL) + CW_BAR, bst);
#ifndef PMASK
#define PMASK 0x1ff
#endif
#define IN(k) (((PMASK >> (k)) & 1) && lo <= (k) && (k) < hi)
#define SEAM(k) do { if (lo <= (k) && (k) + 1 < hi) xcd_barrier(xbar); } while (0)

    if (IN(0)) { FRESH_LANE; p0_prologue(args, lds, gw, NGW, lane, wave); }
    SEAM(0);
    if (IN(1)) {
        pg8::DenseOrder S; S.init(ws + WS_XB, ws + WS_WIN, T, INW, G, bx);
        pg8::EpiU E{(bf16*)(ws + WS_QB), (bf16*)(ws + WS_KB), (bf16*)(ws + WS_VT), (bf16*)(ws + WS_AB), (bf16*)(ws + WS_GATES), (const float*)(ws + WS_BPERM)};
        const int slot = vcu & 3;
        S.i0 = 0; S.i1 = slot;
        pg8::gemm_phase<pg8::EpiU, pg8::DenseOrder>(lds, S, E);
        { FRESH_LANE; side_convert_dma(args, bx, G, wave, lane, lds); }
        __syncthreads();
        S.i0 = slot; S.i1 = 1 << 20;
        pg8::gemm_phase<pg8::EpiU, pg8::DenseOrder>(lds, S, E);
    }
    SEAM(1);
    if (IN(2)) {
        FRESH_LANE;
        __syncthreads();
        for (int i = tid; i < CW * CCH / 4; i += 512) ((LAS f32x4*)(lds + CONV_W_OFF))[i] = ((const f32x4*)args.in[I_CONVW])[i];
        __syncthreads();
        for (int u = vcu; u < 256 + 512; u += G) {
            if (u < 256) attn_unit(args, u, lds, tid, wave, lane);
            else conv_unit(args, u - 256, lds, tid, wave, lane);
        }
    }
    SEAM(2);
    if (IN(3)) {
        pg8::DenseOrder S; S.init(ws + WS_AY, ws + WS_WAB, T, D, G, bx);
        pg8::EpiMerged E{(const bf16*)(ws + WS_GATES), args.in[I_BCONV], (bf16*)(ws + WS_MERGED)};
        pg8::gemm_phase<pg8::EpiMerged, pg8::DenseOrder>(lds, S, E);
    }
    SEAM(3);
    if (IN(4)) {
        pg8::DenseOrder S; S.init(ws + WS_MERGED, ws + WS_WO, T, D, G, bx);
        pg8::EpiPre1 E{(const bf16*)(ws + WS_XB), (bf16*)(ws + WS_HF)};
        pg8::gemm_phase<pg8::EpiPre1, pg8::DenseOrder>(lds, S, E);
    }
    SEAM(4);
    if (IN(5)) {
        FRESH_LANE;
        __syncthreads();
        float bw[64]; f32x4 g1[4], b1[4];
#pragma unroll
        for (int s_ = 0; s_ < 64; ++s_) bw[s_] = args.in[I_WR][(size_t)(128 * wave + 2 * s_ + (lane >> 5)) * NE + (lane & 31)];
#pragma unroll
        for (int j = 0; j < 4; ++j) { g1[j] = *((const f32x4*)args.in[I_LN1G] + lane + 64 * j); b1[j] = *((const f32x4*)args.in[I_LN1B] + lane + 64 * j); }
        for (int c = vcu; c < T / 32; c += G) route_chunk(args, c, lds, tid, wave, lane, bw, g1, b1);
    }
    SEAM(5);
    if (IN(6) || IN(7)) {
        LAS int* tab = (LAS int*)(lds + MISC_OFF + MO_TAB);
        __syncthreads();
        if (tid == 0) { const unsigned* cursor = (const unsigned*)(ws + WS_CTL); int acc = 0;
            for (int e = 0; e < NE; ++e) { const int c = (int)__hip_atomic_load(cursor + e, __ATOMIC_RELAXED, __HIP_MEMORY_SCOPE_AGENT); tab[e] = c; const int ml = (c + 255) >> 8; tab[32 + e] = ml; tab[64 + e] = acc; acc += ml; }
            tab[64 + NE] = acc; }
        __syncthreads();
        const int total_mt = tab[64 + NE];
        if (IN(6)) {
            unsigned* ctl = (unsigned*)(ws + WS_CTL);
            pg8::MoeFusedOrder S{tab, G, vcu, total_mt * 8, total_mt * 4, (const char*)(ws + WS_HB), (const char*)(ws + WS_ACT), (const char*)(ws + WS_WUP), (const char*)(ws + WS_WDN), (const int*)(ws + WS_SLOT), ctl + 8192, ctl + 64};
            pg8::EpiMoe E{pg8::EpiUpX{args.in[I_BUP], ws + WS_ACT}, pg8::EpiDown{args.in[I_BDN], (const int*)(ws + WS_SLOT), ws + WS_YS}};
            pg8::gemm_phase<pg8::EpiMoe, pg8::MoeFusedOrder, true>(lds, S, E);
        }
    }
    SEAM(7);
    if (IN(8)) { FRESH_LANE; for (int m = gw; m < T; m += NGW) combine_row(args, m, lane); }

#undef IN
#undef SEAM
#undef FRESH_LANE
}

extern "C" void kernel_launch(void* const* d_in, const int* in_sizes, int n_in, void* d_out, int out_size, void* d_ws, size_t ws_size, hipStream_t stream) {
    static int grid = 0;
    if (grid == 0) {
        if (n_in != 22 || out_size != T * D || ws_size < WS_END) { fprintf(stderr, "kernel_launch: unexpected problem (n_in %d, out %d, ws %zu)\n", n_in, out_size, ws_size); grid = -1; return; }
        int dev = 0, cus = 0, per_cu = 0;
        hipGetDevice(&dev); hipDeviceGetAttribute(&cus, hipDeviceAttributeMultiprocessorCount, dev);
        hipFuncSetAttribute((const void*)fwd_megakernel, hipFuncAttributeMaxDynamicSharedMemorySize, LDS_BYTES);
        hipOccupancyMaxActiveBlocksPerMultiprocessor(&per_cu, (const void*)fwd_megakernel, 512, LDS_BYTES);
        if (per_cu < 1) { fprintf(stderr, "kernel_launch: occupancy query says %d blocks per CU\n", per_cu); per_cu = 1; }
        (void)hipGetLastError();
        grid = cus * 1;
        fprintf(stderr, "kernel_launch: grid %d (cus %d, occupancy %d)\n", grid, cus, per_cu);
    }
    if (grid < 0) return;
    hipMemsetAsync((char*)d_ws + WS_CTL, 0, 65536, stream);
    Args a{};
    for (int i = 0; i < 22; ++i) a.in[i] = (const float*)d_in[i];
    a.out = (float*)d_out; a.ws = (unsigned char*)d_ws; a.ph_lo = 0; a.ph_hi = 9;
    void* kargs[] = {&a};
    hipError_t e = hipLaunchCooperativeKernel((const void*)fwd_megakernel, dim3(grid), dim3(512), kargs, LDS_BYTES, stream);
    if (e != hipSuccess) fprintf(stderr, "cooperative launch failed: %s (grid %d)\n", hipGetErrorString(e), grid);
}
```

```cpp
#include <hip/hip_runtime.h>
#include <cstdio>
#include <cstdint>

#define GAS __attribute__((address_space(1)))
#define LAS __attribute__((address_space(3)))
typedef unsigned short bf16;
typedef short bf16x8 __attribute__((ext_vector_type(8)));
typedef float f32x4 __attribute__((ext_vector_type(4)));
typedef float f32x2 __attribute__((ext_vector_type(2)));
typedef float f32x16 __attribute__((ext_vector_type(16)));
typedef unsigned u32x4 __attribute__((ext_vector_type(4)));
typedef unsigned u32x2 __attribute__((ext_vector_type(2)));

constexpr int T = 16384, D = 1024, SEQ = 4096, NBATCH = 4;
constexpr int NH = 8, NKV = 2, HD = 64, AW = 512, KVW = 128, CCH = 512, CW = 31;
constexpr int INW = 3840, NE = 32, TOPK = 4, DE = 1024;
constexpr float LN_EPS = 1e-5f;
constexpr float DN_ALPHA = 1.189207115002721f;
constexpr int SLOT_CAP = 16384;
constexpr int MAX_MT = (T * TOPK) / 256 + NE;

constexpr size_t MiB = 1u << 20;
constexpr size_t WS_CTL = 0, CTL_BYTES = 65536;
constexpr int CW_BAR = 4096, CW_T3 = 13312, CW_T4 = 14336;
constexpr size_t WS_WIN = 1 * MiB;
constexpr size_t WS_WAB = 9 * MiB;
constexpr size_t WS_WO = 11 * MiB;
constexpr size_t WS_BPERM = 13 * MiB;
constexpr size_t WS_SLOT = 14 * MiB;
constexpr size_t WS_GATE = 16 * MiB;
constexpr size_t WS_LN1S = 17 * MiB;
constexpr size_t WS_WUP = 32 * MiB;
constexpr size_t WS_WDN = 160 * MiB;
constexpr size_t WS_XB = 224 * MiB;
constexpr size_t WS_QB = 256 * MiB;
constexpr size_t WS_KB = 272 * MiB;
constexpr size_t WS_VT = 276 * MiB;
constexpr size_t WS_AB = 792 * MiB;
constexpr size_t WS_GATES = 296 * MiB;
constexpr size_t WS_AY = 360 * MiB;
constexpr size_t WS_MERGED = 392 * MiB;
constexpr size_t WS_HF = 424 * MiB;
constexpr size_t WS_HB = 488 * MiB;
constexpr size_t WS_ACT = 520 * MiB;
constexpr size_t WS_YS = 664 * MiB;
constexpr size_t WS_END = 810 * MiB;
constexpr int AB_PAD = 32, AB_SEQ = SEQ + AB_PAD;

constexpr int LDS_SCR = 135168;
constexpr int MISC_OFF = 135168;
constexpr int MO_LG = 0, MO_SELE = 4224, MO_SELG = 4736, MO_LCNT = 5248, MO_LBASE = 5376, MO_TAB = 5504, MO_BAR = 6016, MO_RDY = 6080;
constexpr int OFFN_OFF = 147456;
constexpr int LDS_BYTES = 155648;

#define LDS_WAIT() asm volatile("s_waitcnt lgkmcnt(0)" ::: "memory")
#define VM_WAIT() asm volatile("s_waitcnt vmcnt(0)" ::: "memory")

__device__ __forceinline__ unsigned f2bf(float f) { unsigned u = __builtin_bit_cast(unsigned, f); return (u + 0x7fffu + ((u >> 16) & 1u)) >> 16; }
__device__ __forceinline__ unsigned pk2(float lo, float hi) { return f2bf(lo) | (f2bf(hi) << 16); }
__device__ __forceinline__ float bf2f(unsigned b) { return __builtin_bit_cast(float, b << 16); }
__device__ __forceinline__ float bflo(unsigned w) { return __builtin_bit_cast(float, w << 16); }
__device__ __forceinline__ float bfhi(unsigned w) { return __builtin_bit_cast(float, w & 0xffff0000u); }
typedef __bf16 bf16x2_t __attribute__((ext_vector_type(2)));
__device__ __forceinline__ unsigned cvt_pk_bf16(float lo, float hi) { const f32x2 v = {lo, hi}; return __builtin_bit_cast(unsigned, __builtin_convertvector(v, bf16x2_t)); }
__device__ __forceinline__ float sigmoidf_(float x) { return __builtin_amdgcn_rcpf(1.0f + __expf(-x)); }
#define DPP_ADD(v, ctrl) ((v) + __builtin_bit_cast(float, __builtin_amdgcn_update_dpp(0, __builtin_bit_cast(int, (v)), (ctrl), 0xf, 0xf, true)))
__device__ __forceinline__ float wave_sum(float v) {
    v = DPP_ADD(v, 0xB1);
    v = DPP_ADD(v, 0x4E);
    v = DPP_ADD(v, 0x141);
    v = DPP_ADD(v, 0x140);
    const int vi = __builtin_bit_cast(int, v);
    const float r0 = __builtin_bit_cast(float, __builtin_amdgcn_readlane(vi, 0)), r1 = __builtin_bit_cast(float, __builtin_amdgcn_readlane(vi, 16));
    const float r2 = __builtin_bit_cast(float, __builtin_amdgcn_readlane(vi, 32)), r3 = __builtin_bit_cast(float, __builtin_amdgcn_readlane(vi, 48));
    return (r0 + r1) + (r2 + r3);
}
template <class V> __device__ __forceinline__ V ldgo(const void* base, unsigned off) { return *(const V*)((const char*)base + off); }
#define PIN10(a) asm volatile("" : "+v"((a)[0]), "+v"((a)[1]), "+v"((a)[2]), "+v"((a)[3]), "+v"((a)[4]), "+v"((a)[5]), "+v"((a)[6]), "+v"((a)[7]), "+v"((a)[8]), "+v"((a)[9]))

struct Args { const float* in[22]; float* out; unsigned char* ws; int ph_lo, ph_hi; };
enum { I_X = 0, I_WIN, I_BIN, I_SINK, I_WATT, I_CONVW, I_CONVB, I_CLNG, I_CLNB, I_WCONV, I_BCONV, I_WO, I_LN1G, I_LN1B, I_WR, I_BR, I_WUP, I_BUP, I_WDN, I_BDN, I_LN2G, I_LN2B };
constexpr int CVI_UP = NE * 64, CVI_DN = NE * 32, CVI_ITEMS = CVI_UP + CVI_DN;
__device__ __forceinline__ void cvi_decode(const Args& a, int it, const float*& src, unsigned char*& dst, int& nw) {
    if (it < CVI_UP) { const int e = it >> 6, kg = it & 63; nw = 2048; src = a.in[I_WUP] + ((size_t)e * 1024 + 16 * kg) * 2048; dst = a.ws + WS_WUP + (size_t)e * 2048 * 1024 + (size_t)kg * 2048 * 16; }
    else { const int r = it - CVI_UP, e = r >> 5, kg2 = r & 31; nw = 1024; src = a.in[I_WDN] + ((size_t)e * 1024 + 32 * kg2) * 1024; dst = a.ws + WS_WDN + (size_t)e * 1024 * 1024 + (size_t)kg2 * 2 * 1024 * 16; }
}
__device__ __forceinline__ void cvi_slice_ptrs(const Args& a, int it, int wave, int lane, const float*& sp, unsigned& pitch, unsigned char*& dp) {
    const float* src; unsigned char* dst; int nw; cvi_decode(a, it, src, dst, nw);
    const int g = nw == 2048 ? 0 : (wave >> 2), cw = nw == 2048 ? wave : (wave & 3);
    sp = src + (size_t)(16 * g) * nw + 256 * cw + 4 * lane; pitch = (unsigned)nw;
    dp = dst + ((size_t)g * nw + 256 * cw + 4 * lane) * 16;
}
__device__ __forceinline__ void cvi_slice_load(const float* sp, unsigned pitch, f32x4 (&r)[16]) {
#pragma unroll
    for (int kk = 0; kk < 16; ++kk) r[kk] = __builtin_nontemporal_load((const f32x4*)(sp + (size_t)kk * pitch));
}
__device__ __forceinline__ void cvi_slice_out(unsigned char* dp, f32x4 (&r)[16]) {
    asm volatile("" : "+v"(r[0]), "+v"(r[1]), "+v"(r[2]), "+v"(r[3]), "+v"(r[4]), "+v"(r[5]), "+v"(r[6]), "+v"(r[7]), "+v"(r[8]), "+v"(r[9]), "+v"(r[10]), "+v"(r[11]), "+v"(r[12]), "+v"(r[13]), "+v"(r[14]), "+v"(r[15]));
#pragma unroll
    for (int j = 0; j < 4; ++j) { unsigned w[4];
#pragma unroll
        for (int c = 0; c < 4; ++c) { unsigned x = 0u; x = __builtin_amdgcn_cvt_pk_fp8_f32(r[4 * c][j] * 64.0f, r[4 * c + 1][j] * 64.0f, x, false);
            x = __builtin_amdgcn_cvt_pk_fp8_f32(r[4 * c + 2][j] * 64.0f, r[4 * c + 3][j] * 64.0f, x, true); w[c] = x; }
        *(u32x4*)(dp + 16 * j) = (u32x4){w[0], w[1], w[2], w[3]}; }
}
__device__ __forceinline__ void side_convert(const Args& a, int bx, int G, int wave, int lane) {
    int base, nit;
    if (G == 256) { base = bx < 192 ? 11 * bx : 2112 + 15 * (bx - 192); nit = bx < 192 ? 11 : 15; }
    else { const int per = (CVI_ITEMS + G - 1) / G; base = bx * per; nit = base >= CVI_ITEMS ? 0 : (CVI_ITEMS - base < per ? CVI_ITEMS - base : per); }
    const int end = base + nit;
    f32x4 r0[16], r1[16];
    const float* sp0; const float* sp1; unsigned p0 = 0, p1 = 0; unsigned char* d0; unsigned char* d1;
    if (nit > 0) { cvi_slice_ptrs(a, base, wave, lane, sp0, p0, d0); cvi_slice_load(sp0, p0, r0); }
    if (nit > 1) { cvi_slice_ptrs(a, base + 1, wave, lane, sp1, p1, d1); cvi_slice_load(sp1, p1, r1); }
#pragma unroll 1
    for (int it0 = base; it0 < end; it0 += 2) {
        const int it1 = it0 + 1;
        { unsigned char* dcur = d0; cvi_slice_out(dcur, r0); if (it0 + 2 < end) { cvi_slice_ptrs(a, it0 + 2, wave, lane, sp0, p0, d0); cvi_slice_load(sp0, p0, r0); } }
        if (it1 >= end) break;
        { unsigned char* dcur = d1; cvi_slice_out(dcur, r1); if (it1 + 2 < end) { cvi_slice_ptrs(a, it1 + 2, wave, lane, sp1, p1, d1); cvi_slice_load(sp1, p1, r1); } }
    }
}

__device__ __forceinline__ void side_convert_dma(const Args& a, int bx, int G, int wave, int lane, LAS unsigned char* lds) {
    int base, nit;
    if (G == 256) { base = bx < 192 ? 11 * bx : 2112 + 15 * (bx - 192); nit = bx < 192 ? 11 : 15; }
    else { const int per = (CVI_ITEMS + G - 1) / G; base = bx * per; nit = base >= CVI_ITEMS ? 0 : (CVI_ITEMS - base < per ? CVI_ITEMS - base : per); }
    const int end = base + nit;
    LAS unsigned char* wb = lds + wave * 16384;
    const float* sp; unsigned pitch = 0; unsigned char* dnext = nullptr;
#define CVD_DMA(h) do { _Pragma("unroll") for (int kk = 8 * (h); kk < 8 * (h) + 8; ++kk) \
        __builtin_amdgcn_global_load_lds((const unsigned*)(sp + (size_t)kk * pitch), (LAS unsigned*)(wb + kk * 1024), 16, 0, 2); } while (0)
    if (nit > 0) { cvi_slice_ptrs(a, base, wave, lane, sp, pitch, dnext); CVD_DMA(0); CVD_DMA(1); }
#pragma unroll 1
    for (int it = base; it < end; ++it) {
        unsigned char* dcur = dnext;
        f32x4 r[16];
        asm volatile("s_waitcnt vmcnt(8)" ::: "memory");
#pragma unroll
        for (int kk = 0; kk < 8; ++kk) r[kk] = *(const LAS f32x4*)(wb + kk * 1024 + lane * 16);
        asm volatile("s_waitcnt lgkmcnt(0)" ::: "memory");
        asm volatile("" : "+v"(r[0]), "+v"(r[1]), "+v"(r[2]), "+v"(r[3]), "+v"(r[4]), "+v"(r[5]), "+v"(r[6]), "+v"(r[7]));
        const bool more = it + 1 < end;
        if (more) { cvi_slice_ptrs(a, it + 1, wave, lane, sp, pitch, dnext); CVD_DMA(0); }
        if (more) asm volatile("s_waitcnt vmcnt(8)" ::: "memory"); else asm volatile("s_waitcnt vmcnt(0)" ::: "memory");
#pragma unroll
        for (int kk = 8; kk < 16; ++kk) r[kk] = *(const LAS f32x4*)(wb + kk * 1024 + lane * 16);
        asm volatile("s_waitcnt lgkmcnt(0)" ::: "memory");
        asm volatile("" : "+v"(r[8]), "+v"(r[9]), "+v"(r[10]), "+v"(r[11]), "+v"(r[12]), "+v"(r[13]), "+v"(r[14]), "+v"(r[15]));
        if (more) CVD_DMA(1);
        cvi_slice_out(dcur, r);
    }
#undef CVD_DMA
    asm volatile("s_waitcnt vmcnt(0)" ::: "memory");
}

namespace pg8 {
constexpr int BM = 256, BK = 64, HALF = 128, HTB = HALF * BK * 2, STAGE_BYTES = 8 * HTB, NXCD = 8, WGM = 8;
constexpr int KD = 1024, NT_K = KD / BK;
__device__ __forceinline__ void stgw(void* base, unsigned off, u32x4 v) { __builtin_amdgcn_raw_buffer_store_b128(v, __builtin_amdgcn_make_buffer_rsrc(base, 0, 0x7FFFFFFF, 0x00020000), off, 0, 16); }
__device__ __forceinline__ void tile_signal(unsigned* cnt, int pm) { asm volatile("s_waitcnt vmcnt(0)" ::: "memory"); if ((threadIdx.x & 63) == 0) __hip_atomic_fetch_add(cnt + 16 * pm, 1u, __ATOMIC_RELAXED, __HIP_MEMORY_SCOPE_AGENT); }
__device__ __forceinline__ void tile_wait(const unsigned* cnt, int pm, unsigned need, unsigned* tmo) {
    unsigned spins = 0u;
    while (__hip_atomic_load(cnt + 16 * pm, __ATOMIC_RELAXED, __HIP_MEMORY_SCOPE_AGENT) < need) { __builtin_amdgcn_s_sleep(2); if (++spins > (1u << 20)) { __hip_atomic_store(tmo, 1u, __ATOMIC_RELAXED, __HIP_MEMORY_SCOPE_AGENT); break; } }
}
__host__ __device__ __forceinline__ int lds_byte(int r, int c) { const int st = (r >> 4) * 2 + (c >> 5), rr = r & 15, cc = c & 31, ob = rr * 64 + cc * 2; return st * 1024 + (ob ^ (((ob >> 9) & 1) << 5)); }
__host__ __device__ __forceinline__ void stage_rc(int b, int& R, int& C) { const int st = b / 1024, sb = b % 1024, swz = sb ^ (((sb >> 9) & 1) << 5); R = (st >> 1) * 16 + swz / 64; C = (st & 1) * 32 + (swz % 64) / 2; }
__host__ __device__ __forceinline__ int perm32(int rho) { const int n = rho >> 4, i = rho & 15; return 8 * (i >> 2) + 4 * n + (i & 3); }

struct Unit { const char* A; const char* B; int pm, pn, e, mt, cnt, type; };

struct DenseOrder {
    const char* Ab; const char* Bb; int nM, nN, nwg, G, c, i0 = 0, i1 = 1 << 20; static constexpr int rowb = KD * 2; static constexpr bool PARK = false, FUSED = false;
    __device__ __forceinline__ unsigned boff(int Rb, int C) const { return (unsigned)(Rb * rowb + C * 2); }
    __device__ __forceinline__ size_t bstep_k() const { return 128; }
    __device__ __forceinline__ size_t bstep_h() const { return (size_t)HALF * rowb; }
    __device__ void init(const void* A, const void* B, int M, int N, int G_, int c_) { Ab = (const char*)A; Bb = (const char*)B; nM = M / BM; nN = N / BM; nwg = nM * nN; G = G_; c = c_; }
    __device__ __forceinline__ bool next(int i, Unit& u) const {
        if (i + i0 >= i1) return false;
        const long L = (long)(i + i0) * G + c; if (L >= nwg) return false;
        int wgid = (int)L; { const int q = nwg / NXCD, r = nwg % NXCD, xcd = wgid % NXCD, off = wgid / NXCD; wgid = (xcd < r ? xcd * (q + 1) : r * (q + 1) + (xcd - r) * q) + off; }
        const int nig = WGM * nN, gid = wgid / nig, fm = gid * WGM, gsz = (nM - fm) < WGM ? (nM - fm) : WGM;
        u.pm = fm + ((wgid % nig) % gsz); u.pn = (wgid % nig) / gsz; u.e = 0; u.mt = 0; u.cnt = 0; u.type = 0;
        u.A = Ab + (size_t)u.pm * (BM * KD * 2); u.B = Bb + (size_t)u.pn * (BM * KD * 2); return true;
    }
    __device__ __forceinline__ void offsets(const Unit&, const int (&R)[2], const int (&C)[2], unsigned (&off)[2][2]) const {
#pragma unroll
        for (int h = 0; h < 2; ++h)
#pragma unroll
            for (int i = 0; i < 2; ++i) off[h][i] = (unsigned)(((h * HALF + R[i]) * KD + C[i]) * 2);
    }
};
struct MoeOrder {
    const LAS int* tab; int NTN, G, c, total; const char* Ab; const char* Bb; size_t bexp; const int* slot; bool gather; int rowb;
    static constexpr bool PARK = true, FUSED = false;
    int bn16;
    __device__ __forceinline__ unsigned boff(int Rb, int C) const { return (unsigned)((C >> 3) * bn16 + Rb * 16); }
    __device__ __forceinline__ size_t bstep_k() const { return (size_t)8 * bn16; }
    __device__ __forceinline__ size_t bstep_h() const { return (size_t)HALF * 16; }
    __device__ __forceinline__ bool next(int i, Unit& u) const {
        const int L = i * G + c; if (L >= total) return false;
        int e = 0;
        for (int j = 1; j < NE; ++j) e += (L >= NTN * tab[64 + j]) ? 1 : 0;
        e = __builtin_amdgcn_readfirstlane(e);
        const int ms = __builtin_amdgcn_readfirstlane(tab[64 + e]), ml = __builtin_amdgcn_readfirstlane(tab[32 + e]);
        const int r = L - NTN * ms; const int nt = r / ml, mt = r - nt * ml;
        u.e = e; u.mt = mt; u.cnt = __builtin_amdgcn_readfirstlane(tab[e]); u.pm = ms + mt; u.pn = nt; u.type = 0;
        u.A = gather ? Ab : Ab + (size_t)u.pm * (size_t)(BM * rowb);
        u.B = Bb + (size_t)e * bexp + (size_t)nt * (size_t)(BM * 16); return true;
    }
    __device__ __forceinline__ void offsets(const Unit& u, const int (&R)[2], const int (&C)[2], unsigned (&off)[2][2]) const {
#pragma unroll
        for (int h = 0; h < 2; ++h)
#pragma unroll
            for (int i = 0; i < 2; ++i) {
                if (gather) { const int idx = u.mt * BM + h * HALF + R[i]; const int idc = idx < u.cnt ? idx : u.cnt - 1; int tok = slot[u.e * SLOT_CAP + idc] >> 2; tok = idx < u.cnt ? tok : 0; off[h][i] = (unsigned)(tok * rowb + C[i] * 2); }
                else off[h][i] = (unsigned)((h * HALF + R[i]) * rowb + C[i] * 2);
            }
    }
};


#define GAS_U32 __attribute__((address_space(1))) unsigned
struct MoeFusedOrder {
    const LAS int* tab; int G, c, total6, total7; const char* hb; const char* act; const char* wup; const char* wdn; const int* slot; unsigned* cnt; unsigned* tmo;
    static constexpr bool PARK = true, FUSED = true; static constexpr int rowb = 1024;
    __device__ __forceinline__ unsigned boff_t(int type, int R, int C) const {
        const int rs = 64 * (R >> 5) + 32 * ((R >> 2) & 1) + 16 * ((R >> 3) & 1) + 4 * ((R >> 4) & 1) + (R & 3);
        return (unsigned)((C >> 3) * ((type ? 1024 : 2048) * 16) + rs * 16); }
    __device__ __forceinline__ unsigned boff(int R, int C) const { return boff_t(0, R, C); }
    __device__ __forceinline__ size_t bstep_kt(int type) const { return (size_t)8 * (type ? 1024 * 16 : 2048 * 16); }
    __device__ __forceinline__ size_t bstep_ht(int) const { return (size_t)8 * 16; }
    __device__ __forceinline__ size_t bstep_k() const { return bstep_kt(0); }
    __device__ __forceinline__ size_t bstep_h() const { return bstep_ht(0); }
    __device__ __forceinline__ bool next(int i, Unit& u) const {
        int L = i * G + c; if (L >= total6 + total7) return false;
        const int type = L >= total6 ? 1 : 0; L -= type ? total6 : 0; const int NTN = type ? 4 : 8;
        int e = 0;
        for (int j = 1; j < NE; ++j) e += (L >= NTN * tab[64 + j]) ? 1 : 0;
        e = __builtin_amdgcn_readfirstlane(e);
        const int ms = __builtin_amdgcn_readfirstlane(tab[64 + e]), ml = __builtin_amdgcn_readfirstlane(tab[32 + e]);
        const int r = L - NTN * ms; const int nt = r / ml, mt = r - nt * ml;
        u.e = e; u.mt = mt; u.cnt = __builtin_amdgcn_readfirstlane(tab[e]); u.pm = ms + mt; u.pn = nt; u.type = type;
        u.A = type ? act + (size_t)u.pm * (size_t)(BM * rowb) : hb;
        u.B = (type ? wdn + (size_t)e * 1024 * 1024 : wup + (size_t)e * 2048 * 1024) + (size_t)nt * (size_t)(BM * 16); return true;
    }
    __device__ __forceinline__ void offsets(const Unit& u, const int (&R)[2], const int (&C)[2], unsigned (&off)[2][2]) const {
        if (u.type == 0) { int tok[2][2];
#pragma unroll
            for (int h = 0; h < 2; ++h)
#pragma unroll
                for (int i = 0; i < 2; ++i) { const int idx = u.mt * BM + h * HALF + R[i]; tok[h][i] = slot[u.e * SLOT_CAP + (idx < u.cnt ? idx : u.cnt - 1)]; }
#pragma unroll
            for (int h = 0; h < 2; ++h)
#pragma unroll
                for (int i = 0; i < 2; ++i) { const int idx = u.mt * BM + h * HALF + R[i]; const int t = idx < u.cnt ? (tok[h][i] >> 2) : 0; off[h][i] = (unsigned)(t * rowb + C[i] * 2); }
        } else {
#pragma unroll
            for (int h = 0; h < 2; ++h)
#pragma unroll
                for (int i = 0; i < 2; ++i) off[h][i] = (unsigned)((h * HALF + R[i]) * rowb + C[i] * 2);
        }
    }
    __device__ __forceinline__ void early_poll(const Unit& u, LAS unsigned char* lds) const {
        if (threadIdx.x < 64) { const unsigned* p = cnt + 16 * u.pm; unsigned v;
            asm volatile("global_load_dword %0, %1, off sc1\n\ts_waitcnt vmcnt(0)" : "=&v"(v) : "v"(p) : "memory");
            if (threadIdx.x == 0) *(LAS unsigned*)(lds + MISC_OFF + MO_RDY) = v >= 64u ? 1u : 0u; }
    }
    __device__ __forceinline__ void a_ready(const Unit& u) const {
        if (u.type) {
            if (threadIdx.x < 64) { const unsigned* p = cnt + 16 * u.pm; unsigned v, spins = 0u;
                for (;;) { asm volatile("global_load_dword %0, %1, off sc1\n\ts_waitcnt vmcnt(0)" : "=&v"(v) : "v"(p) : "memory");
                    if ((unsigned)__builtin_amdgcn_readfirstlane(v) >= 64u) break;
                    __builtin_amdgcn_s_sleep(2);
                    if (++spins > (1u << 20)) { if (threadIdx.x == 0) __hip_atomic_store(tmo, 1u, __ATOMIC_RELAXED, __HIP_MEMORY_SCOPE_AGENT); break; } }
                }
            asm volatile("" ::: "memory"); __builtin_amdgcn_s_barrier(); asm volatile("" ::: "memory");
        }
    }
    __device__ __forceinline__ void done(const Unit& u) const {
        if (u.type == 0) { asm volatile("s_waitcnt vmcnt(0)" ::: "memory");
            if ((threadIdx.x & 63) == 0) __hip_atomic_fetch_add(cnt + 16 * u.pm, 1u, __ATOMIC_RELAXED, __HIP_MEMORY_SCOPE_AGENT); }
    }
};

typedef f32x4 Acc[2][2][4][2];

typedef int i32x8 __attribute__((ext_vector_type(8)));
struct u32x4x2 { u32x4 a, b; };
template <class Epi, class Sched, bool FP8 = false>
__device__ __forceinline__ void gemm_phase(LAS unsigned char* lds, const Sched& S, const Epi& E) {
    const int tid = threadIdx.x, wid = __builtin_amdgcn_readfirstlane(tid >> 6), lane = tid & 63, wr = wid >> 2, wc = wid & 3, fr = lane & 15, fq = lane >> 4;
    constexpr int ROWB = FP8 ? KD : KD * 2, nt = FP8 ? KD / 128 : NT_K;
    int sR[2], sC[2], sRb[2]; unsigned voffB[2];
#pragma unroll
    for (int i = 0; i < 2; ++i) { int R, C; stage_rc(tid * 16 + i * 8192, R, C); sR[i] = R; sC[i] = C; const int Rb = Epi::PERM ? ((R & ~31) + perm32(R & 31)) : R; sRb[i] = Rb; voffB[i] = S.boff(Rb, C); }
    constexpr size_t kstep = (size_t)(BK * 2);
    size_t kstepB = S.bstep_k(), kstepBn = kstepB, hstepB = S.bstep_h(), hstepBn = hstepB;
    const unsigned ldsw = (unsigned)wid * 1024u;
    const int aoff = lds_byte(wr * 64 + fr, fq * 8), boff = lds_byte(wc * 32 + fr, fq * 8);
    constexpr int KST = 1024;
#define PG8_SA(b, h) (((b) * 2 + (h)) * HTB)
#define PG8_SB(b, h) ((4 + (b) * 2 + (h)) * HTB)
#define PG8_STAGE(bufoff, gbase, voff) do { const char* _gb = (const char*)(gbase); asm volatile("" : "+s"(_gb));     \
        _Pragma("unroll") for (int _i = 0; _i < 2; ++_i) \
        __builtin_amdgcn_global_load_lds((const unsigned*)(_gb + (voff)[_i]), (LAS unsigned*)(lds + (bufoff) + ldsw + _i * 8192), 16, 0, 0); } while (0)
#define PG8_STAGE_A(bufoff, gbase, voff) do { const char* _gb = (const char*)(gbase); asm volatile("" : "+s"(_gb)); \
        _Pragma("unroll") for (int _i = 0; _i < 2; ++_i) \
        __builtin_amdgcn_global_load_lds((const unsigned*)(_gb + (voff)[_i]), (LAS unsigned*)(lds + (bufoff) + ldsw + _i * 8192), 16, 0, 0); } while (0)
#define PG8_LDA(dst, b, h) do { _Pragma("unroll") for (int m = 0; m < 4; ++m) _Pragma("unroll") for (int k = 0; k < 2; ++k) dst[m][k] = *(const LAS bf16x8*)(lds + PG8_SA(b, h) + aoff + m * 2048 + k * KST); } while (0)
#define PG8_LDB(dst, b, h) do { _Pragma("unroll") for (int n = 0; n < 2; ++n) _Pragma("unroll") for (int k = 0; k < 2; ++k) dst[n][k] = *(const LAS bf16x8*)(lds + PG8_SB(b, h) + boff + n * 2048 + k * KST); } while (0)
#define PG8_CAT(x) __builtin_bit_cast(i32x8, (u32x4x2){__builtin_bit_cast(u32x4, (x)[0]), __builtin_bit_cast(u32x4, (x)[1])})
#define PG8_MMA(ai, bj, At, Bt) do { __builtin_amdgcn_s_setprio(1); \
        if constexpr (FP8) { _Pragma("unroll") for (int m = 0; m < 4; ++m) _Pragma("unroll") for (int n = 0; n < 2; ++n) \
            acc[ai][bj][m][n] = __builtin_amdgcn_mfma_scale_f32_16x16x128_f8f6f4(PG8_CAT(Bt[n]), PG8_CAT(At[m]), acc[ai][bj][m][n], 0, 0, 0, Epi::SCALE_B, 0, Epi::SCALE_A); } \
        else { _Pragma("unroll") for (int m = 0; m < 4; ++m) _Pragma("unroll") for (int n = 0; n < 2; ++n) _Pragma("unroll") for (int k = 0; k < 2; ++k) \
            acc[ai][bj][m][n] = __builtin_amdgcn_mfma_f32_16x16x32_bf16(Bt[n][k], At[m][k], acc[ai][bj][m][n], 0, 0, 0); } \
        __builtin_amdgcn_s_setprio(0); } while (0)
#define PG8_WAIT_V(n) asm volatile("s_waitcnt vmcnt(" #n ")" ::: "memory")
#define PG8_WAIT_L(n) asm volatile("s_waitcnt lgkmcnt(" #n ")" ::: "memory")
#define PG8_BAR __builtin_amdgcn_s_barrier()
#define PG8_SCHED __builtin_amdgcn_sched_barrier(0)
    Unit cur, nxt; int ui = 0;
    if (!S.next(0, cur)) return;
    Acc acc;
    bf16x8 At[4][2], B0[2][2], B1[2][2];
    unsigned offA[2][2], offN[2][2];
    S.offsets(cur, sR, sC, offA);
    if constexpr (Sched::FUSED) { kstepB = S.bstep_kt(cur.type); hstepB = S.bstep_ht(cur.type);
#pragma unroll
        for (int i = 0; i < 2; ++i) voffB[i] = S.boff_t(cur.type, sR[i], sC[i]); }
    const char* cA = cur.A; const char* cB = cur.B;
    PG8_STAGE(PG8_SB(0, 0), cB, voffB); PG8_STAGE(PG8_SB(0, 1), cB + hstepB, voffB); PG8_STAGE_A(PG8_SA(0, 0), cA, offA[0]); PG8_STAGE_A(PG8_SA(0, 1), cA, offA[1]);
    if (wr == 1) PG8_BAR;
    PG8_WAIT_V(2); PG8_BAR;
    PG8_STAGE(PG8_SB(1, 0), cB + kstepB, voffB); PG8_STAGE_A(PG8_SA(1, 0), cA + kstep, offA[0]); PG8_STAGE(PG8_SB(1, 1), cB + hstepB + kstepB, voffB);
    PG8_WAIT_V(6); PG8_BAR;
    for (;;) {
#pragma unroll
        for (int a = 0; a < 2; ++a)
#pragma unroll
            for (int b = 0; b < 2; ++b)
#pragma unroll
                for (int m = 0; m < 4; ++m)
#pragma unroll
                    for (int n = 0; n < 2; ++n) acc[a][b][m][n] = (f32x4){0.f, 0.f, 0.f, 0.f};
        const bool has_next = S.next(ui + 1, nxt);
        const char* nA = has_next ? nxt.A : cA; const char* nB = has_next ? nxt.B : cB;
        if constexpr (Sched::FUSED) { kstepBn = has_next ? S.bstep_kt(nxt.type) : kstepB; hstepBn = has_next ? S.bstep_ht(nxt.type) : hstepB; }
        if (has_next) S.offsets(nxt, sR, sC, offN);
        else {
#pragma unroll
            for (int h = 0; h < 2; ++h)
#pragma unroll
                for (int i = 0; i < 2; ++i) offN[h][i] = offA[h][i];
        }
        if constexpr (Sched::PARK) *(LAS u32x4*)(lds + OFFN_OFF + tid * 16) = (u32x4){offN[0][0], offN[0][1], offN[1][0], offN[1][1]};
        if constexpr (Sched::FUSED) { if (has_next && nxt.type) S.early_poll(nxt, lds); }
#pragma unroll 1
        for (int t = 0; t < nt; t += 2) {
            const bool last = (t == nt - 2);
            const char* a1 = cA + (size_t)(t + 1) * kstep;
            const char* a2 = last ? nA : cA + (size_t)(t + 2) * kstep; const char* b2 = last ? nB : cB + (size_t)(t + 2) * kstepB;
            const char* a3 = a2 + kstep; const char* b3 = b2 + (last ? kstepBn : kstepB); const size_t hB = last ? hstepBn : hstepB;
            if constexpr (Sched::FUSED) { if (last && has_next && nxt.type) { const unsigned rdy = __builtin_amdgcn_readfirstlane(*(const LAS unsigned*)(lds + MISC_OFF + MO_RDY)); if (!rdy) S.a_ready(nxt); } }
            if constexpr (Epi::MID_T > 0) { if (t == Epi::MID_T) E.mid(acc, cur, wr, wc, fr, fq); }
            PG8_LDB(B0, 0, 0); PG8_LDB(B1, 0, 1); PG8_SCHED; PG8_LDA(At, 0, 0); PG8_STAGE_A(PG8_SA(1, 1), a1, offA[1]);
            PG8_WAIT_V(8); PG8_WAIT_L(0); PG8_BAR; PG8_MMA(0, 0, At, B0); PG8_MMA(0, 1, At, B1);
            asm volatile("" : "+v"(acc[0][0][0][0]), "+v"(acc[0][0][0][1]), "+v"(acc[0][0][1][0]), "+v"(acc[0][0][1][1]), "+v"(acc[0][0][2][0]), "+v"(acc[0][0][2][1]), "+v"(acc[0][0][3][0]), "+v"(acc[0][0][3][1]));
            asm volatile("" : "+v"(acc[0][1][0][0]), "+v"(acc[0][1][0][1]), "+v"(acc[0][1][1][0]), "+v"(acc[0][1][1][1]), "+v"(acc[0][1][2][0]), "+v"(acc[0][1][2][1]), "+v"(acc[0][1][3][0]), "+v"(acc[0][1][3][1]));
            PG8_BAR; PG8_SCHED;
            if (last) {
                if constexpr (Sched::FUSED) { if (has_next) {
#pragma unroll
                    for (int i = 0; i < 2; ++i) voffB[i] = S.boff_t(nxt.type, sR[i], sC[i]); } }
                if constexpr (Sched::PARK) { const u32x4 pk = *(const LAS u32x4*)(lds + OFFN_OFF + tid * 16); offA[0][0] = pk.x; offA[0][1] = pk.y; offA[1][0] = pk.z; offA[1][1] = pk.w; }
                else {
#pragma unroll
                    for (int h = 0; h < 2; ++h)
#pragma unroll
                        for (int i = 0; i < 2; ++i) offA[h][i] = offN[h][i];
                }
            }
            PG8_LDA(At, 0, 1); PG8_STAGE(PG8_SB(0, 0), b2, voffB); PG8_STAGE(PG8_SB(0, 1), b2 + hB, voffB); PG8_STAGE_A(PG8_SA(0, 0), a2, offA[0]);
            PG8_WAIT_V(8); PG8_WAIT_L(0); PG8_BAR; PG8_MMA(1, 0, At, B0); PG8_MMA(1, 1, At, B1); PG8_BAR; PG8_SCHED;
            PG8_LDB(B0, 1, 0); PG8_LDB(B1, 1, 1); PG8_SCHED; PG8_LDA(At, 1, 0); PG8_STAGE_A(PG8_SA(0, 1), a2, offA[1]);
            PG8_WAIT_V(8); PG8_WAIT_L(0); PG8_BAR; PG8_MMA(0, 0, At, B0); PG8_MMA(0, 1, At, B1); PG8_BAR; PG8_SCHED;
            PG8_LDA(At, 1, 1); PG8_STAGE(PG8_SB(1, 0), b3, voffB); PG8_STAGE(PG8_SB(1, 1), b3 + hB, voffB); PG8_STAGE_A(PG8_SA(1, 0), a3, offA[0]);
            PG8_WAIT_V(8); PG8_WAIT_L(0); PG8_BAR; PG8_MMA(1, 0, At, B0); PG8_MMA(1, 1, At, B1); PG8_BAR; PG8_SCHED;
        }
        if (wr == 0) PG8_BAR;
        E(acc, cur, wr, wc, fr, fq);
        if constexpr (Sched::FUSED) S.done(cur);
        if constexpr (Epi::SIGNAL) tile_signal(E.cnt, cur.pm);
        __builtin_amdgcn_s_waitcnt(0x0F70);
        if (!has_next) break;
        cur = nxt; cA = nA; cB = nB; kstepB = kstepBn; hstepB = hstepBn; ++ui;
        if (wr == 1) PG8_BAR;
    }
    PG8_WAIT_V(0);
    PG8_BAR;
#undef PG8_SA
#undef PG8_SB
#undef PG8_STAGE
#undef PG8_STAGE_A
#undef PG8_LDA
#undef PG8_LDB
#undef PG8_MMA
#undef PG8_WAIT_V
#undef PG8_WAIT_L
#undef PG8_BAR
#undef PG8_SCHED
}

#define EPI_SEED(r, c) asm volatile("" : "+v"(r), "+v"(c))
template <class V> __device__ __forceinline__ V ldg(const void* base, unsigned off) { return *(const V*)((const char*)base + off); }
template <class V> __device__ __forceinline__ void stg(void* base, unsigned off, V v) { *(V*)((char*)base + off) = v; }
__device__ __forceinline__ u32x4 pack8(const f32x4 v0, const f32x4 v1) { u32x4 w; w.x = cvt_pk_bf16(v0[0], v0[1]); w.y = cvt_pk_bf16(v0[2], v0[3]); w.z = cvt_pk_bf16(v1[0], v1[1]); w.w = cvt_pk_bf16(v1[2], v1[3]); return w; }

struct EpiU {
    static constexpr int SCALE_B = 0, SCALE_A = 0;
    static constexpr bool PERM = true, SIGNAL = false; static constexpr int MID_T = 0;
    bf16 *q, *k, *vT, *ab, *gates; const float* bias;
    __device__ __forceinline__ void mid(Acc&, const Unit&, int, int, int, int) const {}
    __device__ __forceinline__ void operator()(const Acc& acc, const Unit& u, int wr, int wc, int fr, int fq) const {
        int rl = wr * 64 + fr, cl = wc * 32 + 8 * fq; EPI_SEED(rl, cl);
        const int row0 = u.pm * BM + rl, pn = u.pn;
        f32x4 bv[2][2];
#pragma unroll
        for (int bj = 0; bj < 2; ++bj)
#pragma unroll
            for (int n = 0; n < 2; ++n) bv[bj][n] = ldg<f32x4>(bias, (unsigned)(pn * BM + bj * HALF + cl + 4 * n) * 4u);
        if (pn < 2) {
            const unsigned o0 = ((unsigned)row0 * AW + pn * BM + cl) * 2u;
#pragma unroll
            for (int ai = 0; ai < 2; ++ai)
#pragma unroll
                for (int m = 0; m < 4; ++m)
#pragma unroll
                    for (int bj = 0; bj < 2; ++bj)
                        stg<u32x4>(q, o0 + (unsigned)((ai * HALF + m * 16) * AW + bj * HALF) * 2u, pack8((acc[ai][bj][m][0] + bv[bj][0]) * 0.125f, (acc[ai][bj][m][1] + bv[bj][1]) * 0.125f));
        } else if (pn == 2) {
            const unsigned o0 = ((unsigned)row0 * KVW + cl) * 2u;
            const int b = row0 >> 12, s0 = row0 & (SEQ - 1);
#pragma unroll
            for (int ai = 0; ai < 2; ++ai)
#pragma unroll
                for (int m = 0; m < 4; ++m) {
                    stg<u32x4>(k, o0 + (unsigned)((ai * HALF + m * 16) * KVW) * 2u, pack8(acc[ai][0][m][0] + bv[0][0], acc[ai][0][m][1] + bv[0][1]));
#pragma unroll
                    for (int n = 0; n < 2; ++n) { const f32x4 v = acc[ai][1][m][n] + bv[1][n];
#pragma unroll
                        for (int j = 0; j < 4; ++j) { const int col = cl + 4 * n + j, kvh = col >> 6, dim = col & 63;
                            stg<bf16>(vT, (unsigned)(((b * NKV + kvh) * HD + dim) * SEQ + s0 + ai * HALF + m * 16) * 2u, (bf16)f2bf(v[j])); } } }
        } else if (pn < 7) {
            const unsigned o0 = ((unsigned)(row0 + AB_PAD * ((row0 >> 12) + 1)) * CCH + (pn - 3) * HALF + cl) * 2u;
#pragma unroll
            for (int ai = 0; ai < 2; ++ai)
#pragma unroll
                for (int m = 0; m < 4; ++m) { f32x4 o[2];
#pragma unroll
                    for (int n = 0; n < 2; ++n) { const f32x4 a = acc[ai][0][m][n] + bv[0][n], g = acc[ai][1][m][n] + bv[1][n];
#pragma unroll
                        for (int j = 0; j < 4; ++j) o[n][j] = a[j] * sigmoidf_(g[j]); }
                    stg<u32x4>(ab, o0 + (unsigned)((ai * HALF + m * 16) * CCH) * 2u, pack8(o[0], o[1])); }
        } else {
            const unsigned o0 = ((unsigned)row0 * 2048 + (pn - 7) * HALF + cl) * 2u;
#pragma unroll
            for (int ai = 0; ai < 2; ++ai)
#pragma unroll
                for (int m = 0; m < 4; ++m) { f32x4 ra[2], gb[2];
#pragma unroll
                    for (int n = 0; n < 2; ++n) { const f32x4 va = acc[ai][0][m][n] + bv[0][n], vb = acc[ai][1][m][n] + bv[1][n];
#pragma unroll
                        for (int j = 0; j < 4; ++j) { const float sb = sigmoidf_(vb[j]); gb[n][j] = sb; ra[n][j] = sigmoidf_(va[j]) * __builtin_amdgcn_rcpf(sb); } }
                    stg<u32x4>(gates, o0 + (unsigned)((ai * HALF + m * 16) * 2048) * 2u, pack8(ra[0], ra[1]));
                    stg<u32x4>(gates, o0 + (unsigned)((ai * HALF + m * 16) * 2048 + 1024) * 2u, pack8(gb[0], gb[1])); }
        }
    }
};
struct EpiMerged {
    static constexpr int SCALE_B = 0, SCALE_A = 0;
    static constexpr bool PERM = true, SIGNAL = true; static constexpr int MID_T = 8;
    const bf16* gates; const float* bc; bf16* merged; unsigned* cnt;
    __device__ __forceinline__ void mid(Acc& acc, const Unit& u, int wr, int wc, int fr, int fq) const {
        int rl = wr * 64 + fr, cl = wc * 32 + 8 * fq; EPI_SEED(rl, cl);
        const unsigned g0 = ((unsigned)(u.pm * BM + rl) * 2048 + u.pn * BM + cl) * 2u;
#pragma unroll
        for (int ai = 0; ai < 2; ++ai) { u32x4 rt[4][2];
#pragma unroll
            for (int m = 0; m < 4; ++m)
#pragma unroll
                for (int bj = 0; bj < 2; ++bj) rt[m][bj] = ldg<u32x4>(gates, g0 + (unsigned)((ai * HALF + m * 16) * 2048 + bj * HALF) * 2u);
            __builtin_amdgcn_sched_barrier(0);
#pragma unroll
            for (int m = 0; m < 4; ++m)
#pragma unroll
                for (int bj = 0; bj < 2; ++bj)
#pragma unroll
                    for (int n = 0; n < 2; ++n) { acc[ai][bj][m][n][0] *= bflo(rt[m][bj][2 * n]); acc[ai][bj][m][n][1] *= bfhi(rt[m][bj][2 * n]); acc[ai][bj][m][n][2] *= bflo(rt[m][bj][2 * n + 1]); acc[ai][bj][m][n][3] *= bfhi(rt[m][bj][2 * n + 1]); }
            __builtin_amdgcn_sched_barrier(0); }
    }
    __device__ __forceinline__ void operator()(const Acc& acc, const Unit& u, int wr, int wc, int fr, int fq) const {
        int rl = wr * 64 + fr, cl = wc * 32 + 8 * fq; EPI_SEED(rl, cl);
        const int row0 = u.pm * BM + rl, col0 = u.pn * BM + cl;
        const unsigned g0 = ((unsigned)row0 * 2048 + 1024 + col0) * 2u, m0 = ((unsigned)row0 * D + col0) * 2u;
        f32x4 bv[2][2];
#pragma unroll
        for (int bj = 0; bj < 2; ++bj)
#pragma unroll
            for (int n = 0; n < 2; ++n) bv[bj][n] = ldg<f32x4>(bc, (unsigned)(col0 + bj * HALF + 4 * n) * 4u);
#pragma unroll
        for (int ai = 0; ai < 2; ++ai)
#pragma unroll
            for (int m = 0; m < 4; ++m) {
#pragma unroll
                for (int bj = 0; bj < 2; ++bj) { const u32x4 gb = ldg<u32x4>(gates, g0 + (unsigned)((ai * HALF + m * 16) * 2048 + bj * HALF) * 2u); f32x4 o[2];
#pragma unroll
                    for (int n = 0; n < 2; ++n) { const f32x4 v = acc[ai][bj][m][n] + bv[bj][n];
                        o[n][0] = v[0] * bflo(gb[2 * n]); o[n][1] = v[1] * bfhi(gb[2 * n]); o[n][2] = v[2] * bflo(gb[2 * n + 1]); o[n][3] = v[3] * bfhi(gb[2 * n + 1]); }
                    stgw(merged, m0 + (unsigned)((ai * HALF + m * 16) * D + bj * HALF) * 2u, pack8(o[0], o[1])); }
                if (m & 1) asm volatile("" ::: "memory"); }
    }
};
struct EpiPre1 {
    static constexpr int SCALE_B = 0, SCALE_A = 0;
    static constexpr bool PERM = true, SIGNAL = true; static constexpr int MID_T = 0;
    const bf16* xb; bf16* out; unsigned* cnt;
    __device__ __forceinline__ void mid(Acc&, const Unit&, int, int, int, int) const {}
    __device__ __forceinline__ void operator()(const Acc& acc, const Unit& u, int wr, int wc, int fr, int fq) const {
        int rl = wr * 64 + fr, cl = wc * 32 + 8 * fq; EPI_SEED(rl, cl);
        const unsigned o0 = ((unsigned)(u.pm * BM + rl) * D + u.pn * BM + cl) * 2u;
        u32x4 xv[2][4][2];
#pragma unroll
        for (int ai = 0; ai < 2; ++ai)
#pragma unroll
            for (int m = 0; m < 4; ++m)
#pragma unroll
                for (int bj = 0; bj < 2; ++bj) xv[ai][m][bj] = ldg<u32x4>(xb, o0 + (unsigned)((ai * HALF + m * 16) * D + bj * HALF) * 2u);
        __builtin_amdgcn_sched_barrier(0);
#pragma unroll
        for (int ai = 0; ai < 2; ++ai)
#pragma unroll
            for (int m = 0; m < 4; ++m)
#pragma unroll
                for (int bj = 0; bj < 2; ++bj) { const u32x4 w = xv[ai][m][bj];
                    const f32x4 r0 = (f32x4){bflo(w.x), bfhi(w.x), bflo(w.y), bfhi(w.y)} * DN_ALPHA + acc[ai][bj][m][0], r1 = (f32x4){bflo(w.z), bfhi(w.z), bflo(w.w), bfhi(w.w)} * DN_ALPHA + acc[ai][bj][m][1];
                    stgw(out, o0 + (unsigned)((ai * HALF + m * 16) * D + bj * HALF) * 2u, pack8(r0, r1)); }
    }
};
struct EpiUp {
    static constexpr bool PERM = true, SIGNAL = false; static constexpr int MID_T = 0;
    static constexpr int SCALE_B = 0x79797979, SCALE_A = 0x7C7C7C7C;
    const float* b_up; unsigned char* act;
    __device__ __forceinline__ void mid(Acc&, const Unit&, int, int, int, int) const {}
    __device__ __forceinline__ void operator()(const Acc& acc, const Unit& u, int wr, int wc, int fr, int fq) const {
        int rl = wr * 64 + fr, cl = wc * 32 + 8 * fq; EPI_SEED(rl, cl);
        const unsigned o0 = (unsigned)(u.pm * BM + rl) * DE + u.pn * HALF + (cl >> 1);
        f32x4 bv[2][2];
#pragma unroll
        for (int bj = 0; bj < 2; ++bj)
#pragma unroll
            for (int n = 0; n < 2; ++n) bv[bj][n] = ldg<f32x4>(b_up, (unsigned)(u.e * 2048 + u.pn * BM + cl + bj * HALF + 4 * n) * 4u);
#pragma unroll
        for (int ai = 0; ai < 2; ++ai)
#pragma unroll
            for (int m = 0; m < 4; ++m)
#pragma unroll
                for (int bj = 0; bj < 2; ++bj) { float o[4];
#pragma unroll
                    for (int n = 0; n < 2; ++n) { const f32x4 v = acc[ai][bj][m][n] + bv[bj][n];
#pragma unroll
                        for (int p = 0; p < 2; ++p) { const float xg = fminf(v[2 * p], 7.0f), xl = fminf(fmaxf(v[2 * p + 1], -7.0f), 7.0f);
                            o[2 * n + p] = xg * sigmoidf_(1.702f * xg) * (xl + 1.0f); } }
                    unsigned w = 0u; w = __builtin_amdgcn_cvt_pk_fp8_f32(o[0] * 8.0f, o[1] * 8.0f, w, false); w = __builtin_amdgcn_cvt_pk_fp8_f32(o[2] * 8.0f, o[3] * 8.0f, w, true);
                    __hip_atomic_store((unsigned*)(act + (o0 + (unsigned)((ai * HALF + m * 16) * DE + bj * 64))), w, __ATOMIC_RELAXED, __HIP_MEMORY_SCOPE_AGENT); }
    }
};
struct EpiDown {
    static constexpr bool PERM = true, SIGNAL = false; static constexpr int MID_T = 0;
    static constexpr int SCALE_B = 0x79797979, SCALE_A = 0x7C7C7C7C;
    const float* b_dn; const int* slot; unsigned char* ys;
    __device__ __forceinline__ void mid(Acc&, const Unit&, int, int, int, int) const {}
    __device__ __forceinline__ void operator()(const Acc& acc, const Unit& u, int wr, int wc, int fr, int fq) const {
        int rl = wr * 64 + fr, cb = 64 * wc + 32 * (fq & 1) + 16 * (fq >> 1); EPI_SEED(rl, cb);
        const int col0 = u.pn * BM + cb, idx0 = u.mt * BM + rl;
        f32x4 bv[2][2];
#pragma unroll
        for (int bj = 0; bj < 2; ++bj)
#pragma unroll
            for (int n = 0; n < 2; ++n) bv[bj][n] = ldg<f32x4>(b_dn, (unsigned)(u.e * D + col0 + 8 * bj + 4 * n) * 4u);
        int asg[2][4];
#pragma unroll
        for (int ai = 0; ai < 2; ++ai)
#pragma unroll
            for (int m = 0; m < 4; ++m) { const int idx = idx0 + ai * HALF + m * 16; asg[ai][m] = ldg<int>(slot, (unsigned)(u.e * SLOT_CAP + (idx < u.cnt ? idx : u.cnt - 1)) * 4u); }
#pragma unroll
        for (int ai = 0; ai < 2; ++ai)
#pragma unroll
            for (int m = 0; m < 4; ++m) { const int idx = idx0 + ai * HALF + m * 16;
                if (idx < u.cnt) { u32x4 w;
#pragma unroll
                    for (int bj = 0; bj < 2; ++bj)
#pragma unroll
                        for (int n = 0; n < 2; ++n) { const f32x4 v = (acc[ai][bj][m][n] + bv[bj][n]) * 16.0f;
                            unsigned x = __builtin_amdgcn_cvt_pk_fp8_f32(v[0], v[1], 0u, false); x = __builtin_amdgcn_cvt_pk_fp8_f32(v[2], v[3], x, true); w[2 * bj + n] = x; }
                    stg<u32x4>(ys, (unsigned)asg[ai][m] * D + col0, w); } }
    }
};
struct EpiUpX {
    const float* b_up; unsigned char* act;
    __device__ __forceinline__ void operator()(const Acc& acc, const Unit& u, int wr, int wc, int fr, int fq) const {
        int rl = wr * 64 + fr, cb = 64 * wc + 32 * (fq & 1) + 16 * (fq >> 1); EPI_SEED(rl, cb);
        f32x4 bv[2][2];
#pragma unroll
        for (int bj = 0; bj < 2; ++bj)
#pragma unroll
            for (int n = 0; n < 2; ++n) bv[bj][n] = ldg<f32x4>(b_up, (unsigned)(u.e * 2048 + u.pn * BM + cb + 8 * bj + 4 * n) * 4u);
        const __amdgpu_buffer_rsrc_t rs = __builtin_amdgcn_make_buffer_rsrc(act, 0, (MAX_MT * 256) * 1024, 0x00020000);
        const unsigned o0 = (unsigned)(u.pm * BM + rl + 16 * (fq >> 1)) * DE + u.pn * HALF + 32 * wc + 16 * (fq & 1);
#pragma unroll
        for (int ai = 0; ai < 2; ++ai)
#pragma unroll
            for (int j = 0; j < 2; ++j) { unsigned d[2][2];
#pragma unroll
                for (int mm = 0; mm < 2; ++mm)
#pragma unroll
                    for (int bj = 0; bj < 2; ++bj) { float o[4];
#pragma unroll
                        for (int n = 0; n < 2; ++n) { const f32x4 v = acc[ai][bj][2 * j + mm][n] + bv[bj][n];
#pragma unroll
                            for (int p = 0; p < 2; ++p) { const float xg = fminf(v[2 * p], 7.0f), xl = fminf(fmaxf(v[2 * p + 1], -7.0f), 7.0f);
                                o[2 * n + p] = (xg * __builtin_amdgcn_rcpf(1.0f + __builtin_amdgcn_exp2f(xg * (-1.702f * 1.44269504f)))) * __builtin_fmaf(xl, 8.0f, 8.0f); } }
                        unsigned w = 0u; w = __builtin_amdgcn_cvt_pk_fp8_f32(o[0], o[1], w, false); w = __builtin_amdgcn_cvt_pk_fp8_f32(o[2], o[3], w, true); d[mm][bj] = w; }
                const u32x2 s0 = __builtin_amdgcn_permlane32_swap(d[0][0], d[1][0], false, false), s1 = __builtin_amdgcn_permlane32_swap(d[0][1], d[1][1], false, false);
                const u32x4 w4 = (u32x4){s0.x, s1.x, s0.y, s1.y};
                __builtin_amdgcn_raw_buffer_store_b128(w4, rs, o0 + (unsigned)((ai * HALF + 32 * j) * DE), 0, 16); }
    }
};
struct EpiMoe {
    static constexpr bool PERM = true, SIGNAL = false; static constexpr int MID_T = 0;
    static constexpr int SCALE_B = 0x79797979, SCALE_A = 0x7C7C7C7C;
    EpiUpX up; EpiDown dn;
    __device__ __forceinline__ void mid(Acc&, const Unit&, int, int, int, int) const {}
    __device__ __forceinline__ void operator()(const Acc& acc, const Unit& u, int wr, int wc, int fr, int fq) const { if (u.type == 0) up(acc, u, wr, wc, fr, fq); else dn(acc, u, wr, wc, fr, fq); }
};
}

#define XB_TMO      128
#define XB_XCNT(j)  (256  + 64 * (j))
#define XB_XSUB(j)  (1280 + 64 * (j))
#define XB_XGEN(j)  (2304 + 64 * (j))
#define XB_TOP      3328
#define XB_TOPGEN   3392
#define XCD_BAR_WORDS 3456
#define XB_SPIN_CAP (1u << 18)
__device__ __forceinline__ unsigned xb_ld(unsigned* p)              { return __hip_atomic_load(p, __ATOMIC_RELAXED, __HIP_MEMORY_SCOPE_AGENT); }
__device__ __forceinline__ unsigned xb_add(unsigned* p, unsigned v) { return __hip_atomic_fetch_add(p, v, __ATOMIC_RELAXED, __HIP_MEMORY_SCOPE_AGENT); }
__device__ __forceinline__ unsigned xb_xcc_id() { return (unsigned)__builtin_amdgcn_s_getreg((3 << 11) | 20) & 0xFu; }
#define XB_SPIN(cond, bar) do { unsigned _sp = 0; while (cond) { __builtin_amdgcn_s_sleep(1); \
    if ((++_sp & 255u) == 0u) { if (xb_ld(&(bar)[XB_TMO])) break; if (_sp > XB_SPIN_CAP) { atomicAdd(&(bar)[XB_TMO], 1u); break; } } } } while (0)
struct XcdBarrier { unsigned* bar; unsigned x; volatile LAS unsigned* st; };
__device__ __forceinline__ XcdBarrier xcd_barrier_post(unsigned* bar, volatile LAS unsigned* st) {
    XcdBarrier b; b.bar = bar; b.x = xb_xcc_id(); b.st = st;
    if (threadIdx.x == 0) (void)xb_add(&bar[XB_XCNT(b.x)], 1u);
    return b;
}
__device__ __forceinline__ void xcd_barrier_complete(unsigned* bar, unsigned x, unsigned& nloc, unsigned& nx) {
    const unsigned G = gridDim.x * gridDim.y * gridDim.z;
    unsigned sum, cnt, mine, sp = 0u;
    for (;;) {
        sum = 0u; cnt = 0u; mine = 0u;
#pragma unroll
        for (unsigned j = 0; j < 16; ++j) { const unsigned c = xb_ld(&bar[XB_XCNT(j)]); sum += c; cnt += (c > 0u) ? 1u : 0u; mine = (j == x) ? c : mine; }
        if (sum == G) break;
        __builtin_amdgcn_s_sleep(1);
        if ((++sp & 255u) == 0u) { if (xb_ld(&bar[XB_TMO])) break; if (sp > XB_SPIN_CAP) { atomicAdd(&bar[XB_TMO], 1u); break; } }
    }
    nloc = mine > 0u ? mine : 1u; nx = cnt > 0u ? cnt : 1u;
}
__device__ __forceinline__ void xcd_barrier(const XcdBarrier& b) {
    asm volatile("s_waitcnt vmcnt(0)" ::: "memory");
    __syncthreads();
    if (threadIdx.x == 64) asm volatile("buffer_inv sc1\n\ts_waitcnt vmcnt(0)" ::: "memory");
    if (threadIdx.x == 0) {
        unsigned* bar = b.bar;
        __builtin_amdgcn_s_waitcnt(0);
        unsigned nloc = b.st[0], nx = b.st[1];
        if (nloc == 0u) { xcd_barrier_complete(bar, b.x, nloc, nx); b.st[0] = nloc; b.st[1] = nx; }
        const unsigned old = xb_add(&bar[XB_XSUB(b.x)], 1u);
        const unsigned gen = old / nloc;
        if (old + 1u == (gen + 1u) * nloc) {
            __builtin_amdgcn_fence(__ATOMIC_RELEASE, "agent");
            asm volatile("s_waitcnt vmcnt(0)" ::: "memory");
            const unsigned og = xb_add(&bar[XB_TOP], 1u);
            const unsigned tg = og / nx;
            if (og + 1u == (tg + 1u) * nx) xb_add(&bar[XB_TOPGEN], 1u);
            else XB_SPIN(xb_ld(&bar[XB_TOPGEN]) == tg, bar);
            xb_add(&bar[XB_XGEN(b.x)], 1u);
            asm volatile("s_waitcnt vmcnt(0)" ::: "memory");
        } else {
            XB_SPIN(xb_ld(&bar[XB_XGEN(b.x)]) == gen, bar);
            asm volatile("s_waitcnt vmcnt(0)" ::: "memory");
        }
    }
    __syncthreads();
}


__device__ __forceinline__ void tr_item(const float* W, int ldw, int scol0, int srow0, bf16* WT, int Kd, int drow0, int dk0, LAS float* scr, int lane) {
#pragma unroll 8
    for (int i = 0; i < 32; ++i) { const int kk = 2 * i + (lane >> 5); scr[kk * 33 + (lane & 31)] = __builtin_nontemporal_load(W + (size_t)(srow0 + kk) * ldw + scol0 + (lane & 31)); }
    LDS_WAIT(); asm volatile("" ::: "memory");
    const int c = lane & 7;
#pragma unroll
    for (int j = 0; j < 4; ++j) { const int n = (lane >> 3) + 8 * j; const LAS float* s = scr + (8 * c) * 33 + n;
        u32x4 o; o.x = pk2(s[0 * 33], s[1 * 33]); o.y = pk2(s[2 * 33], s[3 * 33]); o.z = pk2(s[4 * 33], s[5 * 33]); o.w = pk2(s[6 * 33], s[7 * 33]);
        *(u32x4*)(WT + (size_t)(drow0 + n) * Kd + dk0 + 8 * c) = o; }
    LDS_WAIT(); asm volatile("" ::: "memory");
}
__device__ __forceinline__ int src_col_u(int np) {
    if (np < 768) return np;
    if (np >= 1792) { const int tt = (np - 1792) >> 8, w = (np - 1792) & 255; return w < 128 ? 1792 + 128 * tt + w : 2816 + 128 * tt + (w - 128); }
    const int tt = (np - 768) >> 8, w = (np - 768) & 255;
    return w < 128 ? 768 + 128 * tt + w : 1280 + 128 * tt + (w - 128);
}

__device__ __forceinline__ void p0_prologue(const Args& a, LAS unsigned char* lds, int gw, int NGW, int lane, int wave) {
    unsigned char* ws = a.ws;
    LAS float* scr = (LAS float*)(lds + wave * 16384);
    constexpr int J1 = 16 * 120, J2 = 8 * 32, J3 = 8 * 32, J4 = 16 * 32;
    constexpr int NITEMS = J1 + J2 + J3 + J4;
    for (int it = gw; it < NITEMS; it += NGW) {
        int r = it;
        if (r < J1) { const int kb = r / 120, nb = r % 120; tr_item(a.in[I_WIN], INW, src_col_u(32 * nb), 64 * kb, (bf16*)(ws + WS_WIN), 1024, 32 * nb, 64 * kb, scr, lane); continue; } r -= J1;
        if (r < J2) { const int kb = r / 32, nb = r % 32; tr_item(a.in[I_WATT], D, 32 * nb, 64 * kb, (bf16*)(ws + WS_WAB), 1024, 32 * nb, 64 * kb, scr, lane); continue; } r -= J2;
        if (r < J3) { const int kb = r / 32, nb = r % 32; tr_item(a.in[I_WCONV], D, 32 * nb, 64 * kb, (bf16*)(ws + WS_WAB), 1024, 32 * nb, 512 + 64 * kb, scr, lane); continue; } r -= J3;
        { const int kb = r / 32, nb = r % 32; tr_item(a.in[I_WO], D, 32 * nb, 64 * kb, (bf16*)(ws + WS_WO), 1024, 32 * nb, 64 * kb, scr, lane); }
    }
    const float* x = a.in[I_X]; bf16* xb = (bf16*)(ws + WS_XB);
    for (int m = gw; m < T; m += NGW) {
        const f32x4* xr = (const f32x4*)(x + (size_t)m * D) + lane; u32x2* o = (u32x2*)(xb + (size_t)m * D) + lane;
#pragma unroll
        for (int j = 0; j < 4; ++j) { const f32x4 v = __builtin_nontemporal_load(xr + 64 * j); u32x2 w; w.x = pk2(v[0], v[1]); w.y = pk2(v[2], v[3]); o[64 * j] = w; }
    }
    { u32x4* abz = (u32x4*)(ws + WS_AB); const u32x4 z4 = (u32x4){0u, 0u, 0u, 0u};
      for (int i = gw * 64 + lane; i < NBATCH * AB_PAD * CCH * 2 / 16; i += NGW * 64) { const int bb = i / (AB_PAD * CCH * 2 / 16), q = i % (AB_PAD * CCH * 2 / 16); abz[(size_t)bb * (AB_SEQ * CCH * 2 / 16) + q] = z4; } }
    float* bperm = (float*)(ws + WS_BPERM);
    for (int i = gw * 64 + lane; i < INW; i += NGW * 64) bperm[i] = a.in[I_BIN][src_col_u(i)];
}

constexpr int KLS = 144, VLS = 528, ATT_V_OFF = 256 * KLS, CONV_W_OFF = 70656;
__device__ __forceinline__ void attn_unit(const Args& a, int unit, LAS unsigned char* lds, int tid, int wave, int lane) {
    const bf16* qb = (const bf16*)(a.ws + WS_QB); const bf16* kb = (const bf16*)(a.ws + WS_KB); const bf16* vT = (const bf16*)(a.ws + WS_VT); bf16* ay = (bf16*)(a.ws + WS_AY);
    const int kvh = unit & 1, blk = (unit >> 1) & 31, b = unit >> 6;
    const int r = lane & 15, qd = lane >> 4, w = wave;
    const int t0 = b * SEQ + blk * 128, seq0 = b * SEQ, lo = w & ~1;
    { u32x4 kreg[4], vreg[4];
#pragma unroll
      for (int i = 0; i < 4; ++i) { const int c = tid + 512 * i;
          int tok = t0 - 128 + (c >> 3); tok = tok < seq0 ? seq0 : tok;
          kreg[i] = ldgo<u32x4>(kb, (unsigned)(tok * KVW + kvh * HD + (c & 7) * 8) * 2u);
          int sk = blk * 128 - 128 + 8 * (c & 31); sk = sk < 0 ? 0 : sk;
          vreg[i] = ldgo<u32x4>(vT, (unsigned)(((b * NKV + kvh) * HD + (c >> 5)) * SEQ + sk) * 2u); }
      __builtin_amdgcn_sched_barrier(0);
      asm volatile("" : "+v"(kreg[0]), "+v"(kreg[1]), "+v"(kreg[2]), "+v"(kreg[3]), "+v"(vreg[0]), "+v"(vreg[1]), "+v"(vreg[2]), "+v"(vreg[3]));
#pragma unroll
      for (int i = 0; i < 4; ++i) { const int c = tid + 512 * i;
          *(LAS u32x4*)(lds + (c >> 3) * KLS + (c & 7) * 16) = kreg[i];
          *(LAS u32x4*)(lds + ATT_V_OFF + (c >> 5) * VLS + (c & 31) * 16) = vreg[i]; } }
    __syncthreads();
    const int qi = 16 * w + r;
#pragma unroll 1
    for (int hh = 0; hh < 4; ++hh) {
        const int head = kvh * 4 + hh;
        u32x4 qf[2];
        { const unsigned qo = (unsigned)((t0 + qi) * AW + head * HD + 8 * qd) * 2u; qf[0] = ldgo<u32x4>(qb, qo); qf[1] = ldgo<u32x4>(qb, qo + 64u); }
        const float sinkv = a.in[I_SINK][head];
        int qiv = qi; asm volatile("" : "+v"(qiv));
        const int klo = max(qiv + 1, blk > 0 ? 0 : 128); const int kjb = lo * 16 + 4 * qd - klo; const unsigned span = (unsigned)(qiv + 128 - klo);
        f32x4 s[10];
#pragma unroll
        for (int i = 0; i < 10; ++i) {
            const LAS unsigned char* kp = lds + ((lo + i) * 16 + r) * KLS + qd * 16;
            const u32x4 k0 = *(const LAS u32x4*)kp, k1 = *(const LAS u32x4*)(kp + 64);
            f32x4 z = (f32x4){0.f, 0.f, 0.f, 0.f};
            z = __builtin_amdgcn_mfma_f32_16x16x32_bf16(__builtin_bit_cast(bf16x8, k0), __builtin_bit_cast(bf16x8, qf[0]), z, 0, 0, 0);
            s[i] = __builtin_amdgcn_mfma_f32_16x16x32_bf16(__builtin_bit_cast(bf16x8, k1), __builtin_bit_cast(bf16x8, qf[1]), z, 0, 0, 0);
        }
        float mx = sinkv;
#pragma unroll
        for (int i = 0; i < 10; ++i)
#pragma unroll
            for (int g = 0; g < 4; ++g) { const bool valid = (unsigned)(kjb + (16 * i + g)) <= span; s[i][g] = valid ? s[i][g] : -1e30f; mx = fmaxf(mx, s[i][g]); }
        mx = fmaxf(mx, __shfl_xor(mx, 16)); mx = fmaxf(mx, __shfl_xor(mx, 32));
        float sum = 0.f;
#pragma unroll
        for (int i = 0; i < 10; ++i)
#pragma unroll
            for (int g = 0; g < 4; ++g) { const float p = (s[i][g] > -1e29f) ? __expf(s[i][g] - mx) : 0.f; s[i][g] = p; sum += p; }
        sum += __shfl_xor(sum, 16); sum += __shfl_xor(sum, 32);
        const float inv = 1.0f / (sum + __expf(sinkv - mx));
        f32x4 o[4];
#pragma unroll
        for (int mt = 0; mt < 4; ++mt) o[mt] = (f32x4){0.f, 0.f, 0.f, 0.f};
#pragma unroll
        for (int ip = 0; ip < 5; ++ip) {
            u32x4 pw; pw.x = cvt_pk_bf16(s[2 * ip][0], s[2 * ip][1]); pw.y = cvt_pk_bf16(s[2 * ip][2], s[2 * ip][3]); pw.z = cvt_pk_bf16(s[2 * ip + 1][0], s[2 * ip + 1][1]); pw.w = cvt_pk_bf16(s[2 * ip + 1][2], s[2 * ip + 1][3]);
            const bf16x8 pb = __builtin_bit_cast(bf16x8, pw);
#pragma unroll
            for (int mt = 0; mt < 4; ++mt) { const LAS unsigned char* vp = lds + ATT_V_OFF + (16 * mt + r) * VLS + ((lo + 2 * ip) * 16 + 4 * qd) * 2;
                const u32x2 va = *(const LAS u32x2*)vp, vb = *(const LAS u32x2*)(vp + 32);
                u32x4 vw; vw.x = va.x; vw.y = va.y; vw.z = vb.x; vw.w = vb.y;
                o[mt] = __builtin_amdgcn_mfma_f32_16x16x32_bf16(__builtin_bit_cast(bf16x8, vw), pb, o[mt], 0, 0, 0); }
        }
        const unsigned oo = (unsigned)((t0 + qi) * D + head * HD + 4 * qd) * 2u;
#pragma unroll
        for (int mt = 0; mt < 4; ++mt) { u32x2 wv; wv.x = cvt_pk_bf16(o[mt][0] * inv, o[mt][1] * inv); wv.y = cvt_pk_bf16(o[mt][2] * inv, o[mt][3] * inv); *(u32x2*)((char*)ay + oo + 32u * mt) = wv; }
    }
    __syncthreads();
}

constexpr int CBS = 516;
__device__ __forceinline__ void conv_unit(const Args& a, int unit, LAS unsigned char* lds, int tid, int wave, int lane) {
    const bf16* ab = (const bf16*)(a.ws + WS_AB); bf16* ay = (bf16*)(a.ws + WS_AY);
    LAS float* cb = (LAS float*)lds;
    const int t0 = unit * 32, prow0 = t0 + AB_PAD * ((t0 >> 12) + 1);
    int cp = tid & 255; asm volatile("" : "+v"(cp));
    const int half = wave >> 2;
    const LAS float* wl = (const LAS float*)(lds + CONV_W_OFF) + 2 * cp;
    const f32x2 cbias = *(const f32x2*)(a.in[I_CONVB] + 2 * cp);
#pragma unroll 1
    for (int it = 0; it < 2; ++it) {
        const int tl0 = 16 * half + 8 * it;
        const unsigned o0 = (unsigned)((prow0 + tl0 - 30) * CCH + 2 * cp) * 2u;
        unsigned raw[38];
#pragma unroll
        for (int rr = 0; rr < 38; ++rr) raw[rr] = ldgo<unsigned>(ab, o0 + (unsigned)(rr * CCH * 2));
        __builtin_amdgcn_sched_barrier(0);
        asm volatile("" : "+v"(raw[0]), "+v"(raw[1]), "+v"(raw[2]), "+v"(raw[3]), "+v"(raw[4]), "+v"(raw[5]), "+v"(raw[6]), "+v"(raw[7]), "+v"(raw[8]), "+v"(raw[9]),
                          "+v"(raw[10]), "+v"(raw[11]), "+v"(raw[12]), "+v"(raw[13]), "+v"(raw[14]), "+v"(raw[15]), "+v"(raw[16]), "+v"(raw[17]), "+v"(raw[18]));
        asm volatile("" : "+v"(raw[19]), "+v"(raw[20]), "+v"(raw[21]), "+v"(raw[22]), "+v"(raw[23]), "+v"(raw[24]), "+v"(raw[25]), "+v"(raw[26]), "+v"(raw[27]), "+v"(raw[28]),
                          "+v"(raw[29]), "+v"(raw[30]), "+v"(raw[31]), "+v"(raw[32]), "+v"(raw[33]), "+v"(raw[34]), "+v"(raw[35]), "+v"(raw[36]), "+v"(raw[37]));
        float i0[38], i1[38];
#pragma unroll
        for (int rr = 0; rr < 38; ++rr) { i0[rr] = bflo(raw[rr]); i1[rr] = bfhi(raw[rr]); }
        float a0[8], a1[8];
#pragma unroll
        for (int o = 0; o < 8; ++o) { a0[o] = cbias.x; a1[o] = cbias.y; }
#pragma unroll
        for (int j = 0; j < CW; ++j) { const f32x2 wv = *(const LAS f32x2*)(wl + j * CCH);
#pragma unroll
            for (int o = 0; o < 8; ++o) { a0[o] = fmaf(i0[o + j], wv.x, a0[o]); a1[o] = fmaf(i1[o + j], wv.y, a1[o]); } }
#pragma unroll
        for (int o = 0; o < 8; ++o) *(LAS f32x2*)(cb + (tl0 + o) * CBS + 2 * cp) = (f32x2){a0[o], a1[o]};
    }
    __syncthreads();
    const f32x4 g0 = *(const f32x4*)(a.in[I_CLNG] + 8 * lane), g1 = *(const f32x4*)(a.in[I_CLNG] + 8 * lane + 4), b0 = *(const f32x4*)(a.in[I_CLNB] + 8 * lane), b1 = *(const f32x4*)(a.in[I_CLNB] + 8 * lane + 4);
#pragma unroll
    for (int tt = 0; tt < 4; ++tt) { const int tok = 4 * wave + tt;
        f32x4 v0 = *(const LAS f32x4*)(cb + tok * CBS + 8 * lane), v1 = *(const LAS f32x4*)(cb + tok * CBS + 8 * lane + 4);
        const float mean = wave_sum((v0[0] + v0[1]) + (v0[2] + v0[3]) + (v1[0] + v1[1]) + (v1[2] + v1[3])) * (1.0f / CCH);
        v0 = v0 - mean; v1 = v1 - mean;
        const float var = wave_sum((v0[0] * v0[0] + v0[1] * v0[1]) + (v0[2] * v0[2] + v0[3] * v0[3]) + (v1[0] * v1[0] + v1[1] * v1[1]) + (v1[2] * v1[2] + v1[3] * v1[3])) * (1.0f / CCH);
        const float rstd = 1.0f / sqrtf(var + LN_EPS);
        float y[8];
#pragma unroll
        for (int j = 0; j < 4; ++j) { const float y0 = v0[j] * rstd * g0[j] + b0[j], y1 = v1[j] * rstd * g1[j] + b1[j]; y[j] = y0 * sigmoidf_(y0); y[4 + j] = y1 * sigmoidf_(y1); }
        u32x4 wv; wv.x = cvt_pk_bf16(y[0], y[1]); wv.y = cvt_pk_bf16(y[2], y[3]); wv.z = cvt_pk_bf16(y[4], y[5]); wv.w = cvt_pk_bf16(y[6], y[7]);
        *(u32x4*)(ay + (size_t)(t0 + tok) * D + 512 + 8 * lane) = wv; }
    __syncthreads();
}

constexpr int HLS = 1025;
__device__ __forceinline__ void route_chunk(const Args& a, int chunk, LAS unsigned char* lds, int tid, int wave, int lane, const float (&bw)[64], const f32x4 (&g)[4], const f32x4 (&bb)[4]) {
    const bf16* hf = (const bf16*)(a.ws + WS_HF); unsigned char* hb = a.ws + WS_HB;
    int* slot = (int*)(a.ws + WS_SLOT); float* gatev = (float*)(a.ws + WS_GATE); unsigned* cursor = (unsigned*)(a.ws + WS_CTL);
    LAS float* hl = (LAS float*)lds;
    LAS float* lg = (LAS float*)(lds + MISC_OFF + MO_LG); LAS int* sel_e = (LAS int*)(lds + MISC_OFF + MO_SELE); LAS float* sel_g = (LAS float*)(lds + MISC_OFF + MO_SELG);
    LAS int* lcnt = (LAS int*)(lds + MISC_OFF + MO_LCNT); LAS int* lbase = (LAS int*)(lds + MISC_OFF + MO_LBASE);
    const int t0 = chunk * 32;
    f32x4 v[4][4];
    { u32x2 rw[4][4];
#pragma unroll
      for (int tt = 0; tt < 4; ++tt)
#pragma unroll
        for (int j = 0; j < 4; ++j) rw[tt][j] = *((const u32x2*)(hf + (size_t)(t0 + 4 * wave + tt) * D) + lane + 64 * j);
      __builtin_amdgcn_sched_barrier(0);
      asm volatile("" : "+v"(rw[0][0]), "+v"(rw[0][1]), "+v"(rw[0][2]), "+v"(rw[0][3]), "+v"(rw[1][0]), "+v"(rw[1][1]), "+v"(rw[1][2]), "+v"(rw[1][3]),
                        "+v"(rw[2][0]), "+v"(rw[2][1]), "+v"(rw[2][2]), "+v"(rw[2][3]), "+v"(rw[3][0]), "+v"(rw[3][1]), "+v"(rw[3][2]), "+v"(rw[3][3]));
#pragma unroll
      for (int tt = 0; tt < 4; ++tt)
#pragma unroll
        for (int j = 0; j < 4; ++j) v[tt][j] = (f32x4){bflo(rw[tt][j].x), bfhi(rw[tt][j].x), bflo(rw[tt][j].y), bfhi(rw[tt][j].y)}; }
#pragma unroll
    for (int tt = 0; tt < 4; ++tt) { const int tl = 4 * wave + tt;
        float sm = 0.f;
#pragma unroll
        for (int j = 0; j < 4; ++j) sm += (v[tt][j][0] + v[tt][j][1]) + (v[tt][j][2] + v[tt][j][3]);
        const float mean = wave_sum(sm) * (1.0f / D); float s2 = 0.f;
#pragma unroll
        for (int j = 0; j < 4; ++j) { v[tt][j] = v[tt][j] - mean; s2 += (v[tt][j][0] * v[tt][j][0] + v[tt][j][1] * v[tt][j][1]) + (v[tt][j][2] * v[tt][j][2] + v[tt][j][3] * v[tt][j][3]); }
        const float rstd = 1.0f / sqrtf(wave_sum(s2) * (1.0f / D) + LN_EPS);
        if (lane == 0) *(f32x2*)((float*)(a.ws + WS_LN1S) + 2 * (size_t)(t0 + tl)) = (f32x2){mean, rstd};
#pragma unroll
        for (int j = 0; j < 4; ++j) { const f32x4 h = v[tt][j] * rstd * g[j] + bb[j];
            unsigned wv = 0u; wv = __builtin_amdgcn_cvt_pk_fp8_f32(h[0] * 8.0f, h[1] * 8.0f, wv, false); wv = __builtin_amdgcn_cvt_pk_fp8_f32(h[2] * 8.0f, h[3] * 8.0f, wv, true); *((unsigned*)(hb + (size_t)(t0 + tl) * D) + lane + 64 * j) = wv;
            LAS float* hp = hl + tl * HLS + 4 * lane + 256 * j; hp[0] = h[0]; hp[1] = h[1]; hp[2] = h[2]; hp[3] = h[3]; }
    }
    if (tid < 32) lcnt[tid] = 0;
    __syncthreads();
    f32x16 acc;
#pragma unroll
    for (int i = 0; i < 16; ++i) acc[i] = 0.f;
    { const int tok = lane & 31, kp = lane >> 5; const LAS float* hp = hl + tok * HLS + 128 * wave + kp;
#pragma unroll
      for (int s = 0; s < 64; ++s) acc = __builtin_amdgcn_mfma_f32_32x32x2f32(hp[2 * s], bw[s], acc, 0, 0, 0); }
    __syncthreads();
    { LAS float* part = hl + wave * 1024;
#pragma unroll
      for (int i = 0; i < 16; ++i) { const int rowi = (i & 3) + 8 * (i >> 2) + 4 * (lane >> 5); part[rowi * 32 + (lane & 31)] = acc[i]; } }
    __syncthreads();
    for (int o = tid; o < 1024; o += 512) { float sm = a.in[I_BR][o & 31];
#pragma unroll
        for (int w = 0; w < 8; ++w) sm += hl[w * 1024 + o];
        lg[(o >> 5) * 33 + (o & 31)] = sm; }
    __syncthreads();
    if (tid < 32) { float v[NE];
#pragma unroll
        for (int e = 0; e < NE; ++e) v[e] = lg[tid * 33 + e];
        float tv[4]; int ti[4];
#pragma unroll
        for (int k = 0; k < 4; ++k) { float best = -3.0e38f; int bi = 0;
#pragma unroll
            for (int e = 0; e < NE; ++e) { const bool take = v[e] > best; best = take ? v[e] : best; bi = take ? e : bi; }
            tv[k] = best; ti[k] = bi;
#pragma unroll
            for (int e = 0; e < NE; ++e) v[e] = (e == bi) ? -3.0e38f : v[e]; }
        const float e1 = __expf(tv[1] - tv[0]), e2 = __expf(tv[2] - tv[0]), e3 = __expf(tv[3] - tv[0]); const float inv = 1.0f / (1.0f + e1 + e2 + e3);
        sel_e[4 * tid + 0] = ti[0]; sel_e[4 * tid + 1] = ti[1]; sel_e[4 * tid + 2] = ti[2]; sel_e[4 * tid + 3] = ti[3];
        sel_g[4 * tid + 0] = inv; sel_g[4 * tid + 1] = e1 * inv; sel_g[4 * tid + 2] = e2 * inv; sel_g[4 * tid + 3] = e3 * inv; }
    __syncthreads();
    int my_e = 0, my_rank = 0;
    if (tid < 128) { my_e = sel_e[tid]; my_rank = atomicAdd((int*)&lcnt[my_e], 1); }
    __syncthreads();
    if (tid < 32) { const int c = lcnt[tid]; lbase[tid] = c > 0 ? (int)atomicAdd(cursor + tid, (unsigned)c) : 0; }
    __syncthreads();
    if (tid < 128) { const int asg = (t0 + (tid >> 2)) * 4 + (tid & 3); slot[my_e * SLOT_CAP + lbase[my_e] + my_rank] = asg; gatev[asg] = sel_g[tid]; }
    __syncthreads();
}

__device__ __forceinline__ void combine_row(const Args& a, int m, int lane) {
    const bf16* hf = (const bf16*)(a.ws + WS_HF); const unsigned char* ys = a.ws + WS_YS; const float* gatev = (const float*)(a.ws + WS_GATE);
    f32x4 gt = *(const f32x4*)(gatev + 4 * (size_t)m); gt = gt * (1.0f / 16.0f);
    const f32x2 st = *(const f32x2*)((const float*)(a.ws + WS_LN1S) + 2 * (size_t)m);
    f32x4 v[4]; float sm = 0.f;
#pragma unroll
    for (int j = 0; j < 4; ++j) { const f32x4 g1 = *((const f32x4*)a.in[I_LN1G] + lane + 64 * j), b1 = *((const f32x4*)a.in[I_LN1B] + lane + 64 * j);
        const u32x2 pw = *((const u32x2*)(hf + (size_t)m * D) + lane + 64 * j); f32x4 p = (f32x4){bflo(pw.x), bfhi(pw.x), bflo(pw.y), bfhi(pw.y)}; p = p - st.x; const f32x4 h = p * st.y * g1 + b1;
        v[j] = h * DN_ALPHA;
#pragma unroll
        for (int k = 0; k < 4; ++k) { const unsigned y = *((const unsigned*)(ys + ((size_t)m * 4 + k) * D) + lane + 64 * j); const float gk = gt[k];
            const f32x2 lo = __builtin_amdgcn_cvt_pk_f32_fp8(y, false), hi = __builtin_amdgcn_cvt_pk_f32_fp8(y, true);
            v[j][0] += gk * lo.x; v[j][1] += gk * lo.y; v[j][2] += gk * hi.x; v[j][3] += gk * hi.y; }
        sm += (v[j][0] + v[j][1]) + (v[j][2] + v[j][3]); }
    const float mean = wave_sum(sm) * (1.0f / D); float s2 = 0.f;
#pragma unroll
    for (int j = 0; j < 4; ++j) { v[j] = v[j] - mean; s2 += (v[j][0] * v[j][0] + v[j][1] * v[j][1]) + (v[j][2] * v[j][2] + v[j][3] * v[j][3]); }
    const float rstd = 1.0f / sqrtf(wave_sum(s2) * (1.0f / D) + LN_EPS);
#pragma unroll
    for (int j = 0; j < 4; ++j) { const f32x4 g = *((const f32x4*)a.in[I_LN2G] + lane + 64 * j), bb = *((const f32x4*)a.in[I_LN2B] + lane + 64 * j);
        *((f32x4*)(a.out + (size_t)m * D) + lane + 64 * j) = v[j] * rstd * g + bb; }
}

__global__ void __launch_bounds__(512, 2) fwd_megakernel(Args args) {
    extern __shared__ __attribute__((aligned(16))) unsigned char lds_raw[];
    LAS unsigned char* lds = (LAS unsigned char*)lds_raw;
    const int tid = threadIdx.x, wave = __builtin_amdgcn_readfirstlane(tid >> 6);
#define FRESH_LANE int lane; { int t_ = tid; asm volatile("" : "+v"(t_)); lane = t_ & 63; }
    const int G = gridDim.x, bx = blockIdx.x;
    const int vcu = (G % 8 == 0) ? (bx % 8) * (G / 8) + bx / 8 : bx;
    const int gw = vcu * 8 + wave, NGW = G * 8;
    const int lo = args.ph_lo, hi = args.ph_hi;
    unsigned char* ws = args.ws;
    volatile LAS unsigned* bst = (volatile LAS unsigned*)(lds + MISC_OFF + MO_BAR);
    if (tid < 2) bst[tid] = 0u;
    __syncthreads();
    XcdBarrier xbar = xcd_barrier_post((unsigned*)(ws + WS_CTL) + CW_BAR, bst);
#ifndef PMASK
#define PMASK 0x1ff
#endif
#define IN(k) (((PMASK >> (k)) & 1) && lo <= (k) && (k) < hi)
#define SEAM(k) do { if (lo <= (k) && (k) + 1 < hi) xcd_barrier(xbar); } while (0)

    if (IN(0)) { FRESH_LANE; p0_prologue(args, lds, gw, NGW, lane, wave); }
    SEAM(0);
    if (IN(1)) {
        pg8::DenseOrder S; S.init(ws + WS_XB, ws + WS_WIN, T, INW, G, bx);
        pg8::EpiU E{(bf16*)(ws + WS_QB), (bf16*)(ws + WS_KB), (bf16*)(ws + WS_VT), (bf16*)(ws + WS_AB), (bf16*)(ws + WS_GATES), (const float*)(ws + WS_BPERM)};
        const int slot = vcu & 3;
        S.i0 = 0; S.i1 = slot;
        pg8::gemm_phase<pg8::EpiU, pg8::DenseOrder>(lds, S, E);
        { FRESH_LANE; side_convert_dma(args, bx, G, wave, lane, lds); }
        __syncthreads();
        S.i0 = slot; S.i1 = 1 << 20;
        pg8::gemm_phase<pg8::EpiU, pg8::DenseOrder>(lds, S, E);
    }
    SEAM(1);
    if (IN(2)) {
        FRESH_LANE;
        __syncthreads();
        for (int i = tid; i < CW * CCH / 4; i += 512) ((LAS f32x4*)(lds + CONV_W_OFF))[i] = ((const f32x4*)args.in[I_CONVW])[i];
        __syncthreads();
        for (int u = vcu; u < 256 + 512; u += G) {
            if (u < 256) attn_unit(args, u, lds, tid, wave, lane);
            else conv_unit(args, u - 256, lds, tid, wave, lane);
        }
    }
    SEAM(2);
    if (IN(3)) {
        pg8::DenseOrder S; S.init(ws + WS_AY, ws + WS_WAB, T, D, G, bx);
        pg8::EpiMerged E{(const bf16*)(ws + WS_GATES), args.in[I_BCONV], (bf16*)(ws + WS_MERGED), (unsigned*)(ws + WS_CTL) + CW_T3};
        pg8::gemm_phase<pg8::EpiMerged, pg8::DenseOrder>(lds, S, E);
    }
    if (IN(4)) {
        pg8::DenseOrder S; S.init(ws + WS_MERGED, ws + WS_WO, T, D, G, bx);
        pg8::EpiPre1 E{(const bf16*)(ws + WS_XB), (bf16*)(ws + WS_HF), (unsigned*)(ws + WS_CTL) + CW_T4};
        if (lo <= 3) { __syncthreads();
            if (tid == 0) { pg8::Unit u0; for (int i = 0; S.next(i, u0); ++i) pg8::tile_wait((const unsigned*)(ws + WS_CTL) + CW_T3, u0.pm, 32u, (unsigned*)(ws + WS_CTL) + 64); }
            __syncthreads(); }
        pg8::gemm_phase<pg8::EpiPre1, pg8::DenseOrder>(lds, S, E);
    }
    if (IN(5)) {
        FRESH_LANE;
        __syncthreads();
        if (lo <= 4) { if (tid == 0) { for (int c = vcu; c < T / 32; c += G) pg8::tile_wait((const unsigned*)(ws + WS_CTL) + CW_T4, c >> 3, 32u, (unsigned*)(ws + WS_CTL) + 64); }
            __syncthreads(); }
        float bw[64]; f32x4 g1[4], b1[4];
#pragma unroll
        for (int s_ = 0; s_ < 64; ++s_) bw[s_] = args.in[I_WR][(size_t)(128 * wave + 2 * s_ + (lane >> 5)) * NE + (lane & 31)];
#pragma unroll
        for (int j = 0; j < 4; ++j) { g1[j] = *((const f32x4*)args.in[I_LN1G] + lane + 64 * j); b1[j] = *((const f32x4*)args.in[I_LN1B] + lane + 64 * j); }
        for (int c = vcu; c < T / 32; c += G) route_chunk(args, c, lds, tid, wave, lane, bw, g1, b1);
    }
    SEAM(5);
    if (IN(6) || IN(7)) {
        LAS int* tab = (LAS int*)(lds + MISC_OFF + MO_TAB);
        __syncthreads();
        if (tid == 0) { const unsigned* cursor = (const unsigned*)(ws + WS_CTL); int acc = 0;
            for (int e = 0; e < NE; ++e) { const int c = (int)__hip_atomic_load(cursor + e, __ATOMIC_RELAXED, __HIP_MEMORY_SCOPE_AGENT); tab[e] = c; const int ml = (c + 255) >> 8; tab[32 + e] = ml; tab[64 + e] = acc; acc += ml; }
            tab[64 + NE] = acc; }
        __syncthreads();
        const int total_mt = tab[64 + NE];
        if (IN(6)) {
            unsigned* ctl = (unsigned*)(ws + WS_CTL);
            pg8::MoeFusedOrder S{tab, G, vcu, total_mt * 8, total_mt * 4, (const char*)(ws + WS_HB), (const char*)(ws + WS_ACT), (const char*)(ws + WS_WUP), (const char*)(ws + WS_WDN), (const int*)(ws + WS_SLOT), ctl + 8192, ctl + 64};
            pg8::EpiMoe E{pg8::EpiUpX{args.in[I_BUP], ws + WS_ACT}, pg8::EpiDown{args.in[I_BDN], (const int*)(ws + WS_SLOT), ws + WS_YS}};
            pg8::gemm_phase<pg8::EpiMoe, pg8::MoeFusedOrder, true>(lds, S, E);
        }
    }
    SEAM(7);
    if (IN(8)) { FRESH_LANE; for (int m = gw; m < T; m += NGW) combine_row(args, m, lane); }

#undef IN
#undef SEAM
#undef FRESH_LANE
}

extern "C" void kernel_launch(void* const* d_in, const int* in_sizes, int n_in, void* d_out, int out_size, void* d_ws, size_t ws_size, hipStream_t stream) {
    static int grid = 0;
    if (grid == 0) {
        if (n_in != 22 || out_size != T * D || ws_size < WS_END) { fprintf(stderr, "kernel_launch: unexpected problem (n_in %d, out %d, ws %zu)\n", n_in, out_size, ws_size); grid = -1; return; }
        int dev = 0, cus = 0, per_cu = 0;
        hipGetDevice(&dev); hipDeviceGetAttribute(&cus, hipDeviceAttributeMultiprocessorCount, dev);
        hipFuncSetAttribute((const void*)fwd_megakernel, hipFuncAttributeMaxDynamicSharedMemorySize, LDS_BYTES);
        hipOccupancyMaxActiveBlocksPerMultiprocessor(&per_cu, (const void*)fwd_megakernel, 512, LDS_BYTES);
        if (per_cu < 1) { fprintf(stderr, "kernel_launch: occupancy query says %d blocks per CU\n", per_cu); per_cu = 1; }
        (void)hipGetLastError();
        grid = cus * 1;
        fprintf(stderr, "kernel_launch: grid %d (cus %d, occupancy %d)\n", grid, cus, per_cu);
    }
    if (grid < 0) return;
    hipMemsetAsync((char*)d_ws + WS_CTL, 0, 65536, stream);
    Args a{};
    for (int i = 0; i < 22; ++i) a.in[i] = (const float*)d_in[i];
    a.out = (float*)d_out; a.ws = (unsigned char*)d_ws; a.ph_lo = 0; a.ph_hi = 9;
    void* kargs[] = {&a};
    hipError_t e = hipLaunchCooperativeKernel((const void*)fwd_megakernel, dim3(grid), dim3(512), kargs, LDS_BYTES, stream);
    if (e != hipSuccess) fprintf(stderr, "cooperative launch failed: %s (grid %d)\n", hipGetErrorString(e), grid);
}
```

```cpp
#include <hip/hip_runtime.h>
#include <cstdio>
#include <cstdint>

#define GAS __attribute__((address_space(1)))
#define LAS __attribute__((address_space(3)))
typedef unsigned short bf16;
typedef short bf16x8 __attribute__((ext_vector_type(8)));
typedef float f32x4 __attribute__((ext_vector_type(4)));
typedef float f32x2 __attribute__((ext_vector_type(2)));
typedef float f32x16 __attribute__((ext_vector_type(16)));
typedef unsigned u32x4 __attribute__((ext_vector_type(4)));
typedef unsigned u32x2 __attribute__((ext_vector_type(2)));

constexpr int T = 16384, D = 1024, SEQ = 4096, NBATCH = 4;
constexpr int NH = 8, NKV = 2, HD = 64, AW = 512, KVW = 128, CCH = 512, CW = 31;
constexpr int INW = 3840, NE = 32, TOPK = 4, DE = 1024;
constexpr float LN_EPS = 1e-5f;
constexpr float DN_ALPHA = 1.189207115002721f;
constexpr int SLOT_CAP = 16384;
constexpr int MAX_MT = (T * TOPK) / 256 + NE;

constexpr size_t MiB = 1u << 20;
constexpr size_t WS_CTL = 0, CTL_BYTES = 65536;
constexpr int CW_BAR = 4096, CW_T3 = 13312, CW_T4 = 14336, CW_T2 = 15360;
constexpr size_t WS_WIN = 1 * MiB;
constexpr size_t WS_WAB = 9 * MiB;
constexpr size_t WS_WO = 11 * MiB;
constexpr size_t WS_BPERM = 13 * MiB;
constexpr size_t WS_SLOT = 14 * MiB;
constexpr size_t WS_GATE = 16 * MiB;
constexpr size_t WS_LN1S = 17 * MiB;
constexpr size_t WS_WUP = 32 * MiB;
constexpr size_t WS_WDN = 160 * MiB;
constexpr size_t WS_XB = 224 * MiB;
constexpr size_t WS_QB = 256 * MiB;
constexpr size_t WS_KB = 272 * MiB;
constexpr size_t WS_VT = 276 * MiB;
constexpr size_t WS_AB = 792 * MiB;
constexpr size_t WS_GATES = 296 * MiB;
constexpr size_t WS_AY = 360 * MiB;
constexpr size_t WS_MERGED = 392 * MiB;
constexpr size_t WS_HF = 424 * MiB;
constexpr size_t WS_HB = 488 * MiB;
constexpr size_t WS_ACT = 520 * MiB;
constexpr size_t WS_YS = 664 * MiB;
constexpr size_t WS_END = 810 * MiB;
constexpr int AB_PAD = 32, AB_SEQ = SEQ + AB_PAD;

constexpr int LDS_SCR = 135168;
constexpr int MISC_OFF = 135168;
constexpr int MO_LG = 0, MO_SELE = 4224, MO_SELG = 4736, MO_LCNT = 5248, MO_LBASE = 5376, MO_TAB = 5504, MO_BAR = 6016, MO_RDY = 6080;
constexpr int OFFN_OFF = 147456;
constexpr int LDS_BYTES = 155648;

#define LDS_WAIT() asm volatile("s_waitcnt lgkmcnt(0)" ::: "memory")
#define VM_WAIT() asm volatile("s_waitcnt vmcnt(0)" ::: "memory")

__device__ __forceinline__ unsigned f2bf(float f) { unsigned u = __builtin_bit_cast(unsigned, f); return (u + 0x7fffu + ((u >> 16) & 1u)) >> 16; }
__device__ __forceinline__ unsigned pk2(float lo, float hi) { return f2bf(lo) | (f2bf(hi) << 16); }
__device__ __forceinline__ float bf2f(unsigned b) { return __builtin_bit_cast(float, b << 16); }
__device__ __forceinline__ float bflo(unsigned w) { return __builtin_bit_cast(float, w << 16); }
__device__ __forceinline__ float bfhi(unsigned w) { return __builtin_bit_cast(float, w & 0xffff0000u); }
typedef __bf16 bf16x2_t __attribute__((ext_vector_type(2)));
__device__ __forceinline__ unsigned cvt_pk_bf16(float lo, float hi) { const f32x2 v = {lo, hi}; return __builtin_bit_cast(unsigned, __builtin_convertvector(v, bf16x2_t)); }
__device__ __forceinline__ float sigmoidf_(float x) { return __builtin_amdgcn_rcpf(1.0f + __expf(-x)); }
#define DPP_ADD(v, ctrl) ((v) + __builtin_bit_cast(float, __builtin_amdgcn_update_dpp(0, __builtin_bit_cast(int, (v)), (ctrl), 0xf, 0xf, true)))
__device__ __forceinline__ float wave_sum(float v) {
    v = DPP_ADD(v, 0xB1);
    v = DPP_ADD(v, 0x4E);
    v = DPP_ADD(v, 0x141);
    v = DPP_ADD(v, 0x140);
    const int vi = __builtin_bit_cast(int, v);
    const float r0 = __builtin_bit_cast(float, __builtin_amdgcn_readlane(vi, 0)), r1 = __builtin_bit_cast(float, __builtin_amdgcn_readlane(vi, 16));
    const float r2 = __builtin_bit_cast(float, __builtin_amdgcn_readlane(vi, 32)), r3 = __builtin_bit_cast(float, __builtin_amdgcn_readlane(vi, 48));
    return (r0 + r1) + (r2 + r3);
}
template <class V> __device__ __forceinline__ V ldgo(const void* base, unsigned off) { return *(const V*)((const char*)base + off); }
#define PIN10(a) asm volatile("" : "+v"((a)[0]), "+v"((a)[1]), "+v"((a)[2]), "+v"((a)[3]), "+v"((a)[4]), "+v"((a)[5]), "+v"((a)[6]), "+v"((a)[7]), "+v"((a)[8]), "+v"((a)[9]))

struct Args { const float* in[22]; float* out; unsigned char* ws; int ph_lo, ph_hi; };
enum { I_X = 0, I_WIN, I_BIN, I_SINK, I_WATT, I_CONVW, I_CONVB, I_CLNG, I_CLNB, I_WCONV, I_BCONV, I_WO, I_LN1G, I_LN1B, I_WR, I_BR, I_WUP, I_BUP, I_WDN, I_BDN, I_LN2G, I_LN2B };
constexpr int CVI_UP = NE * 64, CVI_DN = NE * 32, CVI_ITEMS = CVI_UP + CVI_DN;
__device__ __forceinline__ void cvi_decode(const Args& a, int it, const float*& src, unsigned char*& dst, int& nw) {
    if (it < CVI_UP) { const int e = it >> 6, kg = it & 63; nw = 2048; src = a.in[I_WUP] + ((size_t)e * 1024 + 16 * kg) * 2048; dst = a.ws + WS_WUP + (size_t)e * 2048 * 1024 + (size_t)kg * 2048 * 16; }
    else { const int r = it - CVI_UP, e = r >> 5, kg2 = r & 31; nw = 1024; src = a.in[I_WDN] + ((size_t)e * 1024 + 32 * kg2) * 1024; dst = a.ws + WS_WDN + (size_t)e * 1024 * 1024 + (size_t)kg2 * 2 * 1024 * 16; }
}
__device__ __forceinline__ void cvi_slice_ptrs(const Args& a, int it, int wave, int lane, const float*& sp, unsigned& pitch, unsigned char*& dp) {
    const float* src; unsigned char* dst; int nw; cvi_decode(a, it, src, dst, nw);
    const int g = nw == 2048 ? 0 : (wave >> 2), cw = nw == 2048 ? wave : (wave & 3);
    sp = src + (size_t)(16 * g) * nw + 256 * cw + 4 * lane; pitch = (unsigned)nw;
    dp = dst + ((size_t)g * nw + 256 * cw + 4 * lane) * 16;
}
__device__ __forceinline__ void cvi_slice_load(const float* sp, unsigned pitch, f32x4 (&r)[16]) {
#pragma unroll
    for (int kk = 0; kk < 16; ++kk) r[kk] = __builtin_nontemporal_load((const f32x4*)(sp + (size_t)kk * pitch));
}
__device__ __forceinline__ void cvi_slice_out(unsigned char* dp, f32x4 (&r)[16]) {
    asm volatile("" : "+v"(r[0]), "+v"(r[1]), "+v"(r[2]), "+v"(r[3]), "+v"(r[4]), "+v"(r[5]), "+v"(r[6]), "+v"(r[7]), "+v"(r[8]), "+v"(r[9]), "+v"(r[10]), "+v"(r[11]), "+v"(r[12]), "+v"(r[13]), "+v"(r[14]), "+v"(r[15]));
#pragma unroll
    for (int j = 0; j < 4; ++j) { unsigned w[4];
#pragma unroll
        for (int c = 0; c < 4; ++c) { unsigned x = 0u; x = __builtin_amdgcn_cvt_pk_fp8_f32(r[4 * c][j] * 64.0f, r[4 * c + 1][j] * 64.0f, x, false);
            x = __builtin_amdgcn_cvt_pk_fp8_f32(r[4 * c + 2][j] * 64.0f, r[4 * c + 3][j] * 64.0f, x, true); w[c] = x; }
        *(u32x4*)(dp + 16 * j) = (u32x4){w[0], w[1], w[2], w[3]}; }
}
__device__ __forceinline__ void side_convert(const Args& a, int bx, int G, int wave, int lane) {
    int base, nit;
    if (G == 256) { base = bx < 192 ? 11 * bx : 2112 + 15 * (bx - 192); nit = bx < 192 ? 11 : 15; }
    else { const int per = (CVI_ITEMS + G - 1) / G; base = bx * per; nit = base >= CVI_ITEMS ? 0 : (CVI_ITEMS - base < per ? CVI_ITEMS - base : per); }
    const int end = base + nit;
    f32x4 r0[16], r1[16];
    const float* sp0; const float* sp1; unsigned p0 = 0, p1 = 0; unsigned char* d0; unsigned char* d1;
    if (nit > 0) { cvi_slice_ptrs(a, base, wave, lane, sp0, p0, d0); cvi_slice_load(sp0, p0, r0); }
    if (nit > 1) { cvi_slice_ptrs(a, base + 1, wave, lane, sp1, p1, d1); cvi_slice_load(sp1, p1, r1); }
#pragma unroll 1
    for (int it0 = base; it0 < end; it0 += 2) {
        const int it1 = it0 + 1;
        { unsigned char* dcur = d0; cvi_slice_out(dcur, r0); if (it0 + 2 < end) { cvi_slice_ptrs(a, it0 + 2, wave, lane, sp0, p0, d0); cvi_slice_load(sp0, p0, r0); } }
        if (it1 >= end) break;
        { unsigned char* dcur = d1; cvi_slice_out(dcur, r1); if (it1 + 2 < end) { cvi_slice_ptrs(a, it1 + 2, wave, lane, sp1, p1, d1); cvi_slice_load(sp1, p1, r1); } }
    }
}

__device__ __forceinline__ void side_convert_dma(const Args& a, int bx, int G, int wave, int lane, LAS unsigned char* lds) {
    int base, nit;
    if (G == 256) { base = bx < 192 ? 11 * bx : 2112 + 15 * (bx - 192); nit = bx < 192 ? 11 : 15; }
    else { const int per = (CVI_ITEMS + G - 1) / G; base = bx * per; nit = base >= CVI_ITEMS ? 0 : (CVI_ITEMS - base < per ? CVI_ITEMS - base : per); }
    const int end = base + nit;
    LAS unsigned char* wb = lds + wave * 16384;
    const float* sp; unsigned pitch = 0; unsigned char* dnext = nullptr;
#define CVD_DMA(h) do { _Pragma("unroll") for (int kk = 8 * (h); kk < 8 * (h) + 8; ++kk) \
        __builtin_amdgcn_global_load_lds((const unsigned*)(sp + (size_t)kk * pitch), (LAS unsigned*)(wb + kk * 1024), 16, 0, 2); } while (0)
    if (nit > 0) { cvi_slice_ptrs(a, base, wave, lane, sp, pitch, dnext); CVD_DMA(0); CVD_DMA(1); }
#pragma unroll 1
    for (int it = base; it < end; ++it) {
        unsigned char* dcur = dnext;
        f32x4 r[16];
        asm volatile("s_waitcnt vmcnt(8)" ::: "memory");
#pragma unroll
        for (int kk = 0; kk < 8; ++kk) r[kk] = *(const LAS f32x4*)(wb + kk * 1024 + lane * 16);
        asm volatile("s_waitcnt lgkmcnt(0)" ::: "memory");
        asm volatile("" : "+v"(r[0]), "+v"(r[1]), "+v"(r[2]), "+v"(r[3]), "+v"(r[4]), "+v"(r[5]), "+v"(r[6]), "+v"(r[7]));
        const bool more = it + 1 < end;
        if (more) { cvi_slice_ptrs(a, it + 1, wave, lane, sp, pitch, dnext); CVD_DMA(0); }
        if (more) asm volatile("s_waitcnt vmcnt(8)" ::: "memory"); else asm volatile("s_waitcnt vmcnt(0)" ::: "memory");
#pragma unroll
        for (int kk = 8; kk < 16; ++kk) r[kk] = *(const LAS f32x4*)(wb + kk * 1024 + lane * 16);
        asm volatile("s_waitcnt lgkmcnt(0)" ::: "memory");
        asm volatile("" : "+v"(r[8]), "+v"(r[9]), "+v"(r[10]), "+v"(r[11]), "+v"(r[12]), "+v"(r[13]), "+v"(r[14]), "+v"(r[15]));
        if (more) CVD_DMA(1);
        cvi_slice_out(dcur, r);
    }
#undef CVD_DMA
    asm volatile("s_waitcnt vmcnt(0)" ::: "memory");
}

namespace pg8 {
constexpr int BM = 256, BK = 64, HALF = 128, HTB = HALF * BK * 2, STAGE_BYTES = 8 * HTB, NXCD = 8, WGM = 8;
constexpr int KD = 1024, NT_K = KD / BK;
__device__ __forceinline__ void stgw(void* base, unsigned off, u32x4 v) { __builtin_amdgcn_raw_buffer_store_b128(v, __builtin_amdgcn_make_buffer_rsrc(base, 0, 0x7FFFFFFF, 0x00020000), off, 0, 16); }
__device__ __forceinline__ void tile_signal(unsigned* cnt, int pm) { asm volatile("s_waitcnt vmcnt(0)" ::: "memory"); if ((threadIdx.x & 63) == 0) __hip_atomic_fetch_add(cnt + 16 * pm, 1u, __ATOMIC_RELAXED, __HIP_MEMORY_SCOPE_AGENT); }
__device__ __forceinline__ void tile_wait(const unsigned* cnt, int pm, unsigned need, unsigned* tmo) {
    unsigned spins = 0u;
    while (__hip_atomic_load(cnt + 16 * pm, __ATOMIC_RELAXED, __HIP_MEMORY_SCOPE_AGENT) < need) { __builtin_amdgcn_s_sleep(2); if (++spins > (1u << 20)) { __hip_atomic_store(tmo, 1u, __ATOMIC_RELAXED, __HIP_MEMORY_SCOPE_AGENT); break; } }
}
__host__ __device__ __forceinline__ int lds_byte(int r, int c) { const int st = (r >> 4) * 2 + (c >> 5), rr = r & 15, cc = c & 31, ob = rr * 64 + cc * 2; return st * 1024 + (ob ^ (((ob >> 9) & 1) << 5)); }
__host__ __device__ __forceinline__ void stage_rc(int b, int& R, int& C) { const int st = b / 1024, sb = b % 1024, swz = sb ^ (((sb >> 9) & 1) << 5); R = (st >> 1) * 16 + swz / 64; C = (st & 1) * 32 + (swz % 64) / 2; }
__host__ __device__ __forceinline__ int perm32(int rho) { const int n = rho >> 4, i = rho & 15; return 8 * (i >> 2) + 4 * n + (i & 3); }

struct Unit { const char* A; const char* B; int pm, pn, e, mt, cnt, type; };

struct DenseOrder {
    const char* Ab; const char* Bb; int nM, nN, nwg, G, c, i0 = 0, i1 = 1 << 20; static constexpr int rowb = KD * 2; static constexpr bool PARK = false, FUSED = false;
    __device__ __forceinline__ unsigned boff(int Rb, int C) const { return (unsigned)(Rb * rowb + C * 2); }
    __device__ __forceinline__ size_t bstep_k() const { return 128; }
    __device__ __forceinline__ size_t bstep_h() const { return (size_t)HALF * rowb; }
    __device__ void init(const void* A, const void* B, int M, int N, int G_, int c_) { Ab = (const char*)A; Bb = (const char*)B; nM = M / BM; nN = N / BM; nwg = nM * nN; G = G_; c = c_; }
    __device__ __forceinline__ bool next(int i, Unit& u) const {
        if (i + i0 >= i1) return false;
        const long L = (long)(i + i0) * G + c; if (L >= nwg) return false;
        int wgid = (int)L; { const int q = nwg / NXCD, r = nwg % NXCD, xcd = wgid % NXCD, off = wgid / NXCD; wgid = (xcd < r ? xcd * (q + 1) : r * (q + 1) + (xcd - r) * q) + off; }
        const int nig = WGM * nN, gid = wgid / nig, fm = gid * WGM, gsz = (nM - fm) < WGM ? (nM - fm) : WGM;
        u.pm = fm + ((wgid % nig) % gsz); u.pn = (wgid % nig) / gsz; u.e = 0; u.mt = 0; u.cnt = 0; u.type = 0;
        u.A = Ab + (size_t)u.pm * (BM * KD * 2); u.B = Bb + (size_t)u.pn * (BM * KD * 2); return true;
    }
    __device__ __forceinline__ void offsets(const Unit&, const int (&R)[2], const int (&C)[2], unsigned (&off)[2][2]) const {
#pragma unroll
        for (int h = 0; h < 2; ++h)
#pragma unroll
            for (int i = 0; i < 2; ++i) off[h][i] = (unsigned)(((h * HALF + R[i]) * KD + C[i]) * 2);
    }
};
struct MoeOrder {
    const LAS int* tab; int NTN, G, c, total; const char* Ab; const char* Bb; size_t bexp; const int* slot; bool gather; int rowb;
    static constexpr bool PARK = true, FUSED = false;
    int bn16;
    __device__ __forceinline__ unsigned boff(int Rb, int C) const { return (unsigned)((C >> 3) * bn16 + Rb * 16); }
    __device__ __forceinline__ size_t bstep_k() const { return (size_t)8 * bn16; }
    __device__ __forceinline__ size_t bstep_h() const { return (size_t)HALF * 16; }
    __device__ __forceinline__ bool next(int i, Unit& u) const {
        const int L = i * G + c; if (L >= total) return false;
        int e = 0;
        for (int j = 1; j < NE; ++j) e += (L >= NTN * tab[64 + j]) ? 1 : 0;
        e = __builtin_amdgcn_readfirstlane(e);
        const int ms = __builtin_amdgcn_readfirstlane(tab[64 + e]), ml = __builtin_amdgcn_readfirstlane(tab[32 + e]);
        const int r = L - NTN * ms; const int nt = r / ml, mt = r - nt * ml;
        u.e = e; u.mt = mt; u.cnt = __builtin_amdgcn_readfirstlane(tab[e]); u.pm = ms + mt; u.pn = nt; u.type = 0;
        u.A = gather ? Ab : Ab + (size_t)u.pm * (size_t)(BM * rowb);
        u.B = Bb + (size_t)e * bexp + (size_t)nt * (size_t)(BM * 16); return true;
    }
    __device__ __forceinline__ void offsets(const Unit& u, const int (&R)[2], const int (&C)[2], unsigned (&off)[2][2]) const {
#pragma unroll
        for (int h = 0; h < 2; ++h)
#pragma unroll
            for (int i = 0; i < 2; ++i) {
                if (gather) { const int idx = u.mt * BM + h * HALF + R[i]; const int idc = idx < u.cnt ? idx : u.cnt - 1; int tok = slot[u.e * SLOT_CAP + idc] >> 2; tok = idx < u.cnt ? tok : 0; off[h][i] = (unsigned)(tok * rowb + C[i] * 2); }
                else off[h][i] = (unsigned)((h * HALF + R[i]) * rowb + C[i] * 2);
            }
    }
};


#define GAS_U32 __attribute__((address_space(1))) unsigned
struct MoeFusedOrder {
    const LAS int* tab; int G, c, total6, total7; const char* hb; const char* act; const char* wup; const char* wdn; const int* slot; unsigned* cnt; unsigned* tmo;
    static constexpr bool PARK = true, FUSED = true; static constexpr int rowb = 1024;
    __device__ __forceinline__ unsigned boff_t(int type, int R, int C) const {
        const int rs = 64 * (R >> 5) + 32 * ((R >> 2) & 1) + 16 * ((R >> 3) & 1) + 4 * ((R >> 4) & 1) + (R & 3);
        return (unsigned)((C >> 3) * ((type ? 1024 : 2048) * 16) + rs * 16); }
    __device__ __forceinline__ unsigned boff(int R, int C) const { return boff_t(0, R, C); }
    __device__ __forceinline__ size_t bstep_kt(int type) const { return (size_t)8 * (type ? 1024 * 16 : 2048 * 16); }
    __device__ __forceinline__ size_t bstep_ht(int) const { return (size_t)8 * 16; }
    __device__ __forceinline__ size_t bstep_k() const { return bstep_kt(0); }
    __device__ __forceinline__ size_t bstep_h() const { return bstep_ht(0); }
    __device__ __forceinline__ bool next(int i, Unit& u) const {
        int L = i * G + c; if (L >= total6 + total7) return false;
        const int type = L >= total6 ? 1 : 0; L -= type ? total6 : 0; const int NTN = type ? 4 : 8;
        int e = 0;
        for (int j = 1; j < NE; ++j) e += (L >= NTN * tab[64 + j]) ? 1 : 0;
        e = __builtin_amdgcn_readfirstlane(e);
        const int ms = __builtin_amdgcn_readfirstlane(tab[64 + e]), ml = __builtin_amdgcn_readfirstlane(tab[32 + e]);
        const int r = L - NTN * ms; const int nt = r / ml, mt = r - nt * ml;
        u.e = e; u.mt = mt; u.cnt = __builtin_amdgcn_readfirstlane(tab[e]); u.pm = ms + mt; u.pn = nt; u.type = type;
        u.A = type ? act + (size_t)u.pm * (size_t)(BM * rowb) : hb;
        u.B = (type ? wdn + (size_t)e * 1024 * 1024 : wup + (size_t)e * 2048 * 1024) + (size_t)nt * (size_t)(BM * 16); return true;
    }
    __device__ __forceinline__ void offsets(const Unit& u, const int (&R)[2], const int (&C)[2], unsigned (&off)[2][2]) const {
        if (u.type == 0) { int tok[2][2];
#pragma unroll
            for (int h = 0; h < 2; ++h)
#pragma unroll
                for (int i = 0; i < 2; ++i) { const int idx = u.mt * BM + h * HALF + R[i]; tok[h][i] = slot[u.e * SLOT_CAP + (idx < u.cnt ? idx : u.cnt - 1)]; }
#pragma unroll
            for (int h = 0; h < 2; ++h)
#pragma unroll
                for (int i = 0; i < 2; ++i) { const int idx = u.mt * BM + h * HALF + R[i]; const int t = idx < u.cnt ? (tok[h][i] >> 2) : 0; off[h][i] = (unsigned)(t * rowb + C[i] * 2); }
        } else {
#pragma unroll
            for (int h = 0; h < 2; ++h)
#pragma unroll
                for (int i = 0; i < 2; ++i) off[h][i] = (unsigned)((h * HALF + R[i]) * rowb + C[i] * 2);
        }
    }
    __device__ __forceinline__ void early_poll(const Unit& u, LAS unsigned char* lds) const {
        if (threadIdx.x < 64) { const unsigned* p = cnt + 16 * u.pm; unsigned v;
            asm volatile("global_load_dword %0, %1, off sc1\n\ts_waitcnt vmcnt(0)" : "=&v"(v) : "v"(p) : "memory");
            if (threadIdx.x == 0) *(LAS unsigned*)(lds + MISC_OFF + MO_RDY) = v >= 64u ? 1u : 0u; }
    }
    __device__ __forceinline__ void a_ready(const Unit& u) const {
        if (u.type) {
            if (threadIdx.x < 64) { const unsigned* p = cnt + 16 * u.pm; unsigned v, spins = 0u;
                for (;;) { asm volatile("global_load_dword %0, %1, off sc1\n\ts_waitcnt vmcnt(0)" : "=&v"(v) : "v"(p) : "memory");
                    if ((unsigned)__builtin_amdgcn_readfirstlane(v) >= 64u) break;
                    __builtin_amdgcn_s_sleep(2);
                    if (++spins > (1u << 20)) { if (threadIdx.x == 0) __hip_atomic_store(tmo, 1u, __ATOMIC_RELAXED, __HIP_MEMORY_SCOPE_AGENT); break; } }
                }
            asm volatile("" ::: "memory"); __builtin_amdgcn_s_barrier(); asm volatile("" ::: "memory");
        }
    }
    __device__ __forceinline__ void done(const Unit& u) const {
        if (u.type == 0) { asm volatile("s_waitcnt vmcnt(0)" ::: "memory");
            if ((threadIdx.x & 63) == 0) __hip_atomic_fetch_add(cnt + 16 * u.pm, 1u, __ATOMIC_RELAXED, __HIP_MEMORY_SCOPE_AGENT); }
    }
};

typedef f32x4 Acc[2][2][4][2];

typedef int i32x8 __attribute__((ext_vector_type(8)));
struct u32x4x2 { u32x4 a, b; };
template <class Epi, class Sched, bool FP8 = false>
__device__ __forceinline__ void gemm_phase(LAS unsigned char* lds, const Sched& S, const Epi& E) {
    const int tid = threadIdx.x, wid = __builtin_amdgcn_readfirstlane(tid >> 6), lane = tid & 63, wr = wid >> 2, wc = wid & 3, fr = lane & 15, fq = lane >> 4;
    constexpr int ROWB = FP8 ? KD : KD * 2, nt = FP8 ? KD / 128 : NT_K;
    int sR[2], sC[2], sRb[2]; unsigned voffB[2];
#pragma unroll
    for (int i = 0; i < 2; ++i) { int R, C; stage_rc(tid * 16 + i * 8192, R, C); sR[i] = R; sC[i] = C; const int Rb = Epi::PERM ? ((R & ~31) + perm32(R & 31)) : R; sRb[i] = Rb; voffB[i] = S.boff(Rb, C); }
    constexpr size_t kstep = (size_t)(BK * 2);
    size_t kstepB = S.bstep_k(), kstepBn = kstepB, hstepB = S.bstep_h(), hstepBn = hstepB;
    const unsigned ldsw = (unsigned)wid * 1024u;
    const int aoff = lds_byte(wr * 64 + fr, fq * 8), boff = lds_byte(wc * 32 + fr, fq * 8);
    constexpr int KST = 1024;
#define PG8_SA(b, h) (((b) * 2 + (h)) * HTB)
#define PG8_SB(b, h) ((4 + (b) * 2 + (h)) * HTB)
#define PG8_STAGE(bufoff, gbase, voff) do { const char* _gb = (const char*)(gbase); asm volatile("" : "+s"(_gb));     \
        _Pragma("unroll") for (int _i = 0; _i < 2; ++_i) \
        __builtin_amdgcn_global_load_lds((const unsigned*)(_gb + (voff)[_i]), (LAS unsigned*)(lds + (bufoff) + ldsw + _i * 8192), 16, 0, 0); } while (0)
#define PG8_STAGE_A(bufoff, gbase, voff) do { const char* _gb = (const char*)(gbase); asm volatile("" : "+s"(_gb)); \
        _Pragma("unroll") for (int _i = 0; _i < 2; ++_i) \
        __builtin_amdgcn_global_load_lds((const unsigned*)(_gb + (voff)[_i]), (LAS unsigned*)(lds + (bufoff) + ldsw + _i * 8192), 16, 0, 0); } while (0)
#define PG8_LDA(dst, b, h) do { _Pragma("unroll") for (int m = 0; m < 4; ++m) _Pragma("unroll") for (int k = 0; k < 2; ++k) dst[m][k] = *(const LAS bf16x8*)(lds + PG8_SA(b, h) + aoff + m * 2048 + k * KST); } while (0)
#define PG8_LDB(dst, b, h) do { _Pragma("unroll") for (int n = 0; n < 2; ++n) _Pragma("unroll") for (int k = 0; k < 2; ++k) dst[n][k] = *(const LAS bf16x8*)(lds + PG8_SB(b, h) + boff + n * 2048 + k * KST); } while (0)
#define PG8_CAT(x) __builtin_bit_cast(i32x8, (u32x4x2){__builtin_bit_cast(u32x4, (x)[0]), __builtin_bit_cast(u32x4, (x)[1])})
#define PG8_MMA(ai, bj, At, Bt) do { __builtin_amdgcn_s_setprio(1); \
        if constexpr (FP8) { _Pragma("unroll") for (int m = 0; m < 4; ++m) _Pragma("unroll") for (int n = 0; n < 2; ++n) \
            acc[ai][bj][m][n] = __builtin_amdgcn_mfma_scale_f32_16x16x128_f8f6f4(PG8_CAT(Bt[n]), PG8_CAT(At[m]), acc[ai][bj][m][n], 0, 0, 0, Epi::SCALE_B, 0, Epi::SCALE_A); } \
        else { _Pragma("unroll") for (int m = 0; m < 4; ++m) _Pragma("unroll") for (int n = 0; n < 2; ++n) _Pragma("unroll") for (int k = 0; k < 2; ++k) \
            acc[ai][bj][m][n] = __builtin_amdgcn_mfma_f32_16x16x32_bf16(Bt[n][k], At[m][k], acc[ai][bj][m][n], 0, 0, 0); } \
        __builtin_amdgcn_s_setprio(0); } while (0)
#define PG8_WAIT_V(n) asm volatile("s_waitcnt vmcnt(" #n ")" ::: "memory")
#define PG8_WAIT_L(n) asm volatile("s_waitcnt lgkmcnt(" #n ")" ::: "memory")
#define PG8_BAR __builtin_amdgcn_s_barrier()
#define PG8_SCHED __builtin_amdgcn_sched_barrier(0)
    Unit cur, nxt; int ui = 0;
    if (!S.next(0, cur)) return;
    Acc acc;
    bf16x8 At[4][2], B0[2][2], B1[2][2];
    unsigned offA[2][2], offN[2][2];
    S.offsets(cur, sR, sC, offA);
    if constexpr (Sched::FUSED) { kstepB = S.bstep_kt(cur.type); hstepB = S.bstep_ht(cur.type);
#pragma unroll
        for (int i = 0; i < 2; ++i) voffB[i] = S.boff_t(cur.type, sR[i], sC[i]); }
    const char* cA = cur.A; const char* cB = cur.B;
    PG8_STAGE(PG8_SB(0, 0), cB, voffB); PG8_STAGE(PG8_SB(0, 1), cB + hstepB, voffB); PG8_STAGE_A(PG8_SA(0, 0), cA, offA[0]); PG8_STAGE_A(PG8_SA(0, 1), cA, offA[1]);
    if (wr == 1) PG8_BAR;
    PG8_WAIT_V(2); PG8_BAR;
    PG8_STAGE(PG8_SB(1, 0), cB + kstepB, voffB); PG8_STAGE_A(PG8_SA(1, 0), cA + kstep, offA[0]); PG8_STAGE(PG8_SB(1, 1), cB + hstepB + kstepB, voffB);
    PG8_WAIT_V(6); PG8_BAR;
    for (;;) {
#pragma unroll
        for (int a = 0; a < 2; ++a)
#pragma unroll
            for (int b = 0; b < 2; ++b)
#pragma unroll
                for (int m = 0; m < 4; ++m)
#pragma unroll
                    for (int n = 0; n < 2; ++n) acc[a][b][m][n] = (f32x4){0.f, 0.f, 0.f, 0.f};
        const bool has_next = S.next(ui + 1, nxt);
        const char* nA = has_next ? nxt.A : cA; const char* nB = has_next ? nxt.B : cB;
        if constexpr (Sched::FUSED) { kstepBn = has_next ? S.bstep_kt(nxt.type) : kstepB; hstepBn = has_next ? S.bstep_ht(nxt.type) : hstepB; }
        if (has_next) S.offsets(nxt, sR, sC, offN);
        else {
#pragma unroll
            for (int h = 0; h < 2; ++h)
#pragma unroll
                for (int i = 0; i < 2; ++i) offN[h][i] = offA[h][i];
        }
        if constexpr (Sched::PARK) *(LAS u32x4*)(lds + OFFN_OFF + tid * 16) = (u32x4){offN[0][0], offN[0][1], offN[1][0], offN[1][1]};
        if constexpr (Sched::FUSED) { if (has_next && nxt.type) S.early_poll(nxt, lds); }
#pragma unroll 1
        for (int t = 0; t < nt; t += 2) {
            const bool last = (t == nt - 2);
            const char* a1 = cA + (size_t)(t + 1) * kstep;
            const char* a2 = last ? nA : cA + (size_t)(t + 2) * kstep; const char* b2 = last ? nB : cB + (size_t)(t + 2) * kstepB;
            const char* a3 = a2 + kstep; const char* b3 = b2 + (last ? kstepBn : kstepB); const size_t hB = last ? hstepBn : hstepB;
            if constexpr (Sched::FUSED) { if (last && has_next && nxt.type) { const unsigned rdy = __builtin_amdgcn_readfirstlane(*(const LAS unsigned*)(lds + MISC_OFF + MO_RDY)); if (!rdy) S.a_ready(nxt); } }
            if constexpr (Epi::MID_T > 0) { if (t == Epi::MID_T) E.mid(acc, cur, wr, wc, fr, fq); }
            PG8_LDB(B0, 0, 0); PG8_LDB(B1, 0, 1); PG8_SCHED; PG8_LDA(At, 0, 0); PG8_STAGE_A(PG8_SA(1, 1), a1, offA[1]);
            PG8_WAIT_V(8); PG8_WAIT_L(0); PG8_BAR; PG8_MMA(0, 0, At, B0); PG8_MMA(0, 1, At, B1);
            asm volatile("" : "+v"(acc[0][0][0][0]), "+v"(acc[0][0][0][1]), "+v"(acc[0][0][1][0]), "+v"(acc[0][0][1][1]), "+v"(acc[0][0][2][0]), "+v"(acc[0][0][2][1]), "+v"(acc[0][0][3][0]), "+v"(acc[0][0][3][1]));
            asm volatile("" : "+v"(acc[0][1][0][0]), "+v"(acc[0][1][0][1]), "+v"(acc[0][1][1][0]), "+v"(acc[0][1][1][1]), "+v"(acc[0][1][2][0]), "+v"(acc[0][1][2][1]), "+v"(acc[0][1][3][0]), "+v"(acc[0][1][3][1]));
            PG8_BAR; PG8_SCHED;
            if (last) {
                if constexpr (Sched::FUSED) { if (has_next) {
#pragma unroll
                    for (int i = 0; i < 2; ++i) voffB[i] = S.boff_t(nxt.type, sR[i], sC[i]); } }
                if constexpr (Sched::PARK) { const u32x4 pk = *(const LAS u32x4*)(lds + OFFN_OFF + tid * 16); offA[0][0] = pk.x; offA[0][1] = pk.y; offA[1][0] = pk.z; offA[1][1] = pk.w; }
                else {
#pragma unroll
                    for (int h = 0; h < 2; ++h)
#pragma unroll
                        for (int i = 0; i < 2; ++i) offA[h][i] = offN[h][i];
                }
            }
            PG8_LDA(At, 0, 1); PG8_STAGE(PG8_SB(0, 0), b2, voffB); PG8_STAGE(PG8_SB(0, 1), b2 + hB, voffB); PG8_STAGE_A(PG8_SA(0, 0), a2, offA[0]);
            PG8_WAIT_V(8); PG8_WAIT_L(0); PG8_BAR; PG8_MMA(1, 0, At, B0); PG8_MMA(1, 1, At, B1); PG8_BAR; PG8_SCHED;
            PG8_LDB(B0, 1, 0); PG8_LDB(B1, 1, 1); PG8_SCHED; PG8_LDA(At, 1, 0); PG8_STAGE_A(PG8_SA(0, 1), a2, offA[1]);
            PG8_WAIT_V(8); PG8_WAIT_L(0); PG8_BAR; PG8_MMA(0, 0, At, B0); PG8_MMA(0, 1, At, B1); PG8_BAR; PG8_SCHED;
            PG8_LDA(At, 1, 1); PG8_STAGE(PG8_SB(1, 0), b3, voffB); PG8_STAGE(PG8_SB(1, 1), b3 + hB, voffB); PG8_STAGE_A(PG8_SA(1, 0), a3, offA[0]);
            PG8_WAIT_V(8); PG8_WAIT_L(0); PG8_BAR; PG8_MMA(1, 0, At, B0); PG8_MMA(1, 1, At, B1); PG8_BAR; PG8_SCHED;
        }
        if (wr == 0) PG8_BAR;
        E(acc, cur, wr, wc, fr, fq);
        if constexpr (Sched::FUSED) S.done(cur);
        if constexpr (Epi::SIGNAL) tile_signal(E.cnt, cur.pm);
        __builtin_amdgcn_s_waitcnt(0x0F70);
        if (!has_next) break;
        cur = nxt; cA = nA; cB = nB; kstepB = kstepBn; hstepB = hstepBn; ++ui;
        if (wr == 1) PG8_BAR;
    }
    PG8_WAIT_V(0);
    PG8_BAR;
#undef PG8_SA
#undef PG8_SB
#undef PG8_STAGE
#undef PG8_STAGE_A
#undef PG8_LDA
#undef PG8_LDB
#undef PG8_MMA
#undef PG8_WAIT_V
#undef PG8_WAIT_L
#undef PG8_BAR
#undef PG8_SCHED
}

#define EPI_SEED(r, c) asm volatile("" : "+v"(r), "+v"(c))
template <class V> __device__ __forceinline__ V ldg(const void* base, unsigned off) { return *(const V*)((const char*)base + off); }
template <class V> __device__ __forceinline__ void stg(void* base, unsigned off, V v) { *(V*)((char*)base + off) = v; }
__device__ __forceinline__ u32x4 pack8(const f32x4 v0, const f32x4 v1) { u32x4 w; w.x = cvt_pk_bf16(v0[0], v0[1]); w.y = cvt_pk_bf16(v0[2], v0[3]); w.z = cvt_pk_bf16(v1[0], v1[1]); w.w = cvt_pk_bf16(v1[2], v1[3]); return w; }

struct EpiU {
    static constexpr int SCALE_B = 0, SCALE_A = 0;
    static constexpr bool PERM = true, SIGNAL = false; static constexpr int MID_T = 0;
    bf16 *q, *k, *vT, *ab, *gates; const float* bias;
    __device__ __forceinline__ void mid(Acc&, const Unit&, int, int, int, int) const {}
    __device__ __forceinline__ void operator()(const Acc& acc, const Unit& u, int wr, int wc, int fr, int fq) const {
        int rl = wr * 64 + fr, cl = wc * 32 + 8 * fq; EPI_SEED(rl, cl);
        const int row0 = u.pm * BM + rl, pn = u.pn;
        f32x4 bv[2][2];
#pragma unroll
        for (int bj = 0; bj < 2; ++bj)
#pragma unroll
            for (int n = 0; n < 2; ++n) bv[bj][n] = ldg<f32x4>(bias, (unsigned)(pn * BM + bj * HALF + cl + 4 * n) * 4u);
        if (pn < 2) {
            const unsigned o0 = ((unsigned)row0 * AW + pn * BM + cl) * 2u;
#pragma unroll
            for (int ai = 0; ai < 2; ++ai)
#pragma unroll
                for (int m = 0; m < 4; ++m)
#pragma unroll
                    for (int bj = 0; bj < 2; ++bj)
                        stg<u32x4>(q, o0 + (unsigned)((ai * HALF + m * 16) * AW + bj * HALF) * 2u, pack8((acc[ai][bj][m][0] + bv[bj][0]) * 0.125f, (acc[ai][bj][m][1] + bv[bj][1]) * 0.125f));
        } else if (pn == 2) {
            const unsigned o0 = ((unsigned)row0 * KVW + cl) * 2u;
            const int b = row0 >> 12, s0 = row0 & (SEQ - 1);
#pragma unroll
            for (int ai = 0; ai < 2; ++ai)
#pragma unroll
                for (int m = 0; m < 4; ++m) {
                    stg<u32x4>(k, o0 + (unsigned)((ai * HALF + m * 16) * KVW) * 2u, pack8(acc[ai][0][m][0] + bv[0][0], acc[ai][0][m][1] + bv[0][1]));
#pragma unroll
                    for (int n = 0; n < 2; ++n) { const f32x4 v = acc[ai][1][m][n] + bv[1][n];
#pragma unroll
                        for (int j = 0; j < 4; ++j) { const int col = cl + 4 * n + j, kvh = col >> 6, dim = col & 63;
                            stg<bf16>(vT, (unsigned)(((b * NKV + kvh) * HD + dim) * SEQ + s0 + ai * HALF + m * 16) * 2u, (bf16)f2bf(v[j])); } } }
        } else if (pn < 7) {
            const unsigned o0 = ((unsigned)(row0 + AB_PAD * ((row0 >> 12) + 1)) * CCH + (pn - 3) * HALF + cl) * 2u;
#pragma unroll
            for (int ai = 0; ai < 2; ++ai)
#pragma unroll
                for (int m = 0; m < 4; ++m) { f32x4 o[2];
#pragma unroll
                    for (int n = 0; n < 2; ++n) { const f32x4 a = acc[ai][0][m][n] + bv[0][n], g = acc[ai][1][m][n] + bv[1][n];
#pragma unroll
                        for (int j = 0; j < 4; ++j) o[n][j] = a[j] * sigmoidf_(g[j]); }
                    stg<u32x4>(ab, o0 + (unsigned)((ai * HALF + m * 16) * CCH) * 2u, pack8(o[0], o[1])); }
        } else {
            const unsigned o0 = ((unsigned)row0 * 2048 + (pn - 7) * HALF + cl) * 2u;
#pragma unroll
            for (int ai = 0; ai < 2; ++ai)
#pragma unroll
                for (int m = 0; m < 4; ++m) { f32x4 ra[2], gb[2];
#pragma unroll
                    for (int n = 0; n < 2; ++n) { const f32x4 va = acc[ai][0][m][n] + bv[0][n], vb = acc[ai][1][m][n] + bv[1][n];
#pragma unroll
                        for (int j = 0; j < 4; ++j) { const float sb = sigmoidf_(vb[j]); gb[n][j] = sb; ra[n][j] = sigmoidf_(va[j]) * __builtin_amdgcn_rcpf(sb); } }
                    stg<u32x4>(gates, o0 + (unsigned)((ai * HALF + m * 16) * 2048) * 2u, pack8(ra[0], ra[1]));
                    stg<u32x4>(gates, o0 + (unsigned)((ai * HALF + m * 16) * 2048 + 1024) * 2u, pack8(gb[0], gb[1])); }
        }
    }
};
struct EpiMerged {
    static constexpr int SCALE_B = 0, SCALE_A = 0;
    static constexpr bool PERM = true, SIGNAL = true; static constexpr int MID_T = 8;
    const bf16* gates; const float* bc; bf16* merged; unsigned* cnt;
    __device__ __forceinline__ void mid(Acc& acc, const Unit& u, int wr, int wc, int fr, int fq) const {
        int rl = wr * 64 + fr, cl = wc * 32 + 8 * fq; EPI_SEED(rl, cl);
        const unsigned g0 = ((unsigned)(u.pm * BM + rl) * 2048 + u.pn * BM + cl) * 2u;
#pragma unroll
        for (int ai = 0; ai < 2; ++ai) { u32x4 rt[4][2];
#pragma unroll
            for (int m = 0; m < 4; ++m)
#pragma unroll
                for (int bj = 0; bj < 2; ++bj) rt[m][bj] = ldg<u32x4>(gates, g0 + (unsigned)((ai * HALF + m * 16) * 2048 + bj * HALF) * 2u);
            __builtin_amdgcn_sched_barrier(0);
#pragma unroll
            for (int m = 0; m < 4; ++m)
#pragma unroll
                for (int bj = 0; bj < 2; ++bj)
#pragma unroll
                    for (int n = 0; n < 2; ++n) { acc[ai][bj][m][n][0] *= bflo(rt[m][bj][2 * n]); acc[ai][bj][m][n][1] *= bfhi(rt[m][bj][2 * n]); acc[ai][bj][m][n][2] *= bflo(rt[m][bj][2 * n + 1]); acc[ai][bj][m][n][3] *= bfhi(rt[m][bj][2 * n + 1]); }
            __builtin_amdgcn_sched_barrier(0); }
    }
    __device__ __forceinline__ void operator()(const Acc& acc, const Unit& u, int wr, int wc, int fr, int fq) const {
        int rl = wr * 64 + fr, cl = wc * 32 + 8 * fq; EPI_SEED(rl, cl);
        const int row0 = u.pm * BM + rl, col0 = u.pn * BM + cl;
        const unsigned g0 = ((unsigned)row0 * 2048 + 1024 + col0) * 2u, m0 = ((unsigned)row0 * D + col0) * 2u;
        f32x4 bv[2][2];
#pragma unroll
        for (int bj = 0; bj < 2; ++bj)
#pragma unroll
            for (int n = 0; n < 2; ++n) bv[bj][n] = ldg<f32x4>(bc, (unsigned)(col0 + bj * HALF + 4 * n) * 4u);
#pragma unroll
        for (int ai = 0; ai < 2; ++ai)
#pragma unroll
            for (int m = 0; m < 4; ++m) {
#pragma unroll
                for (int bj = 0; bj < 2; ++bj) { const u32x4 gb = ldg<u32x4>(gates, g0 + (unsigned)((ai * HALF + m * 16) * 2048 + bj * HALF) * 2u); f32x4 o[2];
#pragma unroll
                    for (int n = 0; n < 2; ++n) { const f32x4 v = acc[ai][bj][m][n] + bv[bj][n];
                        o[n][0] = v[0] * bflo(gb[2 * n]); o[n][1] = v[1] * bfhi(gb[2 * n]); o[n][2] = v[2] * bflo(gb[2 * n + 1]); o[n][3] = v[3] * bfhi(gb[2 * n + 1]); }
                    stgw(merged, m0 + (unsigned)((ai * HALF + m * 16) * D + bj * HALF) * 2u, pack8(o[0], o[1])); }
                if (m & 1) asm volatile("" ::: "memory"); }
    }
};
struct EpiPre1 {
    static constexpr int SCALE_B = 0, SCALE_A = 0;
    static constexpr bool PERM = true, SIGNAL = true; static constexpr int MID_T = 0;
    const bf16* xb; bf16* out; unsigned* cnt;
    __device__ __forceinline__ void mid(Acc&, const Unit&, int, int, int, int) const {}
    __device__ __forceinline__ void operator()(const Acc& acc, const Unit& u, int wr, int wc, int fr, int fq) const {
        int rl = wr * 64 + fr, cl = wc * 32 + 8 * fq; EPI_SEED(rl, cl);
        const unsigned o0 = ((unsigned)(u.pm * BM + rl) * D + u.pn * BM + cl) * 2u;
        u32x4 xv[2][4][2];
#pragma unroll
        for (int ai = 0; ai < 2; ++ai)
#pragma unroll
            for (int m = 0; m < 4; ++m)
#pragma unroll
                for (int bj = 0; bj < 2; ++bj) xv[ai][m][bj] = ldg<u32x4>(xb, o0 + (unsigned)((ai * HALF + m * 16) * D + bj * HALF) * 2u);
        __builtin_amdgcn_sched_barrier(0);
#pragma unroll
        for (int ai = 0; ai < 2; ++ai)
#pragma unroll
            for (int m = 0; m < 4; ++m)
#pragma unroll
                for (int bj = 0; bj < 2; ++bj) { const u32x4 w = xv[ai][m][bj];
                    const f32x4 r0 = (f32x4){bflo(w.x), bfhi(w.x), bflo(w.y), bfhi(w.y)} * DN_ALPHA + acc[ai][bj][m][0], r1 = (f32x4){bflo(w.z), bfhi(w.z), bflo(w.w), bfhi(w.w)} * DN_ALPHA + acc[ai][bj][m][1];
                    stgw(out, o0 + (unsigned)((ai * HALF + m * 16) * D + bj * HALF) * 2u, pack8(r0, r1)); }
    }
};
struct EpiUp {
    static constexpr bool PERM = true, SIGNAL = false; static constexpr int MID_T = 0;
    static constexpr int SCALE_B = 0x79797979, SCALE_A = 0x7C7C7C7C;
    const float* b_up; unsigned char* act;
    __device__ __forceinline__ void mid(Acc&, const Unit&, int, int, int, int) const {}
    __device__ __forceinline__ void operator()(const Acc& acc, const Unit& u, int wr, int wc, int fr, int fq) const {
        int rl = wr * 64 + fr, cl = wc * 32 + 8 * fq; EPI_SEED(rl, cl);
        const unsigned o0 = (unsigned)(u.pm * BM + rl) * DE + u.pn * HALF + (cl >> 1);
        f32x4 bv[2][2];
#pragma unroll
        for (int bj = 0; bj < 2; ++bj)
#pragma unroll
            for (int n = 0; n < 2; ++n) bv[bj][n] = ldg<f32x4>(b_up, (unsigned)(u.e * 2048 + u.pn * BM + cl + bj * HALF + 4 * n) * 4u);
#pragma unroll
        for (int ai = 0; ai < 2; ++ai)
#pragma unroll
            for (int m = 0; m < 4; ++m)
#pragma unroll
                for (int bj = 0; bj < 2; ++bj) { float o[4];
#pragma unroll
                    for (int n = 0; n < 2; ++n) { const f32x4 v = acc[ai][bj][m][n] + bv[bj][n];
#pragma unroll
                        for (int p = 0; p < 2; ++p) { const float xg = fminf(v[2 * p], 7.0f), xl = fminf(fmaxf(v[2 * p + 1], -7.0f), 7.0f);
                            o[2 * n + p] = xg * sigmoidf_(1.702f * xg) * (xl + 1.0f); } }
                    unsigned w = 0u; w = __builtin_amdgcn_cvt_pk_fp8_f32(o[0] * 8.0f, o[1] * 8.0f, w, false); w = __builtin_amdgcn_cvt_pk_fp8_f32(o[2] * 8.0f, o[3] * 8.0f, w, true);
                    __hip_atomic_store((unsigned*)(act + (o0 + (unsigned)((ai * HALF + m * 16) * DE + bj * 64))), w, __ATOMIC_RELAXED, __HIP_MEMORY_SCOPE_AGENT); }
    }
};
struct EpiDown {
    static constexpr bool PERM = true, SIGNAL = false; static constexpr int MID_T = 0;
    static constexpr int SCALE_B = 0x79797979, SCALE_A = 0x7C7C7C7C;
    const float* b_dn; const int* slot; unsigned char* ys;
    __device__ __forceinline__ void mid(Acc&, const Unit&, int, int, int, int) const {}
    __device__ __forceinline__ void operator()(const Acc& acc, const Unit& u, int wr, int wc, int fr, int fq) const {
        int rl = wr * 64 + fr, cb = 64 * wc + 32 * (fq & 1) + 16 * (fq >> 1); EPI_SEED(rl, cb);
        const int col0 = u.pn * BM + cb, idx0 = u.mt * BM + rl;
        f32x4 bv[2][2];
#pragma unroll
        for (int bj = 0; bj < 2; ++bj)
#pragma unroll
            for (int n = 0; n < 2; ++n) bv[bj][n] = ldg<f32x4>(b_dn, (unsigned)(u.e * D + col0 + 8 * bj + 4 * n) * 4u);
        int asg[2][4];
#pragma unroll
        for (int ai = 0; ai < 2; ++ai)
#pragma unroll
            for (int m = 0; m < 4; ++m) { const int idx = idx0 + ai * HALF + m * 16; asg[ai][m] = ldg<int>(slot, (unsigned)(u.e * SLOT_CAP + (idx < u.cnt ? idx : u.cnt - 1)) * 4u); }
#pragma unroll
        for (int ai = 0; ai < 2; ++ai)
#pragma unroll
            for (int m = 0; m < 4; ++m) { const int idx = idx0 + ai * HALF + m * 16;
                if (idx < u.cnt) { u32x4 w;
#pragma unroll
                    for (int bj = 0; bj < 2; ++bj)
#pragma unroll
                        for (int n = 0; n < 2; ++n) { const f32x4 v = (acc[ai][bj][m][n] + bv[bj][n]) * 16.0f;
                            unsigned x = __builtin_amdgcn_cvt_pk_fp8_f32(v[0], v[1], 0u, false); x = __builtin_amdgcn_cvt_pk_fp8_f32(v[2], v[3], x, true); w[2 * bj + n] = x; }
                    stg<u32x4>(ys, (unsigned)asg[ai][m] * D + col0, w); } }
    }
};
struct EpiUpX {
    const float* b_up; unsigned char* act;
    __device__ __forceinline__ void operator()(const Acc& acc, const Unit& u, int wr, int wc, int fr, int fq) const {
        int rl = wr * 64 + fr, cb = 64 * wc + 32 * (fq & 1) + 16 * (fq >> 1); EPI_SEED(rl, cb);
        f32x4 bv[2][2];
#pragma unroll
        for (int bj = 0; bj < 2; ++bj)
#pragma unroll
            for (int n = 0; n < 2; ++n) bv[bj][n] = ldg<f32x4>(b_up, (unsigned)(u.e * 2048 + u.pn * BM + cb + 8 * bj + 4 * n) * 4u);
        const __amdgpu_buffer_rsrc_t rs = __builtin_amdgcn_make_buffer_rsrc(act, 0, (MAX_MT * 256) * 1024, 0x00020000);
        const unsigned o0 = (unsigned)(u.pm * BM + rl + 16 * (fq >> 1)) * DE + u.pn * HALF + 32 * wc + 16 * (fq & 1);
#pragma unroll
        for (int ai = 0; ai < 2; ++ai)
#pragma unroll
            for (int j = 0; j < 2; ++j) { unsigned d[2][2];
#pragma unroll
                for (int mm = 0; mm < 2; ++mm)
#pragma unroll
                    for (int bj = 0; bj < 2; ++bj) { float o[4];
#pragma unroll
                        for (int n = 0; n < 2; ++n) { const f32x4 v = acc[ai][bj][2 * j + mm][n] + bv[bj][n];
#pragma unroll
                            for (int p = 0; p < 2; ++p) { const float xg = fminf(v[2 * p], 7.0f), xl = fminf(fmaxf(v[2 * p + 1], -7.0f), 7.0f);
                                o[2 * n + p] = (xg * __builtin_amdgcn_rcpf(1.0f + __builtin_amdgcn_exp2f(xg * (-1.702f * 1.44269504f)))) * __builtin_fmaf(xl, 8.0f, 8.0f); } }
                        unsigned w = 0u; w = __builtin_amdgcn_cvt_pk_fp8_f32(o[0], o[1], w, false); w = __builtin_amdgcn_cvt_pk_fp8_f32(o[2], o[3], w, true); d[mm][bj] = w; }
                const u32x2 s0 = __builtin_amdgcn_permlane32_swap(d[0][0], d[1][0], false, false), s1 = __builtin_amdgcn_permlane32_swap(d[0][1], d[1][1], false, false);
                const u32x4 w4 = (u32x4){s0.x, s1.x, s0.y, s1.y};
                __builtin_amdgcn_raw_buffer_store_b128(w4, rs, o0 + (unsigned)((ai * HALF + 32 * j) * DE), 0, 16); }
    }
};
struct EpiMoe {
    static constexpr bool PERM = true, SIGNAL = false; static constexpr int MID_T = 0;
    static constexpr int SCALE_B = 0x79797979, SCALE_A = 0x7C7C7C7C;
    EpiUpX up; EpiDown dn;
    __device__ __forceinline__ void mid(Acc&, const Unit&, int, int, int, int) const {}
    __device__ __forceinline__ void operator()(const Acc& acc, const Unit& u, int wr, int wc, int fr, int fq) const { if (u.type == 0) up(acc, u, wr, wc, fr, fq); else dn(acc, u, wr, wc, fr, fq); }
};
}

#define XB_TMO      128
#define XB_XCNT(j)  (256  + 64 * (j))
#define XB_XSUB(j)  (1280 + 64 * (j))
#define XB_XGEN(j)  (2304 + 64 * (j))
#define XB_TOP      3328
#define XB_TOPGEN   3392
#define XCD_BAR_WORDS 3456
#define XB_SPIN_CAP (1u << 18)
__device__ __forceinline__ unsigned xb_ld(unsigned* p)              { return __hip_atomic_load(p, __ATOMIC_RELAXED, __HIP_MEMORY_SCOPE_AGENT); }
__device__ __forceinline__ unsigned xb_add(unsigned* p, unsigned v) { return __hip_atomic_fetch_add(p, v, __ATOMIC_RELAXED, __HIP_MEMORY_SCOPE_AGENT); }
__device__ __forceinline__ unsigned xb_xcc_id() { return (unsigned)__builtin_amdgcn_s_getreg((3 << 11) | 20) & 0xFu; }
#define XB_SPIN(cond, bar) do { unsigned _sp = 0; while (cond) { __builtin_amdgcn_s_sleep(1); \
    if ((++_sp & 255u) == 0u) { if (xb_ld(&(bar)[XB_TMO])) break; if (_sp > XB_SPIN_CAP) { atomicAdd(&(bar)[XB_TMO], 1u); break; } } } } while (0)
struct XcdBarrier { unsigned* bar; unsigned x; volatile LAS unsigned* st; };
__device__ __forceinline__ XcdBarrier xcd_barrier_post(unsigned* bar, volatile LAS unsigned* st) {
    XcdBarrier b; b.bar = bar; b.x = xb_xcc_id(); b.st = st;
    if (threadIdx.x == 0) (void)xb_add(&bar[XB_XCNT(b.x)], 1u);
    return b;
}
__device__ __forceinline__ void xcd_barrier_complete(unsigned* bar, unsigned x, unsigned& nloc, unsigned& nx) {
    const unsigned G = gridDim.x * gridDim.y * gridDim.z;
    unsigned sum, cnt, mine, sp = 0u;
    for (;;) {
        sum = 0u; cnt = 0u; mine = 0u;
#pragma unroll
        for (unsigned j = 0; j < 16; ++j) { const unsigned c = xb_ld(&bar[XB_XCNT(j)]); sum += c; cnt += (c > 0u) ? 1u : 0u; mine = (j == x) ? c : mine; }
        if (sum == G) break;
        __builtin_amdgcn_s_sleep(1);
        if ((++sp & 255u) == 0u) { if (xb_ld(&bar[XB_TMO])) break; if (sp > XB_SPIN_CAP) { atomicAdd(&bar[XB_TMO], 1u); break; } }
    }
    nloc = mine > 0u ? mine : 1u; nx = cnt > 0u ? cnt : 1u;
}
__device__ __forceinline__ void xcd_barrier(const XcdBarrier& b) {
    asm volatile("s_waitcnt vmcnt(0)" ::: "memory");
    __syncthreads();
    if (threadIdx.x == 64) asm volatile("buffer_inv sc1\n\ts_waitcnt vmcnt(0)" ::: "memory");
    if (threadIdx.x == 0) {
        unsigned* bar = b.bar;
        __builtin_amdgcn_s_waitcnt(0);
        unsigned nloc = b.st[0], nx = b.st[1];
        if (nloc == 0u) { xcd_barrier_complete(bar, b.x, nloc, nx); b.st[0] = nloc; b.st[1] = nx; }
        const unsigned old = xb_add(&bar[XB_XSUB(b.x)], 1u);
        const unsigned gen = old / nloc;
        if (old + 1u == (gen + 1u) * nloc) {
            __builtin_amdgcn_fence(__ATOMIC_RELEASE, "agent");
            asm volatile("s_waitcnt vmcnt(0)" ::: "memory");
            const unsigned og = xb_add(&bar[XB_TOP], 1u);
            const unsigned tg = og / nx;
            if (og + 1u == (tg + 1u) * nx) xb_add(&bar[XB_TOPGEN], 1u);
            else XB_SPIN(xb_ld(&bar[XB_TOPGEN]) == tg, bar);
            xb_add(&bar[XB_XGEN(b.x)], 1u);
            asm volatile("s_waitcnt vmcnt(0)" ::: "memory");
        } else {
            XB_SPIN(xb_ld(&bar[XB_XGEN(b.x)]) == gen, bar);
            asm volatile("s_waitcnt vmcnt(0)" ::: "memory");
        }
    }
    __syncthreads();
}


__device__ __forceinline__ void tr_item(const float* W, int ldw, int scol0, int srow0, bf16* WT, int Kd, int drow0, int dk0, LAS float* scr, int lane) {
#pragma unroll 8
    for (int i = 0; i < 32; ++i) { const int kk = 2 * i + (lane >> 5); scr[kk * 33 + (lane & 31)] = __builtin_nontemporal_load(W + (size_t)(srow0 + kk) * ldw + scol0 + (lane & 31)); }
    LDS_WAIT(); asm volatile("" ::: "memory");
    const int c = lane & 7;
#pragma unroll
    for (int j = 0; j < 4; ++j) { const int n = (lane >> 3) + 8 * j; const LAS float* s = scr + (8 * c) * 33 + n;
        u32x4 o; o.x = pk2(s[0 * 33], s[1 * 33]); o.y = pk2(s[2 * 33], s[3 * 33]); o.z = pk2(s[4 * 33], s[5 * 33]); o.w = pk2(s[6 * 33], s[7 * 33]);
        *(u32x4*)(WT + (size_t)(drow0 + n) * Kd + dk0 + 8 * c) = o; }
    LDS_WAIT(); asm volatile("" ::: "memory");
}
__device__ __forceinline__ int src_col_u(int np) {
    if (np < 768) return np;
    if (np >= 1792) { const int tt = (np - 1792) >> 8, w = (np - 1792) & 255; return w < 128 ? 1792 + 128 * tt + w : 2816 + 128 * tt + (w - 128); }
    const int tt = (np - 768) >> 8, w = (np - 768) & 255;
    return w < 128 ? 768 + 128 * tt + w : 1280 + 128 * tt + (w - 128);
}

__device__ __forceinline__ void p0_prologue(const Args& a, LAS unsigned char* lds, int gw, int NGW, int lane, int wave) {
    unsigned char* ws = a.ws;
    LAS float* scr = (LAS float*)(lds + wave * 16384);
    constexpr int J1 = 16 * 120, J2 = 8 * 32, J3 = 8 * 32, J4 = 16 * 32;
    constexpr int NITEMS = J1 + J2 + J3 + J4;
    for (int it = gw; it < NITEMS; it += NGW) {
        int r = it;
        if (r < J1) { const int kb = r / 120, nb = r % 120; tr_item(a.in[I_WIN], INW, src_col_u(32 * nb), 64 * kb, (bf16*)(ws + WS_WIN), 1024, 32 * nb, 64 * kb, scr, lane); continue; } r -= J1;
        if (r < J2) { const int kb = r / 32, nb = r % 32; tr_item(a.in[I_WATT], D, 32 * nb, 64 * kb, (bf16*)(ws + WS_WAB), 1024, 32 * nb, 64 * kb, scr, lane); continue; } r -= J2;
        if (r < J3) { const int kb = r / 32, nb = r % 32; tr_item(a.in[I_WCONV], D, 32 * nb, 64 * kb, (bf16*)(ws + WS_WAB), 1024, 32 * nb, 512 + 64 * kb, scr, lane); continue; } r -= J3;
        { const int kb = r / 32, nb = r % 32; tr_item(a.in[I_WO], D, 32 * nb, 64 * kb, (bf16*)(ws + WS_WO), 1024, 32 * nb, 64 * kb, scr, lane); }
    }
    const float* x = a.in[I_X]; bf16* xb = (bf16*)(ws + WS_XB);
    for (int m = gw; m < T; m += NGW) {
        const f32x4* xr = (const f32x4*)(x + (size_t)m * D) + lane; u32x2* o = (u32x2*)(xb + (size_t)m * D) + lane;
#pragma unroll
        for (int j = 0; j < 4; ++j) { const f32x4 v = __builtin_nontemporal_load(xr + 64 * j); u32x2 w; w.x = pk2(v[0], v[1]); w.y = pk2(v[2], v[3]); o[64 * j] = w; }
    }
    { u32x4* abz = (u32x4*)(ws + WS_AB); const u32x4 z4 = (u32x4){0u, 0u, 0u, 0u};
      for (int i = gw * 64 + lane; i < NBATCH * AB_PAD * CCH * 2 / 16; i += NGW * 64) { const int bb = i / (AB_PAD * CCH * 2 / 16), q = i % (AB_PAD * CCH * 2 / 16); abz[(size_t)bb * (AB_SEQ * CCH * 2 / 16) + q] = z4; } }
    float* bperm = (float*)(ws + WS_BPERM);
    for (int i = gw * 64 + lane; i < INW; i += NGW * 64) bperm[i] = a.in[I_BIN][src_col_u(i)];
}

constexpr int KLS = 144, VLS = 528, ATT_V_OFF = 256 * KLS, CONV_W_OFF = 70656;
__device__ __forceinline__ void attn_unit(const Args& a, int unit, LAS unsigned char* lds, int tid, int wave, int lane) {
    const bf16* qb = (const bf16*)(a.ws + WS_QB); const bf16* kb = (const bf16*)(a.ws + WS_KB); const bf16* vT = (const bf16*)(a.ws + WS_VT); bf16* ay = (bf16*)(a.ws + WS_AY);
    const int kvh = unit & 1, blk = (unit >> 1) & 31, b = unit >> 6;
    const int r = lane & 15, qd = lane >> 4, w = wave;
    const int t0 = b * SEQ + blk * 128, seq0 = b * SEQ, lo = w & ~1;
    { u32x4 kreg[4], vreg[4];
#pragma unroll
      for (int i = 0; i < 4; ++i) { const int c = tid + 512 * i;
          int tok = t0 - 128 + (c >> 3); tok = tok < seq0 ? seq0 : tok;
          kreg[i] = ldgo<u32x4>(kb, (unsigned)(tok * KVW + kvh * HD + (c & 7) * 8) * 2u);
          int sk = blk * 128 - 128 + 8 * (c & 31); sk = sk < 0 ? 0 : sk;
          vreg[i] = ldgo<u32x4>(vT, (unsigned)(((b * NKV + kvh) * HD + (c >> 5)) * SEQ + sk) * 2u); }
      __builtin_amdgcn_sched_barrier(0);
      asm volatile("" : "+v"(kreg[0]), "+v"(kreg[1]), "+v"(kreg[2]), "+v"(kreg[3]), "+v"(vreg[0]), "+v"(vreg[1]), "+v"(vreg[2]), "+v"(vreg[3]));
#pragma unroll
      for (int i = 0; i < 4; ++i) { const int c = tid + 512 * i;
          *(LAS u32x4*)(lds + (c >> 3) * KLS + (c & 7) * 16) = kreg[i];
          { const int d = c >> 5, rho = 16 * ((d >> 2) & 3) + 4 * (d >> 4) + (d & 3);
            *(LAS u32x4*)(lds + ATT_V_OFF + rho * VLS + (c & 31) * 16) = vreg[i]; } } }
    __syncthreads();
    const int qi = 16 * w + r;
#pragma unroll 1
    for (int hh = 0; hh < 4; ++hh) {
        const int head = kvh * 4 + hh;
        u32x4 qf[2];
        { const unsigned qo = (unsigned)((t0 + qi) * AW + head * HD + 8 * qd) * 2u; qf[0] = ldgo<u32x4>(qb, qo); qf[1] = ldgo<u32x4>(qb, qo + 64u); }
        const float sinkv = a.in[I_SINK][head];
        int qiv = qi; asm volatile("" : "+v"(qiv));
        const int klo = max(qiv + 1, blk > 0 ? 0 : 128); const int kjb = lo * 16 + 4 * qd - klo; const unsigned span = (unsigned)(qiv + 128 - klo);
        f32x4 s[10];
#pragma unroll
        for (int i = 0; i < 10; ++i) {
            const LAS unsigned char* kp = lds + ((lo + i) * 16 + r) * KLS + qd * 16;
            const u32x4 k0 = *(const LAS u32x4*)kp, k1 = *(const LAS u32x4*)(kp + 64);
            f32x4 z = (f32x4){0.f, 0.f, 0.f, 0.f};
            z = __builtin_amdgcn_mfma_f32_16x16x32_bf16(__builtin_bit_cast(bf16x8, k0), __builtin_bit_cast(bf16x8, qf[0]), z, 0, 0, 0);
            s[i] = __builtin_amdgcn_mfma_f32_16x16x32_bf16(__builtin_bit_cast(bf16x8, k1), __builtin_bit_cast(bf16x8, qf[1]), z, 0, 0, 0);
        }
        float mx = sinkv;
#pragma unroll
        for (int i = 0; i < 10; ++i)
#pragma unroll
            for (int g = 0; g < 4; ++g) { const bool valid = (unsigned)(kjb + (16 * i + g)) <= span; s[i][g] = valid ? s[i][g] : -1e30f; mx = fmaxf(mx, s[i][g]); }
        mx = fmaxf(mx, __shfl_xor(mx, 16)); mx = fmaxf(mx, __shfl_xor(mx, 32));
        float sum = 0.f;
#pragma unroll
        for (int i = 0; i < 10; ++i)
#pragma unroll
            for (int g = 0; g < 4; ++g) { const float p = (s[i][g] > -1e29f) ? __expf(s[i][g] - mx) : 0.f; s[i][g] = p; sum += p; }
        sum += __shfl_xor(sum, 16); sum += __shfl_xor(sum, 32);
        const float inv = 1.0f / (sum + __expf(sinkv - mx));
        f32x4 o[4];
#pragma unroll
        for (int mt = 0; mt < 4; ++mt) o[mt] = (f32x4){0.f, 0.f, 0.f, 0.f};
#pragma unroll
        for (int ip = 0; ip < 5; ++ip) {
            u32x4 pw; pw.x = cvt_pk_bf16(s[2 * ip][0], s[2 * ip][1]); pw.y = cvt_pk_bf16(s[2 * ip][2], s[2 * ip][3]); pw.z = cvt_pk_bf16(s[2 * ip + 1][0], s[2 * ip + 1][1]); pw.w = cvt_pk_bf16(s[2 * ip + 1][2], s[2 * ip + 1][3]);
            const bf16x8 pb = __builtin_bit_cast(bf16x8, pw);
#pragma unroll
            for (int mt = 0; mt < 4; ++mt) { const LAS unsigned char* vp = lds + ATT_V_OFF + (16 * mt + r) * VLS + ((lo + 2 * ip) * 16 + 4 * qd) * 2;
                const u32x2 va = *(const LAS u32x2*)vp, vb = *(const LAS u32x2*)(vp + 32);
                u32x4 vw; vw.x = va.x; vw.y = va.y; vw.z = vb.x; vw.w = vb.y;
                o[mt] = __builtin_amdgcn_mfma_f32_16x16x32_bf16(__builtin_bit_cast(bf16x8, vw), pb, o[mt], 0, 0, 0); }
        }
        const unsigned oo = (unsigned)((t0 + qi) * D + head * HD + 16 * qd) * 2u;
        pg8::stgw(ay, oo, pg8::pack8(o[0] * inv, o[1] * inv)); pg8::stgw(ay, oo + 16u, pg8::pack8(o[2] * inv, o[3] * inv));
    }
    pg8::tile_signal((unsigned*)(a.ws + WS_CTL) + CW_T2, t0 >> 8);
    __syncthreads();
}

constexpr int CBS = 516;
__device__ __forceinline__ void conv_unit(const Args& a, int unit, LAS unsigned char* lds, int tid, int wave, int lane) {
    const bf16* ab = (const bf16*)(a.ws + WS_AB); bf16* ay = (bf16*)(a.ws + WS_AY);
    LAS float* cb = (LAS float*)lds;
    const int t0 = unit * 32, prow0 = t0 + AB_PAD * ((t0 >> 12) + 1);
    int cp = tid & 255; asm volatile("" : "+v"(cp));
    const int half = wave >> 2;
    const LAS float* wl = (const LAS float*)(lds + CONV_W_OFF) + 2 * cp;
    const f32x2 cbias = *(const f32x2*)(a.in[I_CONVB] + 2 * cp);
#pragma unroll 1
    for (int it = 0; it < 2; ++it) {
        const int tl0 = 16 * half + 8 * it;
        const unsigned o0 = (unsigned)((prow0 + tl0 - 30) * CCH + 2 * cp) * 2u;
        unsigned raw[38];
#pragma unroll
        for (int rr = 0; rr < 38; ++rr) raw[rr] = ldgo<unsigned>(ab, o0 + (unsigned)(rr * CCH * 2));
        __builtin_amdgcn_sched_barrier(0);
        asm volatile("" : "+v"(raw[0]), "+v"(raw[1]), "+v"(raw[2]), "+v"(raw[3]), "+v"(raw[4]), "+v"(raw[5]), "+v"(raw[6]), "+v"(raw[7]), "+v"(raw[8]), "+v"(raw[9]),
                          "+v"(raw[10]), "+v"(raw[11]), "+v"(raw[12]), "+v"(raw[13]), "+v"(raw[14]), "+v"(raw[15]), "+v"(raw[16]), "+v"(raw[17]), "+v"(raw[18]));
        asm volatile("" : "+v"(raw[19]), "+v"(raw[20]), "+v"(raw[21]), "+v"(raw[22]), "+v"(raw[23]), "+v"(raw[24]), "+v"(raw[25]), "+v"(raw[26]), "+v"(raw[27]), "+v"(raw[28]),
                          "+v"(raw[29]), "+v"(raw[30]), "+v"(raw[31]), "+v"(raw[32]), "+v"(raw[33]), "+v"(raw[34]), "+v"(raw[35]), "+v"(raw[36]), "+v"(raw[37]));
        float i0[38], i1[38];
#pragma unroll
        for (int rr = 0; rr < 38; ++rr) { i0[rr] = bflo(raw[rr]); i1[rr] = bfhi(raw[rr]); }
        float a0[8], a1[8];
#pragma unroll
        for (int o = 0; o < 8; ++o) { a0[o] = cbias.x; a1[o] = cbias.y; }
#pragma unroll
        for (int j = 0; j < CW; ++j) { const f32x2 wv = *(const LAS f32x2*)(wl + j * CCH);
#pragma unroll
            for (int o = 0; o < 8; ++o) { a0[o] = fmaf(i0[o + j], wv.x, a0[o]); a1[o] = fmaf(i1[o + j], wv.y, a1[o]); } }
#pragma unroll
        for (int o = 0; o < 8; ++o) *(LAS f32x2*)(cb + (tl0 + o) * CBS + 2 * cp) = (f32x2){a0[o], a1[o]};
    }
    __syncthreads();
    const f32x4 g0 = *(const f32x4*)(a.in[I_CLNG] + 8 * lane), g1 = *(const f32x4*)(a.in[I_CLNG] + 8 * lane + 4), b0 = *(const f32x4*)(a.in[I_CLNB] + 8 * lane), b1 = *(const f32x4*)(a.in[I_CLNB] + 8 * lane + 4);
#pragma unroll
    for (int tt = 0; tt < 4; ++tt) { const int tok = 4 * wave + tt;
        f32x4 v0 = *(const LAS f32x4*)(cb + tok * CBS + 8 * lane), v1 = *(const LAS f32x4*)(cb + tok * CBS + 8 * lane + 4);
        const float mean = wave_sum((v0[0] + v0[1]) + (v0[2] + v0[3]) + (v1[0] + v1[1]) + (v1[2] + v1[3])) * (1.0f / CCH);
        v0 = v0 - mean; v1 = v1 - mean;
        const float var = wave_sum((v0[0] * v0[0] + v0[1] * v0[1]) + (v0[2] * v0[2] + v0[3] * v0[3]) + (v1[0] * v1[0] + v1[1] * v1[1]) + (v1[2] * v1[2] + v1[3] * v1[3])) * (1.0f / CCH);
        const float rstd = 1.0f / sqrtf(var + LN_EPS);
        float y[8];
#pragma unroll
        for (int j = 0; j < 4; ++j) { const float y0 = v0[j] * rstd * g0[j] + b0[j], y1 = v1[j] * rstd * g1[j] + b1[j]; y[j] = y0 * sigmoidf_(y0); y[4 + j] = y1 * sigmoidf_(y1); }
        u32x4 wv; wv.x = cvt_pk_bf16(y[0], y[1]); wv.y = cvt_pk_bf16(y[2], y[3]); wv.z = cvt_pk_bf16(y[4], y[5]); wv.w = cvt_pk_bf16(y[6], y[7]);
        pg8::stgw(ay, (unsigned)((t0 + tok) * D + 512 + 8 * lane) * 2u, wv); }
    pg8::tile_signal((unsigned*)(a.ws + WS_CTL) + CW_T2, t0 >> 8);
    __syncthreads();
}

constexpr int HLS = 1025;
__device__ __forceinline__ void route_chunk(const Args& a, int chunk, LAS unsigned char* lds, int tid, int wave, int lane, const float (&bw)[64], const f32x4 (&g)[4], const f32x4 (&bb)[4]) {
    const bf16* hf = (const bf16*)(a.ws + WS_HF); unsigned char* hb = a.ws + WS_HB;
    int* slot = (int*)(a.ws + WS_SLOT); float* gatev = (float*)(a.ws + WS_GATE); unsigned* cursor = (unsigned*)(a.ws + WS_CTL);
    LAS float* hl = (LAS float*)lds;
    LAS float* lg = (LAS float*)(lds + MISC_OFF + MO_LG); LAS int* sel_e = (LAS int*)(lds + MISC_OFF + MO_SELE); LAS float* sel_g = (LAS float*)(lds + MISC_OFF + MO_SELG);
    LAS int* lcnt = (LAS int*)(lds + MISC_OFF + MO_LCNT); LAS int* lbase = (LAS int*)(lds + MISC_OFF + MO_LBASE);
    const int t0 = chunk * 32;
    f32x4 v[4][4];
    { u32x2 rw[4][4];
#pragma unroll
      for (int tt = 0; tt < 4; ++tt)
#pragma unroll
        for (int j = 0; j < 4; ++j) rw[tt][j] = *((const u32x2*)(hf + (size_t)(t0 + 4 * wave + tt) * D) + lane + 64 * j);
      __builtin_amdgcn_sched_barrier(0);
      asm volatile("" : "+v"(rw[0][0]), "+v"(rw[0][1]), "+v"(rw[0][2]), "+v"(rw[0][3]), "+v"(rw[1][0]), "+v"(rw[1][1]), "+v"(rw[1][2]), "+v"(rw[1][3]),
                        "+v"(rw[2][0]), "+v"(rw[2][1]), "+v"(rw[2][2]), "+v"(rw[2][3]), "+v"(rw[3][0]), "+v"(rw[3][1]), "+v"(rw[3][2]), "+v"(rw[3][3]));
#pragma unroll
      for (int tt = 0; tt < 4; ++tt)
#pragma unroll
        for (int j = 0; j < 4; ++j) v[tt][j] = (f32x4){bflo(rw[tt][j].x), bfhi(rw[tt][j].x), bflo(rw[tt][j].y), bfhi(rw[tt][j].y)}; }
#pragma unroll
    for (int tt = 0; tt < 4; ++tt) { const int tl = 4 * wave + tt;
        float sm = 0.f;
#pragma unroll
        for (int j = 0; j < 4; ++j) sm += (v[tt][j][0] + v[tt][j][1]) + (v[tt][j][2] + v[tt][j][3]);
        const float mean = wave_sum(sm) * (1.0f / D); float s2 = 0.f;
#pragma unroll
        for (int j = 0; j < 4; ++j) { v[tt][j] = v[tt][j] - mean; s2 += (v[tt][j][0] * v[tt][j][0] + v[tt][j][1] * v[tt][j][1]) + (v[tt][j][2] * v[tt][j][2] + v[tt][j][3] * v[tt][j][3]); }
        const float rstd = 1.0f / sqrtf(wave_sum(s2) * (1.0f / D) + LN_EPS);
        if (lane == 0) *(f32x2*)((float*)(a.ws + WS_LN1S) + 2 * (size_t)(t0 + tl)) = (f32x2){mean, rstd};
#pragma unroll
        for (int j = 0; j < 4; ++j) { const f32x4 h = v[tt][j] * rstd * g[j] + bb[j];
            unsigned wv = 0u; wv = __builtin_amdgcn_cvt_pk_fp8_f32(h[0] * 8.0f, h[1] * 8.0f, wv, false); wv = __builtin_amdgcn_cvt_pk_fp8_f32(h[2] * 8.0f, h[3] * 8.0f, wv, true); *((unsigned*)(hb + (size_t)(t0 + tl) * D) + lane + 64 * j) = wv;
            LAS float* hp = hl + tl * HLS + 4 * lane + 256 * j; hp[0] = h[0]; hp[1] = h[1]; hp[2] = h[2]; hp[3] = h[3]; }
    }
    if (tid < 32) lcnt[tid] = 0;
    __syncthreads();
    f32x16 acc;
#pragma unroll
    for (int i = 0; i < 16; ++i) acc[i] = 0.f;
    { const int tok = lane & 31, kp = lane >> 5; const LAS float* hp = hl + tok * HLS + 128 * wave + kp;
#pragma unroll
      for (int s = 0; s < 64; ++s) acc = __builtin_amdgcn_mfma_f32_32x32x2f32(hp[2 * s], bw[s], acc, 0, 0, 0); }
    __syncthreads();
    { LAS float* part = hl + wave * 1024;
#pragma unroll
      for (int i = 0; i < 16; ++i) { const int rowi = (i & 3) + 8 * (i >> 2) + 4 * (lane >> 5); part[rowi * 32 + (lane & 31)] = acc[i]; } }
    __syncthreads();
    for (int o = tid; o < 1024; o += 512) { float sm = a.in[I_BR][o & 31];
#pragma unroll
        for (int w = 0; w < 8; ++w) sm += hl[w * 1024 + o];
        lg[(o >> 5) * 33 + (o & 31)] = sm; }
    __syncthreads();
    if (tid < 32) { float v[NE];
#pragma unroll
        for (int e = 0; e < NE; ++e) v[e] = lg[tid * 33 + e];
        float tv[4]; int ti[4];
#pragma unroll
        for (int k = 0; k < 4; ++k) { float best = -3.0e38f; int bi = 0;
#pragma unroll
            for (int e = 0; e < NE; ++e) { const bool take = v[e] > best; best = take ? v[e] : best; bi = take ? e : bi; }
            tv[k] = best; ti[k] = bi;
#pragma unroll
            for (int e = 0; e < NE; ++e) v[e] = (e == bi) ? -3.0e38f : v[e]; }
        const float e1 = __expf(tv[1] - tv[0]), e2 = __expf(tv[2] - tv[0]), e3 = __expf(tv[3] - tv[0]); const float inv = 1.0f / (1.0f + e1 + e2 + e3);
        sel_e[4 * tid + 0] = ti[0]; sel_e[4 * tid + 1] = ti[1]; sel_e[4 * tid + 2] = ti[2]; sel_e[4 * tid + 3] = ti[3];
        sel_g[4 * tid + 0] = inv; sel_g[4 * tid + 1] = e1 * inv; sel_g[4 * tid + 2] = e2 * inv; sel_g[4 * tid + 3] = e3 * inv; }
    __syncthreads();
    int my_e = 0, my_rank = 0;
    if (tid < 128) { my_e = sel_e[tid]; my_rank = atomicAdd((int*)&lcnt[my_e], 1); }
    __syncthreads();
    if (tid < 32) { const int c = lcnt[tid]; lbase[tid] = c > 0 ? (int)atomicAdd(cursor + tid, (unsigned)c) : 0; }
    __syncthreads();
    if (tid < 128) { const int asg = (t0 + (tid >> 2)) * 4 + (tid & 3); slot[my_e * SLOT_CAP + lbase[my_e] + my_rank] = asg; gatev[asg] = sel_g[tid]; }
    __syncthreads();
}

__device__ __forceinline__ void combine_row(const Args& a, int m, int lane) {
    const bf16* hf = (const bf16*)(a.ws + WS_HF); const unsigned char* ys = a.ws + WS_YS; const float* gatev = (const float*)(a.ws + WS_GATE);
    f32x4 gt = *(const f32x4*)(gatev + 4 * (size_t)m); gt = gt * (1.0f / 16.0f);
    const f32x2 st = *(const f32x2*)((const float*)(a.ws + WS_LN1S) + 2 * (size_t)m);
    f32x4 v[4]; float sm = 0.f;
#pragma unroll
    for (int j = 0; j < 4; ++j) { const f32x4 g1 = *((const f32x4*)a.in[I_LN1G] + lane + 64 * j), b1 = *((const f32x4*)a.in[I_LN1B] + lane + 64 * j);
        const u32x2 pw = *((const u32x2*)(hf + (size_t)m * D) + lane + 64 * j); f32x4 p = (f32x4){bflo(pw.x), bfhi(pw.x), bflo(pw.y), bfhi(pw.y)}; p = p - st.x; const f32x4 h = p * st.y * g1 + b1;
        v[j] = h * DN_ALPHA;
#pragma unroll
        for (int k = 0; k < 4; ++k) { const unsigned y = *((const unsigned*)(ys + ((size_t)m * 4 + k) * D) + lane + 64 * j); const float gk = gt[k];
            const f32x2 lo = __builtin_amdgcn_cvt_pk_f32_fp8(y, false), hi = __builtin_amdgcn_cvt_pk_f32_fp8(y, true);
            v[j][0] += gk * lo.x; v[j][1] += gk * lo.y; v[j][2] += gk * hi.x; v[j][3] += gk * hi.y; }
        sm += (v[j][0] + v[j][1]) + (v[j][2] + v[j][3]); }
    const float mean = wave_sum(sm) * (1.0f / D); float s2 = 0.f;
#pragma unroll
    for (int j = 0; j < 4; ++j) { v[j] = v[j] - mean; s2 += (v[j][0] * v[j][0] + v[j][1] * v[j][1]) + (v[j][2] * v[j][2] + v[j][3] * v[j][3]); }
    const float rstd = 1.0f / sqrtf(wave_sum(s2) * (1.0f / D) + LN_EPS);
#pragma unroll
    for (int j = 0; j < 4; ++j) { const f32x4 g = *((const f32x4*)a.in[I_LN2G] + lane + 64 * j), bb = *((const f32x4*)a.in[I_LN2B] + lane + 64 * j);
        *((f32x4*)(a.out + (size_t)m * D) + lane + 64 * j) = v[j] * rstd * g + bb; }
}

__global__ void __launch_bounds__(512, 2) fwd_megakernel(Args args) {
    extern __shared__ __attribute__((aligned(16))) unsigned char lds_raw[];
    LAS unsigned char* lds = (LAS unsigned char*)lds_raw;
    const int tid = threadIdx.x, wave = __builtin_amdgcn_readfirstlane(tid >> 6);
#define FRESH_LANE int lane; { int t_ = tid; asm volatile("" : "+v"(t_)); lane = t_ & 63; }
    const int G = gridDim.x, bx = blockIdx.x;
    const int vcu = (G % 8 == 0) ? (bx % 8) * (G / 8) + bx / 8 : bx;
    const int gw = vcu * 8 + wave, NGW = G * 8;
    const int lo = args.ph_lo, hi = args.ph_hi;
    unsigned char* ws = args.ws;
    volatile LAS unsigned* bst = (volatile LAS unsigned*)(lds + MISC_OFF + MO_BAR);
    if (tid < 2) bst[tid] = 0u;
    __syncthreads();
    XcdBarrier xbar = xcd_barrier_post((unsigned*)(ws + WS_CTL) + CW_BAR, bst);
#ifndef PMASK
#define PMASK 0x1ff
#endif
#define IN(k) (((PMASK >> (k)) & 1) && lo <= (k) && (k) < hi)
#define SEAM(k) do { if (lo <= (k) && (k) + 1 < hi) xcd_barrier(xbar); } while (0)

    if (IN(0)) { FRESH_LANE; p0_prologue(args, lds, gw, NGW, lane, wave); }
    SEAM(0);
    if (IN(1)) {
        pg8::DenseOrder S; S.init(ws + WS_XB, ws + WS_WIN, T, INW, G, bx);
        pg8::EpiU E{(bf16*)(ws + WS_QB), (bf16*)(ws + WS_KB), (bf16*)(ws + WS_VT), (bf16*)(ws + WS_AB), (bf16*)(ws + WS_GATES), (const float*)(ws + WS_BPERM)};
        const int slot = vcu & 3;
        S.i0 = 0; S.i1 = slot;
        pg8::gemm_phase<pg8::EpiU, pg8::DenseOrder>(lds, S, E);
        { FRESH_LANE; side_convert_dma(args, bx, G, wave, lane, lds); }
        __syncthreads();
        S.i0 = slot; S.i1 = 1 << 20;
        pg8::gemm_phase<pg8::EpiU, pg8::DenseOrder>(lds, S, E);
    }
    SEAM(1);
    if (IN(2)) {
        FRESH_LANE;
        __syncthreads();
        for (int i = tid; i < CW * CCH / 4; i += 512) ((LAS f32x4*)(lds + CONV_W_OFF))[i] = ((const f32x4*)args.in[I_CONVW])[i];
        __syncthreads();
        for (int u = vcu; u < 256 + 512; u += G) {
            if (u < 256) attn_unit(args, u, lds, tid, wave, lane);
            else conv_unit(args, u - 256, lds, tid, wave, lane);
        }
    }
    if (IN(3)) {
        pg8::DenseOrder S; S.init(ws + WS_AY, ws + WS_WAB, T, D, G, bx);
        pg8::EpiMerged E{(const bf16*)(ws + WS_GATES), args.in[I_BCONV], (bf16*)(ws + WS_MERGED), (unsigned*)(ws + WS_CTL) + CW_T3};
        if (lo <= 2) { __syncthreads();
            if (tid == 0) { pg8::Unit u0; for (int i = 0; S.next(i, u0); ++i) pg8::tile_wait((const unsigned*)(ws + WS_CTL) + CW_T2, u0.pm, 96u, (unsigned*)(ws + WS_CTL) + 64); }
            __syncthreads(); }
        pg8::gemm_phase<pg8::EpiMerged, pg8::DenseOrder>(lds, S, E);
    }
    if (IN(4)) {
        pg8::DenseOrder S; S.init(ws + WS_MERGED, ws + WS_WO, T, D, G, bx);
        pg8::EpiPre1 E{(const bf16*)(ws + WS_XB), (bf16*)(ws + WS_HF), (unsigned*)(ws + WS_CTL) + CW_T4};
        if (lo <= 3) { __syncthreads();
            if (tid == 0) { pg8::Unit u0; for (int i = 0; S.next(i, u0); ++i) pg8::tile_wait((const unsigned*)(ws + WS_CTL) + CW_T3, u0.pm, 32u, (unsigned*)(ws + WS_CTL) + 64); }
            __syncthreads(); }
        pg8::gemm_phase<pg8::EpiPre1, pg8::DenseOrder>(lds, S, E);
    }
    if (IN(5)) {
        FRESH_LANE;
        __syncthreads();
        if (lo <= 4) { if (tid == 0) { for (int c = vcu; c < T / 32; c += G) pg8::tile_wait((const unsigned*)(ws + WS_CTL) + CW_T4, c >> 3, 32u, (unsigned*)(ws + WS_CTL) + 64); }
            __syncthreads(); }
        float bw[64]; f32x4 g1[4], b1[4];
#pragma unroll
        for (int s_ = 0; s_ < 64; ++s_) bw[s_] = args.in[I_WR][(size_t)(128 * wave + 2 * s_ + (lane >> 5)) * NE + (lane & 31)];
#pragma unroll
        for (int j = 0; j < 4; ++j) { g1[j] = *((const f32x4*)args.in[I_LN1G] + lane + 64 * j); b1[j] = *((const f32x4*)args.in[I_LN1B] + lane + 64 * j); }
        for (int c = vcu; c < T / 32; c += G) route_chunk(args, c, lds, tid, wave, lane, bw, g1, b1);
    }
    SEAM(5);
    if (IN(6) || IN(7)) {
        LAS int* tab = (LAS int*)(lds + MISC_OFF + MO_TAB);
        __syncthreads();
        if (tid == 0) { const unsigned* cursor = (const unsigned*)(ws + WS_CTL); int acc = 0;
            for (int e = 0; e < NE; ++e) { const int c = (int)__hip_atomic_load(cursor + e, __ATOMIC_RELAXED, __HIP_MEMORY_SCOPE_AGENT); tab[e] = c; const int ml = (c + 255) >> 8; tab[32 + e] = ml; tab[64 + e] = acc; acc += ml; }
            tab[64 + NE] = acc; }
        __syncthreads();
        const int total_mt = tab[64 + NE];
        if (IN(6)) {
            unsigned* ctl = (unsigned*)(ws + WS_CTL);
            pg8::MoeFusedOrder S{tab, G, vcu, total_mt * 8, total_mt * 4, (const char*)(ws + WS_HB), (const char*)(ws + WS_ACT), (const char*)(ws + WS_WUP), (const char*)(ws + WS_WDN), (const int*)(ws + WS_SLOT), ctl + 8192, ctl + 64};
            pg8::EpiMoe E{pg8::EpiUpX{args.in[I_BUP], ws + WS_ACT}, pg8::EpiDown{args.in[I_BDN], (const int*)(ws + WS_SLOT), ws + WS_YS}};
            pg8::gemm_phase<pg8::EpiMoe, pg8::MoeFusedOrder, true>(lds, S, E);
        }
    }
    SEAM(7);
    if (IN(8)) { FRESH_LANE; for (int m = gw; m < T; m += NGW) combine_row(args, m, lane); }

#undef IN
#undef SEAM
#undef FRESH_LANE
}

extern "C" void kernel_launch(void* const* d_in, const int* in_sizes, int n_in, void* d_out, int out_size, void* d_ws, size_t ws_size, hipStream_t stream) {
    static int grid = 0;
    if (grid == 0) {
        if (n_in != 22 || out_size != T * D || ws_size < WS_END) { fprintf(stderr, "kernel_launch: unexpected problem (n_in %d, out %d, ws %zu)\n", n_in, out_size, ws_size); grid = -1; return; }
        int dev = 0, cus = 0, per_cu = 0;
        hipGetDevice(&dev); hipDeviceGetAttribute(&cus, hipDeviceAttributeMultiprocessorCount, dev);
        hipFuncSetAttribute((const void*)fwd_megakernel, hipFuncAttributeMaxDynamicSharedMemorySize, LDS_BYTES);
        hipOccupancyMaxActiveBlocksPerMultiprocessor(&per_cu, (const void*)fwd_megakernel, 512, LDS_BYTES);
        if (per_cu < 1) { fprintf(stderr, "kernel_launch: occupancy query says %d blocks per CU\n", per_cu); per_cu = 1; }
        (void)hipGetLastError();
        grid = cus * 1;
        fprintf(stderr, "kernel_launch: grid %d (cus %d, occupancy %d)\n", grid, cus, per_cu);
    }
    if (grid < 0) return;
    hipMemsetAsync((char*)d_ws + WS_CTL, 0, 65536, stream);
    Args a{};
    for (int i = 0; i < 22; ++i) a.in[i] = (const float*)d_in[i];
    a.out = (float*)d_out; a.ws = (unsigned char*)d_ws; a.ph_lo = 0; a.ph_hi = 9;
    void* kargs[] = {&a};
    hipError_t e = hipLaunchCooperativeKernel((const void*)fwd_megakernel, dim3(grid), dim3(512), kargs, LDS_BYTES, stream);
    if (e != hipSuccess) fprintf(stderr, "cooperative launch failed: %s (grid %d)\n", hipGetErrorString(e), grid);
}
```

```cpp
#include <hip/hip_runtime.h>
#include <cstdio>
#include <cstdint>

#define GAS __attribute__((address_space(1)))
#define LAS __attribute__((address_space(3)))
typedef unsigned short bf16;
typedef short bf16x8 __attribute__((ext_vector_type(8)));
typedef float f32x4 __attribute__((ext_vector_type(4)));
typedef float f32x2 __attribute__((ext_vector_type(2)));
typedef float f32x16 __attribute__((ext_vector_type(16)));
typedef unsigned u32x4 __attribute__((ext_vector_type(4)));
typedef unsigned u32x2 __attribute__((ext_vector_type(2)));

constexpr int T = 16384, D = 1024, SEQ = 4096, NBATCH = 4;
constexpr int NH = 8, NKV = 2, HD = 64, AW = 512, KVW = 128, CCH = 512, CW = 31;
constexpr int INW = 3840, NE = 32, TOPK = 4, DE = 1024;
constexpr float LN_EPS = 1e-5f;
constexpr float DN_ALPHA = 1.189207115002721f;
constexpr int SLOT_CAP = 16384;
constexpr int MAX_MT = (T * TOPK) / 256 + NE;

constexpr size_t MiB = 1u << 20;
constexpr size_t WS_CTL = 0, CTL_BYTES = 65536;
constexpr int CW_BAR = 4096, CW_T3 = 13312, CW_T4 = 14336, CW_T2 = 15360, CW_T1 = 1024;
constexpr size_t WS_WIN = 1 * MiB;
constexpr size_t WS_WAB = 9 * MiB;
constexpr size_t WS_WO = 11 * MiB;
constexpr size_t WS_BPERM = 13 * MiB;
constexpr size_t WS_SLOT = 14 * MiB;
constexpr size_t WS_GATE = 16 * MiB;
constexpr size_t WS_LN1S = 17 * MiB;
constexpr size_t WS_WUP = 32 * MiB;
constexpr size_t WS_WDN = 160 * MiB;
constexpr size_t WS_XB = 224 * MiB;
constexpr size_t WS_QB = 256 * MiB;
constexpr size_t WS_KB = 272 * MiB;
constexpr size_t WS_VT = 276 * MiB;
constexpr size_t WS_AB = 792 * MiB;
constexpr size_t WS_GATES = 296 * MiB;
constexpr size_t WS_AY = 360 * MiB;
constexpr size_t WS_MERGED = 392 * MiB;
constexpr size_t WS_HF = 424 * MiB;
constexpr size_t WS_HB = 488 * MiB;
constexpr size_t WS_ACT = 520 * MiB;
constexpr size_t WS_YS = 664 * MiB;
constexpr size_t WS_END = 810 * MiB;
constexpr int AB_PAD = 32, AB_SEQ = SEQ + AB_PAD;

constexpr int LDS_SCR = 135168;
constexpr int MISC_OFF = 135168;
constexpr int MO_LG = 0, MO_SELE = 4224, MO_SELG = 4736, MO_LCNT = 5248, MO_LBASE = 5376, MO_TAB = 5504, MO_BAR = 6016, MO_RDY = 6080;
constexpr int OFFN_OFF = 147456;
constexpr int LDS_BYTES = 155648;

#define LDS_WAIT() asm volatile("s_waitcnt lgkmcnt(0)" ::: "memory")
#define VM_WAIT() asm volatile("s_waitcnt vmcnt(0)" ::: "memory")

__device__ __forceinline__ unsigned f2bf(float f) { unsigned u = __builtin_bit_cast(unsigned, f); return (u + 0x7fffu + ((u >> 16) & 1u)) >> 16; }
__device__ __forceinline__ unsigned pk2(float lo, float hi) { return f2bf(lo) | (f2bf(hi) << 16); }
__device__ __forceinline__ float bf2f(unsigned b) { return __builtin_bit_cast(float, b << 16); }
__device__ __forceinline__ float bflo(unsigned w) { return __builtin_bit_cast(float, w << 16); }
__device__ __forceinline__ float bfhi(unsigned w) { return __builtin_bit_cast(float, w & 0xffff0000u); }
typedef __bf16 bf16x2_t __attribute__((ext_vector_type(2)));
__device__ __forceinline__ unsigned cvt_pk_bf16(float lo, float hi) { const f32x2 v = {lo, hi}; return __builtin_bit_cast(unsigned, __builtin_convertvector(v, bf16x2_t)); }
__device__ __forceinline__ float sigmoidf_(float x) { return __builtin_amdgcn_rcpf(1.0f + __expf(-x)); }
#define DPP_ADD(v, ctrl) ((v) + __builtin_bit_cast(float, __builtin_amdgcn_update_dpp(0, __builtin_bit_cast(int, (v)), (ctrl), 0xf, 0xf, true)))
__device__ __forceinline__ float wave_sum(float v) {
    v = DPP_ADD(v, 0xB1);
    v = DPP_ADD(v, 0x4E);
    v = DPP_ADD(v, 0x141);
    v = DPP_ADD(v, 0x140);
    const int vi = __builtin_bit_cast(int, v);
    const float r0 = __builtin_bit_cast(float, __builtin_amdgcn_readlane(vi, 0)), r1 = __builtin_bit_cast(float, __builtin_amdgcn_readlane(vi, 16));
    const float r2 = __builtin_bit_cast(float, __builtin_amdgcn_readlane(vi, 32)), r3 = __builtin_bit_cast(float, __builtin_amdgcn_readlane(vi, 48));
    return (r0 + r1) + (r2 + r3);
}
template <class V> __device__ __forceinline__ V ldgo(const void* base, unsigned off) { return *(const V*)((const char*)base + off); }
#define PIN10(a) asm volatile("" : "+v"((a)[0]), "+v"((a)[1]), "+v"((a)[2]), "+v"((a)[3]), "+v"((a)[4]), "+v"((a)[5]), "+v"((a)[6]), "+v"((a)[7]), "+v"((a)[8]), "+v"((a)[9]))

struct Args { const float* in[22]; float* out; unsigned char* ws; int ph_lo, ph_hi; };
enum { I_X = 0, I_WIN, I_BIN, I_SINK, I_WATT, I_CONVW, I_CONVB, I_CLNG, I_CLNB, I_WCONV, I_BCONV, I_WO, I_LN1G, I_LN1B, I_WR, I_BR, I_WUP, I_BUP, I_WDN, I_BDN, I_LN2G, I_LN2B };
constexpr int CVI_UP = NE * 64, CVI_DN = NE * 32, CVI_ITEMS = CVI_UP + CVI_DN;
__device__ __forceinline__ void cvi_decode(const Args& a, int it, const float*& src, unsigned char*& dst, int& nw) {
    if (it < CVI_UP) { const int e = it >> 6, kg = it & 63; nw = 2048; src = a.in[I_WUP] + ((size_t)e * 1024 + 16 * kg) * 2048; dst = a.ws + WS_WUP + (size_t)e * 2048 * 1024 + (size_t)kg * 2048 * 16; }
    else { const int r = it - CVI_UP, e = r >> 5, kg2 = r & 31; nw = 1024; src = a.in[I_WDN] + ((size_t)e * 1024 + 32 * kg2) * 1024; dst = a.ws + WS_WDN + (size_t)e * 1024 * 1024 + (size_t)kg2 * 2 * 1024 * 16; }
}
__device__ __forceinline__ void cvi_slice_ptrs(const Args& a, int it, int wave, int lane, const float*& sp, unsigned& pitch, unsigned char*& dp) {
    const float* src; unsigned char* dst; int nw; cvi_decode(a, it, src, dst, nw);
    const int g = nw == 2048 ? 0 : (wave >> 2), cw = nw == 2048 ? wave : (wave & 3);
    sp = src + (size_t)(16 * g) * nw + 256 * cw + 4 * lane; pitch = (unsigned)nw;
    dp = dst + ((size_t)g * nw + 256 * cw + 4 * lane) * 16;
}
__device__ __forceinline__ void cvi_slice_load(const float* sp, unsigned pitch, f32x4 (&r)[16]) {
#pragma unroll
    for (int kk = 0; kk < 16; ++kk) r[kk] = __builtin_nontemporal_load((const f32x4*)(sp + (size_t)kk * pitch));
}
__device__ __forceinline__ void cvi_slice_out(unsigned char* dp, f32x4 (&r)[16]) {
    asm volatile("" : "+v"(r[0]), "+v"(r[1]), "+v"(r[2]), "+v"(r[3]), "+v"(r[4]), "+v"(r[5]), "+v"(r[6]), "+v"(r[7]), "+v"(r[8]), "+v"(r[9]), "+v"(r[10]), "+v"(r[11]), "+v"(r[12]), "+v"(r[13]), "+v"(r[14]), "+v"(r[15]));
#pragma unroll
    for (int j = 0; j < 4; ++j) { unsigned w[4];
#pragma unroll
        for (int c = 0; c < 4; ++c) { unsigned x = 0u; x = __builtin_amdgcn_cvt_pk_fp8_f32(r[4 * c][j] * 64.0f, r[4 * c + 1][j] * 64.0f, x, false);
            x = __builtin_amdgcn_cvt_pk_fp8_f32(r[4 * c + 2][j] * 64.0f, r[4 * c + 3][j] * 64.0f, x, true); w[c] = x; }
        *(u32x4*)(dp + 16 * j) = (u32x4){w[0], w[1], w[2], w[3]}; }
}
__device__ __forceinline__ void side_convert(const Args& a, int bx, int G, int wave, int lane) {
    int base, nit;
    if (G == 256) { base = bx < 192 ? 11 * bx : 2112 + 15 * (bx - 192); nit = bx < 192 ? 11 : 15; }
    else { const int per = (CVI_ITEMS + G - 1) / G; base = bx * per; nit = base >= CVI_ITEMS ? 0 : (CVI_ITEMS - base < per ? CVI_ITEMS - base : per); }
    const int end = base + nit;
    f32x4 r0[16], r1[16];
    const float* sp0; const float* sp1; unsigned p0 = 0, p1 = 0; unsigned char* d0; unsigned char* d1;
    if (nit > 0) { cvi_slice_ptrs(a, base, wave, lane, sp0, p0, d0); cvi_slice_load(sp0, p0, r0); }
    if (nit > 1) { cvi_slice_ptrs(a, base + 1, wave, lane, sp1, p1, d1); cvi_slice_load(sp1, p1, r1); }
#pragma unroll 1
    for (int it0 = base; it0 < end; it0 += 2) {
        const int it1 = it0 + 1;
        { unsigned char* dcur = d0; cvi_slice_out(dcur, r0); if (it0 + 2 < end) { cvi_slice_ptrs(a, it0 + 2, wave, lane, sp0, p0, d0); cvi_slice_load(sp0, p0, r0); } }
        if (it1 >= end) break;
        { unsigned char* dcur = d1; cvi_slice_out(dcur, r1); if (it1 + 2 < end) { cvi_slice_ptrs(a, it1 + 2, wave, lane, sp1, p1, d1); cvi_slice_load(sp1, p1, r1); } }
    }
}

__device__ __forceinline__ void side_convert_dma(const Args& a, int bx, int G, int wave, int lane, LAS unsigned char* lds) {
    int base, nit;
    if (G == 256) { base = bx < 192 ? 11 * bx : 2112 + 15 * (bx - 192); nit = bx < 192 ? 11 : 15; }
    else { const int per = (CVI_ITEMS + G - 1) / G; base = bx * per; nit = base >= CVI_ITEMS ? 0 : (CVI_ITEMS - base < per ? CVI_ITEMS - base : per); }
    const int end = base + nit;
    LAS unsigned char* wb = lds + wave * 16384;
    const float* sp; unsigned pitch = 0; unsigned char* dnext = nullptr;
#define CVD_DMA(h) do { _Pragma("unroll") for (int kk = 8 * (h); kk < 8 * (h) + 8; ++kk) \
        __builtin_amdgcn_global_load_lds((const unsigned*)(sp + (size_t)kk * pitch), (LAS unsigned*)(wb + kk * 1024), 16, 0, 2); } while (0)
    if (nit > 0) { cvi_slice_ptrs(a, base, wave, lane, sp, pitch, dnext); CVD_DMA(0); CVD_DMA(1); }
#pragma unroll 1
    for (int it = base; it < end; ++it) {
        unsigned char* dcur = dnext;
        f32x4 r[16];
        asm volatile("s_waitcnt vmcnt(8)" ::: "memory");
#pragma unroll
        for (int kk = 0; kk < 8; ++kk) r[kk] = *(const LAS f32x4*)(wb + kk * 1024 + lane * 16);
        asm volatile("s_waitcnt lgkmcnt(0)" ::: "memory");
        asm volatile("" : "+v"(r[0]), "+v"(r[1]), "+v"(r[2]), "+v"(r[3]), "+v"(r[4]), "+v"(r[5]), "+v"(r[6]), "+v"(r[7]));
        const bool more = it + 1 < end;
        if (more) { cvi_slice_ptrs(a, it + 1, wave, lane, sp, pitch, dnext); CVD_DMA(0); }
        if (more) asm volatile("s_waitcnt vmcnt(8)" ::: "memory"); else asm volatile("s_waitcnt vmcnt(0)" ::: "memory");
#pragma unroll
        for (int kk = 8; kk < 16; ++kk) r[kk] = *(const LAS f32x4*)(wb + kk * 1024 + lane * 16);
        asm volatile("s_waitcnt lgkmcnt(0)" ::: "memory");
        asm volatile("" : "+v"(r[8]), "+v"(r[9]), "+v"(r[10]), "+v"(r[11]), "+v"(r[12]), "+v"(r[13]), "+v"(r[14]), "+v"(r[15]));
        if (more) CVD_DMA(1);
        cvi_slice_out(dcur, r);
    }
#undef CVD_DMA
    asm volatile("s_waitcnt vmcnt(0)" ::: "memory");
}

namespace pg8 {
constexpr int BM = 256, BK = 64, HALF = 128, HTB = HALF * BK * 2, STAGE_BYTES = 8 * HTB, NXCD = 8, WGM = 8;
constexpr int KD = 1024, NT_K = KD / BK;
__device__ __forceinline__ void stgw(void* base, unsigned off, u32x4 v) { __builtin_amdgcn_raw_buffer_store_b128(v, __builtin_amdgcn_make_buffer_rsrc(base, 0, 0x7FFFFFFF, 0x00020000), off, 0, 16); }
__device__ __forceinline__ void tile_signal(unsigned* cnt, int pm) { asm volatile("s_waitcnt vmcnt(0)" ::: "memory"); if ((threadIdx.x & 63) == 0) __hip_atomic_fetch_add(cnt + 16 * pm, 1u, __ATOMIC_RELAXED, __HIP_MEMORY_SCOPE_AGENT); }
__device__ __forceinline__ void tile_wait(const unsigned* cnt, int pm, unsigned need, unsigned* tmo) {
    unsigned spins = 0u;
    while (__hip_atomic_load(cnt + 16 * pm, __ATOMIC_RELAXED, __HIP_MEMORY_SCOPE_AGENT) < need) { __builtin_amdgcn_s_sleep(2); if (++spins > (1u << 20)) { __hip_atomic_store(tmo, 1u, __ATOMIC_RELAXED, __HIP_MEMORY_SCOPE_AGENT); break; } }
}
__host__ __device__ __forceinline__ int lds_byte(int r, int c) { const int st = (r >> 4) * 2 + (c >> 5), rr = r & 15, cc = c & 31, ob = rr * 64 + cc * 2; return st * 1024 + (ob ^ (((ob >> 9) & 1) << 5)); }
__host__ __device__ __forceinline__ void stage_rc(int b, int& R, int& C) { const int st = b / 1024, sb = b % 1024, swz = sb ^ (((sb >> 9) & 1) << 5); R = (st >> 1) * 16 + swz / 64; C = (st & 1) * 32 + (swz % 64) / 2; }
__host__ __device__ __forceinline__ int perm32(int rho) { const int n = rho >> 4, i = rho & 15; return 8 * (i >> 2) + 4 * n + (i & 3); }

struct Unit { const char* A; const char* B; int pm, pn, e, mt, cnt, type; };

struct DenseOrder {
    const char* Ab; const char* Bb; int nM, nN, nwg, G, c, i0 = 0, i1 = 1 << 20; static constexpr int rowb = KD * 2; static constexpr bool PARK = false, FUSED = false;
    __device__ __forceinline__ unsigned boff(int Rb, int C) const { return (unsigned)(Rb * rowb + C * 2); }
    __device__ __forceinline__ size_t bstep_k() const { return 128; }
    __device__ __forceinline__ size_t bstep_h() const { return (size_t)HALF * rowb; }
    __device__ void init(const void* A, const void* B, int M, int N, int G_, int c_) { Ab = (const char*)A; Bb = (const char*)B; nM = M / BM; nN = N / BM; nwg = nM * nN; G = G_; c = c_; }
    __device__ __forceinline__ bool next(int i, Unit& u) const {
        if (i + i0 >= i1) return false;
        const long L = (long)(i + i0) * G + c; if (L >= nwg) return false;
        int wgid = (int)L; { const int q = nwg / NXCD, r = nwg % NXCD, xcd = wgid % NXCD, off = wgid / NXCD; wgid = (xcd < r ? xcd * (q + 1) : r * (q + 1) + (xcd - r) * q) + off; }
        const int nig = WGM * nN, gid = wgid / nig, fm = gid * WGM, gsz = (nM - fm) < WGM ? (nM - fm) : WGM;
        u.pm = fm + ((wgid % nig) % gsz); u.pn = (wgid % nig) / gsz; u.e = 0; u.mt = 0; u.cnt = 0; u.type = 0;
        u.A = Ab + (size_t)u.pm * (BM * KD * 2); u.B = Bb + (size_t)u.pn * (BM * KD * 2); return true;
    }
    __device__ __forceinline__ void offsets(const Unit&, const int (&R)[2], const int (&C)[2], unsigned (&off)[2][2]) const {
#pragma unroll
        for (int h = 0; h < 2; ++h)
#pragma unroll
            for (int i = 0; i < 2; ++i) off[h][i] = (unsigned)(((h * HALF + R[i]) * KD + C[i]) * 2);
    }
};
struct MoeOrder {
    const LAS int* tab; int NTN, G, c, total; const char* Ab; const char* Bb; size_t bexp; const int* slot; bool gather; int rowb;
    static constexpr bool PARK = true, FUSED = false;
    int bn16;
    __device__ __forceinline__ unsigned boff(int Rb, int C) const { return (unsigned)((C >> 3) * bn16 + Rb * 16); }
    __device__ __forceinline__ size_t bstep_k() const { return (size_t)8 * bn16; }
    __device__ __forceinline__ size_t bstep_h() const { return (size_t)HALF * 16; }
    __device__ __forceinline__ bool next(int i, Unit& u) const {
        const int L = i * G + c; if (L >= total) return false;
        int e = 0;
        for (int j = 1; j < NE; ++j) e += (L >= NTN * tab[64 + j]) ? 1 : 0;
        e = __builtin_amdgcn_readfirstlane(e);
        const int ms = __builtin_amdgcn_readfirstlane(tab[64 + e]), ml = __builtin_amdgcn_readfirstlane(tab[32 + e]);
        const int r = L - NTN * ms; const int nt = r / ml, mt = r - nt * ml;
        u.e = e; u.mt = mt; u.cnt = __builtin_amdgcn_readfirstlane(tab[e]); u.pm = ms + mt; u.pn = nt; u.type = 0;
        u.A = gather ? Ab : Ab + (size_t)u.pm * (size_t)(BM * rowb);
        u.B = Bb + (size_t)e * bexp + (size_t)nt * (size_t)(BM * 16); return true;
    }
    __device__ __forceinline__ void offsets(const Unit& u, const int (&R)[2], const int (&C)[2], unsigned (&off)[2][2]) const {
#pragma unroll
        for (int h = 0; h < 2; ++h)
#pragma unroll
            for (int i = 0; i < 2; ++i) {
                if (gather) { const int idx = u.mt * BM + h * HALF + R[i]; const int idc = idx < u.cnt ? idx : u.cnt - 1; int tok = slot[u.e * SLOT_CAP + idc] >> 2; tok = idx < u.cnt ? tok : 0; off[h][i] = (unsigned)(tok * rowb + C[i] * 2); }
                else off[h][i] = (unsigned)((h * HALF + R[i]) * rowb + C[i] * 2);
            }
    }
};


#define GAS_U32 __attribute__((address_space(1))) unsigned
struct MoeFusedOrder {
    const LAS int* tab; int G, c, total6, total7; const char* hb; const char* act; const char* wup; const char* wdn; const int* slot; unsigned* cnt; unsigned* tmo;
    static constexpr bool PARK = true, FUSED = true; static constexpr int rowb = 1024;
    __device__ __forceinline__ unsigned boff_t(int type, int R, int C) const {
        const int rs = 64 * (R >> 5) + 32 * ((R >> 2) & 1) + 16 * ((R >> 3) & 1) + 4 * ((R >> 4) & 1) + (R & 3);
        return (unsigned)((C >> 3) * ((type ? 1024 : 2048) * 16) + rs * 16); }
    __device__ __forceinline__ unsigned boff(int R, int C) const { return boff_t(0, R, C); }
    __device__ __forceinline__ size_t bstep_kt(int type) const { return (size_t)8 * (type ? 1024 * 16 : 2048 * 16); }
    __device__ __forceinline__ size_t bstep_ht(int) const { return (size_t)8 * 16; }
    __device__ __forceinline__ size_t bstep_k() const { return bstep_kt(0); }
    __device__ __forceinline__ size_t bstep_h() const { return bstep_ht(0); }
    __device__ __forceinline__ bool next(int i, Unit& u) const {
        int L = i * G + c; if (L >= total6 + total7) return false;
        const int type = L >= total6 ? 1 : 0; L -= type ? total6 : 0; const int NTN = type ? 4 : 8;
        int e = 0;
        for (int j = 1; j < NE; ++j) e += (L >= NTN * tab[64 + j]) ? 1 : 0;
        e = __builtin_amdgcn_readfirstlane(e);
        const int ms = __builtin_amdgcn_readfirstlane(tab[64 + e]), ml = __builtin_amdgcn_readfirstlane(tab[32 + e]);
        const int r = L - NTN * ms; const int nt = r / ml, mt = r - nt * ml;
        u.e = e; u.mt = mt; u.cnt = __builtin_amdgcn_readfirstlane(tab[e]); u.pm = ms + mt; u.pn = nt; u.type = type;
        u.A = type ? act + (size_t)u.pm * (size_t)(BM * rowb) : hb;
        u.B = (type ? wdn + (size_t)e * 1024 * 1024 : wup + (size_t)e * 2048 * 1024) + (size_t)nt * (size_t)(BM * 16); return true;
    }
    __device__ __forceinline__ void offsets(const Unit& u, const int (&R)[2], const int (&C)[2], unsigned (&off)[2][2]) const {
        if (u.type == 0) { int tok[2][2];
#pragma unroll
            for (int h = 0; h < 2; ++h)
#pragma unroll
                for (int i = 0; i < 2; ++i) { const int idx = u.mt * BM + h * HALF + R[i]; tok[h][i] = slot[u.e * SLOT_CAP + (idx < u.cnt ? idx : u.cnt - 1)]; }
#pragma unroll
            for (int h = 0; h < 2; ++h)
#pragma unroll
                for (int i = 0; i < 2; ++i) { const int idx = u.mt * BM + h * HALF + R[i]; const int t = idx < u.cnt ? (tok[h][i] >> 2) : 0; off[h][i] = (unsigned)(t * rowb + C[i] * 2); }
        } else {
#pragma unroll
            for (int h = 0; h < 2; ++h)
#pragma unroll
                for (int i = 0; i < 2; ++i) off[h][i] = (unsigned)((h * HALF + R[i]) * rowb + C[i] * 2);
        }
    }
    __device__ __forceinline__ void early_poll(const Unit& u, LAS unsigned char* lds) const {
        if (threadIdx.x < 64) { const unsigned* p = cnt + 16 * u.pm; unsigned v;
            asm volatile("global_load_dword %0, %1, off sc1\n\ts_waitcnt vmcnt(0)" : "=&v"(v) : "v"(p) : "memory");
            if (threadIdx.x == 0) *(LAS unsigned*)(lds + MISC_OFF + MO_RDY) = v >= 64u ? 1u : 0u; }
    }
    __device__ __forceinline__ void a_ready(const Unit& u) const {
        if (u.type) {
            if (threadIdx.x < 64) { const unsigned* p = cnt + 16 * u.pm; unsigned v, spins = 0u;
                for (;;) { asm volatile("global_load_dword %0, %1, off sc1\n\ts_waitcnt vmcnt(0)" : "=&v"(v) : "v"(p) : "memory");
                    if ((unsigned)__builtin_amdgcn_readfirstlane(v) >= 64u) break;
                    __builtin_amdgcn_s_sleep(2);
                    if (++spins > (1u << 20)) { if (threadIdx.x == 0) __hip_atomic_store(tmo, 1u, __ATOMIC_RELAXED, __HIP_MEMORY_SCOPE_AGENT); break; } }
                }
            asm volatile("" ::: "memory"); __builtin_amdgcn_s_barrier(); asm volatile("" ::: "memory");
        }
    }
    __device__ __forceinline__ void done(const Unit& u) const {
        if (u.type == 0) { asm volatile("s_waitcnt vmcnt(0)" ::: "memory");
            if ((threadIdx.x & 63) == 0) __hip_atomic_fetch_add(cnt + 16 * u.pm, 1u, __ATOMIC_RELAXED, __HIP_MEMORY_SCOPE_AGENT); }
    }
};

typedef f32x4 Acc[2][2][4][2];

typedef int i32x8 __attribute__((ext_vector_type(8)));
struct u32x4x2 { u32x4 a, b; };
template <class Epi, class Sched, bool FP8 = false>
__device__ __forceinline__ void gemm_phase(LAS unsigned char* lds, const Sched& S, const Epi& E) {
    const int tid = threadIdx.x, wid = __builtin_amdgcn_readfirstlane(tid >> 6), lane = tid & 63, wr = wid >> 2, wc = wid & 3, fr = lane & 15, fq = lane >> 4;
    constexpr int ROWB = FP8 ? KD : KD * 2, nt = FP8 ? KD / 128 : NT_K;
    int sR[2], sC[2], sRb[2]; unsigned voffB[2];
#pragma unroll
    for (int i = 0; i < 2; ++i) { int R, C; stage_rc(tid * 16 + i * 8192, R, C); sR[i] = R; sC[i] = C; const int Rb = Epi::PERM ? ((R & ~31) + perm32(R & 31)) : R; sRb[i] = Rb; voffB[i] = S.boff(Rb, C); }
    constexpr size_t kstep = (size_t)(BK * 2);
    size_t kstepB = S.bstep_k(), kstepBn = kstepB, hstepB = S.bstep_h(), hstepBn = hstepB;
    const unsigned ldsw = (unsigned)wid * 1024u;
    const int aoff = lds_byte(wr * 64 + fr, fq * 8), boff = lds_byte(wc * 32 + fr, fq * 8);
    constexpr int KST = 1024;
#define PG8_SA(b, h) (((b) * 2 + (h)) * HTB)
#define PG8_SB(b, h) ((4 + (b) * 2 + (h)) * HTB)
#define PG8_STAGE(bufoff, gbase, voff) do { const char* _gb = (const char*)(gbase); asm volatile("" : "+s"(_gb));     \
        _Pragma("unroll") for (int _i = 0; _i < 2; ++_i) \
        __builtin_amdgcn_global_load_lds((const unsigned*)(_gb + (voff)[_i]), (LAS unsigned*)(lds + (bufoff) + ldsw + _i * 8192), 16, 0, 0); } while (0)
#define PG8_STAGE_A(bufoff, gbase, voff) do { const char* _gb = (const char*)(gbase); asm volatile("" : "+s"(_gb)); \
        _Pragma("unroll") for (int _i = 0; _i < 2; ++_i) \
        __builtin_amdgcn_global_load_lds((const unsigned*)(_gb + (voff)[_i]), (LAS unsigned*)(lds + (bufoff) + ldsw + _i * 8192), 16, 0, 0); } while (0)
#define PG8_LDA(dst, b, h) do { _Pragma("unroll") for (int m = 0; m < 4; ++m) _Pragma("unroll") for (int k = 0; k < 2; ++k) dst[m][k] = *(const LAS bf16x8*)(lds + PG8_SA(b, h) + aoff + m * 2048 + k * KST); } while (0)
#define PG8_LDB(dst, b, h) do { _Pragma("unroll") for (int n = 0; n < 2; ++n) _Pragma("unroll") for (int k = 0; k < 2; ++k) dst[n][k] = *(const LAS bf16x8*)(lds + PG8_SB(b, h) + boff + n * 2048 + k * KST); } while (0)
#define PG8_CAT(x) __builtin_bit_cast(i32x8, (u32x4x2){__builtin_bit_cast(u32x4, (x)[0]), __builtin_bit_cast(u32x4, (x)[1])})
#define PG8_MMA(ai, bj, At, Bt) do { __builtin_amdgcn_s_setprio(1); \
        if constexpr (FP8) { _Pragma("unroll") for (int m = 0; m < 4; ++m) _Pragma("unroll") for (int n = 0; n < 2; ++n) \
            acc[ai][bj][m][n] = __builtin_amdgcn_mfma_scale_f32_16x16x128_f8f6f4(PG8_CAT(Bt[n]), PG8_CAT(At[m]), acc[ai][bj][m][n], 0, 0, 0, Epi::SCALE_B, 0, Epi::SCALE_A); } \
        else { _Pragma("unroll") for (int m = 0; m < 4; ++m) _Pragma("unroll") for (int n = 0; n < 2; ++n) _Pragma("unroll") for (int k = 0; k < 2; ++k) \
            acc[ai][bj][m][n] = __builtin_amdgcn_mfma_f32_16x16x32_bf16(Bt[n][k], At[m][k], acc[ai][bj][m][n], 0, 0, 0); } \
        __builtin_amdgcn_s_setprio(0); } while (0)
#define PG8_WAIT_V(n) asm volatile("s_waitcnt vmcnt(" #n ")" ::: "memory")
#define PG8_WAIT_L(n) asm volatile("s_waitcnt lgkmcnt(" #n ")" ::: "memory")
#define PG8_BAR __builtin_amdgcn_s_barrier()
#define PG8_SCHED __builtin_amdgcn_sched_barrier(0)
    Unit cur, nxt; int ui = 0;
    if (!S.next(0, cur)) return;
    Acc acc;
    bf16x8 At[4][2], B0[2][2], B1[2][2];
    unsigned offA[2][2], offN[2][2];
    S.offsets(cur, sR, sC, offA);
    if constexpr (Sched::FUSED) { kstepB = S.bstep_kt(cur.type); hstepB = S.bstep_ht(cur.type);
#pragma unroll
        for (int i = 0; i < 2; ++i) voffB[i] = S.boff_t(cur.type, sR[i], sC[i]); }
    const char* cA = cur.A; const char* cB = cur.B;
    PG8_STAGE(PG8_SB(0, 0), cB, voffB); PG8_STAGE(PG8_SB(0, 1), cB + hstepB, voffB); PG8_STAGE_A(PG8_SA(0, 0), cA, offA[0]); PG8_STAGE_A(PG8_SA(0, 1), cA, offA[1]);
    if (wr == 1) PG8_BAR;
    PG8_WAIT_V(2); PG8_BAR;
    PG8_STAGE(PG8_SB(1, 0), cB + kstepB, voffB); PG8_STAGE_A(PG8_SA(1, 0), cA + kstep, offA[0]); PG8_STAGE(PG8_SB(1, 1), cB + hstepB + kstepB, voffB);
    PG8_WAIT_V(6); PG8_BAR;
    for (;;) {
#pragma unroll
        for (int a = 0; a < 2; ++a)
#pragma unroll
            for (int b = 0; b < 2; ++b)
#pragma unroll
                for (int m = 0; m < 4; ++m)
#pragma unroll
                    for (int n = 0; n < 2; ++n) acc[a][b][m][n] = (f32x4){0.f, 0.f, 0.f, 0.f};
        const bool has_next = S.next(ui + 1, nxt);
        const char* nA = has_next ? nxt.A : cA; const char* nB = has_next ? nxt.B : cB;
        if constexpr (Sched::FUSED) { kstepBn = has_next ? S.bstep_kt(nxt.type) : kstepB; hstepBn = has_next ? S.bstep_ht(nxt.type) : hstepB; }
        if (has_next) S.offsets(nxt, sR, sC, offN);
        else {
#pragma unroll
            for (int h = 0; h < 2; ++h)
#pragma unroll
                for (int i = 0; i < 2; ++i) offN[h][i] = offA[h][i];
        }
        if constexpr (Sched::PARK) *(LAS u32x4*)(lds + OFFN_OFF + tid * 16) = (u32x4){offN[0][0], offN[0][1], offN[1][0], offN[1][1]};
        if constexpr (Sched::FUSED) { if (has_next && nxt.type) S.early_poll(nxt, lds); }
#pragma unroll 1
        for (int t = 0; t < nt; t += 2) {
            const bool last = (t == nt - 2);
            const char* a1 = cA + (size_t)(t + 1) * kstep;
            const char* a2 = last ? nA : cA + (size_t)(t + 2) * kstep; const char* b2 = last ? nB : cB + (size_t)(t + 2) * kstepB;
            const char* a3 = a2 + kstep; const char* b3 = b2 + (last ? kstepBn : kstepB); const size_t hB = last ? hstepBn : hstepB;
            if constexpr (Sched::FUSED) { if (last && has_next && nxt.type) { const unsigned rdy = __builtin_amdgcn_readfirstlane(*(const LAS unsigned*)(lds + MISC_OFF + MO_RDY)); if (!rdy) S.a_ready(nxt); } }
            if constexpr (Epi::MID_T > 0) { if (t == Epi::MID_T) E.mid(acc, cur, wr, wc, fr, fq); }
            PG8_LDB(B0, 0, 0); PG8_LDB(B1, 0, 1); PG8_SCHED; PG8_LDA(At, 0, 0); PG8_STAGE_A(PG8_SA(1, 1), a1, offA[1]);
            PG8_WAIT_V(8); PG8_WAIT_L(0); PG8_BAR; PG8_MMA(0, 0, At, B0); PG8_MMA(0, 1, At, B1);
            asm volatile("" : "+v"(acc[0][0][0][0]), "+v"(acc[0][0][0][1]), "+v"(acc[0][0][1][0]), "+v"(acc[0][0][1][1]), "+v"(acc[0][0][2][0]), "+v"(acc[0][0][2][1]), "+v"(acc[0][0][3][0]), "+v"(acc[0][0][3][1]));
            asm volatile("" : "+v"(acc[0][1][0][0]), "+v"(acc[0][1][0][1]), "+v"(acc[0][1][1][0]), "+v"(acc[0][1][1][1]), "+v"(acc[0][1][2][0]), "+v"(acc[0][1][2][1]), "+v"(acc[0][1][3][0]), "+v"(acc[0][1][3][1]));
            PG8_BAR; PG8_SCHED;
            if (last) {
                if constexpr (Sched::FUSED) { if (has_next) {
#pragma unroll
                    for (int i = 0; i < 2; ++i) voffB[i] = S.boff_t(nxt.type, sR[i], sC[i]); } }
                if constexpr (Sched::PARK) { const u32x4 pk = *(const LAS u32x4*)(lds + OFFN_OFF + tid * 16); offA[0][0] = pk.x; offA[0][1] = pk.y; offA[1][0] = pk.z; offA[1][1] = pk.w; }
                else {
#pragma unroll
                    for (int h = 0; h < 2; ++h)
#pragma unroll
                        for (int i = 0; i < 2; ++i) offA[h][i] = offN[h][i];
                }
            }
            PG8_LDA(At, 0, 1); PG8_STAGE(PG8_SB(0, 0), b2, voffB); PG8_STAGE(PG8_SB(0, 1), b2 + hB, voffB); PG8_STAGE_A(PG8_SA(0, 0), a2, offA[0]);
            PG8_WAIT_V(8); PG8_WAIT_L(0); PG8_BAR; PG8_MMA(1, 0, At, B0); PG8_MMA(1, 1, At, B1); PG8_BAR; PG8_SCHED;
            PG8_LDB(B0, 1, 0); PG8_LDB(B1, 1, 1); PG8_SCHED; PG8_LDA(At, 1, 0); PG8_STAGE_A(PG8_SA(0, 1), a2, offA[1]);
            PG8_WAIT_V(8); PG8_WAIT_L(0); PG8_BAR; PG8_MMA(0, 0, At, B0); PG8_MMA(0, 1, At, B1); PG8_BAR; PG8_SCHED;
            PG8_LDA(At, 1, 1); PG8_STAGE(PG8_SB(1, 0), b3, voffB); PG8_STAGE(PG8_SB(1, 1), b3 + hB, voffB); PG8_STAGE_A(PG8_SA(1, 0), a3, offA[0]);
            PG8_WAIT_V(8); PG8_WAIT_L(0); PG8_BAR; PG8_MMA(1, 0, At, B0); PG8_MMA(1, 1, At, B1); PG8_BAR; PG8_SCHED;
        }
        if (wr == 0) PG8_BAR;
        E(acc, cur, wr, wc, fr, fq);
        if constexpr (Sched::FUSED) S.done(cur);
        if constexpr (Epi::SIGNAL) tile_signal(E.cnt, cur.pm);
        __builtin_amdgcn_s_waitcnt(0x0F70);
        if (!has_next) break;
        cur = nxt; cA = nA; cB = nB; kstepB = kstepBn; hstepB = hstepBn; ++ui;
        if (wr == 1) PG8_BAR;
    }
    PG8_WAIT_V(0);
    PG8_BAR;
#undef PG8_SA
#undef PG8_SB
#undef PG8_STAGE
#undef PG8_STAGE_A
#undef PG8_LDA
#undef PG8_LDB
#undef PG8_MMA
#undef PG8_WAIT_V
#undef PG8_WAIT_L
#undef PG8_BAR
#undef PG8_SCHED
}

#define EPI_SEED(r, c) asm volatile("" : "+v"(r), "+v"(c))
template <class V> __device__ __forceinline__ V ldg(const void* base, unsigned off) { return *(const V*)((const char*)base + off); }
template <class V> __device__ __forceinline__ void stg(void* base, unsigned off, V v) { *(V*)((char*)base + off) = v; }
__device__ __forceinline__ u32x4 pack8(const f32x4 v0, const f32x4 v1) { u32x4 w; w.x = cvt_pk_bf16(v0[0], v0[1]); w.y = cvt_pk_bf16(v0[2], v0[3]); w.z = cvt_pk_bf16(v1[0], v1[1]); w.w = cvt_pk_bf16(v1[2], v1[3]); return w; }

struct EpiU {
    static constexpr int SCALE_B = 0, SCALE_A = 0;
    static constexpr bool PERM = true, SIGNAL = true; static constexpr int MID_T = 0;
    bf16 *q, *k, *vT, *ab, *gates; const float* bias; unsigned* cnt;
    __device__ __forceinline__ void mid(Acc&, const Unit&, int, int, int, int) const {}
    __device__ __forceinline__ void operator()(const Acc& acc, const Unit& u, int wr, int wc, int fr, int fq) const {
        int rl = wr * 64 + fr, cl = wc * 32 + 8 * fq; EPI_SEED(rl, cl);
        const int row0 = u.pm * BM + rl, pn = u.pn;
        f32x4 bv[2][2];
#pragma unroll
        for (int bj = 0; bj < 2; ++bj)
#pragma unroll
            for (int n = 0; n < 2; ++n) bv[bj][n] = ldg<f32x4>(bias, (unsigned)(pn * BM + bj * HALF + cl + 4 * n) * 4u);
        if (pn < 2) {
            const unsigned o0 = ((unsigned)row0 * AW + pn * BM + cl) * 2u;
#pragma unroll
            for (int ai = 0; ai < 2; ++ai)
#pragma unroll
                for (int m = 0; m < 4; ++m)
#pragma unroll
                    for (int bj = 0; bj < 2; ++bj)
                        stgw(q, o0 + (unsigned)((ai * HALF + m * 16) * AW + bj * HALF) * 2u, pack8((acc[ai][bj][m][0] + bv[bj][0]) * 0.125f, (acc[ai][bj][m][1] + bv[bj][1]) * 0.125f));
        } else if (pn == 2) {
            const unsigned o0 = ((unsigned)row0 * KVW + cl) * 2u;
#pragma unroll
            for (int ai = 0; ai < 2; ++ai)
#pragma unroll
                for (int m = 0; m < 4; ++m) {
                    stgw(k, o0 + (unsigned)((ai * HALF + m * 16) * KVW) * 2u, pack8(acc[ai][0][m][0] + bv[0][0], acc[ai][0][m][1] + bv[0][1]));
                    stgw(vT, o0 + (unsigned)((ai * HALF + m * 16) * KVW) * 2u, pack8(acc[ai][1][m][0] + bv[1][0], acc[ai][1][m][1] + bv[1][1])); }
        } else if (pn < 7) {
            const unsigned o0 = ((unsigned)(row0 + AB_PAD * ((row0 >> 12) + 1)) * CCH + (pn - 3) * HALF + cl) * 2u;
#pragma unroll
            for (int ai = 0; ai < 2; ++ai)
#pragma unroll
                for (int m = 0; m < 4; ++m) { f32x4 o[2];
#pragma unroll
                    for (int n = 0; n < 2; ++n) { const f32x4 a = acc[ai][0][m][n] + bv[0][n], g = acc[ai][1][m][n] + bv[1][n];
#pragma unroll
                        for (int j = 0; j < 4; ++j) o[n][j] = a[j] * sigmoidf_(g[j]); }
                    stgw(ab, o0 + (unsigned)((ai * HALF + m * 16) * CCH) * 2u, pack8(o[0], o[1])); }
        } else {
            const unsigned o0 = ((unsigned)row0 * 2048 + (pn - 7) * HALF + cl) * 2u;
#pragma unroll
            for (int ai = 0; ai < 2; ++ai)
#pragma unroll
                for (int m = 0; m < 4; ++m) { f32x4 ra[2], gb[2];
#pragma unroll
                    for (int n = 0; n < 2; ++n) { const f32x4 va = acc[ai][0][m][n] + bv[0][n], vb = acc[ai][1][m][n] + bv[1][n];
#pragma unroll
                        for (int j = 0; j < 4; ++j) { const float sb = sigmoidf_(vb[j]); gb[n][j] = sb; ra[n][j] = sigmoidf_(va[j]) * __builtin_amdgcn_rcpf(sb); } }
                    stgw(gates, o0 + (unsigned)((ai * HALF + m * 16) * 2048) * 2u, pack8(ra[0], ra[1]));
                    stgw(gates, o0 + (unsigned)((ai * HALF + m * 16) * 2048 + 1024) * 2u, pack8(gb[0], gb[1])); }
        }
    }
};
struct EpiMerged {
    static constexpr int SCALE_B = 0, SCALE_A = 0;
    static constexpr bool PERM = true, SIGNAL = true; static constexpr int MID_T = 8;
    const bf16* gates; const float* bc; bf16* merged; unsigned* cnt;
    __device__ __forceinline__ void mid(Acc& acc, const Unit& u, int wr, int wc, int fr, int fq) const {
        int rl = wr * 64 + fr, cl = wc * 32 + 8 * fq; EPI_SEED(rl, cl);
        const unsigned g0 = ((unsigned)(u.pm * BM + rl) * 2048 + u.pn * BM + cl) * 2u;
#pragma unroll
        for (int ai = 0; ai < 2; ++ai) { u32x4 rt[4][2];
#pragma unroll
            for (int m = 0; m < 4; ++m)
#pragma unroll
                for (int bj = 0; bj < 2; ++bj) rt[m][bj] = ldg<u32x4>(gates, g0 + (unsigned)((ai * HALF + m * 16) * 2048 + bj * HALF) * 2u);
            __builtin_amdgcn_sched_barrier(0);
#pragma unroll
            for (int m = 0; m < 4; ++m)
#pragma unroll
                for (int bj = 0; bj < 2; ++bj)
#pragma unroll
                    for (int n = 0; n < 2; ++n) { acc[ai][bj][m][n][0] *= bflo(rt[m][bj][2 * n]); acc[ai][bj][m][n][1] *= bfhi(rt[m][bj][2 * n]); acc[ai][bj][m][n][2] *= bflo(rt[m][bj][2 * n + 1]); acc[ai][bj][m][n][3] *= bfhi(rt[m][bj][2 * n + 1]); }
            __builtin_amdgcn_sched_barrier(0); }
    }
    __device__ __forceinline__ void operator()(const Acc& acc, const Unit& u, int wr, int wc, int fr, int fq) const {
        int rl = wr * 64 + fr, cl = wc * 32 + 8 * fq; EPI_SEED(rl, cl);
        const int row0 = u.pm * BM + rl, col0 = u.pn * BM + cl;
        const unsigned g0 = ((unsigned)row0 * 2048 + 1024 + col0) * 2u, m0 = ((unsigned)row0 * D + col0) * 2u;
        f32x4 bv[2][2];
#pragma unroll
        for (int bj = 0; bj < 2; ++bj)
#pragma unroll
            for (int n = 0; n < 2; ++n) bv[bj][n] = ldg<f32x4>(bc, (unsigned)(col0 + bj * HALF + 4 * n) * 4u);
#pragma unroll
        for (int ai = 0; ai < 2; ++ai)
#pragma unroll
            for (int m = 0; m < 4; ++m) {
#pragma unroll
                for (int bj = 0; bj < 2; ++bj) { const u32x4 gb = ldg<u32x4>(gates, g0 + (unsigned)((ai * HALF + m * 16) * 2048 + bj * HALF) * 2u); f32x4 o[2];
#pragma unroll
                    for (int n = 0; n < 2; ++n) { const f32x4 v = acc[ai][bj][m][n] + bv[bj][n];
                        o[n][0] = v[0] * bflo(gb[2 * n]); o[n][1] = v[1] * bfhi(gb[2 * n]); o[n][2] = v[2] * bflo(gb[2 * n + 1]); o[n][3] = v[3] * bfhi(gb[2 * n + 1]); }
                    stgw(merged, m0 + (unsigned)((ai * HALF + m * 16) * D + bj * HALF) * 2u, pack8(o[0], o[1])); }
                if (m & 1) asm volatile("" ::: "memory"); }
    }
};
struct EpiPre1 {
    static constexpr int SCALE_B = 0, SCALE_A = 0;
    static constexpr bool PERM = true, SIGNAL = true; static constexpr int MID_T = 0;
    const bf16* xb; bf16* out; unsigned* cnt;
    __device__ __forceinline__ void mid(Acc&, const Unit&, int, int, int, int) const {}
    __device__ __forceinline__ void operator()(const Acc& acc, const Unit& u, int wr, int wc, int fr, int fq) const {
        int rl = wr * 64 + fr, cl = wc * 32 + 8 * fq; EPI_SEED(rl, cl);
        const unsigned o0 = ((unsigned)(u.pm * BM + rl) * D + u.pn * BM + cl) * 2u;
        u32x4 xv[2][4][2];
#pragma unroll
        for (int ai = 0; ai < 2; ++ai)
#pragma unroll
            for (int m = 0; m < 4; ++m)
#pragma unroll
                for (int bj = 0; bj < 2; ++bj) xv[ai][m][bj] = ldg<u32x4>(xb, o0 + (unsigned)((ai * HALF + m * 16) * D + bj * HALF) * 2u);
        __builtin_amdgcn_sched_barrier(0);
#pragma unroll
        for (int ai = 0; ai < 2; ++ai)
#pragma unroll
            for (int m = 0; m < 4; ++m)
#pragma unroll
                for (int bj = 0; bj < 2; ++bj) { const u32x4 w = xv[ai][m][bj];
                    const f32x4 r0 = (f32x4){bflo(w.x), bfhi(w.x), bflo(w.y), bfhi(w.y)} * DN_ALPHA + acc[ai][bj][m][0], r1 = (f32x4){bflo(w.z), bfhi(w.z), bflo(w.w), bfhi(w.w)} * DN_ALPHA + acc[ai][bj][m][1];
                    stgw(out, o0 + (unsigned)((ai * HALF + m * 16) * D + bj * HALF) * 2u, pack8(r0, r1)); }
    }
};
struct EpiUp {
    static constexpr bool PERM = true, SIGNAL = false; static constexpr int MID_T = 0;
    static constexpr int SCALE_B = 0x79797979, SCALE_A = 0x7C7C7C7C;
    const float* b_up; unsigned char* act;
    __device__ __forceinline__ void mid(Acc&, const Unit&, int, int, int, int) const {}
    __device__ __forceinline__ void operator()(const Acc& acc, const Unit& u, int wr, int wc, int fr, int fq) const {
        int rl = wr * 64 + fr, cl = wc * 32 + 8 * fq; EPI_SEED(rl, cl);
        const unsigned o0 = (unsigned)(u.pm * BM + rl) * DE + u.pn * HALF + (cl >> 1);
        f32x4 bv[2][2];
#pragma unroll
        for (int bj = 0; bj < 2; ++bj)
#pragma unroll
            for (int n = 0; n < 2; ++n) bv[bj][n] = ldg<f32x4>(b_up, (unsigned)(u.e * 2048 + u.pn * BM + cl + bj * HALF + 4 * n) * 4u);
#pragma unroll
        for (int ai = 0; ai < 2; ++ai)
#pragma unroll
            for (int m = 0; m < 4; ++m)
#pragma unroll
                for (int bj = 0; bj < 2; ++bj) { float o[4];
#pragma unroll
                    for (int n = 0; n < 2; ++n) { const f32x4 v = acc[ai][bj][m][n] + bv[bj][n];
#pragma unroll
                        for (int p = 0; p < 2; ++p) { const float xg = fminf(v[2 * p], 7.0f), xl = fminf(fmaxf(v[2 * p + 1], -7.0f), 7.0f);
                            o[2 * n + p] = xg * sigmoidf_(1.702f * xg) * (xl + 1.0f); } }
                    unsigned w = 0u; w = __builtin_amdgcn_cvt_pk_fp8_f32(o[0] * 8.0f, o[1] * 8.0f, w, false); w = __builtin_amdgcn_cvt_pk_fp8_f32(o[2] * 8.0f, o[3] * 8.0f, w, true);
                    __hip_atomic_store((unsigned*)(act + (o0 + (unsigned)((ai * HALF + m * 16) * DE + bj * 64))), w, __ATOMIC_RELAXED, __HIP_MEMORY_SCOPE_AGENT); }
    }
};
struct EpiDown {
    static constexpr bool PERM = true, SIGNAL = false; static constexpr int MID_T = 0;
    static constexpr int SCALE_B = 0x79797979, SCALE_A = 0x7C7C7C7C;
    const float* b_dn; const int* slot; unsigned char* ys;
    __device__ __forceinline__ void mid(Acc&, const Unit&, int, int, int, int) const {}
    __device__ __forceinline__ void operator()(const Acc& acc, const Unit& u, int wr, int wc, int fr, int fq) const {
        int rl = wr * 64 + fr, cb = 64 * wc + 32 * (fq & 1) + 16 * (fq >> 1); EPI_SEED(rl, cb);
        const int col0 = u.pn * BM + cb, idx0 = u.mt * BM + rl;
        f32x4 bv[2][2];
#pragma unroll
        for (int bj = 0; bj < 2; ++bj)
#pragma unroll
            for (int n = 0; n < 2; ++n) bv[bj][n] = ldg<f32x4>(b_dn, (unsigned)(u.e * D + col0 + 8 * bj + 4 * n) * 4u);
        int asg[2][4];
#pragma unroll
        for (int ai = 0; ai < 2; ++ai)
#pragma unroll
            for (int m = 0; m < 4; ++m) { const int idx = idx0 + ai * HALF + m * 16; asg[ai][m] = ldg<int>(slot, (unsigned)(u.e * SLOT_CAP + (idx < u.cnt ? idx : u.cnt - 1)) * 4u); }
#pragma unroll
        for (int ai = 0; ai < 2; ++ai)
#pragma unroll
            for (int m = 0; m < 4; ++m) { const int idx = idx0 + ai * HALF + m * 16;
                if (idx < u.cnt) { u32x4 w;
#pragma unroll
                    for (int bj = 0; bj < 2; ++bj)
#pragma unroll
                        for (int n = 0; n < 2; ++n) { const f32x4 v = (acc[ai][bj][m][n] + bv[bj][n]) * 16.0f;
                            unsigned x = __builtin_amdgcn_cvt_pk_fp8_f32(v[0], v[1], 0u, false); x = __builtin_amdgcn_cvt_pk_fp8_f32(v[2], v[3], x, true); w[2 * bj + n] = x; }
                    stg<u32x4>(ys, (unsigned)asg[ai][m] * D + col0, w); } }
    }
};
struct EpiUpX {
    const float* b_up; unsigned char* act;
    __device__ __forceinline__ void operator()(const Acc& acc, const Unit& u, int wr, int wc, int fr, int fq) const {
        int rl = wr * 64 + fr, cb = 64 * wc + 32 * (fq & 1) + 16 * (fq >> 1); EPI_SEED(rl, cb);
        f32x4 bv[2][2];
#pragma unroll
        for (int bj = 0; bj < 2; ++bj)
#pragma unroll
            for (int n = 0; n < 2; ++n) bv[bj][n] = ldg<f32x4>(b_up, (unsigned)(u.e * 2048 + u.pn * BM + cb + 8 * bj + 4 * n) * 4u);
        const __amdgpu_buffer_rsrc_t rs = __builtin_amdgcn_make_buffer_rsrc(act, 0, (MAX_MT * 256) * 1024, 0x00020000);
        const unsigned o0 = (unsigned)(u.pm * BM + rl + 16 * (fq >> 1)) * DE + u.pn * HALF + 32 * wc + 16 * (fq & 1);
#pragma unroll
        for (int ai = 0; ai < 2; ++ai)
#pragma unroll
            for (int j = 0; j < 2; ++j) { unsigned d[2][2];
#pragma unroll
                for (int mm = 0; mm < 2; ++mm)
#pragma unroll
                    for (int bj = 0; bj < 2; ++bj) { float o[4];
#pragma unroll
                        for (int n = 0; n < 2; ++n) { const f32x4 v = acc[ai][bj][2 * j + mm][n] + bv[bj][n];
#pragma unroll
                            for (int p = 0; p < 2; ++p) { const float xg = fminf(v[2 * p], 7.0f), xl = fminf(fmaxf(v[2 * p + 1], -7.0f), 7.0f);
                                o[2 * n + p] = (xg * __builtin_amdgcn_rcpf(1.0f + __builtin_amdgcn_exp2f(xg * (-1.702f * 1.44269504f)))) * __builtin_fmaf(xl, 8.0f, 8.0f); } }
                        unsigned w = 0u; w = __builtin_amdgcn_cvt_pk_fp8_f32(o[0], o[1], w, false); w = __builtin_amdgcn_cvt_pk_fp8_f32(o[2], o[3], w, true); d[mm][bj] = w; }
                const u32x2 s0 = __builtin_amdgcn_permlane32_swap(d[0][0], d[1][0], false, false), s1 = __builtin_amdgcn_permlane32_swap(d[0][1], d[1][1], false, false);
                const u32x4 w4 = (u32x4){s0.x, s1.x, s0.y, s1.y};
                __builtin_amdgcn_raw_buffer_store_b128(w4, rs, o0 + (unsigned)((ai * HALF + 32 * j) * DE), 0, 16); }
    }
};
struct EpiMoe {
    static constexpr bool PERM = true, SIGNAL = false; static constexpr int MID_T = 0;
    static constexpr int SCALE_B = 0x79797979, SCALE_A = 0x7C7C7C7C;
    EpiUpX up; EpiDown dn;
    __device__ __forceinline__ void mid(Acc&, const Unit&, int, int, int, int) const {}
    __device__ __forceinline__ void operator()(const Acc& acc, const Unit& u, int wr, int wc, int fr, int fq) const { if (u.type == 0) up(acc, u, wr, wc, fr, fq); else dn(acc, u, wr, wc, fr, fq); }
};
}

#define XB_TMO      128
#define XB_XCNT(j)  (256  + 64 * (j))
#define XB_XSUB(j)  (1280 + 64 * (j))
#define XB_XGEN(j)  (2304 + 64 * (j))
#define XB_TOP      3328
#define XB_TOPGEN   3392
#define XCD_BAR_WORDS 3456
#define XB_SPIN_CAP (1u << 18)
__device__ __forceinline__ unsigned xb_ld(unsigned* p)              { return __hip_atomic_load(p, __ATOMIC_RELAXED, __HIP_MEMORY_SCOPE_AGENT); }
__device__ __forceinline__ unsigned xb_add(unsigned* p, unsigned v) { return __hip_atomic_fetch_add(p, v, __ATOMIC_RELAXED, __HIP_MEMORY_SCOPE_AGENT); }
__device__ __forceinline__ unsigned xb_xcc_id() { return (unsigned)__builtin_amdgcn_s_getreg((3 << 11) | 20) & 0xFu; }
#define XB_SPIN(cond, bar) do { unsigned _sp = 0; while (cond) { __builtin_amdgcn_s_sleep(1); \
    if ((++_sp & 255u) == 0u) { if (xb_ld(&(bar)[XB_TMO])) break; if (_sp > XB_SPIN_CAP) { atomicAdd(&(bar)[XB_TMO], 1u); break; } } } } while (0)
struct XcdBarrier { unsigned* bar; unsigned x; volatile LAS unsigned* st; };
__device__ __forceinline__ XcdBarrier xcd_barrier_post(unsigned* bar, volatile LAS unsigned* st) {
    XcdBarrier b; b.bar = bar; b.x = xb_xcc_id(); b.st = st;
    if (threadIdx.x == 0) (void)xb_add(&bar[XB_XCNT(b.x)], 1u);
    return b;
}
__device__ __forceinline__ void xcd_barrier_complete(unsigned* bar, unsigned x, unsigned& nloc, unsigned& nx) {
    const unsigned G = gridDim.x * gridDim.y * gridDim.z;
    unsigned sum, cnt, mine, sp = 0u;
    for (;;) {
        sum = 0u; cnt = 0u; mine = 0u;
#pragma unroll
        for (unsigned j = 0; j < 16; ++j) { const unsigned c = xb_ld(&bar[XB_XCNT(j)]); sum += c; cnt += (c > 0u) ? 1u : 0u; mine = (j == x) ? c : mine; }
        if (sum == G) break;
        __builtin_amdgcn_s_sleep(1);
        if ((++sp & 255u) == 0u) { if (xb_ld(&bar[XB_TMO])) break; if (sp > XB_SPIN_CAP) { atomicAdd(&bar[XB_TMO], 1u); break; } }
    }
    nloc = mine > 0u ? mine : 1u; nx = cnt > 0u ? cnt : 1u;
}
__device__ __forceinline__ void xcd_barrier(const XcdBarrier& b) {
    asm volatile("s_waitcnt vmcnt(0)" ::: "memory");
    __syncthreads();
    if (threadIdx.x == 64) asm volatile("buffer_inv sc1\n\ts_waitcnt vmcnt(0)" ::: "memory");
    if (threadIdx.x == 0) {
        unsigned* bar = b.bar;
        __builtin_amdgcn_s_waitcnt(0);
        unsigned nloc = b.st[0], nx = b.st[1];
        if (nloc == 0u) { xcd_barrier_complete(bar, b.x, nloc, nx); b.st[0] = nloc; b.st[1] = nx; }
        const unsigned old = xb_add(&bar[XB_XSUB(b.x)], 1u);
        const unsigned gen = old / nloc;
        if (old + 1u == (gen + 1u) * nloc) {
            __builtin_amdgcn_fence(__ATOMIC_RELEASE, "agent");
            asm volatile("s_waitcnt vmcnt(0)" ::: "memory");
            const unsigned og = xb_add(&bar[XB_TOP], 1u);
            const unsigned tg = og / nx;
            if (og + 1u == (tg + 1u) * nx) xb_add(&bar[XB_TOPGEN], 1u);
            else XB_SPIN(xb_ld(&bar[XB_TOPGEN]) == tg, bar);
            xb_add(&bar[XB_XGEN(b.x)], 1u);
            asm volatile("s_waitcnt vmcnt(0)" ::: "memory");
        } else {
            XB_SPIN(xb_ld(&bar[XB_XGEN(b.x)]) == gen, bar);
            asm volatile("s_waitcnt vmcnt(0)" ::: "memory");
        }
    }
    __syncthreads();
}


__device__ __forceinline__ void tr_item(const float* W, int ldw, int scol0, int srow0, bf16* WT, int Kd, int drow0, int dk0, LAS float* scr, int lane) {
#pragma unroll 8
    for (int i = 0; i < 32; ++i) { const int kk = 2 * i + (lane >> 5); scr[kk * 33 + (lane & 31)] = __builtin_nontemporal_load(W + (size_t)(srow0 + kk) * ldw + scol0 + (lane & 31)); }
    LDS_WAIT(); asm volatile("" ::: "memory");
    const int c = lane & 7;
#pragma unroll
    for (int j = 0; j < 4; ++j) { const int n = (lane >> 3) + 8 * j; const LAS float* s = scr + (8 * c) * 33 + n;
        u32x4 o; o.x = pk2(s[0 * 33], s[1 * 33]); o.y = pk2(s[2 * 33], s[3 * 33]); o.z = pk2(s[4 * 33], s[5 * 33]); o.w = pk2(s[6 * 33], s[7 * 33]);
        *(u32x4*)(WT + (size_t)(drow0 + n) * Kd + dk0 + 8 * c) = o; }
    LDS_WAIT(); asm volatile("" ::: "memory");
}
__device__ __forceinline__ int src_col_u(int np) {
    if (np < 768) return np;
    if (np >= 1792) { const int tt = (np - 1792) >> 8, w = (np - 1792) & 255; return w < 128 ? 1792 + 128 * tt + w : 2816 + 128 * tt + (w - 128); }
    const int tt = (np - 768) >> 8, w = (np - 768) & 255;
    return w < 128 ? 768 + 128 * tt + w : 1280 + 128 * tt + (w - 128);
}

__device__ __forceinline__ void p0_prologue(const Args& a, LAS unsigned char* lds, int gw, int NGW, int lane, int wave) {
    unsigned char* ws = a.ws;
    LAS float* scr = (LAS float*)(lds + wave * 16384);
    constexpr int J1 = 16 * 120, J2 = 8 * 32, J3 = 8 * 32, J4 = 16 * 32;
    constexpr int NITEMS = J1 + J2 + J3 + J4;
    for (int it = gw; it < NITEMS; it += NGW) {
        int r = it;
        if (r < J1) { const int kb = r / 120, nb = r % 120; tr_item(a.in[I_WIN], INW, src_col_u(32 * nb), 64 * kb, (bf16*)(ws + WS_WIN), 1024, 32 * nb, 64 * kb, scr, lane); continue; } r -= J1;
        if (r < J2) { const int kb = r / 32, nb = r % 32; tr_item(a.in[I_WATT], D, 32 * nb, 64 * kb, (bf16*)(ws + WS_WAB), 1024, 32 * nb, 64 * kb, scr, lane); continue; } r -= J2;
        if (r < J3) { const int kb = r / 32, nb = r % 32; tr_item(a.in[I_WCONV], D, 32 * nb, 64 * kb, (bf16*)(ws + WS_WAB), 1024, 32 * nb, 512 + 64 * kb, scr, lane); continue; } r -= J3;
        { const int kb = r / 32, nb = r % 32; tr_item(a.in[I_WO], D, 32 * nb, 64 * kb, (bf16*)(ws + WS_WO), 1024, 32 * nb, 64 * kb, scr, lane); }
    }
    const float* x = a.in[I_X]; bf16* xb = (bf16*)(ws + WS_XB);
    for (int m = gw; m < T; m += NGW) {
        const f32x4* xr = (const f32x4*)(x + (size_t)m * D) + lane; u32x2* o = (u32x2*)(xb + (size_t)m * D) + lane;
#pragma unroll
        for (int j = 0; j < 4; ++j) { const f32x4 v = __builtin_nontemporal_load(xr + 64 * j); u32x2 w; w.x = pk2(v[0], v[1]); w.y = pk2(v[2], v[3]); o[64 * j] = w; }
    }
    { u32x4* abz = (u32x4*)(ws + WS_AB); const u32x4 z4 = (u32x4){0u, 0u, 0u, 0u};
      for (int i = gw * 64 + lane; i < NBATCH * AB_PAD * CCH * 2 / 16; i += NGW * 64) { const int bb = i / (AB_PAD * CCH * 2 / 16), q = i % (AB_PAD * CCH * 2 / 16); abz[(size_t)bb * (AB_SEQ * CCH * 2 / 16) + q] = z4; } }
    float* bperm = (float*)(ws + WS_BPERM);
    for (int i = gw * 64 + lane; i < INW; i += NGW * 64) bperm[i] = a.in[I_BIN][src_col_u(i)];
}

constexpr int KLS = 144, VLS = 528, ATT_V_OFF = 256 * KLS, CONV_W_OFF = 70656;
__device__ __forceinline__ void attn_unit(const Args& a, int unit, LAS unsigned char* lds, int tid, int wave, int lane) {
    const bf16* qb = (const bf16*)(a.ws + WS_QB); const bf16* kb = (const bf16*)(a.ws + WS_KB); const bf16* vT = (const bf16*)(a.ws + WS_VT); bf16* ay = (bf16*)(a.ws + WS_AY);
    const int kvh = unit & 1, blk = (unit >> 1) & 31, b = unit >> 6;
    const int r = lane & 15, qd = lane >> 4, w = wave;
    const int t0 = b * SEQ + blk * 128, seq0 = b * SEQ, lo = w & ~1;
    { u32x4 kreg[4], vreg[4];
#pragma unroll
      for (int i = 0; i < 4; ++i) { const int c = tid + 512 * i;
          int tok = t0 - 128 + (c >> 3); tok = tok < seq0 ? seq0 : tok;
          kreg[i] = ldgo<u32x4>(kb, (unsigned)(tok * KVW + kvh * HD + (c & 7) * 8) * 2u);
          vreg[i] = ldgo<u32x4>(vT, (unsigned)(tok * KVW + kvh * HD + (c & 7) * 8) * 2u); }
      __builtin_amdgcn_sched_barrier(0);
      asm volatile("" : "+v"(kreg[0]), "+v"(kreg[1]), "+v"(kreg[2]), "+v"(kreg[3]), "+v"(vreg[0]), "+v"(vreg[1]), "+v"(vreg[2]), "+v"(vreg[3]));
#pragma unroll
      for (int i = 0; i < 4; ++i) { const int c = tid + 512 * i;
          *(LAS u32x4*)(lds + (c >> 3) * KLS + (c & 7) * 16) = kreg[i];
#pragma unroll
          for (int j = 0; j < 8; ++j) { const int d = 8 * (c & 7) + j, rho = 16 * ((d >> 2) & 3) + 4 * (d >> 4) + (d & 3); const unsigned wj = vreg[i][j >> 1];
              *(LAS unsigned short*)(lds + ATT_V_OFF + rho * VLS + (c >> 3) * 2) = (unsigned short)((j & 1) ? (wj >> 16) : (wj & 0xffffu)); } } }
    __syncthreads();
    const int qi = 16 * w + r;
#pragma unroll 1
    for (int hh = 0; hh < 4; ++hh) {
        const int head = kvh * 4 + hh;
        u32x4 qf[2];
        { const unsigned qo = (unsigned)((t0 + qi) * AW + head * HD + 8 * qd) * 2u; qf[0] = ldgo<u32x4>(qb, qo); qf[1] = ldgo<u32x4>(qb, qo + 64u); }
        const float sinkv = a.in[I_SINK][head];
        int qiv = qi; asm volatile("" : "+v"(qiv));
        const int klo = max(qiv + 1, blk > 0 ? 0 : 128); const int kjb = lo * 16 + 4 * qd - klo; const unsigned span = (unsigned)(qiv + 128 - klo);
        f32x4 s[10];
#pragma unroll
        for (int i = 0; i < 10; ++i) {
            const LAS unsigned char* kp = lds + ((lo + i) * 16 + r) * KLS + qd * 16;
            const u32x4 k0 = *(const LAS u32x4*)kp, k1 = *(const LAS u32x4*)(kp + 64);
            f32x4 z = (f32x4){0.f, 0.f, 0.f, 0.f};
            z = __builtin_amdgcn_mfma_f32_16x16x32_bf16(__builtin_bit_cast(bf16x8, k0), __builtin_bit_cast(bf16x8, qf[0]), z, 0, 0, 0);
            s[i] = __builtin_amdgcn_mfma_f32_16x16x32_bf16(__builtin_bit_cast(bf16x8, k1), __builtin_bit_cast(bf16x8, qf[1]), z, 0, 0, 0);
        }
        float mx = sinkv;
#pragma unroll
        for (int i = 0; i < 10; ++i)
#pragma unroll
            for (int g = 0; g < 4; ++g) { const bool valid = (unsigned)(kjb + (16 * i + g)) <= span; s[i][g] = valid ? s[i][g] : -1e30f; mx = fmaxf(mx, s[i][g]); }
        mx = fmaxf(mx, __shfl_xor(mx, 16)); mx = fmaxf(mx, __shfl_xor(mx, 32));
        float sum = 0.f;
#pragma unroll
        for (int i = 0; i < 10; ++i)
#pragma unroll
            for (int g = 0; g < 4; ++g) { const float p = (s[i][g] > -1e29f) ? __expf(s[i][g] - mx) : 0.f; s[i][g] = p; sum += p; }
        sum += __shfl_xor(sum, 16); sum += __shfl_xor(sum, 32);
        const float inv = 1.0f / (sum + __expf(sinkv - mx));
        f32x4 o[4];
#pragma unroll
        for (int mt = 0; mt < 4; ++mt) o[mt] = (f32x4){0.f, 0.f, 0.f, 0.f};
#pragma unroll
        for (int ip = 0; ip < 5; ++ip) {
            u32x4 pw; pw.x = cvt_pk_bf16(s[2 * ip][0], s[2 * ip][1]); pw.y = cvt_pk_bf16(s[2 * ip][2], s[2 * ip][3]); pw.z = cvt_pk_bf16(s[2 * ip + 1][0], s[2 * ip + 1][1]); pw.w = cvt_pk_bf16(s[2 * ip + 1][2], s[2 * ip + 1][3]);
            const bf16x8 pb = __builtin_bit_cast(bf16x8, pw);
#pragma unroll
            for (int mt = 0; mt < 4; ++mt) { const LAS unsigned char* vp = lds + ATT_V_OFF + (16 * mt + r) * VLS + ((lo + 2 * ip) * 16 + 4 * qd) * 2;
                const u32x2 va = *(const LAS u32x2*)vp, vb = *(const LAS u32x2*)(vp + 32);
                u32x4 vw; vw.x = va.x; vw.y = va.y; vw.z = vb.x; vw.w = vb.y;
                o[mt] = __builtin_amdgcn_mfma_f32_16x16x32_bf16(__builtin_bit_cast(bf16x8, vw), pb, o[mt], 0, 0, 0); }
        }
        const unsigned oo = (unsigned)((t0 + qi) * D + head * HD + 16 * qd) * 2u;
        pg8::stgw(ay, oo, pg8::pack8(o[0] * inv, o[1] * inv)); pg8::stgw(ay, oo + 16u, pg8::pack8(o[2] * inv, o[3] * inv));
    }
    pg8::tile_signal((unsigned*)(a.ws + WS_CTL) + CW_T2, t0 >> 8);
    __syncthreads();
}

constexpr int CBS = 516;
__device__ __forceinline__ void conv_unit(const Args& a, int unit, LAS unsigned char* lds, int tid, int wave, int lane) {
    const bf16* ab = (const bf16*)(a.ws + WS_AB); bf16* ay = (bf16*)(a.ws + WS_AY);
    LAS float* cb = (LAS float*)lds;
    const int t0 = unit * 32, prow0 = t0 + AB_PAD * ((t0 >> 12) + 1);
    int cp = tid & 255; asm volatile("" : "+v"(cp));
    const int half = wave >> 2;
    const LAS float* wl = (const LAS float*)(lds + CONV_W_OFF) + 2 * cp;
    const f32x2 cbias = *(const f32x2*)(a.in[I_CONVB] + 2 * cp);
#pragma unroll 1
    for (int it = 0; it < 2; ++it) {
        const int tl0 = 16 * half + 8 * it;
        const unsigned o0 = (unsigned)((prow0 + tl0 - 30) * CCH + 2 * cp) * 2u;
        unsigned raw[38];
#pragma unroll
        for (int rr = 0; rr < 38; ++rr) raw[rr] = ldgo<unsigned>(ab, o0 + (unsigned)(rr * CCH * 2));
        __builtin_amdgcn_sched_barrier(0);
        asm volatile("" : "+v"(raw[0]), "+v"(raw[1]), "+v"(raw[2]), "+v"(raw[3]), "+v"(raw[4]), "+v"(raw[5]), "+v"(raw[6]), "+v"(raw[7]), "+v"(raw[8]), "+v"(raw[9]),
                          "+v"(raw[10]), "+v"(raw[11]), "+v"(raw[12]), "+v"(raw[13]), "+v"(raw[14]), "+v"(raw[15]), "+v"(raw[16]), "+v"(raw[17]), "+v"(raw[18]));
        asm volatile("" : "+v"(raw[19]), "+v"(raw[20]), "+v"(raw[21]), "+v"(raw[22]), "+v"(raw[23]), "+v"(raw[24]), "+v"(raw[25]), "+v"(raw[26]), "+v"(raw[27]), "+v"(raw[28]),
                          "+v"(raw[29]), "+v"(raw[30]), "+v"(raw[31]), "+v"(raw[32]), "+v"(raw[33]), "+v"(raw[34]), "+v"(raw[35]), "+v"(raw[36]), "+v"(raw[37]));
        float i0[38], i1[38];
#pragma unroll
        for (int rr = 0; rr < 38; ++rr) { i0[rr] = bflo(raw[rr]); i1[rr] = bfhi(raw[rr]); }
        float a0[8], a1[8];
#pragma unroll
        for (int o = 0; o < 8; ++o) { a0[o] = cbias.x; a1[o] = cbias.y; }
#pragma unroll
        for (int j = 0; j < CW; ++j) { const f32x2 wv = *(const LAS f32x2*)(wl + j * CCH);
#pragma unroll
            for (int o = 0; o < 8; ++o) { a0[o] = fmaf(i0[o + j], wv.x, a0[o]); a1[o] = fmaf(i1[o + j], wv.y, a1[o]); } }
#pragma unroll
        for (int o = 0; o < 8; ++o) *(LAS f32x2*)(cb + (tl0 + o) * CBS + 2 * cp) = (f32x2){a0[o], a1[o]};
    }
    __syncthreads();
    const f32x4 g0 = *(const f32x4*)(a.in[I_CLNG] + 8 * lane), g1 = *(const f32x4*)(a.in[I_CLNG] + 8 * lane + 4), b0 = *(const f32x4*)(a.in[I_CLNB] + 8 * lane), b1 = *(const f32x4*)(a.in[I_CLNB] + 8 * lane + 4);
#pragma unroll
    for (int tt = 0; tt < 4; ++tt) { const int tok = 4 * wave + tt;
        f32x4 v0 = *(const LAS f32x4*)(cb + tok * CBS + 8 * lane), v1 = *(const LAS f32x4*)(cb + tok * CBS + 8 * lane + 4);
        const float mean = wave_sum((v0[0] + v0[1]) + (v0[2] + v0[3]) + (v1[0] + v1[1]) + (v1[2] + v1[3])) * (1.0f / CCH);
        v0 = v0 - mean; v1 = v1 - mean;
        const float var = wave_sum((v0[0] * v0[0] + v0[1] * v0[1]) + (v0[2] * v0[2] + v0[3] * v0[3]) + (v1[0] * v1[0] + v1[1] * v1[1]) + (v1[2] * v1[2] + v1[3] * v1[3])) * (1.0f / CCH);
        const float rstd = 1.0f / sqrtf(var + LN_EPS);
        float y[8];
#pragma unroll
        for (int j = 0; j < 4; ++j) { const float y0 = v0[j] * rstd * g0[j] + b0[j], y1 = v1[j] * rstd * g1[j] + b1[j]; y[j] = y0 * sigmoidf_(y0); y[4 + j] = y1 * sigmoidf_(y1); }
        u32x4 wv; wv.x = cvt_pk_bf16(y[0], y[1]); wv.y = cvt_pk_bf16(y[2], y[3]); wv.z = cvt_pk_bf16(y[4], y[5]); wv.w = cvt_pk_bf16(y[6], y[7]);
        pg8::stgw(ay, (unsigned)((t0 + tok) * D + 512 + 8 * lane) * 2u, wv); }
    pg8::tile_signal((unsigned*)(a.ws + WS_CTL) + CW_T2, t0 >> 8);
    __syncthreads();
}

constexpr int HLS = 1025;
__device__ __forceinline__ void route_chunk(const Args& a, int chunk, LAS unsigned char* lds, int tid, int wave, int lane, const float (&bw)[64], const f32x4 (&g)[4], const f32x4 (&bb)[4]) {
    const bf16* hf = (const bf16*)(a.ws + WS_HF); unsigned char* hb = a.ws + WS_HB;
    int* slot = (int*)(a.ws + WS_SLOT); float* gatev = (float*)(a.ws + WS_GATE); unsigned* cursor = (unsigned*)(a.ws + WS_CTL);
    LAS float* hl = (LAS float*)lds;
    LAS float* lg = (LAS float*)(lds + MISC_OFF + MO_LG); LAS int* sel_e = (LAS int*)(lds + MISC_OFF + MO_SELE); LAS float* sel_g = (LAS float*)(lds + MISC_OFF + MO_SELG);
    LAS int* lcnt = (LAS int*)(lds + MISC_OFF + MO_LCNT); LAS int* lbase = (LAS int*)(lds + MISC_OFF + MO_LBASE);
    const int t0 = chunk * 32;
    f32x4 v[4][4];
    { u32x2 rw[4][4];
#pragma unroll
      for (int tt = 0; tt < 4; ++tt)
#pragma unroll
        for (int j = 0; j < 4; ++j) rw[tt][j] = *((const u32x2*)(hf + (size_t)(t0 + 4 * wave + tt) * D) + lane + 64 * j);
      __builtin_amdgcn_sched_barrier(0);
      asm volatile("" : "+v"(rw[0][0]), "+v"(rw[0][1]), "+v"(rw[0][2]), "+v"(rw[0][3]), "+v"(rw[1][0]), "+v"(rw[1][1]), "+v"(rw[1][2]), "+v"(rw[1][3]),
                        "+v"(rw[2][0]), "+v"(rw[2][1]), "+v"(rw[2][2]), "+v"(rw[2][3]), "+v"(rw[3][0]), "+v"(rw[3][1]), "+v"(rw[3][2]), "+v"(rw[3][3]));
#pragma unroll
      for (int tt = 0; tt < 4; ++tt)
#pragma unroll
        for (int j = 0; j < 4; ++j) v[tt][j] = (f32x4){bflo(rw[tt][j].x), bfhi(rw[tt][j].x), bflo(rw[tt][j].y), bfhi(rw[tt][j].y)}; }
#pragma unroll
    for (int tt = 0; tt < 4; ++tt) { const int tl = 4 * wave + tt;
        float sm = 0.f;
#pragma unroll
        for (int j = 0; j < 4; ++j) sm += (v[tt][j][0] + v[tt][j][1]) + (v[tt][j][2] + v[tt][j][3]);
        const float mean = wave_sum(sm) * (1.0f / D); float s2 = 0.f;
#pragma unroll
        for (int j = 0; j < 4; ++j) { v[tt][j] = v[tt][j] - mean; s2 += (v[tt][j][0] * v[tt][j][0] + v[tt][j][1] * v[tt][j][1]) + (v[tt][j][2] * v[tt][j][2] + v[tt][j][3] * v[tt][j][3]); }
        const float rstd = 1.0f / sqrtf(wave_sum(s2) * (1.0f / D) + LN_EPS);
        if (lane == 0) *(f32x2*)((float*)(a.ws + WS_LN1S) + 2 * (size_t)(t0 + tl)) = (f32x2){mean, rstd};
#pragma unroll
        for (int j = 0; j < 4; ++j) { const f32x4 h = v[tt][j] * rstd * g[j] + bb[j];
            unsigned wv = 0u; wv = __builtin_amdgcn_cvt_pk_fp8_f32(h[0] * 8.0f, h[1] * 8.0f, wv, false); wv = __builtin_amdgcn_cvt_pk_fp8_f32(h[2] * 8.0f, h[3] * 8.0f, wv, true); *((unsigned*)(hb + (size_t)(t0 + tl) * D) + lane + 64 * j) = wv;
            LAS float* hp = hl + tl * HLS + 4 * lane + 256 * j; hp[0] = h[0]; hp[1] = h[1]; hp[2] = h[2]; hp[3] = h[3]; }
    }
    if (tid < 32) lcnt[tid] = 0;
    __syncthreads();
    f32x16 acc;
#pragma unroll
    for (int i = 0; i < 16; ++i) acc[i] = 0.f;
    { const int tok = lane & 31, kp = lane >> 5; const LAS float* hp = hl + tok * HLS + 128 * wave + kp;
#pragma unroll
      for (int s = 0; s < 64; ++s) acc = __builtin_amdgcn_mfma_f32_32x32x2f32(hp[2 * s], bw[s], acc, 0, 0, 0); }
    __syncthreads();
    { LAS float* part = hl + wave * 1024;
#pragma unroll
      for (int i = 0; i < 16; ++i) { const int rowi = (i & 3) + 8 * (i >> 2) + 4 * (lane >> 5); part[rowi * 32 + (lane & 31)] = acc[i]; } }
    __syncthreads();
    for (int o = tid; o < 1024; o += 512) { float sm = a.in[I_BR][o & 31];
#pragma unroll
        for (int w = 0; w < 8; ++w) sm += hl[w * 1024 + o];
        lg[(o >> 5) * 33 + (o & 31)] = sm; }
    __syncthreads();
    if (tid < 32) { float v[NE];
#pragma unroll
        for (int e = 0; e < NE; ++e) v[e] = lg[tid * 33 + e];
        float tv[4]; int ti[4];
#pragma unroll
        for (int k = 0; k < 4; ++k) { float best = -3.0e38f; int bi = 0;
#pragma unroll
            for (int e = 0; e < NE; ++e) { const bool take = v[e] > best; best = take ? v[e] : best; bi = take ? e : bi; }
            tv[k] = best; ti[k] = bi;
#pragma unroll
            for (int e = 0; e < NE; ++e) v[e] = (e == bi) ? -3.0e38f : v[e]; }
        const float e1 = __expf(tv[1] - tv[0]), e2 = __expf(tv[2] - tv[0]), e3 = __expf(tv[3] - tv[0]); const float inv = 1.0f / (1.0f + e1 + e2 + e3);
        sel_e[4 * tid + 0] = ti[0]; sel_e[4 * tid + 1] = ti[1]; sel_e[4 * tid + 2] = ti[2]; sel_e[4 * tid + 3] = ti[3];
        sel_g[4 * tid + 0] = inv; sel_g[4 * tid + 1] = e1 * inv; sel_g[4 * tid + 2] = e2 * inv; sel_g[4 * tid + 3] = e3 * inv; }
    __syncthreads();
    int my_e = 0, my_rank = 0;
    if (tid < 128) { my_e = sel_e[tid]; my_rank = atomicAdd((int*)&lcnt[my_e], 1); }
    __syncthreads();
    if (tid < 32) { const int c = lcnt[tid]; lbase[tid] = c > 0 ? (int)atomicAdd(cursor + tid, (unsigned)c) : 0; }
    __syncthreads();
    if (tid < 128) { const int asg = (t0 + (tid >> 2)) * 4 + (tid & 3); slot[my_e * SLOT_CAP + lbase[my_e] + my_rank] = asg; gatev[asg] = sel_g[tid]; }
    __syncthreads();
}

__device__ __forceinline__ void combine_row(const Args& a, int m, int lane) {
    const bf16* hf = (const bf16*)(a.ws + WS_HF); const unsigned char* ys = a.ws + WS_YS; const float* gatev = (const float*)(a.ws + WS_GATE);
    f32x4 gt = *(const f32x4*)(gatev + 4 * (size_t)m); gt = gt * (1.0f / 16.0f);
    const f32x2 st = *(const f32x2*)((const float*)(a.ws + WS_LN1S) + 2 * (size_t)m);
    f32x4 v[4]; float sm = 0.f;
#pragma unroll
    for (int j = 0; j < 4; ++j) { const f32x4 g1 = *((const f32x4*)a.in[I_LN1G] + lane + 64 * j), b1 = *((const f32x4*)a.in[I_LN1B] + lane + 64 * j);
        const u32x2 pw = *((const u32x2*)(hf + (size_t)m * D) + lane + 64 * j); f32x4 p = (f32x4){bflo(pw.x), bfhi(pw.x), bflo(pw.y), bfhi(pw.y)}; p = p - st.x; const f32x4 h = p * st.y * g1 + b1;
        v[j] = h * DN_ALPHA;
#pragma unroll
        for (int k = 0; k < 4; ++k) { const unsigned y = *((const unsigned*)(ys + ((size_t)m * 4 + k) * D) + lane + 64 * j); const float gk = gt[k];
            const f32x2 lo = __builtin_amdgcn_cvt_pk_f32_fp8(y, false), hi = __builtin_amdgcn_cvt_pk_f32_fp8(y, true);
            v[j][0] += gk * lo.x; v[j][1] += gk * lo.y; v[j][2] += gk * hi.x; v[j][3] += gk * hi.y; }
        sm += (v[j][0] + v[j][1]) + (v[j][2] + v[j][3]); }
    const float mean = wave_sum(sm) * (1.0f / D); float s2 = 0.f;
#pragma unroll
    for (int j = 0; j < 4; ++j) { v[j] = v[j] - mean; s2 += (v[j][0] * v[j][0] + v[j][1] * v[j][1]) + (v[j][2] * v[j][2] + v[j][3] * v[j][3]); }
    const float rstd = 1.0f / sqrtf(wave_sum(s2) * (1.0f / D) + LN_EPS);
#pragma unroll
    for (int j = 0; j < 4; ++j) { const f32x4 g = *((const f32x4*)a.in[I_LN2G] + lane + 64 * j), bb = *((const f32x4*)a.in[I_LN2B] + lane + 64 * j);
        *((f32x4*)(a.out + (size_t)m * D) + lane + 64 * j) = v[j] * rstd * g + bb; }
}

__global__ void __launch_bounds__(512, 2) fwd_megakernel(Args args) {
    extern __shared__ __attribute__((aligned(16))) unsigned char lds_raw[];
    LAS unsigned char* lds = (LAS unsigned char*)lds_raw;
    const int tid = threadIdx.x, wave = __builtin_amdgcn_readfirstlane(tid >> 6);
#define FRESH_LANE int lane; { int t_ = tid; asm volatile("" : "+v"(t_)); lane = t_ & 63; }
    const int G = gridDim.x, bx = blockIdx.x;
    const int vcu = (G % 8 == 0) ? (bx % 8) * (G / 8) + bx / 8 : bx;
    const int gw = vcu * 8 + wave, NGW = G * 8;
    const int lo = args.ph_lo, hi = args.ph_hi;
    unsigned char* ws = args.ws;
    volatile LAS unsigned* bst = (volatile LAS unsigned*)(lds + MISC_OFF + MO_BAR);
    if (tid < 2) bst[tid] = 0u;
    __syncthreads();
    XcdBarrier xbar = xcd_barrier_post((unsigned*)(ws + WS_CTL) + CW_BAR, bst);
#ifndef PMASK
#define PMASK 0x1ff
#endif
#define IN(k) (((PMASK >> (k)) & 1) && lo <= (k) && (k) < hi)
#define SEAM(k) do { if (lo <= (k) && (k) + 1 < hi) xcd_barrier(xbar); } while (0)

    if (IN(0)) { FRESH_LANE; p0_prologue(args, lds, gw, NGW, lane, wave); }
    SEAM(0);
    if (IN(1)) {
        pg8::DenseOrder S; S.init(ws + WS_XB, ws + WS_WIN, T, INW, G, bx);
        pg8::EpiU E{(bf16*)(ws + WS_QB), (bf16*)(ws + WS_KB), (bf16*)(ws + WS_VT), (bf16*)(ws + WS_AB), (bf16*)(ws + WS_GATES), (const float*)(ws + WS_BPERM), (unsigned*)(ws + WS_CTL) + CW_T1};
        const int slot = vcu & 3;
        S.i0 = 0; S.i1 = slot;
        pg8::gemm_phase<pg8::EpiU, pg8::DenseOrder>(lds, S, E);
        { FRESH_LANE; side_convert_dma(args, bx, G, wave, lane, lds); }
        __syncthreads();
        S.i0 = slot; S.i1 = 1 << 20;
        pg8::gemm_phase<pg8::EpiU, pg8::DenseOrder>(lds, S, E);
    }
    if (IN(2)) {
        FRESH_LANE;
        __syncthreads();
        for (int i = tid; i < CW * CCH / 4; i += 512) ((LAS f32x4*)(lds + CONV_W_OFF))[i] = ((const f32x4*)args.in[I_CONVW])[i];
        __syncthreads();
        for (int u = vcu; u < 256 + 512; u += G) {
            if (lo <= 1) { const int tq = u < 256 ? (u >> 6) * SEQ + ((u >> 1) & 31) * 128 : (u - 256) * 32, back = u < 256 ? 128 : 30;
                if (tid == 0) { const int m1 = tq >> 8, tb = tq - back, m0 = (tb >> 12) == (tq >> 12) && tb >= 0 ? tb >> 8 : m1;
                    pg8::tile_wait((const unsigned*)(ws + WS_CTL) + CW_T1, m1, 120u, (unsigned*)(ws + WS_CTL) + 64);
                    if (m0 != m1) pg8::tile_wait((const unsigned*)(ws + WS_CTL) + CW_T1, m0, 120u, (unsigned*)(ws + WS_CTL) + 64); }
                __syncthreads(); }
            if (u < 256) attn_unit(args, u, lds, tid, wave, lane);
            else conv_unit(args, u - 256, lds, tid, wave, lane);
        }
    }
    if (IN(3)) {
        pg8::DenseOrder S; S.init(ws + WS_AY, ws + WS_WAB, T, D, G, bx);
        pg8::EpiMerged E{(const bf16*)(ws + WS_GATES), args.in[I_BCONV], (bf16*)(ws + WS_MERGED), (unsigned*)(ws + WS_CTL) + CW_T3};
        if (lo <= 2) { __syncthreads();
            if (tid == 0) { pg8::Unit u0; for (int i = 0; S.next(i, u0); ++i) pg8::tile_wait((const unsigned*)(ws + WS_CTL) + CW_T2, u0.pm, 96u, (unsigned*)(ws + WS_CTL) + 64); }
            __syncthreads(); }
        pg8::gemm_phase<pg8::EpiMerged, pg8::DenseOrder>(lds, S, E);
    }
    if (IN(4)) {
        pg8::DenseOrder S; S.init(ws + WS_MERGED, ws + WS_WO, T, D, G, bx);
        pg8::EpiPre1 E{(const bf16*)(ws + WS_XB), (bf16*)(ws + WS_HF), (unsigned*)(ws + WS_CTL) + CW_T4};
        if (lo <= 3) { __syncthreads();
            if (tid == 0) { pg8::Unit u0; for (int i = 0; S.next(i, u0); ++i) pg8::tile_wait((const unsigned*)(ws + WS_CTL) + CW_T3, u0.pm, 32u, (unsigned*)(ws + WS_CTL) + 64); }
            __syncthreads(); }
        pg8::gemm_phase<pg8::EpiPre1, pg8::DenseOrder>(lds, S, E);
    }
    if (IN(5)) {
        FRESH_LANE;
        __syncthreads();
        if (lo <= 4) { if (tid == 0) { for (int c = vcu; c < T / 32; c += G) pg8::tile_wait((const unsigned*)(ws + WS_CTL) + CW_T4, c >> 3, 32u, (unsigned*)(ws + WS_CTL) + 64); }
            __syncthreads(); }
        float bw[64]; f32x4 g1[4], b1[4];
#pragma unroll
        for (int s_ = 0; s_ < 64; ++s_) bw[s_] = args.in[I_WR][(size_t)(128 * wave + 2 * s_ + (lane >> 5)) * NE + (lane & 31)];
#pragma unroll
        for (int j = 0; j < 4; ++j) { g1[j] = *((const f32x4*)args.in[I_LN1G] + lane + 64 * j); b1[j] = *((const f32x4*)args.in[I_LN1B] + lane + 64 * j); }
        for (int c = vcu; c < T / 32; c += G) route_chunk(args, c, lds, tid, wave, lane, bw, g1, b1);
    }
    SEAM(5);
    if (IN(6) || IN(7)) {
        LAS int* tab = (LAS int*)(lds + MISC_OFF + MO_TAB);
        __syncthreads();
        if (tid == 0) { const unsigned* cursor = (const unsigned*)(ws + WS_CTL); int acc = 0;
            for (int e = 0; e < NE; ++e) { const int c = (int)__hip_atomic_load(cursor + e, __ATOMIC_RELAXED, __HIP_MEMORY_SCOPE_AGENT); tab[e] = c; const int ml = (c + 255) >> 8; tab[32 + e] = ml; tab[64 + e] = acc; acc += ml; }
            tab[64 + NE] = acc; }
        __syncthreads();
        const int total_mt = tab[64 + NE];
        if (IN(6)) {
            unsigned* ctl = (unsigned*)(ws + WS_CTL);
            pg8::MoeFusedOrder S{tab, G, vcu, total_mt * 8, total_mt * 4, (const char*)(ws + WS_HB), (const char*)(ws + WS_ACT), (const char*)(ws + WS_WUP), (const char*)(ws + WS_WDN), (const int*)(ws + WS_SLOT), ctl + 8192, ctl + 64};
            pg8::EpiMoe E{pg8::EpiUpX{args.in[I_BUP], ws + WS_ACT}, pg8::EpiDown{args.in[I_BDN], (const int*)(ws + WS_SLOT), ws + WS_YS}};
            pg8::gemm_phase<pg8::EpiMoe, pg8::MoeFusedOrder, true>(lds, S, E);
        }
    }
    SEAM(7);
    if (IN(8)) { FRESH_LANE; for (int m = gw; m < T; m += NGW) combine_row(args, m, lane); }

#undef IN
#undef SEAM
#undef FRESH_LANE
}

extern "C" void kernel_launch(void* const* d_in, const int* in_sizes, int n_in, void* d_out, int out_size, void* d_ws, size_t ws_size, hipStream_t stream) {
    static int grid = 0;
    if (grid == 0) {
        if (n_in != 22 || out_size != T * D || ws_size < WS_END) { fprintf(stderr, "kernel_launch: unexpected problem (n_in %d, out %d, ws %zu)\n", n_in, out_size, ws_size); grid = -1; return; }
        int dev = 0, cus = 0, per_cu = 0;
        hipGetDevice(&dev); hipDeviceGetAttribute(&cus, hipDeviceAttributeMultiprocessorCount, dev);
        hipFuncSetAttribute((const void*)fwd_megakernel, hipFuncAttributeMaxDynamicSharedMemorySize, LDS_BYTES);
        hipOccupancyMaxActiveBlocksPerMultiprocessor(&per_cu, (const void*)fwd_megakernel, 512, LDS_BYTES);
        if (per_cu < 1) { fprintf(stderr, "kernel_launch: occupancy query says %d blocks per CU\n", per_cu); per_cu = 1; }
        (void)hipGetLastError();
        grid = cus * 1;
        fprintf(stderr, "kernel_launch: grid %d (cus %d, occupancy %d)\n", grid, cus, per_cu);
    }
    if (grid < 0) return;
    hipMemsetAsync((char*)d_ws + WS_CTL, 0, 65536, stream);
    Args a{};
    for (int i = 0; i < 22; ++i) a.in[i] = (const float*)d_in[i];
    a.out = (float*)d_out; a.ws = (unsigned char*)d_ws; a.ph_lo = 0; a.ph_hi = 9;
    void* kargs[] = {&a};
    hipError_t e = hipLaunchCooperativeKernel((const void*)fwd_megakernel, dim3(grid), dim3(512), kargs, LDS_BYTES, stream);
    if (e != hipSuccess) fprintf(stderr, "cooperative launch failed: %s (grid %d)\n", hipGetErrorString(e), grid);
}
```

```cpp
#include <hip/hip_runtime.h>
#include <cstdio>
#include <cstdint>

#define GAS __attribute__((address_space(1)))
#define LAS __attribute__((address_space(3)))
typedef unsigned short bf16;
typedef short bf16x8 __attribute__((ext_vector_type(8)));
typedef float f32x4 __attribute__((ext_vector_type(4)));
typedef float f32x2 __attribute__((ext_vector_type(2)));
typedef float f32x16 __attribute__((ext_vector_type(16)));
typedef unsigned u32x4 __attribute__((ext_vector_type(4)));
typedef unsigned u32x2 __attribute__((ext_vector_type(2)));

constexpr int T = 16384, D = 1024, SEQ = 4096, NBATCH = 4;
constexpr int NH = 8, NKV = 2, HD = 64, AW = 512, KVW = 128, CCH = 512, CW = 31;
constexpr int INW = 3840, NE = 32, TOPK = 4, DE = 1024;
constexpr float LN_EPS = 1e-5f;
constexpr float DN_ALPHA = 1.189207115002721f;
constexpr int SLOT_CAP = 16384;
constexpr int MAX_MT = (T * TOPK) / 256 + NE;

constexpr size_t MiB = 1u << 20;
constexpr size_t WS_CTL = 0, CTL_BYTES = 65536;
constexpr int CW_INIT = 16380; constexpr unsigned CTL_MAGIC = 0x1CEB00DAu;
constexpr int CW_BAR = 4096, CW_T3 = 13312, CW_T4 = 14336, CW_T2 = 15360, CW_T1 = 1024;
constexpr size_t WS_WIN = 1 * MiB;
constexpr size_t WS_WAB = 9 * MiB;
constexpr size_t WS_WO = 11 * MiB;
constexpr size_t WS_BPERM = 13 * MiB;
constexpr size_t WS_SLOT = 14 * MiB;
constexpr size_t WS_GATE = 16 * MiB;
constexpr size_t WS_LN1S = 17 * MiB;
constexpr size_t WS_WUP = 32 * MiB;
constexpr size_t WS_WDN = 160 * MiB;
constexpr size_t WS_XB = 224 * MiB;
constexpr size_t WS_QB = 256 * MiB;
constexpr size_t WS_KB = 272 * MiB;
constexpr size_t WS_VT = 276 * MiB;
constexpr size_t WS_AB = 792 * MiB;
constexpr size_t WS_GATES = 296 * MiB;
constexpr size_t WS_AY = 360 * MiB;
constexpr size_t WS_MERGED = 392 * MiB;
constexpr size_t WS_HF = 424 * MiB;
constexpr size_t WS_HB = 488 * MiB;
constexpr size_t WS_ACT = 520 * MiB;
constexpr size_t WS_YS = 664 * MiB;
constexpr size_t WS_END = 810 * MiB;
constexpr int AB_PAD = 32, AB_SEQ = SEQ + AB_PAD;

constexpr int LDS_SCR = 135168;
constexpr int MISC_OFF = 135168;
constexpr int MO_LG = 0, MO_SELE = 8448, MO_SELG = 9472, MO_LCNT = 10496, MO_LBASE = 10624, MO_TAB = 10752, MO_BAR = 11264, MO_RDY = 11328;
constexpr int OFFN_OFF = 147456;
constexpr int LDS_BYTES = 155648;

#define LDS_WAIT() asm volatile("s_waitcnt lgkmcnt(0)" ::: "memory")
#define VM_WAIT() asm volatile("s_waitcnt vmcnt(0)" ::: "memory")

__device__ __forceinline__ unsigned f2bf(float f) { unsigned u = __builtin_bit_cast(unsigned, f); return (u + 0x7fffu + ((u >> 16) & 1u)) >> 16; }
__device__ __forceinline__ unsigned pk2(float lo, float hi) { return f2bf(lo) | (f2bf(hi) << 16); }
__device__ __forceinline__ float bf2f(unsigned b) { return __builtin_bit_cast(float, b << 16); }
__device__ __forceinline__ float bflo(unsigned w) { return __builtin_bit_cast(float, w << 16); }
__device__ __forceinline__ float bfhi(unsigned w) { return __builtin_bit_cast(float, w & 0xffff0000u); }
typedef __bf16 bf16x2_t __attribute__((ext_vector_type(2)));
__device__ __forceinline__ unsigned cvt_pk_bf16(float lo, float hi) { const f32x2 v = {lo, hi}; return __builtin_bit_cast(unsigned, __builtin_convertvector(v, bf16x2_t)); }
__device__ __forceinline__ float sigmoidf_(float x) { return __builtin_amdgcn_rcpf(1.0f + __expf(-x)); }
#define DPP_ADD(v, ctrl) ((v) + __builtin_bit_cast(float, __builtin_amdgcn_update_dpp(0, __builtin_bit_cast(int, (v)), (ctrl), 0xf, 0xf, true)))
__device__ __forceinline__ float wave_sum(float v) {
    v = DPP_ADD(v, 0xB1);
    v = DPP_ADD(v, 0x4E);
    v = DPP_ADD(v, 0x141);
    v = DPP_ADD(v, 0x140);
    const int vi = __builtin_bit_cast(int, v);
    const float r0 = __builtin_bit_cast(float, __builtin_amdgcn_readlane(vi, 0)), r1 = __builtin_bit_cast(float, __builtin_amdgcn_readlane(vi, 16));
    const float r2 = __builtin_bit_cast(float, __builtin_amdgcn_readlane(vi, 32)), r3 = __builtin_bit_cast(float, __builtin_amdgcn_readlane(vi, 48));
    return (r0 + r1) + (r2 + r3);
}
template <class V> __device__ __forceinline__ V ldgo(const void* base, unsigned off) { return *(const V*)((const char*)base + off); }
#define PIN10(a) asm volatile("" : "+v"((a)[0]), "+v"((a)[1]), "+v"((a)[2]), "+v"((a)[3]), "+v"((a)[4]), "+v"((a)[5]), "+v"((a)[6]), "+v"((a)[7]), "+v"((a)[8]), "+v"((a)[9]))

struct Args { const float* in[22]; float* out; unsigned char* ws; int ph_lo, ph_hi; };
enum { I_X = 0, I_WIN, I_BIN, I_SINK, I_WATT, I_CONVW, I_CONVB, I_CLNG, I_CLNB, I_WCONV, I_BCONV, I_WO, I_LN1G, I_LN1B, I_WR, I_BR, I_WUP, I_BUP, I_WDN, I_BDN, I_LN2G, I_LN2B };
constexpr int CVI_UP = NE * 64, CVI_DN = NE * 32, CVI_ITEMS = CVI_UP + CVI_DN;
__device__ __forceinline__ void cvi_decode(const Args& a, int it, const float*& src, unsigned char*& dst, int& nw) {
    if (it < CVI_UP) { const int e = it >> 6, kg = it & 63; nw = 2048; src = a.in[I_WUP] + ((size_t)e * 1024 + 16 * kg) * 2048; dst = a.ws + WS_WUP + (size_t)e * 2048 * 1024 + (size_t)kg * 2048 * 16; }
    else { const int r = it - CVI_UP, e = r >> 5, kg2 = r & 31; nw = 1024; src = a.in[I_WDN] + ((size_t)e * 1024 + 32 * kg2) * 1024; dst = a.ws + WS_WDN + (size_t)e * 1024 * 1024 + (size_t)kg2 * 2 * 1024 * 16; }
}
__device__ __forceinline__ void cvi_slice_ptrs(const Args& a, int it, int wave, int lane, const float*& sp, unsigned& pitch, unsigned char*& dp) {
    const float* src; unsigned char* dst; int nw; cvi_decode(a, it, src, dst, nw);
    const int g = nw == 2048 ? 0 : (wave >> 2), cw = nw == 2048 ? wave : (wave & 3);
    sp = src + (size_t)(16 * g) * nw + 256 * cw + 4 * lane; pitch = (unsigned)nw;
    dp = dst + ((size_t)g * nw + 256 * cw + 4 * lane) * 16;
}
__device__ __forceinline__ void cvi_slice_load(const float* sp, unsigned pitch, f32x4 (&r)[16]) {
#pragma unroll
    for (int kk = 0; kk < 16; ++kk) r[kk] = __builtin_nontemporal_load((const f32x4*)(sp + (size_t)kk * pitch));
}
__device__ __forceinline__ void cvi_slice_out(unsigned char* dp, f32x4 (&r)[16]) {
    asm volatile("" : "+v"(r[0]), "+v"(r[1]), "+v"(r[2]), "+v"(r[3]), "+v"(r[4]), "+v"(r[5]), "+v"(r[6]), "+v"(r[7]), "+v"(r[8]), "+v"(r[9]), "+v"(r[10]), "+v"(r[11]), "+v"(r[12]), "+v"(r[13]), "+v"(r[14]), "+v"(r[15]));
#pragma unroll
    for (int j = 0; j < 4; ++j) { unsigned w[4];
#pragma unroll
        for (int c = 0; c < 4; ++c) { unsigned x = 0u; x = __builtin_amdgcn_cvt_pk_fp8_f32(r[4 * c][j] * 64.0f, r[4 * c + 1][j] * 64.0f, x, false);
            x = __builtin_amdgcn_cvt_pk_fp8_f32(r[4 * c + 2][j] * 64.0f, r[4 * c + 3][j] * 64.0f, x, true); w[c] = x; }
        *(u32x4*)(dp + 16 * j) = (u32x4){w[0], w[1], w[2], w[3]}; }
}
__device__ __forceinline__ void side_convert(const Args& a, int bx, int G, int wave, int lane) {
    int base, nit;
    if (G == 256) { base = bx < 192 ? 11 * bx : 2112 + 15 * (bx - 192); nit = bx < 192 ? 11 : 15; }
    else { const int per = (CVI_ITEMS + G - 1) / G; base = bx * per; nit = base >= CVI_ITEMS ? 0 : (CVI_ITEMS - base < per ? CVI_ITEMS - base : per); }
    const int end = base + nit;
    f32x4 r0[16], r1[16];
    const float* sp0; const float* sp1; unsigned p0 = 0, p1 = 0; unsigned char* d0; unsigned char* d1;
    if (nit > 0) { cvi_slice_ptrs(a, base, wave, lane, sp0, p0, d0); cvi_slice_load(sp0, p0, r0); }
    if (nit > 1) { cvi_slice_ptrs(a, base + 1, wave, lane, sp1, p1, d1); cvi_slice_load(sp1, p1, r1); }
#pragma unroll 1
    for (int it0 = base; it0 < end; it0 += 2) {
        const int it1 = it0 + 1;
        { unsigned char* dcur = d0; cvi_slice_out(dcur, r0); if (it0 + 2 < end) { cvi_slice_ptrs(a, it0 + 2, wave, lane, sp0, p0, d0); cvi_slice_load(sp0, p0, r0); } }
        if (it1 >= end) break;
        { unsigned char* dcur = d1; cvi_slice_out(dcur, r1); if (it1 + 2 < end) { cvi_slice_ptrs(a, it1 + 2, wave, lane, sp1, p1, d1); cvi_slice_load(sp1, p1, r1); } }
    }
}

__device__ __forceinline__ void side_convert_dma(const Args& a, int bx, int G, int wave, int lane, LAS unsigned char* lds) {
    int base, nit;
    if (G == 256) { base = bx < 192 ? 11 * bx : 2112 + 15 * (bx - 192); nit = bx < 192 ? 11 : 15; }
    else { const int per = (CVI_ITEMS + G - 1) / G; base = bx * per; nit = base >= CVI_ITEMS ? 0 : (CVI_ITEMS - base < per ? CVI_ITEMS - base : per); }
    const int end = base + nit;
    LAS unsigned char* wb = lds + wave * 16384;
    const float* sp; unsigned pitch = 0; unsigned char* dnext = nullptr;
#define CVD_DMA(h) do { _Pragma("unroll") for (int kk = 8 * (h); kk < 8 * (h) + 8; ++kk) \
        __builtin_amdgcn_global_load_lds((const unsigned*)(sp + (size_t)kk * pitch), (LAS unsigned*)(wb + kk * 1024), 16, 0, 2); } while (0)
    if (nit > 0) { cvi_slice_ptrs(a, base, wave, lane, sp, pitch, dnext); CVD_DMA(0); CVD_DMA(1); }
#pragma unroll 1
    for (int it = base; it < end; ++it) {
        unsigned char* dcur = dnext;
        f32x4 r[16];
        asm volatile("s_waitcnt vmcnt(8)" ::: "memory");
#pragma unroll
        for (int kk = 0; kk < 8; ++kk) r[kk] = *(const LAS f32x4*)(wb + kk * 1024 + lane * 16);
        asm volatile("s_waitcnt lgkmcnt(0)" ::: "memory");
        asm volatile("" : "+v"(r[0]), "+v"(r[1]), "+v"(r[2]), "+v"(r[3]), "+v"(r[4]), "+v"(r[5]), "+v"(r[6]), "+v"(r[7]));
        const bool more = it + 1 < end;
        if (more) { cvi_slice_ptrs(a, it + 1, wave, lane, sp, pitch, dnext); CVD_DMA(0); }
        if (more) asm volatile("s_waitcnt vmcnt(8)" ::: "memory"); else asm volatile("s_waitcnt vmcnt(0)" ::: "memory");
#pragma unroll
        for (int kk = 8; kk < 16; ++kk) r[kk] = *(const LAS f32x4*)(wb + kk * 1024 + lane * 16);
        asm volatile("s_waitcnt lgkmcnt(0)" ::: "memory");
        asm volatile("" : "+v"(r[8]), "+v"(r[9]), "+v"(r[10]), "+v"(r[11]), "+v"(r[12]), "+v"(r[13]), "+v"(r[14]), "+v"(r[15]));
        if (more) CVD_DMA(1);
        cvi_slice_out(dcur, r);
    }
#undef CVD_DMA
    asm volatile("s_waitcnt vmcnt(0)" ::: "memory");
}

namespace pg8 {
constexpr int BM = 256, BK = 64, HALF = 128, HTB = HALF * BK * 2, STAGE_BYTES = 8 * HTB, NXCD = 8, WGM = 8;
constexpr int KD = 1024, NT_K = KD / BK;
__device__ __forceinline__ void stgw(void* base, unsigned off, u32x4 v) { __builtin_amdgcn_raw_buffer_store_b128(v, __builtin_amdgcn_make_buffer_rsrc(base, 0, 0x7FFFFFFF, 0x00020000), off, 0, 16); }
__device__ __forceinline__ void stgw8(void* base, unsigned off, u32x2 v) { __builtin_amdgcn_raw_buffer_store_b64(v, __builtin_amdgcn_make_buffer_rsrc(base, 0, 0x7FFFFFFF, 0x00020000), off, 0, 16); }
__device__ __forceinline__ void stgw4(void* base, unsigned off, unsigned v) { __builtin_amdgcn_raw_buffer_store_b32(v, __builtin_amdgcn_make_buffer_rsrc(base, 0, 0x7FFFFFFF, 0x00020000), off, 0, 16); }
__device__ __forceinline__ void tile_signal(unsigned* cnt, int pm) { asm volatile("s_waitcnt vmcnt(0)" ::: "memory"); if ((threadIdx.x & 63) == 0) __hip_atomic_fetch_add(cnt + 16 * pm, 1u, __ATOMIC_RELAXED, __HIP_MEMORY_SCOPE_AGENT); }
__device__ __forceinline__ void tile_signal_nowait(const unsigned* cnt, int pm) {
    if ((threadIdx.x & 63) == 0) { unsigned off_ = 64u * (unsigned)pm, one_ = 1u; asm volatile("global_atomic_add %0, %1, %2" :: "v"(off_), "v"(one_), "s"(cnt) : "memory"); }
}
__device__ __forceinline__ void tile_wait(const unsigned* cnt, int pm, unsigned need, unsigned* tmo) {
    unsigned spins = 0u;
    while (__hip_atomic_load(cnt + 16 * pm, __ATOMIC_RELAXED, __HIP_MEMORY_SCOPE_AGENT) < need) { __builtin_amdgcn_s_sleep(2); if (++spins > (1u << 20)) { __hip_atomic_store(tmo, 1u, __ATOMIC_RELAXED, __HIP_MEMORY_SCOPE_AGENT); break; } }
}
__host__ __device__ __forceinline__ int lds_byte(int r, int c) { const int st = (r >> 4) * 2 + (c >> 5), rr = r & 15, cc = c & 31, ob = rr * 64 + cc * 2; return st * 1024 + (ob ^ (((ob >> 9) & 1) << 5)); }
__host__ __device__ __forceinline__ void stage_rc(int b, int& R, int& C) { const int st = b / 1024, sb = b % 1024, swz = sb ^ (((sb >> 9) & 1) << 5); R = (st >> 1) * 16 + swz / 64; C = (st & 1) * 32 + (swz % 64) / 2; }
__host__ __device__ __forceinline__ int perm32(int rho) { const int n = rho >> 4, i = rho & 15; return 8 * (i >> 2) + 4 * n + (i & 3); }

struct Unit { const char* A; const char* B; int pm, pn, e, mt, cnt, type; };

struct DenseOrder {
    const char* Ab; const char* Bb; int nM, nN, nwg, G, c, i0 = 0, i1 = 1 << 20; static constexpr int rowb = KD * 2; static constexpr bool PARK = false, FUSED = false;
    __device__ __forceinline__ unsigned boff(int Rb, int C) const { return (unsigned)(Rb * rowb + C * 2); }
    __device__ __forceinline__ size_t bstep_k() const { return 128; }
    __device__ __forceinline__ size_t bstep_h() const { return (size_t)HALF * rowb; }
    __device__ void init(const void* A, const void* B, int M, int N, int G_, int c_) { Ab = (const char*)A; Bb = (const char*)B; nM = M / BM; nN = N / BM; nwg = nM * nN; G = G_; c = c_; }
    __device__ __forceinline__ bool next(int i, Unit& u) const {
        if (i + i0 >= i1) return false;
        const long L = (long)(i + i0) * G + c; if (L >= nwg) return false;
        int wgid = (int)L; { const int q = nwg / NXCD, r = nwg % NXCD, xcd = wgid % NXCD, off = wgid / NXCD; wgid = (xcd < r ? xcd * (q + 1) : r * (q + 1) + (xcd - r) * q) + off; }
        const int nig = WGM * nN, gid = wgid / nig, fm = gid * WGM, gsz = (nM - fm) < WGM ? (nM - fm) : WGM;
        u.pm = fm + ((wgid % nig) % gsz); u.pn = (wgid % nig) / gsz; u.e = 0; u.mt = 0; u.cnt = 0; u.type = 0;
        u.A = Ab + (size_t)u.pm * (BM * KD * 2); u.B = Bb + (size_t)u.pn * (BM * KD * 2); return true;
    }
    __device__ __forceinline__ void offsets(const Unit&, const int (&R)[2], const int (&C)[2], unsigned (&off)[2][2]) const {
#pragma unroll
        for (int h = 0; h < 2; ++h)
#pragma unroll
            for (int i = 0; i < 2; ++i) off[h][i] = (unsigned)(((h * HALF + R[i]) * KD + C[i]) * 2);
    }
};
struct MoeOrder {
    const LAS int* tab; int NTN, G, c, total; const char* Ab; const char* Bb; size_t bexp; const int* slot; bool gather; int rowb;
    static constexpr bool PARK = true, FUSED = false;
    int bn16;
    __device__ __forceinline__ unsigned boff(int Rb, int C) const { return (unsigned)((C >> 3) * bn16 + Rb * 16); }
    __device__ __forceinline__ size_t bstep_k() const { return (size_t)8 * bn16; }
    __device__ __forceinline__ size_t bstep_h() const { return (size_t)HALF * 16; }
    __device__ __forceinline__ bool next(int i, Unit& u) const {
        const int L = i * G + c; if (L >= total) return false;
        int e = 0;
        for (int j = 1; j < NE; ++j) e += (L >= NTN * tab[64 + j]) ? 1 : 0;
        e = __builtin_amdgcn_readfirstlane(e);
        const int ms = __builtin_amdgcn_readfirstlane(tab[64 + e]), ml = __builtin_amdgcn_readfirstlane(tab[32 + e]);
        const int r = L - NTN * ms; const int nt = r / ml, mt = r - nt * ml;
        u.e = e; u.mt = mt; u.cnt = __builtin_amdgcn_readfirstlane(tab[e]); u.pm = ms + mt; u.pn = nt; u.type = 0;
        u.A = gather ? Ab : Ab + (size_t)u.pm * (size_t)(BM * rowb);
        u.B = Bb + (size_t)e * bexp + (size_t)nt * (size_t)(BM * 16); return true;
    }
    __device__ __forceinline__ void offsets(const Unit& u, const int (&R)[2], const int (&C)[2], unsigned (&off)[2][2]) const {
#pragma unroll
        for (int h = 0; h < 2; ++h)
#pragma unroll
            for (int i = 0; i < 2; ++i) {
                if (gather) { const int idx = u.mt * BM + h * HALF + R[i]; const int idc = idx < u.cnt ? idx : u.cnt - 1; int tok = slot[u.e * SLOT_CAP + idc] >> 2; tok = idx < u.cnt ? tok : 0; off[h][i] = (unsigned)(tok * rowb + C[i] * 2); }
                else off[h][i] = (unsigned)((h * HALF + R[i]) * rowb + C[i] * 2);
            }
    }
};


#define GAS_U32 __attribute__((address_space(1))) unsigned
struct MoeFusedOrder {
    const LAS int* tab; int G, c, total6, total7; const char* hb; const char* act; const char* wup; const char* wdn; const int* slot; unsigned* cnt; unsigned* tmo;
    static constexpr bool PARK = true, FUSED = true; static constexpr int rowb = 1024;
    __device__ __forceinline__ unsigned boff_t(int type, int R, int C) const {
        const int rs = 64 * (R >> 5) + 32 * ((R >> 2) & 1) + 16 * ((R >> 3) & 1) + 4 * ((R >> 4) & 1) + (R & 3);
        return (unsigned)((C >> 3) * ((type ? 1024 : 2048) * 16) + rs * 16); }
    __device__ __forceinline__ unsigned boff(int R, int C) const { return boff_t(0, R, C); }
    __device__ __forceinline__ size_t bstep_kt(int type) const { return (size_t)8 * (type ? 1024 * 16 : 2048 * 16); }
    __device__ __forceinline__ size_t bstep_ht(int) const { return (size_t)8 * 16; }
    __device__ __forceinline__ size_t bstep_k() const { return bstep_kt(0); }
    __device__ __forceinline__ size_t bstep_h() const { return bstep_ht(0); }
    __device__ __forceinline__ bool next(int i, Unit& u) const {
        int L = i * G + c; if (L >= total6 + total7) return false;
        const int type = L >= total6 ? 1 : 0; L -= type ? total6 : 0; const int NTN = type ? 4 : 8;
        int e = 0;
        for (int j = 1; j < NE; ++j) e += (L >= NTN * tab[64 + j]) ? 1 : 0;
        e = __builtin_amdgcn_readfirstlane(e);
        const int ms = __builtin_amdgcn_readfirstlane(tab[64 + e]), ml = __builtin_amdgcn_readfirstlane(tab[32 + e]);
        const int r = L - NTN * ms; const int nt = r / ml, mt = r - nt * ml;
        u.e = e; u.mt = mt; u.cnt = __builtin_amdgcn_readfirstlane(tab[e]); u.pm = ms + mt; u.pn = nt; u.type = type;
        u.A = type ? act + (size_t)u.pm * (size_t)(BM * rowb) : hb;
        u.B = (type ? wdn + (size_t)e * 1024 * 1024 : wup + (size_t)e * 2048 * 1024) + (size_t)nt * (size_t)(BM * 16); return true;
    }
    __device__ __forceinline__ void offsets_issue(const Unit& u, const int (&R)[2], int (&tok)[2][2]) const {
        if (u.type == 0) {
#pragma unroll
            for (int h = 0; h < 2; ++h)
#pragma unroll
                for (int i = 0; i < 2; ++i) { const int idx = u.mt * BM + h * HALF + R[i]; tok[h][i] = slot[u.e * SLOT_CAP + (idx < u.cnt ? idx : u.cnt - 1)]; }
        } else {
#pragma unroll
            for (int h = 0; h < 2; ++h)
#pragma unroll
                for (int i = 0; i < 2; ++i) tok[h][i] = 0;
        }
    }
    __device__ __forceinline__ void offsets_finish(const Unit& u, const int (&R)[2], const int (&C)[2], const int (&tok)[2][2], unsigned (&off)[2][2]) const {
#pragma unroll
        for (int h = 0; h < 2; ++h)
#pragma unroll
            for (int i = 0; i < 2; ++i) { const int idx = u.mt * BM + h * HALF + R[i]; const int t = idx < u.cnt ? (tok[h][i] >> 2) : 0;
                off[h][i] = u.type ? (unsigned)((h * HALF + R[i]) * rowb + C[i] * 2) : (unsigned)(t * rowb + C[i] * 2); }
    }
    __device__ __forceinline__ void offsets(const Unit& u, const int (&R)[2], const int (&C)[2], unsigned (&off)[2][2]) const { int tok[2][2]; offsets_issue(u, R, tok); offsets_finish(u, R, C, tok, off); }
    __device__ __forceinline__ void early_poll(const Unit& u, LAS unsigned char* lds) const {
        if (threadIdx.x < 64) { const unsigned* p = cnt + 16 * u.pm; unsigned v;
            asm volatile("global_load_dword %0, %1, off sc1\n\ts_waitcnt vmcnt(0)" : "=&v"(v) : "v"(p) : "memory");
            if (threadIdx.x == 0) *(LAS unsigned*)(lds + MISC_OFF + MO_RDY) = v >= 64u ? 1u : 0u; }
    }
    __device__ __forceinline__ void a_ready(const Unit& u) const {
        if (u.type) {
            if (threadIdx.x < 64) { const unsigned* p = cnt + 16 * u.pm; unsigned v, spins = 0u;
                for (;;) { asm volatile("global_load_dword %0, %1, off sc1\n\ts_waitcnt vmcnt(0)" : "=&v"(v) : "v"(p) : "memory");
                    if ((unsigned)__builtin_amdgcn_readfirstlane(v) >= 64u) break;
                    __builtin_amdgcn_s_sleep(2);
                    if (++spins > (1u << 20)) { if (threadIdx.x == 0) __hip_atomic_store(tmo, 1u, __ATOMIC_RELAXED, __HIP_MEMORY_SCOPE_AGENT); break; } }
                }
            asm volatile("" ::: "memory"); __builtin_amdgcn_s_barrier(); asm volatile("" ::: "memory");
        }
    }
    __device__ __forceinline__ void done(const Unit& u) const {
        if (u.type == 0) { asm volatile("s_waitcnt vmcnt(0)" ::: "memory");
            if ((threadIdx.x & 63) == 0) __hip_atomic_fetch_add(cnt + 16 * u.pm, 1u, __ATOMIC_RELAXED, __HIP_MEMORY_SCOPE_AGENT); }
    }
};

typedef f32x4 Acc[2][2][4][2];

typedef int i32x8 __attribute__((ext_vector_type(8)));
struct u32x4x2 { u32x4 a, b; };
template <class Epi, class Sched, bool FP8 = false>
__device__ __forceinline__ void gemm_phase(LAS unsigned char* lds, const Sched& S, const Epi& E) {
    const int tid = threadIdx.x, wid = __builtin_amdgcn_readfirstlane(tid >> 6), lane = tid & 63, wr = wid >> 2, wc = wid & 3, fr = lane & 15, fq = lane >> 4;
    constexpr int ROWB = FP8 ? KD : KD * 2, nt = FP8 ? KD / 128 : NT_K;
    int sR[2], sC[2], sRb[2]; unsigned voffB[2];
#pragma unroll
    for (int i = 0; i < 2; ++i) { int R, C; stage_rc(tid * 16 + i * 8192, R, C); sR[i] = R; sC[i] = C; const int Rb = Epi::PERM ? ((R & ~31) + perm32(R & 31)) : R; sRb[i] = Rb; voffB[i] = S.boff(Rb, C); }
    constexpr size_t kstep = (size_t)(BK * 2);
    size_t kstepB = S.bstep_k(), kstepBn = kstepB, hstepB = S.bstep_h(), hstepBn = hstepB;
    const unsigned ldsw = (unsigned)wid * 1024u;
    const int aoff = lds_byte(wr * 64 + fr, fq * 8), boff = lds_byte(wc * 32 + fr, fq * 8);
    constexpr int KST = 1024;
#define PG8_SA(b, h) (((b) * 2 + (h)) * HTB)
#define PG8_SB(b, h) ((4 + (b) * 2 + (h)) * HTB)
#define PG8_STAGE(bufoff, gbase, voff) do { const char* _gb = (const char*)(gbase); asm volatile("" : "+s"(_gb));     \
        _Pragma("unroll") for (int _i = 0; _i < 2; ++_i) \
        __builtin_amdgcn_global_load_lds((const unsigned*)(_gb + (voff)[_i]), (LAS unsigned*)(lds + (bufoff) + ldsw + _i * 8192), 16, 0, 0); } while (0)
#define PG8_STAGE_A(bufoff, gbase, voff) do { const char* _gb = (const char*)(gbase); asm volatile("" : "+s"(_gb)); \
        _Pragma("unroll") for (int _i = 0; _i < 2; ++_i) \
        __builtin_amdgcn_global_load_lds((const unsigned*)(_gb + (voff)[_i]), (LAS unsigned*)(lds + (bufoff) + ldsw + _i * 8192), 16, 0, 0); } while (0)
#define PG8_LDA(dst, b, h) do { _Pragma("unroll") for (int m = 0; m < 4; ++m) _Pragma("unroll") for (int k = 0; k < 2; ++k) dst[m][k] = *(const LAS bf16x8*)(lds + PG8_SA(b, h) + aoff + m * 2048 + k * KST); } while (0)
#define PG8_LDB(dst, b, h) do { _Pragma("unroll") for (int n = 0; n < 2; ++n) _Pragma("unroll") for (int k = 0; k < 2; ++k) dst[n][k] = *(const LAS bf16x8*)(lds + PG8_SB(b, h) + boff + n * 2048 + k * KST); } while (0)
#define PG8_CAT(x) __builtin_bit_cast(i32x8, (u32x4x2){__builtin_bit_cast(u32x4, (x)[0]), __builtin_bit_cast(u32x4, (x)[1])})
#define PG8_MMA(ai, bj, At, Bt) do { __builtin_amdgcn_s_setprio(1); \
        if constexpr (FP8) { _Pragma("unroll") for (int m = 0; m < 4; ++m) _Pragma("unroll") for (int n = 0; n < 2; ++n) \
            acc[ai][bj][m][n] = __builtin_amdgcn_mfma_scale_f32_16x16x128_f8f6f4(PG8_CAT(Bt[n]), PG8_CAT(At[m]), acc[ai][bj][m][n], 0, 0, 0, Epi::SCALE_B, 0, Epi::SCALE_A); } \
        else { _Pragma("unroll") for (int m = 0; m < 4; ++m) _Pragma("unroll") for (int n = 0; n < 2; ++n) _Pragma("unroll") for (int k = 0; k < 2; ++k) \
            acc[ai][bj][m][n] = __builtin_amdgcn_mfma_f32_16x16x32_bf16(Bt[n][k], At[m][k], acc[ai][bj][m][n], 0, 0, 0); } \
        __builtin_amdgcn_s_setprio(0); } while (0)
#define PG8_WAIT_V(n) asm volatile("s_waitcnt vmcnt(" #n ")" ::: "memory")
#define PG8_WAIT_L(n) asm volatile("s_waitcnt lgkmcnt(" #n ")" ::: "memory")
#define PG8_BAR __builtin_amdgcn_s_barrier()
#define PG8_SCHED __builtin_amdgcn_sched_barrier(0)
    Unit cur, nxt, nn; bool has_nn = false; int ui = 0; int pend_pm = -1, pend_sig = -1;
    if (!S.next(0, cur)) return;
    Acc acc;
    bf16x8 At[4][2], B0[2][2], B1[2][2];
    unsigned offA[2][2], offN[2][2];
    S.offsets(cur, sR, sC, offA);
    if constexpr (Sched::FUSED) { kstepB = S.bstep_kt(cur.type); hstepB = S.bstep_ht(cur.type);
#pragma unroll
        for (int i = 0; i < 2; ++i) voffB[i] = S.boff_t(cur.type, sR[i], sC[i]); }
    const char* cA = cur.A; const char* cB = cur.B;
    PG8_STAGE(PG8_SB(0, 0), cB, voffB); PG8_STAGE(PG8_SB(0, 1), cB + hstepB, voffB); PG8_STAGE_A(PG8_SA(0, 0), cA, offA[0]); PG8_STAGE_A(PG8_SA(0, 1), cA, offA[1]);
    if (wr == 1) PG8_BAR;
    PG8_WAIT_V(2); PG8_BAR;
    PG8_STAGE(PG8_SB(1, 0), cB + kstepB, voffB); PG8_STAGE_A(PG8_SA(1, 0), cA + kstep, offA[0]); PG8_STAGE(PG8_SB(1, 1), cB + hstepB + kstepB, voffB);
    PG8_WAIT_V(6); PG8_BAR;
    for (;;) {
#pragma unroll
        for (int a = 0; a < 2; ++a)
#pragma unroll
            for (int b = 0; b < 2; ++b)
#pragma unroll
                for (int m = 0; m < 4; ++m)
#pragma unroll
                    for (int n = 0; n < 2; ++n) acc[a][b][m][n] = (f32x4){0.f, 0.f, 0.f, 0.f};
        bool has_next;
        if constexpr (Sched::FUSED) { if (ui == 0) has_next = S.next(1, nxt); else { has_next = has_nn; nxt = nn; } }
        else has_next = S.next(ui + 1, nxt);
        const char* nA = has_next ? nxt.A : cA; const char* nB = has_next ? nxt.B : cB;
        if constexpr (Sched::FUSED) { kstepBn = has_next ? S.bstep_kt(nxt.type) : kstepB; hstepBn = has_next ? S.bstep_ht(nxt.type) : hstepB; }
        if (!Sched::FUSED || ui == 0) {
            if (has_next) S.offsets(nxt, sR, sC, offN);
            else {
#pragma unroll
                for (int h = 0; h < 2; ++h)
#pragma unroll
                    for (int i = 0; i < 2; ++i) offN[h][i] = offA[h][i];
            }
            if constexpr (Sched::PARK) *(LAS u32x4*)(lds + OFFN_OFF + tid * 16) = (u32x4){offN[0][0], offN[0][1], offN[1][0], offN[1][1]};
        }
        if constexpr (Sched::FUSED) { if (has_next && nxt.type) S.early_poll(nxt, lds); }
#pragma unroll 1
        for (int t = 0; t < nt; t += 2) {
            const bool last = (t == nt - 2);
            const char* a1 = cA + (size_t)(t + 1) * kstep;
            const char* a2 = last ? nA : cA + (size_t)(t + 2) * kstep; const char* b2 = last ? nB : cB + (size_t)(t + 2) * kstepB;
            const char* a3 = a2 + kstep; const char* b3 = b2 + (last ? kstepBn : kstepB); const size_t hB = last ? hstepBn : hstepB;
            if constexpr (Sched::FUSED) { if (last && has_next && nxt.type) { const unsigned rdy = __builtin_amdgcn_readfirstlane(*(const LAS unsigned*)(lds + MISC_OFF + MO_RDY)); if (!rdy) S.a_ready(nxt); } }
            if constexpr (Epi::MID_T > 0) { if (t == Epi::MID_T) E.mid(acc, cur, wr, wc, fr, fq); }
            PG8_LDB(B0, 0, 0); PG8_LDB(B1, 0, 1); PG8_SCHED; PG8_LDA(At, 0, 0); PG8_STAGE_A(PG8_SA(1, 1), a1, offA[1]);
            PG8_WAIT_V(8); PG8_WAIT_L(0); PG8_BAR; PG8_MMA(0, 0, At, B0); PG8_MMA(0, 1, At, B1);
            asm volatile("" : "+v"(acc[0][0][0][0]), "+v"(acc[0][0][0][1]), "+v"(acc[0][0][1][0]), "+v"(acc[0][0][1][1]), "+v"(acc[0][0][2][0]), "+v"(acc[0][0][2][1]), "+v"(acc[0][0][3][0]), "+v"(acc[0][0][3][1]));
            asm volatile("" : "+v"(acc[0][1][0][0]), "+v"(acc[0][1][0][1]), "+v"(acc[0][1][1][0]), "+v"(acc[0][1][1][1]), "+v"(acc[0][1][2][0]), "+v"(acc[0][1][2][1]), "+v"(acc[0][1][3][0]), "+v"(acc[0][1][3][1]));
            PG8_BAR; PG8_SCHED;
            if (last) {
                if constexpr (Sched::FUSED) { if (has_next) {
#pragma unroll
                    for (int i = 0; i < 2; ++i) voffB[i] = S.boff_t(nxt.type, sR[i], sC[i]); } }
                if constexpr (Sched::PARK) { const u32x4 pk = *(const LAS u32x4*)(lds + OFFN_OFF + tid * 16); offA[0][0] = pk.x; offA[0][1] = pk.y; offA[1][0] = pk.z; offA[1][1] = pk.w; }
                else {
#pragma unroll
                    for (int h = 0; h < 2; ++h)
#pragma unroll
                        for (int i = 0; i < 2; ++i) offA[h][i] = offN[h][i];
                }
            }
            PG8_LDA(At, 0, 1); PG8_STAGE(PG8_SB(0, 0), b2, voffB); PG8_STAGE(PG8_SB(0, 1), b2 + hB, voffB); PG8_STAGE_A(PG8_SA(0, 0), a2, offA[0]);
            PG8_WAIT_V(8); PG8_WAIT_L(0); PG8_BAR; PG8_MMA(1, 0, At, B0); PG8_MMA(1, 1, At, B1); PG8_BAR; PG8_SCHED;
            PG8_LDB(B0, 1, 0); PG8_LDB(B1, 1, 1); PG8_SCHED; PG8_LDA(At, 1, 0); PG8_STAGE_A(PG8_SA(0, 1), a2, offA[1]);
            PG8_WAIT_V(8); PG8_WAIT_L(0); PG8_BAR; PG8_MMA(0, 0, At, B0); PG8_MMA(0, 1, At, B1); PG8_BAR; PG8_SCHED;
            PG8_LDA(At, 1, 1); PG8_STAGE(PG8_SB(1, 0), b3, voffB); PG8_STAGE(PG8_SB(1, 1), b3 + hB, voffB); PG8_STAGE_A(PG8_SA(1, 0), a3, offA[0]);
            PG8_WAIT_V(8); PG8_WAIT_L(0); PG8_BAR; PG8_MMA(1, 0, At, B0); PG8_MMA(1, 1, At, B1); PG8_BAR; PG8_SCHED;
        }
        if (wr == 0) PG8_BAR;
        unsigned vo_ = 0u;
        if constexpr (Sched::FUSED) { if (has_next) {
            const char* pb_ = nB + (size_t)(16 * (nxt.mt & 3) + 2 * wid) * (kstepBn >> 3); vo_ = (unsigned)(lane >> 5) * (unsigned)(kstepBn >> 3) + (unsigned)(lane & 31) * 128u;
            asm volatile("global_load_dword %0, %0, %1" : "+v"(vo_) : "s"(pb_) : "memory"); } }
        int tokn[2][2];
        if constexpr (Sched::FUSED) { has_nn = has_next ? S.next(ui + 2, nn) : false; if (has_nn) S.offsets_issue(nn, sR, tokn); }
        if constexpr (Sched::FUSED) { if (pend_pm >= 0 && lane == 0) __hip_atomic_fetch_add(S.cnt + 16 * pend_pm, 1u, __ATOMIC_RELAXED, __HIP_MEMORY_SCOPE_AGENT); }
        if constexpr (Epi::SIGNAL) { if (pend_sig >= 0) tile_signal_nowait(E.cnt, pend_sig); }
        E(acc, cur, wr, wc, fr, fq);
        if constexpr (Sched::FUSED) { if (has_nn) { S.offsets_finish(nn, sR, sC, tokn, offN); *(LAS u32x4*)(lds + OFFN_OFF + tid * 16) = (u32x4){offN[0][0], offN[0][1], offN[1][0], offN[1][1]}; } }
        if constexpr (Sched::FUSED) { if (has_next) pend_pm = cur.type == 0 ? cur.pm : -1; else S.done(cur); }
        __builtin_amdgcn_s_waitcnt(0x0F70); asm volatile("" :: "v"(vo_));
        if constexpr (Epi::SIGNAL) { if (has_next) pend_sig = cur.pm; else tile_signal_nowait(E.cnt, cur.pm); }
        if (!has_next) break;
        cur = nxt; cA = nA; cB = nB; kstepB = kstepBn; hstepB = hstepBn; ++ui;
        if (wr == 1) PG8_BAR;
    }
    PG8_BAR;
#undef PG8_SA
#undef PG8_SB
#undef PG8_STAGE
#undef PG8_STAGE_A
#undef PG8_LDA
#undef PG8_LDB
#undef PG8_MMA
#undef PG8_WAIT_V
#undef PG8_WAIT_L
#undef PG8_BAR
#undef PG8_SCHED
}

#define EPI_SEED(r, c) asm volatile("" : "+v"(r), "+v"(c))
template <class V> __device__ __forceinline__ V ldg(const void* base, unsigned off) { return *(const V*)((const char*)base + off); }
template <class V> __device__ __forceinline__ void stg(void* base, unsigned off, V v) { *(V*)((char*)base + off) = v; }
__device__ __forceinline__ u32x4 pack8(const f32x4 v0, const f32x4 v1) { u32x4 w; w.x = cvt_pk_bf16(v0[0], v0[1]); w.y = cvt_pk_bf16(v0[2], v0[3]); w.z = cvt_pk_bf16(v1[0], v1[1]); w.w = cvt_pk_bf16(v1[2], v1[3]); return w; }

struct EpiU {
    static constexpr int SCALE_B = 0, SCALE_A = 0;
    static constexpr bool PERM = true, SIGNAL = true; static constexpr int MID_T = 0;
    bf16 *q, *k, *vT, *ab, *gates; const float* bias; unsigned* cnt;
    __device__ __forceinline__ void mid(Acc&, const Unit&, int, int, int, int) const {}
    __device__ __forceinline__ void operator()(const Acc& acc, const Unit& u, int wr, int wc, int fr, int fq) const {
        int rl = wr * 64 + fr, cl = wc * 32 + 8 * fq; EPI_SEED(rl, cl);
        const int row0 = u.pm * BM + rl, pn = u.pn;
        f32x4 bv[2][2];
#pragma unroll
        for (int bj = 0; bj < 2; ++bj)
#pragma unroll
            for (int n = 0; n < 2; ++n) bv[bj][n] = ldg<f32x4>(bias, (unsigned)(pn * BM + bj * HALF + cl + 4 * n) * 4u);
        if (pn < 2) {
            const unsigned o0 = ((unsigned)row0 * AW + pn * BM + cl) * 2u;
#pragma unroll
            for (int ai = 0; ai < 2; ++ai)
#pragma unroll
                for (int m = 0; m < 4; ++m)
#pragma unroll
                    for (int bj = 0; bj < 2; ++bj)
                        stgw(q, o0 + (unsigned)((ai * HALF + m * 16) * AW + bj * HALF) * 2u, pack8((acc[ai][bj][m][0] + bv[bj][0]) * 0.125f, (acc[ai][bj][m][1] + bv[bj][1]) * 0.125f));
        } else if (pn == 2) {
            const unsigned o0 = ((unsigned)row0 * KVW + cl) * 2u;
#pragma unroll
            for (int ai = 0; ai < 2; ++ai)
#pragma unroll
                for (int m = 0; m < 4; ++m) {
                    stgw(k, o0 + (unsigned)((ai * HALF + m * 16) * KVW) * 2u, pack8(acc[ai][0][m][0] + bv[0][0], acc[ai][0][m][1] + bv[0][1]));
                    stgw(vT, o0 + (unsigned)((ai * HALF + m * 16) * KVW) * 2u, pack8(acc[ai][1][m][0] + bv[1][0], acc[ai][1][m][1] + bv[1][1])); }
        } else if (pn < 7) {
            const unsigned o0 = ((unsigned)(row0 + AB_PAD * ((row0 >> 12) + 1)) * CCH + (pn - 3) * HALF + cl) * 2u;
#pragma unroll
            for (int ai = 0; ai < 2; ++ai)
#pragma unroll
                for (int m = 0; m < 4; ++m) { f32x4 o[2];
#pragma unroll
                    for (int n = 0; n < 2; ++n) { const f32x4 a = acc[ai][0][m][n] + bv[0][n], g = acc[ai][1][m][n] + bv[1][n];
#pragma unroll
                        for (int j = 0; j < 4; ++j) o[n][j] = a[j] * sigmoidf_(g[j]); }
                    stgw(ab, o0 + (unsigned)((ai * HALF + m * 16) * CCH) * 2u, pack8(o[0], o[1])); }
        } else {
            const unsigned o0 = ((unsigned)row0 * 2048 + (pn - 7) * HALF + cl) * 2u;
#pragma unroll
            for (int ai = 0; ai < 2; ++ai)
#pragma unroll
                for (int m = 0; m < 4; ++m) { f32x4 ra[2], gb[2];
#pragma unroll
                    for (int n = 0; n < 2; ++n) { const f32x4 va = acc[ai][0][m][n] + bv[0][n], vb = acc[ai][1][m][n] + bv[1][n];
#pragma unroll
                        for (int j = 0; j < 4; ++j) { const float da = 1.0f + __builtin_amdgcn_exp2f(va[j] * -1.44269504f), db = 1.0f + __builtin_amdgcn_exp2f(vb[j] * -1.44269504f);
                            gb[n][j] = __builtin_amdgcn_rcpf(db); ra[n][j] = db * __builtin_amdgcn_rcpf(da); } }
                    stgw(gates, o0 + (unsigned)((ai * HALF + m * 16) * 2048) * 2u, pack8(ra[0], ra[1]));
                    stgw(gates, o0 + (unsigned)((ai * HALF + m * 16) * 2048 + 1024) * 2u, pack8(gb[0], gb[1])); }
        }
    }
};
struct EpiMerged {
    static constexpr int SCALE_B = 0, SCALE_A = 0;
    static constexpr bool PERM = true, SIGNAL = true; static constexpr int MID_T = 8;
    const bf16* gates; const float* bc; bf16* merged; unsigned* cnt;
    __device__ __forceinline__ void mid(Acc& acc, const Unit& u, int wr, int wc, int fr, int fq) const {
        int rl = wr * 64 + fr, cl = wc * 32 + 8 * fq; EPI_SEED(rl, cl);
        const unsigned g0 = ((unsigned)(u.pm * BM + rl) * 2048 + u.pn * BM + cl) * 2u;
#pragma unroll
        for (int ai = 0; ai < 2; ++ai) { u32x4 rt[4][2];
#pragma unroll
            for (int m = 0; m < 4; ++m)
#pragma unroll
                for (int bj = 0; bj < 2; ++bj) rt[m][bj] = ldg<u32x4>(gates, g0 + (unsigned)((ai * HALF + m * 16) * 2048 + bj * HALF) * 2u);
            __builtin_amdgcn_sched_barrier(0);
#pragma unroll
            for (int m = 0; m < 4; ++m)
#pragma unroll
                for (int bj = 0; bj < 2; ++bj)
#pragma unroll
                    for (int n = 0; n < 2; ++n) { acc[ai][bj][m][n][0] *= bflo(rt[m][bj][2 * n]); acc[ai][bj][m][n][1] *= bfhi(rt[m][bj][2 * n]); acc[ai][bj][m][n][2] *= bflo(rt[m][bj][2 * n + 1]); acc[ai][bj][m][n][3] *= bfhi(rt[m][bj][2 * n + 1]); }
            __builtin_amdgcn_sched_barrier(0); }
    }
    __device__ __forceinline__ void operator()(const Acc& acc, const Unit& u, int wr, int wc, int fr, int fq) const {
        int rl = wr * 64 + fr, cl = wc * 32 + 8 * fq; EPI_SEED(rl, cl);
        const int row0 = u.pm * BM + rl, col0 = u.pn * BM + cl;
        const unsigned g0 = ((unsigned)row0 * 2048 + 1024 + col0) * 2u, m0 = ((unsigned)row0 * D + col0) * 2u;
        f32x4 bv[2][2];
#pragma unroll
        for (int bj = 0; bj < 2; ++bj)
#pragma unroll
            for (int n = 0; n < 2; ++n) bv[bj][n] = ldg<f32x4>(bc, (unsigned)(col0 + bj * HALF + 4 * n) * 4u);
#pragma unroll
        for (int ai = 0; ai < 2; ++ai)
#pragma unroll
            for (int m = 0; m < 4; ++m) {
#pragma unroll
                for (int bj = 0; bj < 2; ++bj) { const u32x4 gb = ldg<u32x4>(gates, g0 + (unsigned)((ai * HALF + m * 16) * 2048 + bj * HALF) * 2u); f32x4 o[2];
#pragma unroll
                    for (int n = 0; n < 2; ++n) { const f32x4 v = acc[ai][bj][m][n] + bv[bj][n];
                        o[n][0] = v[0] * bflo(gb[2 * n]); o[n][1] = v[1] * bfhi(gb[2 * n]); o[n][2] = v[2] * bflo(gb[2 * n + 1]); o[n][3] = v[3] * bfhi(gb[2 * n + 1]); }
                    stgw(merged, m0 + (unsigned)((ai * HALF + m * 16) * D + bj * HALF) * 2u, pack8(o[0], o[1])); }
                if (m & 1) asm volatile("" ::: "memory"); }
    }
};
struct EpiPre1 {
    static constexpr int SCALE_B = 0, SCALE_A = 0;
    static constexpr bool PERM = true, SIGNAL = true; static constexpr int MID_T = 0;
    const bf16* xb; bf16* out; unsigned* cnt;
    __device__ __forceinline__ void mid(Acc&, const Unit&, int, int, int, int) const {}
    __device__ __forceinline__ void operator()(const Acc& acc, const Unit& u, int wr, int wc, int fr, int fq) const {
        int rl = wr * 64 + fr, cl = wc * 32 + 8 * fq; EPI_SEED(rl, cl);
        const unsigned o0 = ((unsigned)(u.pm * BM + rl) * D + u.pn * BM + cl) * 2u;
        u32x4 xv[2][4][2];
#pragma unroll
        for (int ai = 0; ai < 2; ++ai)
#pragma unroll
            for (int m = 0; m < 4; ++m)
#pragma unroll
                for (int bj = 0; bj < 2; ++bj) xv[ai][m][bj] = ldg<u32x4>(xb, o0 + (unsigned)((ai * HALF + m * 16) * D + bj * HALF) * 2u);
        __builtin_amdgcn_sched_barrier(0);
#pragma unroll
        for (int ai = 0; ai < 2; ++ai)
#pragma unroll
            for (int m = 0; m < 4; ++m)
#pragma unroll
                for (int bj = 0; bj < 2; ++bj) { const u32x4 w = xv[ai][m][bj];
                    const f32x4 r0 = (f32x4){bflo(w.x), bfhi(w.x), bflo(w.y), bfhi(w.y)} * DN_ALPHA + acc[ai][bj][m][0], r1 = (f32x4){bflo(w.z), bfhi(w.z), bflo(w.w), bfhi(w.w)} * DN_ALPHA + acc[ai][bj][m][1];
                    stgw(out, o0 + (unsigned)((ai * HALF + m * 16) * D + bj * HALF) * 2u, pack8(r0, r1)); }
    }
};
struct EpiUp {
    static constexpr bool PERM = true, SIGNAL = false; static constexpr int MID_T = 0;
    static constexpr int SCALE_B = 0x79797979, SCALE_A = 0x7C7C7C7C;
    const float* b_up; unsigned char* act;
    __device__ __forceinline__ void mid(Acc&, const Unit&, int, int, int, int) const {}
    __device__ __forceinline__ void operator()(const Acc& acc, const Unit& u, int wr, int wc, int fr, int fq) const {
        int rl = wr * 64 + fr, cl = wc * 32 + 8 * fq; EPI_SEED(rl, cl);
        const unsigned o0 = (unsigned)(u.pm * BM + rl) * DE + u.pn * HALF + (cl >> 1);
        f32x4 bv[2][2];
#pragma unroll
        for (int bj = 0; bj < 2; ++bj)
#pragma unroll
            for (int n = 0; n < 2; ++n) bv[bj][n] = ldg<f32x4>(b_up, (unsigned)(u.e * 2048 + u.pn * BM + cl + bj * HALF + 4 * n) * 4u);
#pragma unroll
        for (int ai = 0; ai < 2; ++ai)
#pragma unroll
            for (int m = 0; m < 4; ++m)
#pragma unroll
                for (int bj = 0; bj < 2; ++bj) { float o[4];
#pragma unroll
                    for (int n = 0; n < 2; ++n) { const f32x4 v = acc[ai][bj][m][n] + bv[bj][n];
#pragma unroll
                        for (int p = 0; p < 2; ++p) { const float xg = fminf(v[2 * p], 7.0f), xl = fminf(fmaxf(v[2 * p + 1], -7.0f), 7.0f);
                            o[2 * n + p] = xg * sigmoidf_(1.702f * xg) * (xl + 1.0f); } }
                    unsigned w = 0u; w = __builtin_amdgcn_cvt_pk_fp8_f32(o[0] * 8.0f, o[1] * 8.0f, w, false); w = __builtin_amdgcn_cvt_pk_fp8_f32(o[2] * 8.0f, o[3] * 8.0f, w, true);
                    __hip_atomic_store((unsigned*)(act + (o0 + (unsigned)((ai * HALF + m * 16) * DE + bj * 64))), w, __ATOMIC_RELAXED, __HIP_MEMORY_SCOPE_AGENT); }
    }
};
struct EpiDown {
    static constexpr bool PERM = true, SIGNAL = false; static constexpr int MID_T = 0;
    static constexpr int SCALE_B = 0x79797979, SCALE_A = 0x7C7C7C7C;
    const float* b_dn; const int* slot; unsigned char* ys;
    __device__ __forceinline__ void mid(Acc&, const Unit&, int, int, int, int) const {}
    __device__ __forceinline__ void operator()(const Acc& acc, const Unit& u, int wr, int wc, int fr, int fq) const {
        int rl = wr * 64 + fr, cb = 64 * wc + 32 * (fq & 1) + 16 * (fq >> 1); EPI_SEED(rl, cb);
        const int col0 = u.pn * BM + cb, idx0 = u.mt * BM + rl;
        f32x4 bv[2][2];
#pragma unroll
        for (int bj = 0; bj < 2; ++bj)
#pragma unroll
            for (int n = 0; n < 2; ++n) bv[bj][n] = ldg<f32x4>(b_dn, (unsigned)(u.e * D + col0 + 8 * bj + 4 * n) * 4u);
        int asg[2][4];
#pragma unroll
        for (int ai = 0; ai < 2; ++ai)
#pragma unroll
            for (int m = 0; m < 4; ++m) { const int idx = idx0 + ai * HALF + m * 16; asg[ai][m] = ldg<int>(slot, (unsigned)(u.e * SLOT_CAP + (idx < u.cnt ? idx : u.cnt - 1)) * 4u); }
#pragma unroll
        for (int ai = 0; ai < 2; ++ai)
#pragma unroll
            for (int m = 0; m < 4; ++m) { const int idx = idx0 + ai * HALF + m * 16;
                if (idx < u.cnt) { u32x4 w;
#pragma unroll
                    for (int bj = 0; bj < 2; ++bj)
#pragma unroll
                        for (int n = 0; n < 2; ++n) { const f32x4 v = (acc[ai][bj][m][n] + bv[bj][n]) * 16.0f;
                            unsigned x = __builtin_amdgcn_cvt_pk_fp8_f32(v[0], v[1], 0u, false); x = __builtin_amdgcn_cvt_pk_fp8_f32(v[2], v[3], x, true); w[2 * bj + n] = x; }
                    stg<u32x4>(ys, (unsigned)asg[ai][m] * D + col0, w); } }
    }
};
struct EpiUpX {
    const float* b_up; unsigned char* act;
    __device__ __forceinline__ void operator()(const Acc& acc, const Unit& u, int wr, int wc, int fr, int fq) const {
        int rl = wr * 64 + fr, cb = 64 * wc + 32 * (fq & 1) + 16 * (fq >> 1); EPI_SEED(rl, cb);
        f32x4 bv[2][2];
#pragma unroll
        for (int bj = 0; bj < 2; ++bj)
#pragma unroll
            for (int n = 0; n < 2; ++n) bv[bj][n] = ldg<f32x4>(b_up, (unsigned)(u.e * 2048 + u.pn * BM + cb + 8 * bj + 4 * n) * 4u);
        const __amdgpu_buffer_rsrc_t rs = __builtin_amdgcn_make_buffer_rsrc(act, 0, (MAX_MT * 256) * 1024, 0x00020000);
        const unsigned o0 = (unsigned)(u.pm * BM + rl + 16 * (fq >> 1)) * DE + u.pn * HALF + 32 * wc + 16 * (fq & 1);
#pragma unroll
        for (int ai = 0; ai < 2; ++ai)
#pragma unroll
            for (int j = 0; j < 2; ++j) { unsigned d[2][2];
#pragma unroll
                for (int mm = 0; mm < 2; ++mm)
#pragma unroll
                    for (int bj = 0; bj < 2; ++bj) { float o[4];
#pragma unroll
                        for (int n = 0; n < 2; ++n) { const f32x4 v = acc[ai][bj][2 * j + mm][n] + bv[bj][n];
#pragma unroll
                            for (int p = 0; p < 2; ++p) { const float xg = fminf(v[2 * p], 7.0f), xl = fminf(fmaxf(v[2 * p + 1], -7.0f), 7.0f);
                                o[2 * n + p] = (xg * __builtin_amdgcn_rcpf(1.0f + __builtin_amdgcn_exp2f(xg * (-1.702f * 1.44269504f)))) * __builtin_fmaf(xl, 8.0f, 8.0f); } }
                        unsigned w = 0u; w = __builtin_amdgcn_cvt_pk_fp8_f32(o[0], o[1], w, false); w = __builtin_amdgcn_cvt_pk_fp8_f32(o[2], o[3], w, true); d[mm][bj] = w; }
                const u32x2 s0 = __builtin_amdgcn_permlane32_swap(d[0][0], d[1][0], false, false), s1 = __builtin_amdgcn_permlane32_swap(d[0][1], d[1][1], false, false);
                const u32x4 w4 = (u32x4){s0.x, s1.x, s0.y, s1.y};
                __builtin_amdgcn_raw_buffer_store_b128(w4, rs, o0 + (unsigned)((ai * HALF + 32 * j) * DE), 0, 16); }
    }
};
struct EpiMoe {
    static constexpr bool PERM = true, SIGNAL = false; static constexpr int MID_T = 0;
    static constexpr int SCALE_B = 0x79797979, SCALE_A = 0x7C7C7C7C;
    EpiUpX up; EpiDown dn;
    __device__ __forceinline__ void mid(Acc&, const Unit&, int, int, int, int) const {}
    __device__ __forceinline__ void operator()(const Acc& acc, const Unit& u, int wr, int wc, int fr, int fq) const { if (u.type == 0) up(acc, u, wr, wc, fr, fq); else dn(acc, u, wr, wc, fr, fq); }
};
}

#define XB_TMO      128
#define XB_XCNT(j)  (256  + 64 * (j))
#define XB_XSUB(j)  (1280 + 64 * (j))
#define XB_XGEN(j)  (2304 + 64 * (j))
#define XB_TOP      3328
#define XB_TOPGEN   3392
#define XCD_BAR_WORDS 3456
#define XB_SPIN_CAP (1u << 18)
__device__ __forceinline__ unsigned xb_ld(unsigned* p)              { return __hip_atomic_load(p, __ATOMIC_RELAXED, __HIP_MEMORY_SCOPE_AGENT); }
__device__ __forceinline__ unsigned xb_add(unsigned* p, unsigned v) { return __hip_atomic_fetch_add(p, v, __ATOMIC_RELAXED, __HIP_MEMORY_SCOPE_AGENT); }
__device__ __forceinline__ unsigned xb_xcc_id() { return (unsigned)__builtin_amdgcn_s_getreg((3 << 11) | 20) & 0xFu; }
#define XB_SPIN(cond, bar) do { unsigned _sp = 0; while (cond) { __builtin_amdgcn_s_sleep(1); \
    if ((++_sp & 255u) == 0u) { if (xb_ld(&(bar)[XB_TMO])) break; if (_sp > XB_SPIN_CAP) { atomicAdd(&(bar)[XB_TMO], 1u); break; } } } } while (0)
struct XcdBarrier { unsigned* bar; unsigned x; volatile LAS unsigned* st; };
__device__ __forceinline__ XcdBarrier xcd_barrier_post(unsigned* bar, volatile LAS unsigned* st) {
    XcdBarrier b; b.bar = bar; b.x = xb_xcc_id(); b.st = st;
    return b;
}
__device__ __forceinline__ void ctl_join(const XcdBarrier& b, unsigned* flag) {
    if (threadIdx.x == 0) { unsigned sp = 0u; while (xb_ld(flag) != CTL_MAGIC) { __builtin_amdgcn_s_sleep(2); if (++sp > (1u << 20)) break; }
        (void)xb_add(&b.bar[XB_XCNT(b.x)], 1u); }
}
__device__ __forceinline__ void xcd_barrier_complete(unsigned* bar, unsigned x, unsigned& nloc, unsigned& nx) {
    const unsigned G = gridDim.x * gridDim.y * gridDim.z;
    unsigned sum, cnt, mine, sp = 0u;
    for (;;) {
        sum = 0u; cnt = 0u; mine = 0u;
#pragma unroll
        for (unsigned j = 0; j < 16; ++j) { const unsigned c = xb_ld(&bar[XB_XCNT(j)]); sum += c; cnt += (c > 0u) ? 1u : 0u; mine = (j == x) ? c : mine; }
        if (sum == G) break;
        __builtin_amdgcn_s_sleep(1);
        if ((++sp & 255u) == 0u) { if (xb_ld(&bar[XB_TMO])) break; if (sp > XB_SPIN_CAP) { atomicAdd(&bar[XB_TMO], 1u); break; } }
    }
    nloc = mine > 0u ? mine : 1u; nx = cnt > 0u ? cnt : 1u;
}
__device__ __forceinline__ void xcd_barrier(const XcdBarrier& b, bool fence = true) {
    asm volatile("s_waitcnt vmcnt(0)" ::: "memory");
    __syncthreads();
    if (threadIdx.x == 64) asm volatile("buffer_inv sc1\n\ts_waitcnt vmcnt(0)" ::: "memory");
    if (threadIdx.x == 0) {
        unsigned* bar = b.bar;
        __builtin_amdgcn_s_waitcnt(0);
        unsigned nloc = b.st[0], nx = b.st[1];
        if (nloc == 0u) { xcd_barrier_complete(bar, b.x, nloc, nx); b.st[0] = nloc; b.st[1] = nx; }
        const unsigned old = xb_add(&bar[XB_XSUB(b.x)], 1u);
        const unsigned gen = old / nloc;
        if (old + 1u == (gen + 1u) * nloc) {
            if (fence) { __builtin_amdgcn_fence(__ATOMIC_RELEASE, "agent");
                asm volatile("s_waitcnt vmcnt(0)" ::: "memory"); }
            const unsigned og = xb_add(&bar[XB_TOP], 1u);
            const unsigned tg = og / nx;
            if (og + 1u == (tg + 1u) * nx) xb_add(&bar[XB_TOPGEN], 1u);
            else XB_SPIN(xb_ld(&bar[XB_TOPGEN]) == tg, bar);
            xb_add(&bar[XB_XGEN(b.x)], 1u);
            asm volatile("s_waitcnt vmcnt(0)" ::: "memory");
        } else {
            XB_SPIN(xb_ld(&bar[XB_XGEN(b.x)]) == gen, bar);
            asm volatile("s_waitcnt vmcnt(0)" ::: "memory");
        }
    }
    __syncthreads();
}


__device__ __forceinline__ void tr_item(const float* W, int ldw, int scol0, int srow0, bf16* WT, int Kd, int drow0, int dk0, LAS float* scr, int lane) {
#pragma unroll 8
    for (int i = 0; i < 32; ++i) { const int kk = 2 * i + (lane >> 5); scr[kk * 33 + (lane & 31)] = __builtin_nontemporal_load(W + (size_t)(srow0 + kk) * ldw + scol0 + (lane & 31)); }
    LDS_WAIT(); asm volatile("" ::: "memory");
    const int c = lane & 7;
#pragma unroll
    for (int j = 0; j < 4; ++j) { const int n = (lane >> 3) + 8 * j; const LAS float* s = scr + (8 * c) * 33 + n;
        u32x4 o; o.x = pk2(s[0 * 33], s[1 * 33]); o.y = pk2(s[2 * 33], s[3 * 33]); o.z = pk2(s[4 * 33], s[5 * 33]); o.w = pk2(s[6 * 33], s[7 * 33]);
        pg8::stgw(WT, (unsigned)(((drow0 + n) * Kd + dk0 + 8 * c) * 2), o); }
    LDS_WAIT(); asm volatile("" ::: "memory");
}
__device__ __forceinline__ int src_col_u(int np) {
    if (np < 768) return np;
    if (np >= 1792) { const int tt = (np - 1792) >> 8, w = (np - 1792) & 255; return w < 128 ? 1792 + 128 * tt + w : 2816 + 128 * tt + (w - 128); }
    const int tt = (np - 768) >> 8, w = (np - 768) & 255;
    return w < 128 ? 768 + 128 * tt + w : 1280 + 128 * tt + (w - 128);
}

__device__ __forceinline__ void p0_prologue(const Args& a, LAS unsigned char* lds, int gw, int NGW, int lane, int wave, const XcdBarrier& xbr) {
    unsigned char* ws = a.ws;
    LAS float* scr = (LAS float*)(lds + wave * 16384);
    constexpr int J1 = 16 * 120, J2 = 8 * 32, J3 = 8 * 32, J4 = 16 * 32;
    constexpr int NITEMS = J1 + J2 + J3 + J4;
    for (int it = gw; it < NITEMS; it += NGW) {
        int r = it;
        if (r < J1) { const int kb = r / 120, nb = r % 120; tr_item(a.in[I_WIN], INW, src_col_u(32 * nb), 64 * kb, (bf16*)(ws + WS_WIN), 1024, 32 * nb, 64 * kb, scr, lane); continue; } r -= J1;
        if (r < J2) { const int kb = r / 32, nb = r % 32; tr_item(a.in[I_WATT], D, 32 * nb, 64 * kb, (bf16*)(ws + WS_WAB), 1024, 32 * nb, 64 * kb, scr, lane); continue; } r -= J2;
        if (r < J3) { const int kb = r / 32, nb = r % 32; tr_item(a.in[I_WCONV], D, 32 * nb, 64 * kb, (bf16*)(ws + WS_WAB), 1024, 32 * nb, 512 + 64 * kb, scr, lane); continue; } r -= J3;
        { const int kb = r / 32, nb = r % 32; tr_item(a.in[I_WO], D, 32 * nb, 64 * kb, (bf16*)(ws + WS_WO), 1024, 32 * nb, 64 * kb, scr, lane); }
    }
    ctl_join(xbr, (unsigned*)(ws + WS_CTL) + CW_INIT);
    const float* x = a.in[I_X]; bf16* xb = (bf16*)(ws + WS_XB);
    for (int m = gw; m < T; m += 4 * NGW) {
        f32x4 v[4][4];
#pragma unroll
        for (int rr = 0; rr < 4; ++rr) { const int mr = m + rr * NGW < T ? m + rr * NGW : m; const f32x4* xr = (const f32x4*)(x + (size_t)mr * D) + lane;
#pragma unroll
            for (int j = 0; j < 4; ++j) v[rr][j] = __builtin_nontemporal_load(xr + 64 * j); }
        __builtin_amdgcn_sched_barrier(0);
#pragma unroll
        for (int rr = 0; rr < 4; ++rr) { if (m + rr * NGW < T) { const unsigned o = (unsigned)(m + rr * NGW) * (unsigned)(D * 2) + (unsigned)lane * 8u;
#pragma unroll
            for (int j = 0; j < 4; ++j) { u32x2 w; w.x = pk2(v[rr][j][0], v[rr][j][1]); w.y = pk2(v[rr][j][2], v[rr][j][3]); pg8::stgw8(xb, o + 512u * j, w); } } }
        __builtin_amdgcn_sched_barrier(0);
    }
    { u32x4* abz = (u32x4*)(ws + WS_AB); const u32x4 z4 = (u32x4){0u, 0u, 0u, 0u};
      for (int i = gw * 64 + lane; i < NBATCH * AB_PAD * CCH * 2 / 16; i += NGW * 64) { const int bb = i / (AB_PAD * CCH * 2 / 16), q = i % (AB_PAD * CCH * 2 / 16); pg8::stgw(abz, (unsigned)((bb * (AB_SEQ * CCH * 2 / 16) + q) * 16), z4); } }
    float* bperm = (float*)(ws + WS_BPERM);
    for (int i = gw * 64 + lane; i < INW; i += NGW * 64) pg8::stgw4(bperm, 4u * (unsigned)i, __builtin_bit_cast(unsigned, a.in[I_BIN][src_col_u(i)]));
}

__device__ __forceinline__ float quad16_max(float x) { const unsigned u = __builtin_bit_cast(unsigned, x);
    u32x2 a = __builtin_amdgcn_permlane32_swap(u, u, false, false); x = fmaxf(__builtin_bit_cast(float, a.x), __builtin_bit_cast(float, a.y));
    const unsigned v = __builtin_bit_cast(unsigned, x); u32x2 b = __builtin_amdgcn_permlane16_swap(v, v, false, false); return fmaxf(__builtin_bit_cast(float, b.x), __builtin_bit_cast(float, b.y)); }
__device__ __forceinline__ float quad16_sum(float x) { const unsigned u = __builtin_bit_cast(unsigned, x);
    u32x2 a = __builtin_amdgcn_permlane32_swap(u, u, false, false); x = __builtin_bit_cast(float, a.x) + __builtin_bit_cast(float, a.y);
    const unsigned v = __builtin_bit_cast(unsigned, x); u32x2 b = __builtin_amdgcn_permlane16_swap(v, v, false, false); return __builtin_bit_cast(float, b.x) + __builtin_bit_cast(float, b.y); }
constexpr int KLS = 144, VLS = 528, ATT_V_OFF = 256 * KLS, CONV_W_OFF = 70656;
__device__ __forceinline__ void attn_unit(const Args& a, int unit, LAS unsigned char* lds, int tid, int wave, int lane) {
    const bf16* qb = (const bf16*)(a.ws + WS_QB); const bf16* kb = (const bf16*)(a.ws + WS_KB); const bf16* vT = (const bf16*)(a.ws + WS_VT); bf16* ay = (bf16*)(a.ws + WS_AY);
    const int kvh = unit & 1, blk = (unit >> 1) & 31, b = unit >> 6;
    const int r = lane & 15, qd = lane >> 4, w = wave;
    const int t0 = b * SEQ + blk * 128, seq0 = b * SEQ, lo = w & ~1;
    { u32x4 kreg[4], vreg[4];
#pragma unroll
      for (int i = 0; i < 4; ++i) { const int c = tid + 512 * i;
          int tok = t0 - 128 + (c >> 3); tok = tok < seq0 ? seq0 : tok;
          kreg[i] = ldgo<u32x4>(kb, (unsigned)(tok * KVW + kvh * HD + (c & 7) * 8) * 2u);
          vreg[i] = ldgo<u32x4>(vT, (unsigned)(tok * KVW + kvh * HD + (c & 7) * 8) * 2u); }
      __builtin_amdgcn_sched_barrier(0);
      asm volatile("" : "+v"(kreg[0]), "+v"(kreg[1]), "+v"(kreg[2]), "+v"(kreg[3]), "+v"(vreg[0]), "+v"(vreg[1]), "+v"(vreg[2]), "+v"(vreg[3]));
#pragma unroll
      for (int i = 0; i < 4; ++i) { const int c = tid + 512 * i;
          *(LAS u32x4*)(lds + (c >> 3) * KLS + (c & 7) * 16) = kreg[i];
#pragma unroll
          for (int j = 0; j < 8; ++j) { const int d = 8 * (c & 7) + j, rho = 16 * ((d >> 2) & 3) + 4 * (d >> 4) + (d & 3); const unsigned wj = vreg[i][j >> 1];
              *(LAS unsigned short*)(lds + ATT_V_OFF + rho * VLS + (c >> 3) * 2) = (unsigned short)((j & 1) ? (wj >> 16) : (wj & 0xffffu)); } } }
    __syncthreads();
    const int qi = 16 * w + r;
#pragma unroll 1
    for (int hh = 0; hh < 4; ++hh) {
        const int head = kvh * 4 + hh;
        u32x4 qf[2];
        { const unsigned qo = (unsigned)((t0 + qi) * AW + head * HD + 8 * qd) * 2u; qf[0] = ldgo<u32x4>(qb, qo); qf[1] = ldgo<u32x4>(qb, qo + 64u); }
        const float sinkv = a.in[I_SINK][head];
        int qiv = qi; asm volatile("" : "+v"(qiv));
        const int klo = max(qiv + 1, blk > 0 ? 0 : 128); const int kjb = lo * 16 + 4 * qd - klo; const unsigned span = (unsigned)(qiv + 128 - klo);
        f32x4 s[10];
#pragma unroll
        for (int i = 0; i < 10; ++i) {
            const LAS unsigned char* kp = lds + ((lo + i) * 16 + r) * KLS + qd * 16;
            const u32x4 k0 = *(const LAS u32x4*)kp, k1 = *(const LAS u32x4*)(kp + 64);
            f32x4 z = (f32x4){0.f, 0.f, 0.f, 0.f};
            z = __builtin_amdgcn_mfma_f32_16x16x32_bf16(__builtin_bit_cast(bf16x8, k0), __builtin_bit_cast(bf16x8, qf[0]), z, 0, 0, 0);
            s[i] = __builtin_amdgcn_mfma_f32_16x16x32_bf16(__builtin_bit_cast(bf16x8, k1), __builtin_bit_cast(bf16x8, qf[1]), z, 0, 0, 0);
        }
        float mx = sinkv;
#pragma unroll
        for (int i = 0; i < 10; ++i)
#pragma unroll
            for (int g = 0; g < 4; ++g) { const bool valid = (unsigned)(kjb + (16 * i + g)) <= span; s[i][g] = valid ? s[i][g] : -__builtin_inff(); mx = fmaxf(mx, s[i][g]); }
        mx = quad16_max(mx);
        float sum = 0.f; const float mxl = -mx * 1.44269504f;
#pragma unroll
        for (int i = 0; i < 10; ++i)
#pragma unroll
            for (int g = 0; g < 4; ++g) { const float p = __builtin_amdgcn_exp2f(__builtin_fmaf(s[i][g], 1.44269504f, mxl)); s[i][g] = p; sum += p; }
        sum = quad16_sum(sum);
        const float inv = 1.0f / (sum + __builtin_amdgcn_exp2f(__builtin_fmaf(sinkv, 1.44269504f, mxl)));
        f32x4 o[4];
#pragma unroll
        for (int mt = 0; mt < 4; ++mt) o[mt] = (f32x4){0.f, 0.f, 0.f, 0.f};
#pragma unroll
        for (int ip = 0; ip < 5; ++ip) {
            u32x4 pw; pw.x = cvt_pk_bf16(s[2 * ip][0], s[2 * ip][1]); pw.y = cvt_pk_bf16(s[2 * ip][2], s[2 * ip][3]); pw.z = cvt_pk_bf16(s[2 * ip + 1][0], s[2 * ip + 1][1]); pw.w = cvt_pk_bf16(s[2 * ip + 1][2], s[2 * ip + 1][3]);
            const bf16x8 pb = __builtin_bit_cast(bf16x8, pw);
#pragma unroll
            for (int mt = 0; mt < 4; ++mt) { const LAS unsigned char* vp = lds + ATT_V_OFF + (16 * mt + r) * VLS + ((lo + 2 * ip) * 16 + 4 * qd) * 2;
                const u32x2 va = *(const LAS u32x2*)vp, vb = *(const LAS u32x2*)(vp + 32);
                u32x4 vw; vw.x = va.x; vw.y = va.y; vw.z = vb.x; vw.w = vb.y;
                o[mt] = __builtin_amdgcn_mfma_f32_16x16x32_bf16(__builtin_bit_cast(bf16x8, vw), pb, o[mt], 0, 0, 0); }
        }
        const unsigned oo = (unsigned)((t0 + qi) * D + head * HD + 16 * qd) * 2u;
        pg8::stgw(ay, oo, pg8::pack8(o[0] * inv, o[1] * inv)); pg8::stgw(ay, oo + 16u, pg8::pack8(o[2] * inv, o[3] * inv));
    }
    pg8::tile_signal((unsigned*)(a.ws + WS_CTL) + CW_T2, t0 >> 8);
    __syncthreads();
}

constexpr int CBS = 516;
__device__ __forceinline__ void conv_unit(const Args& a, int unit, LAS unsigned char* lds, int tid, int wave, int lane) {
    const bf16* ab = (const bf16*)(a.ws + WS_AB); bf16* ay = (bf16*)(a.ws + WS_AY);
    LAS float* cb = (LAS float*)lds;
    const int t0 = unit * 32, prow0 = t0 + AB_PAD * ((t0 >> 12) + 1);
    int cp = tid & 255; asm volatile("" : "+v"(cp));
    const int half = wave >> 2;
    const LAS float* wl = (const LAS float*)(lds + CONV_W_OFF) + 2 * cp;
    const f32x2 cbias = *(const f32x2*)(a.in[I_CONVB] + 2 * cp);
#pragma unroll 1
    for (int it = 0; it < 2; ++it) {
        const int tl0 = 16 * half + 8 * it;
        const unsigned o0 = (unsigned)((prow0 + tl0 - 30) * CCH + 2 * cp) * 2u;
        unsigned raw[38];
#pragma unroll
        for (int rr = 0; rr < 38; ++rr) raw[rr] = ldgo<unsigned>(ab, o0 + (unsigned)(rr * CCH * 2));
        __builtin_amdgcn_sched_barrier(0);
        asm volatile("" : "+v"(raw[0]), "+v"(raw[1]), "+v"(raw[2]), "+v"(raw[3]), "+v"(raw[4]), "+v"(raw[5]), "+v"(raw[6]), "+v"(raw[7]), "+v"(raw[8]), "+v"(raw[9]),
                          "+v"(raw[10]), "+v"(raw[11]), "+v"(raw[12]), "+v"(raw[13]), "+v"(raw[14]), "+v"(raw[15]), "+v"(raw[16]), "+v"(raw[17]), "+v"(raw[18]));
        asm volatile("" : "+v"(raw[19]), "+v"(raw[20]), "+v"(raw[21]), "+v"(raw[22]), "+v"(raw[23]), "+v"(raw[24]), "+v"(raw[25]), "+v"(raw[26]), "+v"(raw[27]), "+v"(raw[28]),
                          "+v"(raw[29]), "+v"(raw[30]), "+v"(raw[31]), "+v"(raw[32]), "+v"(raw[33]), "+v"(raw[34]), "+v"(raw[35]), "+v"(raw[36]), "+v"(raw[37]));
        float i0[38], i1[38];
#pragma unroll
        for (int rr = 0; rr < 38; ++rr) { i0[rr] = bflo(raw[rr]); i1[rr] = bfhi(raw[rr]); }
        float a0[8], a1[8];
#pragma unroll
        for (int o = 0; o < 8; ++o) { a0[o] = cbias.x; a1[o] = cbias.y; }
#pragma unroll
        for (int j = 0; j < CW; ++j) { const f32x2 wv = *(const LAS f32x2*)(wl + j * CCH);
#pragma unroll
            for (int o = 0; o < 8; ++o) { a0[o] = fmaf(i0[o + j], wv.x, a0[o]); a1[o] = fmaf(i1[o + j], wv.y, a1[o]); } }
#pragma unroll
        for (int o = 0; o < 8; ++o) *(LAS f32x2*)(cb + (tl0 + o) * CBS + 2 * cp) = (f32x2){a0[o], a1[o]};
    }
    __syncthreads();
    const f32x4 g0 = *(const f32x4*)(a.in[I_CLNG] + 8 * lane), g1 = *(const f32x4*)(a.in[I_CLNG] + 8 * lane + 4), b0 = *(const f32x4*)(a.in[I_CLNB] + 8 * lane), b1 = *(const f32x4*)(a.in[I_CLNB] + 8 * lane + 4);
#pragma unroll
    for (int tt = 0; tt < 4; ++tt) { const int tok = 4 * wave + tt;
        f32x4 v0 = *(const LAS f32x4*)(cb + tok * CBS + 8 * lane), v1 = *(const LAS f32x4*)(cb + tok * CBS + 8 * lane + 4);
        const float mean = wave_sum((v0[0] + v0[1]) + (v0[2] + v0[3]) + (v1[0] + v1[1]) + (v1[2] + v1[3])) * (1.0f / CCH);
        v0 = v0 - mean; v1 = v1 - mean;
        const float var = wave_sum((v0[0] * v0[0] + v0[1] * v0[1]) + (v0[2] * v0[2] + v0[3] * v0[3]) + (v1[0] * v1[0] + v1[1] * v1[1]) + (v1[2] * v1[2] + v1[3] * v1[3])) * (1.0f / CCH);
        const float rstd = 1.0f / sqrtf(var + LN_EPS);
        float y[8];
#pragma unroll
        for (int j = 0; j < 4; ++j) { const float y0 = v0[j] * rstd * g0[j] + b0[j], y1 = v1[j] * rstd * g1[j] + b1[j]; y[j] = y0 * sigmoidf_(y0); y[4 + j] = y1 * sigmoidf_(y1); }
        u32x4 wv; wv.x = cvt_pk_bf16(y[0], y[1]); wv.y = cvt_pk_bf16(y[2], y[3]); wv.z = cvt_pk_bf16(y[4], y[5]); wv.w = cvt_pk_bf16(y[6], y[7]);
        pg8::stgw(ay, (unsigned)((t0 + tok) * D + 512 + 8 * lane) * 2u, wv); }
    pg8::tile_signal((unsigned*)(a.ws + WS_CTL) + CW_T2, t0 >> 8);
    __syncthreads();
}

constexpr int HLB = 2064;
__device__ __forceinline__ void route_pair(const Args& a, int c0, int c1, LAS unsigned char* lds, int tid, int wave, int lane, const u32x4 (&whi)[8], const u32x4 (&wlo)[8], const f32x4 (&g)[4], const f32x4 (&bb)[4]) {
    const bf16* hf = (const bf16*)(a.ws + WS_HF); unsigned char* hb = a.ws + WS_HB;
    int* slot = (int*)(a.ws + WS_SLOT); float* gatev = (float*)(a.ws + WS_GATE); unsigned* cursor = (unsigned*)(a.ws + WS_CTL);
    LAS float* lg = (LAS float*)(lds + MISC_OFF + MO_LG); LAS int* sel_e = (LAS int*)(lds + MISC_OFF + MO_SELE); LAS float* sel_g = (LAS float*)(lds + MISC_OFF + MO_SELG);
    LAS int* lcnt = (LAS int*)(lds + MISC_OFF + MO_LCNT); LAS int* lbase = (LAS int*)(lds + MISC_OFF + MO_LBASE);
    const int nch = c1 >= 0 ? 2 : 1;
    u32x2 rw[2][4][4];
#pragma unroll
    for (int cc = 0; cc < 2; ++cc) { const int t0 = (cc == 0 ? c0 : (c1 >= 0 ? c1 : c0)) * 32;
#pragma unroll
      for (int tt = 0; tt < 4; ++tt)
#pragma unroll
        for (int j = 0; j < 4; ++j) rw[cc][tt][j] = *((const u32x2*)(hf + (size_t)(t0 + 4 * wave + tt) * D) + lane + 64 * j); }
    __builtin_amdgcn_sched_barrier(0);
#pragma unroll
    for (int cc = 0; cc < 2; ++cc) {
      asm volatile("" : "+v"(rw[cc][0][0]), "+v"(rw[cc][0][1]), "+v"(rw[cc][0][2]), "+v"(rw[cc][0][3]), "+v"(rw[cc][1][0]), "+v"(rw[cc][1][1]), "+v"(rw[cc][1][2]), "+v"(rw[cc][1][3]),
                        "+v"(rw[cc][2][0]), "+v"(rw[cc][2][1]), "+v"(rw[cc][2][2]), "+v"(rw[cc][2][3]), "+v"(rw[cc][3][0]), "+v"(rw[cc][3][1]), "+v"(rw[cc][3][2]), "+v"(rw[cc][3][3]));
      if (cc < nch) { const int t0 = (cc == 0 ? c0 : c1) * 32;
#pragma unroll
        for (int tt = 0; tt < 4; ++tt) { const int tl = 32 * cc + 4 * wave + tt; f32x4 v[4];
#pragma unroll
            for (int j = 0; j < 4; ++j) v[j] = (f32x4){bflo(rw[cc][tt][j].x), bfhi(rw[cc][tt][j].x), bflo(rw[cc][tt][j].y), bfhi(rw[cc][tt][j].y)};
            float sm = 0.f;
#pragma unroll
            for (int j = 0; j < 4; ++j) sm += (v[j][0] + v[j][1]) + (v[j][2] + v[j][3]);
            const float mean = wave_sum(sm) * (1.0f / D); float s2 = 0.f;
#pragma unroll
            for (int j = 0; j < 4; ++j) { v[j] = v[j] - mean; s2 += (v[j][0] * v[j][0] + v[j][1] * v[j][1]) + (v[j][2] * v[j][2] + v[j][3] * v[j][3]); }
            const float rstd = 1.0f / sqrtf(wave_sum(s2) * (1.0f / D) + LN_EPS);
            if (lane == 0) *(f32x2*)((float*)(a.ws + WS_LN1S) + 2 * (size_t)(t0 + 4 * wave + tt)) = (f32x2){mean, rstd};
#pragma unroll
            for (int j = 0; j < 4; ++j) { const f32x4 h = v[j] * rstd * g[j] + bb[j];
                unsigned wv = 0u; wv = __builtin_amdgcn_cvt_pk_fp8_f32(h[0] * 8.0f, h[1] * 8.0f, wv, false); wv = __builtin_amdgcn_cvt_pk_fp8_f32(h[2] * 8.0f, h[3] * 8.0f, wv, true);
                *((unsigned*)(hb + (size_t)(t0 + 4 * wave + tt) * D) + lane + 64 * j) = wv;
                *(LAS u32x2*)(lds + tl * HLB + (4 * lane + 256 * j) * 2) = (u32x2){cvt_pk_bf16(h[0], h[1]), cvt_pk_bf16(h[2], h[3])}; } } } }
    if (tid < 32) lcnt[tid] = 0;
    __syncthreads();
    f32x16 acc[2], acc1[2];
#pragma unroll
    for (int rb = 0; rb < 2; ++rb)
#pragma unroll
        for (int i = 0; i < 16; ++i) { acc[rb][i] = 0.f; acc1[rb][i] = 0.f; }
#pragma unroll
    for (int t = 0; t < 8; ++t)
#pragma unroll
        for (int rb = 0; rb < 2; ++rb) { const bf16x8 ah = *(const LAS bf16x8*)(lds + (32 * rb + (lane & 31)) * HLB + (128 * wave + 16 * t + 8 * (lane >> 5)) * 2);
            acc[rb] = __builtin_amdgcn_mfma_f32_32x32x16_bf16(ah, __builtin_bit_cast(bf16x8, whi[t]), acc[rb], 0, 0, 0);
            acc1[rb] = __builtin_amdgcn_mfma_f32_32x32x16_bf16(ah, __builtin_bit_cast(bf16x8, wlo[t]), acc1[rb], 0, 0, 0); }
    __syncthreads();
    { LAS float* part = (LAS float*)lds + wave * 2048;
#pragma unroll
      for (int rb = 0; rb < 2; ++rb)
#pragma unroll
        for (int i = 0; i < 16; ++i) { const int rowi = 32 * rb + (i & 3) + 8 * (i >> 2) + 4 * (lane >> 5); part[rowi * 32 + (lane & 31)] = acc[rb][i] + acc1[rb][i]; } }
    __syncthreads();
    for (int o = tid; o < 2048; o += 512) { float sm = a.in[I_BR][o & 31];
#pragma unroll
        for (int w = 0; w < 8; ++w) sm += ((const LAS float*)lds)[w * 2048 + o];
        lg[(o >> 5) * 33 + (o & 31)] = sm; }
    __syncthreads();
    if (tid < 32 * nch) { float v[NE];
#pragma unroll
        for (int e = 0; e < NE; ++e) v[e] = lg[tid * 33 + e];
        float tv[4]; int ti[4];
#pragma unroll
        for (int k = 0; k < 4; ++k) { float best = -3.0e38f; int bi = 0;
#pragma unroll
            for (int e = 0; e < NE; ++e) { const bool take = v[e] > best; best = take ? v[e] : best; bi = take ? e : bi; }
            tv[k] = best; ti[k] = bi;
#pragma unroll
            for (int e = 0; e < NE; ++e) v[e] = (e == bi) ? -3.0e38f : v[e]; }
        const float e1 = __expf(tv[1] - tv[0]), e2 = __expf(tv[2] - tv[0]), e3 = __expf(tv[3] - tv[0]); const float inv = 1.0f / (1.0f + e1 + e2 + e3);
        sel_e[4 * tid + 0] = ti[0]; sel_e[4 * tid + 1] = ti[1]; sel_e[4 * tid + 2] = ti[2]; sel_e[4 * tid + 3] = ti[3];
        sel_g[4 * tid + 0] = inv; sel_g[4 * tid + 1] = e1 * inv; sel_g[4 * tid + 2] = e2 * inv; sel_g[4 * tid + 3] = e3 * inv; }
    __syncthreads();
    int my_e = 0, my_rank = 0;
    if (tid < 128 * nch) { my_e = sel_e[tid]; my_rank = atomicAdd((int*)&lcnt[my_e], 1); }
    __syncthreads();
    if (tid < 32) { const int c = lcnt[tid]; lbase[tid] = c > 0 ? (int)atomicAdd(cursor + tid, (unsigned)c) : 0; }
    __syncthreads();
    if (tid < 128 * nch) { const int tokg = (tid < 128 ? c0 : c1) * 32 + ((tid >> 2) & 31); const int asg = tokg * 4 + (tid & 3); slot[my_e * SLOT_CAP + lbase[my_e] + my_rank] = asg; gatev[asg] = sel_g[tid]; }
    __syncthreads();
}

struct LnParams { f32x4 g1[4], b1[4], g2[4], b2[4]; };
__device__ __forceinline__ void combine_rows2(const Args& a, int mA, int mB, int lane, const LnParams& P) {
    const bf16* hf = (const bf16*)(a.ws + WS_HF); const unsigned char* ys = a.ws + WS_YS; const float* gatev = (const float*)(a.ws + WS_GATE);
    const int mr[2] = {mA, mB >= 0 ? mB : mA};
    f32x4 gt[2]; f32x2 st[2]; u32x2 pw[2][4]; unsigned y[2][4][4];
#pragma unroll
    for (int r = 0; r < 2; ++r) { gt[r] = *(const f32x4*)(gatev + 4 * (size_t)mr[r]); st[r] = *(const f32x2*)((const float*)(a.ws + WS_LN1S) + 2 * (size_t)mr[r]);
#pragma unroll
        for (int j = 0; j < 4; ++j) { pw[r][j] = *((const u32x2*)(hf + (size_t)mr[r] * D) + lane + 64 * j);
#pragma unroll
            for (int k = 0; k < 4; ++k) y[r][j][k] = *((const unsigned*)(ys + ((size_t)mr[r] * 4 + k) * D) + lane + 64 * j); } }
    __builtin_amdgcn_sched_barrier(0);
#pragma unroll
    for (int r = 0; r < 2; ++r) { if (r == 1 && mB < 0) break;
        const f32x4 gtr = gt[r] * (1.0f / 16.0f);
        f32x4 v[4]; float sm = 0.f;
#pragma unroll
        for (int j = 0; j < 4; ++j) { f32x4 p = (f32x4){bflo(pw[r][j].x), bfhi(pw[r][j].x), bflo(pw[r][j].y), bfhi(pw[r][j].y)}; p = p - st[r].x; const f32x4 h = p * st[r].y * P.g1[j] + P.b1[j];
            v[j] = h * DN_ALPHA;
#pragma unroll
            for (int k = 0; k < 4; ++k) { const unsigned yy = y[r][j][k]; const float gk = gtr[k];
                const f32x2 lo = __builtin_amdgcn_cvt_pk_f32_fp8(yy, false), hi = __builtin_amdgcn_cvt_pk_f32_fp8(yy, true);
                v[j][0] += gk * lo.x; v[j][1] += gk * lo.y; v[j][2] += gk * hi.x; v[j][3] += gk * hi.y; }
            sm += (v[j][0] + v[j][1]) + (v[j][2] + v[j][3]); }
        const float mean = wave_sum(sm) * (1.0f / D); float s2 = 0.f;
#pragma unroll
        for (int j = 0; j < 4; ++j) { v[j] = v[j] - mean; s2 += (v[j][0] * v[j][0] + v[j][1] * v[j][1]) + (v[j][2] * v[j][2] + v[j][3] * v[j][3]); }
        const float rstd = 1.0f / sqrtf(wave_sum(s2) * (1.0f / D) + LN_EPS);
#pragma unroll
        for (int j = 0; j < 4; ++j) *((f32x4*)(a.out + (size_t)mr[r] * D) + lane + 64 * j) = v[j] * rstd * P.g2[j] + P.b2[j]; }
}


__global__ void __launch_bounds__(512, 2) fwd_megakernel(Args args) {
    extern __shared__ __attribute__((aligned(16))) unsigned char lds_raw[];
    LAS unsigned char* lds = (LAS unsigned char*)lds_raw;
    const int tid = threadIdx.x, wave = __builtin_amdgcn_readfirstlane(tid >> 6);
#define FRESH_LANE int lane; { int t_ = tid; asm volatile("" : "+v"(t_)); lane = t_ & 63; }
    const int G = gridDim.x, bx = blockIdx.x;
    const int vcu = (G % 8 == 0) ? (bx % 8) * (G / 8) + bx / 8 : bx;
    const int gw = vcu * 8 + wave, NGW = G * 8;
    const int lo = args.ph_lo, hi = args.ph_hi;
    unsigned char* ws = args.ws;
    volatile LAS unsigned* bst = (volatile LAS unsigned*)(lds + MISC_OFF + MO_BAR);
    if (tid < 2) bst[tid] = 0u;
    __syncthreads();
    if (bx == 0 && wave == 7) {
        const int l7 = tid & 63;
#pragma unroll 8
        for (int k = 0; k < 64; ++k) { const int ch = k * 64 + l7; if (ch < 4095) pg8::stgw(ws + WS_CTL, (unsigned)ch * 16u, (u32x4){0u, 0u, 0u, 0u}); }
        asm volatile("s_waitcnt vmcnt(0)" ::: "memory");
        if (l7 == 0) __hip_atomic_store((unsigned*)(ws + WS_CTL) + CW_INIT, CTL_MAGIC, __ATOMIC_RELAXED, __HIP_MEMORY_SCOPE_AGENT);
    }
    XcdBarrier xbar = xcd_barrier_post((unsigned*)(ws + WS_CTL) + CW_BAR, bst);
    if (!(lo <= 0 && 0 < hi)) ctl_join(xbar, (unsigned*)(ws + WS_CTL) + CW_INIT);
#ifndef PMASK
#define PMASK 0x1ff
#endif
#define IN(k) (((PMASK >> (k)) & 1) && lo <= (k) && (k) < hi)
#define SEAM(k) do { if (lo <= (k) && (k) + 1 < hi) xcd_barrier(xbar, (k) != 0); } while (0)

    if (IN(0)) { FRESH_LANE; p0_prologue(args, lds, gw, NGW, lane, wave, xbar); }
    SEAM(0);
    if (IN(1)) {
        pg8::DenseOrder S; S.init(ws + WS_XB, ws + WS_WIN, T, INW, G, bx);
        pg8::EpiU E{(bf16*)(ws + WS_QB), (bf16*)(ws + WS_KB), (bf16*)(ws + WS_VT), (bf16*)(ws + WS_AB), (bf16*)(ws + WS_GATES), (const float*)(ws + WS_BPERM), (unsigned*)(ws + WS_CTL) + CW_T1};
        const int slot = vcu & 3;
        S.i0 = 0; S.i1 = slot;
        pg8::gemm_phase<pg8::EpiU, pg8::DenseOrder>(lds, S, E);
        { FRESH_LANE; side_convert_dma(args, bx, G, wave, lane, lds); }
        __syncthreads();
        S.i0 = slot; S.i1 = 1 << 20;
        pg8::gemm_phase<pg8::EpiU, pg8::DenseOrder>(lds, S, E);
    }
    if (IN(2)) {
        FRESH_LANE;
        __syncthreads();
        for (int i = tid; i < CW * CCH / 4; i += 512) ((LAS f32x4*)(lds + CONV_W_OFF))[i] = ((const f32x4*)args.in[I_CONVW])[i];
        __syncthreads();
        for (int u = vcu; u < 256 + 512; u += G) {
            if (lo <= 1) { const int tq = u < 256 ? (u >> 6) * SEQ + ((u >> 1) & 31) * 128 : (u - 256) * 32, back = u < 256 ? 128 : 30;
                if (tid == 0) { const int m1 = tq >> 8, tb = tq - back, m0 = (tb >> 12) == (tq >> 12) && tb >= 0 ? tb >> 8 : m1;
                    pg8::tile_wait((const unsigned*)(ws + WS_CTL) + CW_T1, m1, 120u, (unsigned*)(ws + WS_CTL) + 64);
                    if (m0 != m1) pg8::tile_wait((const unsigned*)(ws + WS_CTL) + CW_T1, m0, 120u, (unsigned*)(ws + WS_CTL) + 64); }
                __syncthreads(); }
            if (u < 256) attn_unit(args, u, lds, tid, wave, lane);
            else conv_unit(args, u - 256, lds, tid, wave, lane);
        }
    }
    if (IN(3)) {
        pg8::DenseOrder S; S.init(ws + WS_AY, ws + WS_WAB, T, D, G, bx);
        pg8::EpiMerged E{(const bf16*)(ws + WS_GATES), args.in[I_BCONV], (bf16*)(ws + WS_MERGED), (unsigned*)(ws + WS_CTL) + CW_T3};
        if (lo <= 2) { __syncthreads();
            if (tid == 0) { pg8::Unit u0; for (int i = 0; S.next(i, u0); ++i) pg8::tile_wait((const unsigned*)(ws + WS_CTL) + CW_T2, u0.pm, 96u, (unsigned*)(ws + WS_CTL) + 64); }
            __syncthreads(); }
        pg8::gemm_phase<pg8::EpiMerged, pg8::DenseOrder>(lds, S, E);
    }
    if (IN(4)) {
        pg8::DenseOrder S; S.init(ws + WS_MERGED, ws + WS_WO, T, D, G, bx);
        pg8::EpiPre1 E{(const bf16*)(ws + WS_XB), (bf16*)(ws + WS_HF), (unsigned*)(ws + WS_CTL) + CW_T4};
        if (lo <= 3) { __syncthreads();
            if (tid == 0) { pg8::Unit u0; for (int i = 0; S.next(i, u0); ++i) pg8::tile_wait((const unsigned*)(ws + WS_CTL) + CW_T3, u0.pm, 32u, (unsigned*)(ws + WS_CTL) + 64); }
            __syncthreads(); }
        pg8::gemm_phase<pg8::EpiPre1, pg8::DenseOrder>(lds, S, E);
    }
    if (IN(5)) {
        FRESH_LANE;
        __syncthreads();
        if (lo <= 4) { if (tid == 0) { for (int c = vcu; c < T / 32; c += G) pg8::tile_wait((const unsigned*)(ws + WS_CTL) + CW_T4, c >> 3, 32u, (unsigned*)(ws + WS_CTL) + 64); }
            __syncthreads(); }
        u32x4 whi[8], wlo[8]; f32x4 g1[4], b1[4];
#pragma unroll
        for (int t = 0; t < 8; ++t) { float wv[8];
#pragma unroll
            for (int j = 0; j < 8; ++j) wv[j] = args.in[I_WR][(size_t)(128 * wave + 16 * t + 8 * (lane >> 5) + j) * NE + (lane & 31)];
#pragma unroll
            for (int j = 0; j < 4; ++j) { const unsigned hw = cvt_pk_bf16(wv[2 * j], wv[2 * j + 1]); whi[t][j] = hw; wlo[t][j] = cvt_pk_bf16(wv[2 * j] - bflo(hw), wv[2 * j + 1] - bfhi(hw)); } }
#pragma unroll
        for (int j = 0; j < 4; ++j) { g1[j] = *((const f32x4*)args.in[I_LN1G] + lane + 64 * j); b1[j] = *((const f32x4*)args.in[I_LN1B] + lane + 64 * j); }
        for (int c = vcu; c < T / 32; c += 2 * G) route_pair(args, c, c + G < T / 32 ? c + G : -1, lds, tid, wave, lane, whi, wlo, g1, b1);
    }
    SEAM(5);
    if (IN(6) || IN(7)) {
        LAS int* tab = (LAS int*)(lds + MISC_OFF + MO_TAB);
        __syncthreads();
        if (tid < NE) { const unsigned* cursor = (const unsigned*)(ws + WS_CTL);
            const int c = (int)__hip_atomic_load(cursor + tid, __ATOMIC_RELAXED, __HIP_MEMORY_SCOPE_AGENT); tab[tid] = c; tab[32 + tid] = (c + 255) >> 8; }
        __syncthreads();
        if (tid == 0) { int acc = 0;
            for (int e = 0; e < NE; ++e) { tab[64 + e] = acc; acc += tab[32 + e]; }
            tab[64 + NE] = acc; }
        __syncthreads();
        const int total_mt = tab[64 + NE];
        if (IN(6)) {
            unsigned* ctl = (unsigned*)(ws + WS_CTL);
            pg8::MoeFusedOrder S{tab, G, vcu, total_mt * 8, total_mt * 4, (const char*)(ws + WS_HB), (const char*)(ws + WS_ACT), (const char*)(ws + WS_WUP), (const char*)(ws + WS_WDN), (const int*)(ws + WS_SLOT), ctl + 8192, ctl + 64};
            pg8::EpiMoe E{pg8::EpiUpX{args.in[I_BUP], ws + WS_ACT}, pg8::EpiDown{args.in[I_BDN], (const int*)(ws + WS_SLOT), ws + WS_YS}};
            pg8::gemm_phase<pg8::EpiMoe, pg8::MoeFusedOrder, true>(lds, S, E);
        }
    }
    SEAM(7);
    if (IN(8)) { FRESH_LANE; LnParams P;
#pragma unroll
        for (int j = 0; j < 4; ++j) { P.g1[j] = *((const f32x4*)args.in[I_LN1G] + lane + 64 * j); P.b1[j] = *((const f32x4*)args.in[I_LN1B] + lane + 64 * j); P.g2[j] = *((const f32x4*)args.in[I_LN2G] + lane + 64 * j); P.b2[j] = *((const f32x4*)args.in[I_LN2B] + lane + 64 * j); }
        for (int m = gw; m < T; m += 2 * NGW) combine_rows2(args, m, m + NGW < T ? m + NGW : -1, lane, P); }
    if (bx == 0 && tid == 0) __hip_atomic_store((unsigned*)(ws + WS_CTL) + CW_INIT, 0u, __ATOMIC_RELAXED, __HIP_MEMORY_SCOPE_AGENT);

#undef IN
#undef SEAM
#undef FRESH_LANE
}

extern "C" void kernel_launch(void* const* d_in, const int* in_sizes, int n_in, void* d_out, int out_size, void* d_ws, size_t ws_size, hipStream_t stream) {
    static int grid = 0;
    if (grid == 0) {
        if (n_in != 22 || out_size != T * D || ws_size < WS_END) { fprintf(stderr, "kernel_launch: unexpected problem (n_in %d, out %d, ws %zu)\n", n_in, out_size, ws_size); grid = -1; return; }
        int dev = 0, cus = 0, per_cu = 0;
        hipGetDevice(&dev); hipDeviceGetAttribute(&cus, hipDeviceAttributeMultiprocessorCount, dev);
        hipFuncSetAttribute((const void*)fwd_megakernel, hipFuncAttributeMaxDynamicSharedMemorySize, LDS_BYTES);
        hipOccupancyMaxActiveBlocksPerMultiprocessor(&per_cu, (const void*)fwd_megakernel, 512, LDS_BYTES);
        if (per_cu < 1) { fprintf(stderr, "kernel_launch: occupancy query says %d blocks per CU\n", per_cu); per_cu = 1; }
        (void)hipGetLastError();
        grid = cus * 1;
        fprintf(stderr, "kernel_launch: grid %d (cus %d, occupancy %d)\n", grid, cus, per_cu);
    }
    if (grid < 0) return;
    Args a{};
    for (int i = 0; i < 22; ++i) a.in[i] = (const float*)d_in[i];
    a.out = (float*)d_out; a.ws = (unsigned char*)d_ws; a.ph_lo = 0; a.ph_hi = 9;
    void* kargs[] = {&a};
    hipError_t e = hipLaunchCooperativeKernel((const void*)fwd_megakernel, dim3(grid), dim3(512), kargs, LDS_BYTES, stream);
    if (e != hipSuccess) fprintf(stderr, "cooperative launch failed: %s (grid %d)\n", hipGetErrorString(e), grid);
}
```
